# Optimizing an MI355X kernel written in HIP

```python
import jax
import jax.numpy as jnp
from jax import lax
import numpy as np

D_MODEL = 1024
BATCH = 8
SEQ = 4096
DEPTH = 4

CTX_LEN = 256
GRID_W = 64
EPS = 1e-6
ROPE_THETA = 10000.0

GLA_HEADS = 4
GLA_V = 3 * D_MODEL // 8
GLA_DV = GLA_V // GLA_HEADS
GLA_DK = GLA_DV // 2
GLA_QK = GLA_HEADS * GLA_DK
GLA_GATE_RANK = 16
GLA_GATE_TAU = 16.0
GLA_CHUNK = 16

NA_HEADS = 6
NA_W = 3 * D_MODEL // 8
NA_DH = NA_W // NA_HEADS
NA_KH_MAX = 8
NA_KW = 16

POOL_WINDOWS = (2, 4, 8, 16)
POOL_WIDTH = D_MODEL // 4
POOL_GROUP = POOL_WIDTH // len(POOL_WINDOWS)

MIX_WIDTH = GLA_V + NA_W + POOL_WIDTH
IN_SPLITS = (GLA_QK, GLA_QK, GLA_V, GLA_GATE_RANK, GLA_GATE_RANK, GLA_V, NA_W, NA_W, NA_W, POOL_WIDTH)
IN_WIDTH = sum(IN_SPLITS)

N_EXPERTS = 32
TOP_K = 4
D_FF = D_MODEL
SWIGLU_LIMIT = 7.0
SWIGLU_ALPHA = 1.702
MOE_BLOCK = 128

kernel_name = 'hybrid_gla_natten_pool_moe_diffusion_block'


def rmsnorm(x, g):
    xf = x.astype(jnp.float32)
    y = xf * lax.rsqrt(jnp.mean(xf * xf, axis=-1, keepdims=True) + EPS) * g.astype(jnp.float32)
    return y.astype(x.dtype)


def modulate(h, shift, scale):
    return h * (1 + scale) + shift


def split_in(p):
    return jnp.split(p, np.cumsum(IN_SPLITS)[:-1].tolist(), axis=-1)


def axial_rope(x, row, col):
    dt = x.dtype
    xf = x.astype(jnp.float32)
    half = x.shape[-1] // 2

    def rotate(xp, pos):
        d = xp.shape[-1]
        inv_freq = ROPE_THETA ** (-jnp.arange(0, d, 2, dtype=jnp.float32) / d)
        ang = pos.astype(jnp.float32)[:, None] * inv_freq[None]
        cos = jnp.cos(ang)[None, :, None]
        sin = jnp.sin(ang)[None, :, None]
        x1, x2 = jnp.split(xp, 2, axis=-1)
        return jnp.concatenate([x1 * cos - x2 * sin, x1 * sin + x2 * cos], axis=-1)

    return jnp.concatenate([rotate(xf[..., :half], row), rotate(xf[..., half:], col)], axis=-1).astype(dt)


def gla_chunked(q, k, v, log_a, s0, with_output=True):
    B, H, T, dk = q.shape
    dv = v.shape[-1]
    n = T // GLA_CHUNK
    f32 = jnp.float32
    qc = q.reshape(B, H, n, GLA_CHUNK, dk).astype(f32)
    kc = k.reshape(B, H, n, GLA_CHUNK, dk).astype(f32)
    vc = v.reshape(B, H, n, GLA_CHUNK, dv).astype(f32)
    b = jnp.cumsum(log_a.reshape(B, H, n, GLA_CHUNK, dk).astype(f32), axis=3)
    b_last = b[:, :, :, -1]
    k_to_end = kc * jnp.exp(b_last[:, :, :, None] - b)
    ds = jnp.einsum('bhncd,bhncv->bhndv', k_to_end, vc)

    def step(s, inp):
        ds_n, bl_n = inp
        return s * jnp.exp(bl_n)[..., None] + ds_n, s

    s_fin, s_start = lax.scan(step, s0, (jnp.moveaxis(ds, 2, 0), jnp.moveaxis(b_last, 2, 0)))
    if not with_output:
        return None, s_fin
    s_start = jnp.moveaxis(s_start, 0, 2)
    o_inter = jnp.einsum('bhncd,bhndv->bhncv', qc * jnp.exp(b), s_start)
    incl = jnp.tril(jnp.ones((GLA_CHUNK, GLA_CHUNK), bool))
    rel = b[:, :, :, :, None, :] - b[:, :, :, None, :, :]
    decay = jnp.where(incl[:, :, None], jnp.exp(jnp.minimum(rel, 0.0)), 0.0)
    scores = jnp.einsum('bhnid,bhnjd,bhnijd->bhnij', qc, kc, decay)
    o_intra = jnp.einsum('bhnij,bhnjv->bhniv', scores, vc)
    o = (o_intra + o_inter).reshape(B, H, T, dv)
    return o.astype(v.dtype), s_fin


def gla_output(o, g, norm_g):
    o = jnp.swapaxes(o, 1, 2)
    B, T = o.shape[0], o.shape[1]
    of = o.astype(jnp.float32)
    of = of * lax.rsqrt(jnp.mean(of * of, axis=-1, keepdims=True) + EPS)
    of = of.reshape(B, T, GLA_V) * norm_g.astype(jnp.float32)
    return (of * jax.nn.silu(g.astype(jnp.float32))).astype(g.dtype)


def gla_group(pieces_x, pieces_c, row, col, wa2, ba, norm_g, need_ctx):
    def prep(pieces, rotate):
        q, k, v, a_f, a_b, g = pieces
        B, T, _ = q.shape
        q = q.reshape(B, T, GLA_HEADS, GLA_DK)
        k = k.reshape(B, T, GLA_HEADS, GLA_DK)
        if rotate:
            q = axial_rope(q, row, col)
            k = axial_rope(k, row, col)
        q = q * GLA_DK ** -0.5
        v = v.reshape(B, T, GLA_HEADS, GLA_DV)

        def log_decay(a, d):
            z = (a @ wa2[d] + ba[d]).astype(jnp.float32)
            return (jax.nn.log_sigmoid(z) / GLA_GATE_TAU).reshape(B, T, GLA_HEADS, GLA_DK)

        tr = lambda t: jnp.swapaxes(t, 1, 2)
        return tr(q), tr(k), tr(v), tr(log_decay(a_f, 0)), tr(log_decay(a_b, 1)), g

    qx, kx, vx, lfx, lbx, gx = prep(pieces_x, True)
    qc, kc, vc, lfc, lbc, gc = prep(pieces_c, False)
    B = qx.shape[0]
    s0 = jnp.zeros((B, GLA_HEADS, GLA_DK, GLA_DV), jnp.float32)
    flip = lambda t: jnp.flip(t, axis=2)
    oc_f, sc_f = gla_chunked(qc, kc, vc, lfc, s0, need_ctx)
    oc_b, sc_b = gla_chunked(flip(qc), flip(kc), flip(vc), flip(lbc), s0, need_ctx)
    ox_f, _ = gla_chunked(qx, kx, vx, lfx, sc_f)
    ox_b, _ = gla_chunked(flip(qx), flip(kx), flip(vx), flip(lbx), sc_b)
    out_x = gla_output(ox_f + flip(ox_b), gx, norm_g)
    out_c = gla_output(oc_f + flip(oc_b), gc, norm_g) if need_ctx else None
    return out_x, out_c


def neighbourhood_attention(q, k, v, kc, vc, rpb):
    B, S, H, dh = q.shape
    R = S // GRID_W
    kh = min(NA_KH_MAX, R)
    kg = k.reshape(B, R, GRID_W, H, dh)
    vg = v.reshape(B, R, GRID_W, H, dh)
    qg = q.reshape(B, R, GRID_W, H, dh)
    cols = jnp.arange(GRID_W)
    col_idx = jnp.clip(cols - NA_KW // 2, 0, GRID_W - NA_KW)[:, None] + jnp.arange(NA_KW)[None]
    col_bias_idx = col_idx - cols[:, None] + NA_KW - 1
    rows = jnp.arange(R)
    row_start = jnp.clip(rows - kh // 2, 0, R - kh)
    n_nb = kh * NA_KW

    def one_row(args):
        r, rs, q_r = args
        k_blk = lax.dynamic_slice_in_dim(kg, rs, kh, axis=1)
        v_blk = lax.dynamic_slice_in_dim(vg, rs, kh, axis=1)
        k_nb = k_blk[:, :, col_idx]
        v_nb = v_blk[:, :, col_idx]
        row_bias_idx = rs + jnp.arange(kh) - r + NA_KH_MAX - 1
        bias = rpb[:, row_bias_idx[None, :, None], col_bias_idx[:, None, :]]
        s_nb = jnp.einsum('bqhd,biqjhd->bhqij', q_r, k_nb) + bias
        s_ctx = jnp.einsum('bqhd,blhd->bhql', q_r, kc)
        logits = jnp.concatenate([s_nb.reshape(B, H, GRID_W, n_nb), s_ctx], axis=-1).astype(jnp.float32)
        p = jax.nn.softmax(logits, axis=-1).astype(q_r.dtype)
        p_nb = p[..., :n_nb].reshape(B, H, GRID_W, kh, NA_KW)
        p_ctx = p[..., n_nb:]
        return (jnp.einsum('bhqij,biqjhd->bqhd', p_nb, v_nb)
                + jnp.einsum('bhql,blhd->bqhd', p_ctx, vc))

    out = lax.map(one_row, (rows, row_start, jnp.moveaxis(qg, 1, 0)))
    return jnp.moveaxis(out, 0, 1).reshape(B, S, H * dh)


def context_attention(q, k, v):
    B, L, H, dh = q.shape
    s = jnp.einsum('bqhd,bkhd->bhqk', q, k).astype(jnp.float32)
    p = jax.nn.softmax(s, axis=-1).astype(q.dtype)
    return jnp.einsum('bhqk,bkhd->bqhd', p, v).reshape(B, L, H * dh)


def na_group(pieces_x, pieces_c, rpb, need_ctx):
    qx, kx, vx = pieces_x
    qc, kc, vc = pieces_c
    B, S, _ = qx.shape
    L = kc.shape[1]
    hx = lambda t: t.reshape(B, S, NA_HEADS, NA_DH)
    hc = lambda t: t.reshape(B, L, NA_HEADS, NA_DH)
    kch, vch = hc(kc), hc(vc)
    out_x = neighbourhood_attention(hx(qx) * NA_DH ** -0.5, hx(kx), hx(vx), kch, vch, rpb)
    out_c = context_attention(hc(qc) * NA_DH ** -0.5, kch, vch) if need_ctx else None
    return out_x, out_c


def pool_mix(u, pool_w, pool_scale):
    B, T, _ = u.shape
    uf = u.astype(jnp.float32)
    cs = jnp.concatenate([jnp.zeros((B, 1, POOL_WIDTH), jnp.float32), jnp.cumsum(uf, axis=1)], axis=1)
    t = jnp.arange(T)
    groups = []
    for g, w in enumerate(POOL_WINDOWS):
        lo = jnp.clip(t - w // 2, 0, T)
        hi = jnp.clip(t + w - w // 2, 0, T)
        sl = slice(g * POOL_GROUP, (g + 1) * POOL_GROUP)
        cnt = (hi - lo).astype(jnp.float32)[None, :, None]
        groups.append((cs[:, hi, sl] - cs[:, lo, sl]) / cnt - uf[:, :, sl])
    y = jnp.stack(groups, axis=2).astype(u.dtype)
    y = jnp.einsum('btgi,gio->btgo', y, pool_w).reshape(B, T, POOL_WIDTH)
    return y * pool_scale


def token_mixer(hx, hc, row, col, w_in, gla_wa2, gla_ba, gla_norm_g, na_rpb, pool_w, pool_scale, w_out, need_ctx):
    px = split_in(hx @ w_in)
    pc = split_in(hc @ w_in)
    gla_x, gla_c = gla_group(px[0:6], pc[0:6], row, col, gla_wa2, gla_ba, gla_norm_g, need_ctx)
    na_x, na_c = na_group(px[6:9], pc[6:9], na_rpb, need_ctx)
    out_x = jnp.concatenate([gla_x, na_x, pool_mix(px[9], pool_w, pool_scale)], axis=-1) @ w_out
    if not need_ctx:
        return out_x, None
    out_c = jnp.concatenate([gla_c, na_c, pool_mix(pc[9], pool_w, pool_scale)], axis=-1) @ w_out
    return out_x, out_c


def moe_ffn(h, router_w, router_b, w_gu, b_gu, w_down, b_down):
    T, D = h.shape
    logits = (h @ router_w + router_b).astype(jnp.float32)
    top_logit, top_e = lax.top_k(logits, TOP_K)
    gate = jax.nn.softmax(top_logit, axis=-1).astype(h.dtype)
    A = T * TOP_K
    flat_e = top_e.reshape(A)
    flat_tok = jnp.repeat(jnp.arange(T, dtype=jnp.int32), TOP_K)
    flat_gate = gate.reshape(A)
    order = jnp.argsort(flat_e)
    e_sorted = flat_e[order]
    counts = jnp.bincount(flat_e, length=N_EXPERTS)
    padded = (counts + MOE_BLOCK - 1) // MOE_BLOCK * MOE_BLOCK
    start = jnp.cumsum(counts) - counts
    pend = jnp.cumsum(padded)
    pstart = pend - padded
    dest = pstart[e_sorted] + jnp.arange(A) - start[e_sorted]
    n_blocks = (A + MOE_BLOCK - 1) // MOE_BLOCK + N_EXPERTS
    P = n_blocks * MOE_BLOCK
    slot_tok = jnp.full((P,), T, jnp.int32).at[dest].set(flat_tok[order])
    slot_gate = jnp.zeros((P,), h.dtype).at[dest].set(flat_gate[order])
    block_e = jnp.minimum(jnp.searchsorted(pend, jnp.arange(n_blocks) * MOE_BLOCK, side='right'), N_EXPERTS - 1)
    h_pad = jnp.concatenate([h, jnp.zeros((1, D), h.dtype)], axis=0)

    def expert_block(args):
        tok_b, e = args
        xb = h_pad[tok_b]
        gu = xb @ w_gu[e] + b_gu[e]
        g, u = jnp.split(gu, 2, axis=-1)
        g = jnp.minimum(g, SWIGLU_LIMIT)
        u = jnp.clip(u, -SWIGLU_LIMIT, SWIGLU_LIMIT)
        act = g * jax.nn.sigmoid(SWIGLU_ALPHA * g) * (u + 1)
        return act @ w_down[e] + b_down[e]

    yb = lax.map(expert_block, (slot_tok.reshape(n_blocks, MOE_BLOCK), block_e)).reshape(P, D)
    y = jnp.zeros((T + 1, D), h.dtype).at[slot_tok].add(yb * slot_gate[:, None])
    return y[:T]


def setup_inputs(seed: int = 0) -> dict:
    key = jax.random.key(seed)
    ks = jax.random.split(key, 24)
    f32 = jnp.float32
    D = D_MODEL
    nrm = lambda k, shape, s: jax.random.normal(k, shape, f32) * s
    return {
        'x': nrm(ks[0], (BATCH, SEQ, D), 1.0),
        'c': nrm(ks[1], (BATCH, D), 1.0),
        'ctx': nrm(ks[2], (BATCH, CTX_LEN, D), 1.0),
        'c_ctx': nrm(ks[3], (D,), 1.0),
        'norm1_g': 1.0 + nrm(ks[4], (DEPTH, D), 0.05),
        'norm2_g': 1.0 + nrm(ks[5], (DEPTH, D), 0.05),
        'w_ada': nrm(ks[6], (DEPTH, D, 6 * D), 0.5 * D ** -0.5),
        'b_ada': nrm(ks[7], (DEPTH, 6 * D), 0.02),
        'w_in': nrm(ks[8], (DEPTH, D, IN_WIDTH), D ** -0.5),
        'gla_wa2': nrm(ks[9], (DEPTH, 2, GLA_GATE_RANK, GLA_QK), GLA_GATE_RANK ** -0.5),
        'gla_ba': nrm(ks[10], (DEPTH, 2, GLA_QK), 0.1),
        'gla_norm_g': 1.0 + nrm(ks[11], (DEPTH, GLA_V), 0.05),
        'na_rpb': nrm(ks[12], (DEPTH, NA_HEADS, 2 * NA_KH_MAX - 1, 2 * NA_KW - 1), 0.05),
        'pool_w': nrm(ks[13], (DEPTH, len(POOL_WINDOWS), POOL_GROUP, POOL_GROUP), POOL_GROUP ** -0.5),
        'pool_scale': 1.0 + nrm(ks[14], (DEPTH, POOL_WIDTH), 0.1),
        'w_out': nrm(ks[15], (DEPTH, MIX_WIDTH, D), MIX_WIDTH ** -0.5),
        'router_w': nrm(ks[16], (DEPTH, D, N_EXPERTS), D ** -0.5),
        'router_b': nrm(ks[17], (DEPTH, N_EXPERTS), 0.01),
        'w_gu': nrm(ks[18], (DEPTH, N_EXPERTS, D, 2 * D_FF), D ** -0.5),
        'b_gu': nrm(ks[19], (DEPTH, N_EXPERTS, 2 * D_FF), 0.01),
        'w_down': nrm(ks[20], (DEPTH, N_EXPERTS, D_FF, D), D_FF ** -0.5),
        'b_down': nrm(ks[21], (DEPTH, N_EXPERTS, D), 0.01),
        'final_g': 1.0 + nrm(ks[22], (D,), 0.05),
    }


def reference(x, c, ctx, c_ctx, norm1_g, norm2_g, w_ada, b_ada, w_in, gla_wa2, gla_ba, gla_norm_g,
              na_rpb, pool_w, pool_scale, w_out, router_w, router_b, w_gu, b_gu, w_down, b_down, final_g):
    B, S, D = x.shape
    L = ctx.shape[1]
    t = jnp.arange(S)
    row = t // GRID_W
    col = t % GRID_W
    cond_x = jax.nn.silu(c)
    cond_c = jax.nn.silu(c_ctx)[None]
    xc = ctx
    for l in range(DEPTH):
        need_ctx = l < DEPTH - 1
        mod_x = (cond_x @ w_ada[l] + b_ada[l])[:, None]
        mod_c = (cond_c @ w_ada[l] + b_ada[l])[:, None]
        sh1x, sc1x, g1x, sh2x, sc2x, g2x = jnp.split(mod_x, 6, axis=-1)
        sh1c, sc1c, g1c, sh2c, sc2c, g2c = jnp.split(mod_c, 6, axis=-1)
        hx = modulate(rmsnorm(x, norm1_g[l]), sh1x, sc1x)
        hc = modulate(rmsnorm(xc, norm1_g[l]), sh1c, sc1c)
        mx, mc = token_mixer(hx, hc, row, col, w_in[l], gla_wa2[l], gla_ba[l], gla_norm_g[l], na_rpb[l],
                             pool_w[l], pool_scale[l], w_out[l], need_ctx)
        x = x + g1x * mx
        hx2 = modulate(rmsnorm(x, norm2_g[l]), sh2x, sc2x)
        moe_args = (router_w[l], router_b[l], w_gu[l], b_gu[l], w_down[l], b_down[l])
        if need_ctx:
            xc = xc + g1c * mc
            hc2 = modulate(rmsnorm(xc, norm2_g[l]), sh2c, sc2c)
            tokens = jnp.concatenate([hx2.reshape(B * S, D), hc2.reshape(B * L, D)], axis=0)
            y = moe_ffn(tokens, *moe_args)
            yx = y[:B * S].reshape(B, S, D)
            xc = xc + g2c * y[B * S:].reshape(B, L, D)
        else:
            yx = moe_ffn(hx2.reshape(B * S, D), *moe_args).reshape(B, S, D)
        x = x + g2x * yx
    return rmsnorm(x, final_g)
```

```cpp
#include <hip/hip_runtime.h>
#include <cstdio>
#include <cstdint>
#include <cstddef>

#ifndef MK_N_LAUNCHES
#define MK_N_LAUNCHES 1
#endif

#define GAS __attribute__((address_space(1)))
#define LAS __attribute__((address_space(3)))
typedef unsigned short bf16;
typedef short bf16x8 __attribute__((ext_vector_type(8)));
typedef short bf16x4 __attribute__((ext_vector_type(4)));
typedef float f32x4 __attribute__((ext_vector_type(4)));
typedef float f32x2 __attribute__((ext_vector_type(2)));
typedef unsigned u32x4 __attribute__((ext_vector_type(4)));
typedef unsigned u32x2 __attribute__((ext_vector_type(2)));

constexpr int NB = 8, SEQ = 4096, DM = 1024, CTXL = 256, DEPTH = 4, GRIDW = 64;
constexpr int TX = NB * SEQ, TC = NB * CTXL, TT = TX + TC;
constexpr int NP = 2816;
constexpr int C_NAQ = 0, C_NAK = 384, C_NAV = 768, C_GV = 1152, C_GQ = 1536, C_GK = 1728, C_GG = 1920, C_POOL = 2304, C_AF = 2560, C_AB = 2576;
constexpr int VT_C0 = 768, VT_NC = 768, VTS = TT + 128;
constexpr int NE = 32, TOPK = 4, NASG = TT * TOPK;
constexpr int SLOT_DUMMY = NASG + 256;
constexpr int GH = 4, GDK = 48, GDV = 96, NH = 6, NDH = 64;
constexpr float EPS = 1e-6f;
constexpr int NWAVES = 8, NTHREADS = 512;
constexpr int PPL = 9;
constexpr int NPHASES = 2 + PPL * DEPTH;
#ifndef MOE_FP8
#define MOE_FP8 0
#endif
#ifndef REPMASK
#define REPMASK 0
#endif
#define REPS(b) (1 + ((REPMASK >> (b)) & 1))
#ifndef GLA_CHECK
#define GLA_CHECK 0
#endif

constexpr size_t MiB = 1u << 20;
constexpr size_t WS_CTL = 0, CTL_ZERO_BYTES = 128 * 1024;
constexpr size_t WS_MOD = 2 * MiB;
constexpr size_t WS_BIN = 4 * MiB;
constexpr size_t WS_BOUT = 26 * MiB;
constexpr size_t WS_BGU = 34 * MiB;
constexpr size_t WS_BDN = 546 * MiB;
constexpr size_t WS_X = 802 * MiB;
constexpr size_t WS_H = 938 * MiB;
constexpr size_t WS_P = 1008 * MiB;
constexpr size_t WS_VTX = 1196 * MiB;
constexpr size_t WS_VTC = 1220 * MiB;
constexpr size_t WS_MIX = 1222 * MiB;
constexpr size_t WS_OF = 1290 * MiB;
constexpr size_t WS_OB = 1341 * MiB;
constexpr size_t WS_ACT = 1392 * MiB;
constexpr size_t WS_YB = 1665 * MiB;
constexpr size_t WS_LIST = 1938 * MiB;
constexpr size_t WS_GATE = 1943 * MiB;
constexpr size_t WS_DS = 1944 * MiB;
constexpr size_t WS_GD = 2025 * MiB;
constexpr size_t WS_ROPE = 2026 * MiB;
constexpr size_t WS_VTA = 2027 * MiB;
constexpr size_t WS_OPS = 2080 * MiB;
constexpr size_t WS_STB = 2132 * MiB;
constexpr size_t WS_H8 = 2172 * MiB;
constexpr size_t WS_INV = 2208 * MiB;
constexpr size_t WS_END = 2209 * MiB;
constexpr int CW_BAR = 4096;
constexpr int CW_CNT = 16384;

constexpr int STAGE_BYTES = 132096;
constexpr int MISC_OFF = STAGE_BYTES;
constexpr int TAB_OFF = MISC_OFF + 1024;
constexpr int MAXU = 28;
constexpr int LDS_BYTES = TAB_OFF + MAXU * 1024;
static_assert(LDS_BYTES <= 163840, "LDS");

#define LDS_WAIT() asm volatile("s_waitcnt lgkmcnt(0)" ::: "memory")
#define VM_WAIT() asm volatile("s_waitcnt vmcnt(0)" ::: "memory")
__device__ __forceinline__ unsigned f2bf(float f) { unsigned u = __builtin_bit_cast(unsigned, f); return (u + 0x7fffu + ((u >> 16) & 1u)) >> 16; }
__device__ __forceinline__ unsigned pk2(float lo, float hi) { return f2bf(lo) | (f2bf(hi) << 16); }
__device__ __forceinline__ float bf2f(unsigned b) { return __builtin_bit_cast(float, (b & 0xffffu) << 16); }
__device__ __forceinline__ float bflo(unsigned w) { return __builtin_bit_cast(float, w << 16); }
__device__ __forceinline__ float bfhi(unsigned w) { return __builtin_bit_cast(float, w & 0xffff0000u); }
__device__ __forceinline__ unsigned cvt_pk_bf16(float lo, float hi) { unsigned r; asm volatile("v_cvt_pk_bf16_f32 %0, %1, %2" : "=v"(r) : "v"(lo), "v"(hi)); return r; }
__device__ __forceinline__ unsigned pk4_fp8(float a, float b, float c, float d) { int p = __builtin_amdgcn_cvt_pk_fp8_f32(a, b, 0, false); p = __builtin_amdgcn_cvt_pk_fp8_f32(c, d, p, true); return (unsigned)p; }
constexpr float W8_SCALE = 64.f, W8_INV = 1.f / 64.f;
__device__ __forceinline__ float wave_sum(float v) {
#pragma unroll
    for (int o = 1; o < 64; o <<= 1) v += __shfl_xor(v, o);
    return v;
}
__device__ __forceinline__ float silu_f(float x) { return x / (1.f + __expf(-x)); }

#define XB_TMO      128
#define XB_XCNT(j)  (256  + 64 * (j))
#define XB_XSUB(j)  (1280 + 64 * (j))
#define XB_XGEN(j)  (2304 + 64 * (j))
#define XB_TOP      3328
#define XB_TOPGEN   3392
#define XCD_BAR_WORDS 3456
#define XB_SPIN_CAP (1u << 18)
__device__ __forceinline__ unsigned xb_ld(unsigned* p)              { return __hip_atomic_load(p, __ATOMIC_RELAXED, __HIP_MEMORY_SCOPE_AGENT); }
__device__ __forceinline__ unsigned xb_add(unsigned* p, unsigned v) { return __hip_atomic_fetch_add(p, v, __ATOMIC_RELAXED, __HIP_MEMORY_SCOPE_AGENT); }
__device__ __forceinline__ unsigned xb_xcc_id() { return (unsigned)__builtin_amdgcn_s_getreg((3 << 11) | 20) & 0xFu; }
#define XB_SPIN(cond, bar) do { unsigned _sp = 0; while (cond) { __builtin_amdgcn_s_sleep(1); \
    if ((++_sp & 255u) == 0u) { if (xb_ld(&(bar)[XB_TMO])) break; if (_sp > XB_SPIN_CAP) { atomicAdd(&(bar)[XB_TMO], 1u); break; } } } } while (0)
struct XcdBarrier { unsigned* bar; unsigned x; volatile LAS unsigned* st; };
__device__ __forceinline__ XcdBarrier xcd_barrier_post(unsigned* bar, volatile LAS unsigned* st) {
    XcdBarrier b; b.bar = bar; b.x = xb_xcc_id(); b.st = st;
    if (threadIdx.x == 0) (void)xb_add(&bar[XB_XCNT(b.x)], 1u);
    return b;
}
__device__ __forceinline__ void xcd_barrier_complete(unsigned* bar, unsigned x, unsigned& nloc, unsigned& nx) {
    const unsigned G = gridDim.x * gridDim.y * gridDim.z;
    unsigned sum, cnt, mine, sp = 0u;
    for (;;) {
        sum = 0u; cnt = 0u; mine = 0u;
#pragma unroll
        for (unsigned j = 0; j < 16; ++j) { const unsigned c = xb_ld(&bar[XB_XCNT(j)]); sum += c; cnt += (c > 0u) ? 1u : 0u; mine = (j == x) ? c : mine; }
        if (sum == G) break;
        __builtin_amdgcn_s_sleep(1);
        if ((++sp & 255u) == 0u) { if (xb_ld(&bar[XB_TMO])) break; if (sp > XB_SPIN_CAP) { atomicAdd(&bar[XB_TMO], 1u); break; } }
    }
    nloc = mine > 0u ? mine : 1u; nx = cnt > 0u ? cnt : 1u;
}
__device__ __forceinline__ void xcd_barrier(const XcdBarrier& b) {
    asm volatile("s_waitcnt vmcnt(0)" ::: "memory");
    __syncthreads();
    if (threadIdx.x == 0) {
        unsigned* bar = b.bar;
        __builtin_amdgcn_s_waitcnt(0);
        unsigned nloc = b.st[0], nx = b.st[1];
        if (nloc == 0u) { xcd_barrier_complete(bar, b.x, nloc, nx); b.st[0] = nloc; b.st[1] = nx; }
        const unsigned old = xb_add(&bar[XB_XSUB(b.x)], 1u);
        const unsigned gen = old / nloc;
        if (old + 1u == (gen + 1u) * nloc) {
            __builtin_amdgcn_fence(__ATOMIC_RELEASE, "agent");
            asm volatile("s_waitcnt vmcnt(0)" ::: "memory");
            const unsigned og = xb_add(&bar[XB_TOP], 1u);
            const unsigned tg = og / nx;
            if (og + 1u == (tg + 1u) * nx) xb_add(&bar[XB_TOPGEN], 1u);
            else XB_SPIN(xb_ld(&bar[XB_TOPGEN]) == tg, bar);
            __builtin_amdgcn_fence(__ATOMIC_ACQUIRE, "agent");
            xb_add(&bar[XB_XGEN(b.x)], 1u);
            asm volatile("s_waitcnt vmcnt(0)" ::: "memory");
        } else {
            XB_SPIN(xb_ld(&bar[XB_XGEN(b.x)]) == gen, bar);
            __builtin_amdgcn_fence(__ATOMIC_ACQUIRE, "agent");
            asm volatile("s_waitcnt vmcnt(0)" ::: "memory");
        }
    }
    __syncthreads();
}

namespace g8 {
constexpr int BM = 256, BK = 64, HALF = 128, HTB = HALF * BK * 2, NXCD = 8, WGM = 8, KD = 1024;
__device__ __forceinline__ int lds_byte(int r, int c) { const int st = (r >> 4) * 2 + (c >> 5), rr = r & 15, cc = c & 31, ob = rr * 64 + cc * 2; return st * 1024 + (ob ^ (((ob >> 9) & 1) << 5)); }
__device__ __forceinline__ void stage_rc(int b, int& R, int& C) { const int st = b / 1024, sb = b % 1024, swz = sb ^ (((sb >> 9) & 1) << 5); R = (st >> 1) * 16 + swz / 64; C = (st & 1) * 32 + (swz % 64) / 2; }
__device__ __forceinline__ int perm32(int rho) { const int n = rho >> 4, i = rho & 15; return 8 * (i >> 2) + 4 * n + (i & 3); }
struct Unit { int pm, pn, e; };
typedef int i32x8 __attribute__((ext_vector_type(8)));
typedef int i32x4 __attribute__((ext_vector_type(4)));
__device__ __forceinline__ i32x8 cat8(bf16x8 a, bf16x8 b) { const i32x4 x = __builtin_bit_cast(i32x4, a), y = __builtin_bit_cast(i32x4, b); return (i32x8){x.x, x.y, x.z, x.w, y.x, y.y, y.z, y.w}; }
__device__ __forceinline__ bool static_unit(long L, int nM, int nN, Unit& u) {
    const int nwg = nM * nN; if (L >= nwg) return false;
    int wgid = (int)L; { const int q = nwg / NXCD, r = nwg % NXCD, xcd = wgid % NXCD, off = wgid / NXCD; wgid = (xcd < r ? xcd * (q + 1) : r * (q + 1) + (xcd - r) * q) + off; }
    const int nig = WGM * nN, gid = wgid / nig, fm = gid * WGM, gsz = (nM - fm) < WGM ? (nM - fm) : WGM;
    u.pm = fm + ((wgid % nig) % gsz); u.pn = (wgid % nig) / gsz; u.e = 0; return true;
}

#ifndef PROBE_DRY
#define PROBE_DRY 0
#endif
#ifndef STAG_TICKS
#define STAG_TICKS 0
#endif
template <class Prob>
__device__ __forceinline__ void gemm_phase(LAS unsigned char* lds, const Prob& P) {

    int tid_ = threadIdx.x; asm volatile("" : "+v"(tid_));
    const int tid = tid_, wid = __builtin_amdgcn_readfirstlane(tid >> 6), lane = tid & 63, wr = wid >> 2, wc = wid & 3, fr = lane & 15, fq = lane >> 4;
    constexpr int RPB = Prob::FP8 ? KD : KD * 2, nt = RPB / (BK * 2);
    unsigned voffB[2];
    { int R0, C0, R1, C1; stage_rc(tid * 16, R0, C0); stage_rc(tid * 16 + 8192, R1, C1); const int Rb0 = Prob::PERM ? ((R0 & ~31) + perm32(R0 & 31)) : R0, Rb1 = Prob::PERM ? ((R1 & ~31) + perm32(R1 & 31)) : R1;
      voffB[0] = (unsigned)(Rb0 * RPB + C0 * 2); voffB[1] = (unsigned)(Rb1 * RPB + C1 * 2); }
    const size_t kstep = (size_t)(BK * 2), hstepB = (size_t)HALF * RPB;
    const unsigned ldsw = (unsigned)wid * 1024u;
    const int aoff = lds_byte(wr * 64 + fr, fq * 8), boff = lds_byte(wc * 32 + fr, fq * 8);
#define G8_SA(b, h) (((b) * 2 + (h)) * HTB)
#define G8_SB(b, h) ((4 + (b) * 2 + (h)) * HTB)
#define G8_STAGE(bufoff, gbase, voff) do { _Pragma("unroll") for (int _i = 0; _i < 2; ++_i) \
        __builtin_amdgcn_global_load_lds((const unsigned*)((const char*)(gbase) + (voff)[_i]), (LAS unsigned*)(lds + (bufoff) + ldsw + _i * 8192), 16, 0, 0); } while (0)
#define G8_LDA(dst, b, h) do { _Pragma("unroll") for (int m = 0; m < 4; ++m) _Pragma("unroll") for (int k = 0; k < 2; ++k) dst[m][k] = *(const LAS bf16x8*)(lds + G8_SA(b, h) + aoff + m * 2048 + k * 1024); } while (0)
#define G8_LDB(dst, b, h) do { _Pragma("unroll") for (int n = 0; n < 2; ++n) _Pragma("unroll") for (int k = 0; k < 2; ++k) dst[n][k] = *(const LAS bf16x8*)(lds + G8_SB(b, h) + boff + n * 2048 + k * 1024); } while (0)
#define G8_MMA(ai, bj, At, Bt) do { __builtin_amdgcn_s_setprio(1); if constexpr (Prob::FP8) { \
        _Pragma("unroll") for (int m = 0; m < 4; ++m) _Pragma("unroll") for (int n = 0; n < 2; ++n) \
        acc[ai][bj][m][n] = __builtin_amdgcn_mfma_scale_f32_16x16x128_f8f6f4(cat8(Bt[n][0], Bt[n][1]), cat8(At[m][0], At[m][1]), acc[ai][bj][m][n], 0, 0, 0, 0x7f7f7f7f, 0, 0x7f7f7f7f); } else { \
        _Pragma("unroll") for (int m = 0; m < 4; ++m) _Pragma("unroll") for (int n = 0; n < 2; ++n) _Pragma("unroll") for (int k = 0; k < 2; ++k) \
        acc[ai][bj][m][n] = __builtin_amdgcn_mfma_f32_16x16x32_bf16(Bt[n][k], At[m][k], acc[ai][bj][m][n], 0, 0, 0); } __builtin_amdgcn_s_setprio(0); } while (0)
#define G8_WAIT_V(n) asm volatile("s_waitcnt vmcnt(" #n ")" ::: "memory")
#define G8_WAIT_L(n) asm volatile("s_waitcnt lgkmcnt(" #n ")" ::: "memory")
#define G8_BAR __builtin_amdgcn_s_barrier()
#define G8_SCHED __builtin_amdgcn_sched_barrier(0)
    Unit cur, nxt; int ui = 0;
    if (!P.next(0, cur)) return;
    f32x4 acc[2][2][4][2];
#pragma unroll
    for (int a = 0; a < 2; ++a)
#pragma unroll
        for (int b = 0; b < 2; ++b)
#pragma unroll
            for (int m = 0; m < 4; ++m)
#pragma unroll
                for (int n = 0; n < 2; ++n) acc[a][b][m][n] = (f32x4){0.f, 0.f, 0.f, 0.f};
    bf16x8 At[4][2], B0[2][2], B1[2][2];
    unsigned cvA[2][2];
    P.a_off(cur, 0, tid, cvA);
    const char* cA = P.a_base(cur);
    const char* cB = P.b_ptr(cur);
    G8_STAGE(G8_SB(0, 0), cB, voffB); G8_STAGE(G8_SB(0, 1), cB + hstepB, voffB); G8_STAGE(G8_SA(0, 0), cA, cvA[0]); G8_STAGE(G8_SA(0, 1), cA, cvA[1]);
    if (wr == 1) G8_BAR;
    G8_WAIT_V(2); G8_BAR;
    G8_STAGE(G8_SB(1, 0), cB + kstep, voffB); G8_STAGE(G8_SA(1, 0), cA + kstep, cvA[0]); G8_STAGE(G8_SB(1, 1), cB + hstepB + kstep, voffB);
    G8_WAIT_V(6); G8_BAR;
    for (;;) {
        const bool has_next = P.next(ui + 1, nxt);
        const char* nB = has_next ? P.b_ptr(nxt) : cB;
        const char* nA = has_next ? P.a_base(nxt) : cA;
        for (int t = 0; t < nt; t += 2) {
            const bool last = (t == nt - 2);
            const char* a1 = cA + (size_t)(t + 1) * kstep;
            const char* a2 = last ? nA : cA + (size_t)(t + 2) * kstep; const char* b2 = last ? nB : cB + (size_t)(t + 2) * kstep;
            const char* a3 = a2 + kstep; const char* b3 = b2 + kstep;
            G8_LDB(B0, 0, 0); G8_LDB(B1, 0, 1); G8_SCHED; G8_LDA(At, 0, 0); G8_STAGE(G8_SA(1, 1), a1, cvA[1]);
            G8_WAIT_V(8); G8_WAIT_L(0); G8_BAR; G8_MMA(0, 0, At, B0); G8_MMA(0, 1, At, B1); G8_BAR; G8_SCHED;
            if (last && has_next) { int tz = threadIdx.x; asm volatile("" : "+v"(tz)); P.a_off(nxt, ui + 1, tz, cvA); }
            G8_LDA(At, 0, 1); G8_STAGE(G8_SB(0, 0), b2, voffB); G8_STAGE(G8_SB(0, 1), b2 + hstepB, voffB); G8_STAGE(G8_SA(0, 0), a2, cvA[0]);
            G8_WAIT_V(8); G8_WAIT_L(0); G8_BAR; G8_MMA(1, 0, At, B0); G8_MMA(1, 1, At, B1); G8_BAR; G8_SCHED;
            G8_LDB(B0, 1, 0); G8_LDB(B1, 1, 1); G8_SCHED; G8_LDA(At, 1, 0); G8_STAGE(G8_SA(0, 1), a2, cvA[1]);
            G8_WAIT_V(8); G8_WAIT_L(0); G8_BAR; G8_MMA(0, 0, At, B0); G8_MMA(0, 1, At, B1); G8_BAR; G8_SCHED;
            G8_LDA(At, 1, 1); G8_STAGE(G8_SB(1, 0), b3, voffB); G8_STAGE(G8_SB(1, 1), b3 + hstepB, voffB); G8_STAGE(G8_SA(1, 0), a3, cvA[0]);
            G8_WAIT_V(8); G8_WAIT_L(0); G8_BAR; G8_MMA(1, 0, At, B0); G8_MMA(1, 1, At, B1); G8_BAR; G8_SCHED;
        }
        if (wr == 0) G8_BAR;
        P.epi(acc, cur, ui, wr, wc, fr, fq);
        if (!has_next) break;
#pragma unroll
        for (int a = 0; a < 2; ++a)
#pragma unroll
            for (int b = 0; b < 2; ++b)
#pragma unroll
                for (int m = 0; m < 4; ++m)
#pragma unroll
                    for (int n = 0; n < 2; ++n) acc[a][b][m][n] = (f32x4){0.f, 0.f, 0.f, 0.f};
        cur = nxt; cB = nB; cA = nA; ++ui;
        if (wr == 1) G8_BAR;
    }
    G8_WAIT_V(0);
    G8_BAR;
#undef G8_SA
#undef G8_SB
#undef G8_STAGE
#undef G8_LDA
#undef G8_LDB
#undef G8_MMA
#undef G8_WAIT_V
#undef G8_WAIT_L
#undef G8_BAR
#undef G8_SCHED
}


struct ProbIn {
    static constexpr bool PERM = true, FP8 = false;
    const char* A; const char* Bt; bf16* O; bf16* VT; int G, c; int dry;
    __device__ __forceinline__ static bool swapped(const Unit& u) { return u.pn >= 3 && u.pn <= 5; }
    __device__ __forceinline__ bool next(int i, Unit& u) const { return static_unit((long)i * G + c, TT / 256, NP / 256, u); }
    __device__ __forceinline__ void a_off(const Unit& u, int, int tid, unsigned (&v)[2][2]) const {
        int R0, C0, R1, C1; stage_rc(tid * 16, R0, C0); stage_rc(tid * 16 + 8192, R1, C1);
        const int rt = swapped(u) ? u.pn : u.pm;
#pragma unroll
        for (int h = 0; h < 2; ++h) { v[h][0] = (unsigned)((rt * 256 + h * 128 + R0) * KD + C0) * 2u; v[h][1] = (unsigned)((rt * 256 + h * 128 + R1) * KD + C1) * 2u; }
    }
    __device__ __forceinline__ const char* a_base(const Unit& u) const { return swapped(u) ? Bt : A; }
    __device__ __forceinline__ const char* b_ptr(const Unit& u) const { return swapped(u) ? A + (size_t)u.pm * 256 * KD * 2 : Bt + (size_t)u.pn * 256 * KD * 2; }
    __device__ __forceinline__ void epi(const f32x4 (&acc)[2][2][4][2], const Unit& u, int, int wr, int wc, int fr, int fq) const {
        if (PROBE_DRY && dry) { asm volatile("" :: "v"(acc[0][0][0][0][0]), "v"(acc[1][1][3][1][3]), "v"(acc[0][1][2][0][1]), "v"(acc[1][0][1][1][2])); return; }
        const bool sw = swapped(u);
        bf16* base = sw ? VT + (size_t)(u.pn * 256 - VT_C0 + wr * 64 + fr) * VTS + u.pm * 256 + wc * 32 + 8 * fq
                        : O + (size_t)(u.pm * 256 + wr * 64 + fr) * NP + u.pn * 256 + wc * 32 + 8 * fq;
        const size_t ld = sw ? (size_t)VTS : (size_t)NP;
#pragma unroll
        for (int ai = 0; ai < 2; ++ai)
#pragma unroll
            for (int m = 0; m < 4; ++m) { bf16* rowp = base + (size_t)(ai * 128 + m * 16) * ld;
#pragma unroll
                for (int bj = 0; bj < 2; ++bj) { const f32x4 v0 = acc[ai][bj][m][0], v1 = acc[ai][bj][m][1];
                    u32x4 w; w.x = cvt_pk_bf16(v0[0], v0[1]); w.y = cvt_pk_bf16(v0[2], v0[3]); w.z = cvt_pk_bf16(v1[0], v1[1]); w.w = cvt_pk_bf16(v1[2], v1[3]);
                    *(u32x4*)(rowp + bj * 128) = w; } }
    }
};
struct ProbOut {
    static constexpr bool PERM = false, FP8 = false;
    const char* A; const char* Bt; float* X; const float* modl  ; int G, c, nM;
    __device__ __forceinline__ bool next(int i, Unit& u) const { return static_unit((long)i * G + c, nM, DM / 256, u); }
    __device__ __forceinline__ void a_off(const Unit& u, int, int tid, unsigned (&v)[2][2]) const {
        int R0, C0, R1, C1; stage_rc(tid * 16, R0, C0); stage_rc(tid * 16 + 8192, R1, C1);
#pragma unroll
        for (int h = 0; h < 2; ++h) { v[h][0] = (unsigned)((u.pm * 256 + h * 128 + R0) * KD + C0) * 2u; v[h][1] = (unsigned)((u.pm * 256 + h * 128 + R1) * KD + C1) * 2u; }
    }
    __device__ __forceinline__ const char* a_base(const Unit&) const { return A; }
    __device__ __forceinline__ const char* b_ptr(const Unit& u) const { return Bt + (size_t)u.pn * 256 * KD * 2; }
    __device__ __forceinline__ void epi(const f32x4 (&acc)[2][2][4][2], const Unit& u, int, int wr, int wc, int fr, int fq) const {
        const int r0 = u.pm * 256, br = r0 < TX ? (r0 / SEQ) : NB;
        const float* g1 = modl + (size_t)br * 6 * DM + 2 * DM;
        const int row0 = r0 + wr * 64 + fr, col0 = u.pn * 256 + wc * 32 + 4 * fq;
        f32x4 gv[2][2];
#pragma unroll
        for (int bj = 0; bj < 2; ++bj)
#pragma unroll
            for (int n = 0; n < 2; ++n) gv[bj][n] = *(const f32x4*)(g1 + col0 + bj * 128 + n * 16);
#pragma unroll
        for (int ai = 0; ai < 2; ++ai) {
            f32x4 xv[4][2][2];
#pragma unroll
            for (int m = 0; m < 4; ++m)
#pragma unroll
                for (int bj = 0; bj < 2; ++bj)
#pragma unroll
                    for (int n = 0; n < 2; ++n) xv[m][bj][n] = *(const f32x4*)(X + (size_t)(row0 + ai * 128 + m * 16) * DM + col0 + bj * 128 + n * 16);
#pragma unroll
            for (int m = 0; m < 4; ++m)
#pragma unroll
                for (int bj = 0; bj < 2; ++bj)
#pragma unroll
                    for (int n = 0; n < 2; ++n) *(f32x4*)(X + (size_t)(row0 + ai * 128 + m * 16) * DM + col0 + bj * 128 + n * 16) = xv[m][bj][n] + gv[bj][n] * acc[ai][bj][m][n];
        }
    }
};
__device__ __forceinline__ bool moe_unit(long L, int npn, const volatile LAS int* tp, Unit& u) {
    const int q = (int)(L / npn); if (q >= tp[NE]) return false;
    int e = 0;
#pragma unroll 1
    while (tp[e + 1] <= q) ++e;
    u.e = e; u.pm = q - tp[e]; u.pn = (int)(L % npn); return true;
}
struct ProbGU {
    static constexpr bool PERM = true, FP8 = (MOE_FP8 != 0); static constexpr unsigned EB = FP8 ? 1u : 2u;
    const char* A; const char* Bt  ; unsigned char* ACT; const float* bgu  ; const volatile LAS int* tp; const LAS int* tab; int G, c; int dry; const volatile LAS int* eb;
    __device__ __forceinline__ bool next(int i, Unit& u) const { return i < MAXU && moe_unit((long)i * G + c, 8, tp, u); }
    __device__ __forceinline__ void a_off(const Unit&, int ui, int tid, unsigned (&v)[2][2]) const {
        int R0, C0, R1, C1; stage_rc(tid * 16, R0, C0); stage_rc(tid * 16 + 8192, R1, C1);
#pragma unroll
        for (int h = 0; h < 2; ++h) { const int a0 = tab[ui * 256 + h * 128 + R0], a1 = tab[ui * 256 + h * 128 + R1];
            v[h][0] = (unsigned)(a0 < 0 ? TT : (a0 >> 2)) * (unsigned)KD * EB + (unsigned)C0 * 2u; v[h][1] = (unsigned)(a1 < 0 ? TT : (a1 >> 2)) * (unsigned)KD * EB + (unsigned)C1 * 2u; }
    }
    __device__ __forceinline__ const char* a_base(const Unit&) const { return A; }
    __device__ __forceinline__ const char* b_ptr(const Unit& u) const { return Bt + ((size_t)u.e * 2 * DM + (size_t)u.pn * 256) * KD * EB; }
    __device__ __forceinline__ void epi(const f32x4 (&acc)[2][2][4][2], const Unit& u, int ui, int wr, int wc, int fr, int fq) const {
        if (PROBE_DRY && dry) { asm volatile("" :: "v"(acc[0][0][0][0][0]), "v"(acc[1][1][3][1][3]), "v"(acc[0][1][2][0][1]), "v"(acc[1][0][1][1][2])); return; }
        const int cb = u.pn * 128 + wc * 32 + 8 * fq;
        const float* bg = bgu + (size_t)u.e * 2 * DM + cb; const float* bu = bg + DM;
        const f32x4 bg0 = *(const f32x4*)bg, bg1 = *(const f32x4*)(bg + 4), bu0 = *(const f32x4*)bu, bu1 = *(const f32x4*)(bu + 4);
        const int ebu = eb[u.e] + u.pm * 256;
#pragma unroll
        for (int ai = 0; ai < 2; ++ai)
#pragma unroll
            for (int m = 0; m < 4; ++m) {
                const int a = tab[ui * 256 + ai * 128 + wr * 64 + m * 16 + fr];
                unsigned char* rowp = ACT + ((size_t)(a < 0 ? SLOT_DUMMY : ebu + ai * 128 + wr * 64 + m * 16 + fr) * DM + cb) * EB;
                float o[8];
#pragma unroll
                for (int n = 0; n < 2; ++n) { const f32x4 gb = n ? bg1 : bg0, ub = n ? bu1 : bu0;
#pragma unroll
                    for (int j = 0; j < 4; ++j) { float g = acc[ai][0][m][n][j] * (FP8 ? W8_INV : 1.f) + gb[j], uu = acc[ai][1][m][n][j] * (FP8 ? W8_INV : 1.f) + ub[j];
                        g = fminf(g, 7.f); uu = fminf(fmaxf(uu, -7.f), 7.f);
                        o[n * 4 + j] = g * __builtin_amdgcn_rcpf(1.f + __expf(-1.702f * g)) * (uu + 1.f); } }
                if constexpr (FP8) { u32x2 w; w.x = pk4_fp8(o[0], o[1], o[2], o[3]); w.y = pk4_fp8(o[4], o[5], o[6], o[7]); *(u32x2*)rowp = w; }
                else { u32x4 w; w.x = cvt_pk_bf16(o[0], o[1]); w.y = cvt_pk_bf16(o[2], o[3]); w.z = cvt_pk_bf16(o[4], o[5]); w.w = cvt_pk_bf16(o[6], o[7]); *(u32x4*)rowp = w; } }
    }
};
struct ProbDN {
    static constexpr bool PERM = true, FP8 = (MOE_FP8 != 0); static constexpr unsigned EB = FP8 ? 1u : 2u;
    const char* A; const char* Bt  ; bf16* YB; const float* bdn  ; const float* gate; const volatile LAS int* tp; const LAS int* tab; int G, c; int dry; const volatile LAS int* eb;
    __device__ __forceinline__ bool next(int i, Unit& u) const { return i < MAXU && moe_unit((long)i * G + c, 4, tp, u); }
    __device__ __forceinline__ void a_off(const Unit& u, int, int tid, unsigned (&v)[2][2]) const {
        int R0, C0, R1, C1; stage_rc(tid * 16, R0, C0); stage_rc(tid * 16 + 8192, R1, C1);
        const int r0 = eb[u.e] + u.pm * 256;
#pragma unroll
        for (int h = 0; h < 2; ++h) { v[h][0] = (unsigned)(r0 + h * 128 + R0) * (unsigned)KD * EB + (unsigned)C0 * 2u; v[h][1] = (unsigned)(r0 + h * 128 + R1) * (unsigned)KD * EB + (unsigned)C1 * 2u; }
    }
    __device__ __forceinline__ const char* a_base(const Unit&) const { return A; }
    __device__ __forceinline__ const char* b_ptr(const Unit& u) const { return Bt + ((size_t)u.e * DM + (size_t)u.pn * 256) * KD * EB; }
    __device__ __forceinline__ void epi(const f32x4 (&acc)[2][2][4][2], const Unit& u, int ui, int wr, int wc, int fr, int fq) const {
        if (PROBE_DRY && dry) { asm volatile("" :: "v"(acc[0][0][0][0][0]), "v"(acc[1][1][3][1][3]), "v"(acc[0][1][2][0][1]), "v"(acc[1][0][1][1][2])); return; }
        const int col0 = u.pn * 256 + wc * 32 + 8 * fq;
        const float* bd = bdn + (size_t)u.e * DM + col0;
        f32x4 bv[2][2];
#pragma unroll
        for (int bj = 0; bj < 2; ++bj)
#pragma unroll
            for (int n = 0; n < 2; ++n) bv[bj][n] = *(const f32x4*)(bd + bj * 128 + 4 * n);
        int ar[2][4], sl[2][4]; float gt[2][4]; const int ebu = eb[u.e] + u.pm * 256;
#pragma unroll
        for (int ai = 0; ai < 2; ++ai)
#pragma unroll
            for (int m = 0; m < 4; ++m) { const int a = tab[ui * 256 + ai * 128 + wr * 64 + m * 16 + fr]; ar[ai][m] = a < 0 ? NASG : a; sl[ai][m] = a < 0 ? SLOT_DUMMY : ebu + ai * 128 + wr * 64 + m * 16 + fr; }
#pragma unroll
        for (int ai = 0; ai < 2; ++ai)
#pragma unroll
            for (int m = 0; m < 4; ++m) gt[ai][m] = gate[ar[ai][m]];
#pragma unroll
        for (int ai = 0; ai < 2; ++ai)
#pragma unroll
            for (int m = 0; m < 4; ++m) {
                bf16* rowp = YB + (size_t)sl[ai][m] * DM + col0;
#pragma unroll
                for (int bj = 0; bj < 2; ++bj) { const f32x4 v0 = (acc[ai][bj][m][0] * (FP8 ? W8_INV : 1.f) + bv[bj][0]) * gt[ai][m], v1 = (acc[ai][bj][m][1] * (FP8 ? W8_INV : 1.f) + bv[bj][1]) * gt[ai][m];
                    u32x4 w; w.x = cvt_pk_bf16(v0[0], v0[1]); w.y = cvt_pk_bf16(v0[2], v0[3]); w.z = cvt_pk_bf16(v1[0], v1[1]); w.w = cvt_pk_bf16(v1[2], v1[3]);
                    *(u32x4*)(rowp + bj * 128) = w; } }
    }
};
}

struct Args { const float* in[23]; float* out; unsigned char* ws; int ph_lo, ph_hi; };
struct Frame {
    LAS unsigned char* lds; volatile LAS unsigned* MISC;
    int tid, lane, wave, G, vcu;
    const float *x, *c, *ctx, *c_ctx, *norm1_g, *norm2_g, *w_ada, *b_ada, *w_in, *gla_wa2, *gla_ba, *gla_norm_g, *na_rpb, *pool_w, *pool_scale, *w_out, *router_w, *router_b, *w_gu, *b_gu, *w_down, *b_down, *final_g;
    float* out; unsigned char* ws; unsigned* ctl;
    float* mod; bf16 *Bin, *Bout, *Bgu, *Bdn; float* X; bf16 *H, *P, *VTX, *VTC, *MIX; float *OF, *OB; bf16 *ACT, *YB; int* LIST; float* GATE; float *DS, *GD, *ROPE; bf16 *VTA, *OPS, *STB; unsigned char* H8; int* INV;
};


#define CAS __attribute__((address_space(4)))
__device__ __forceinline__ void frame_ptrs(Frame& F) {
    const CAS unsigned char* ka = (const CAS unsigned char*)__builtin_amdgcn_kernarg_segment_ptr();
    asm volatile("" : "+s"(ka));
    typedef const GAS float* gfp;
    const CAS gfp* in = (const CAS gfp*)ka;
    F.x = (const float*)in[0]; F.c = (const float*)in[1]; F.ctx = (const float*)in[2]; F.c_ctx = (const float*)in[3]; F.norm1_g = (const float*)in[4]; F.norm2_g = (const float*)in[5];
    F.w_ada = (const float*)in[6]; F.b_ada = (const float*)in[7]; F.w_in = (const float*)in[8]; F.gla_wa2 = (const float*)in[9]; F.gla_ba = (const float*)in[10]; F.gla_norm_g = (const float*)in[11];
    F.na_rpb = (const float*)in[12]; F.pool_w = (const float*)in[13]; F.pool_scale = (const float*)in[14]; F.w_out = (const float*)in[15]; F.router_w = (const float*)in[16]; F.router_b = (const float*)in[17];
    F.w_gu = (const float*)in[18]; F.b_gu = (const float*)in[19]; F.w_down = (const float*)in[20]; F.b_down = (const float*)in[21]; F.final_g = (const float*)in[22];
    F.out = (float*)*(GAS float* const CAS*)(ka + 184);
    GAS unsigned char* ws = *(GAS unsigned char* const CAS*)(ka + 192);
    F.ws = (unsigned char*)ws; F.ctl = (unsigned*)(ws + WS_CTL);
    F.mod = (float*)(ws + WS_MOD); F.Bin = (bf16*)(ws + WS_BIN); F.Bout = (bf16*)(ws + WS_BOUT); F.Bgu = (bf16*)(ws + WS_BGU); F.Bdn = (bf16*)(ws + WS_BDN);
    F.X = (float*)(ws + WS_X); F.H = (bf16*)(ws + WS_H); F.P = (bf16*)(ws + WS_P); F.VTX = (bf16*)(ws + WS_VTX); F.VTC = (bf16*)(ws + WS_VTC); F.MIX = (bf16*)(ws + WS_MIX);
    F.OF = (float*)(ws + WS_OF); F.OB = (float*)(ws + WS_OB); F.ACT = (bf16*)(ws + WS_ACT); F.YB = (bf16*)(ws + WS_YB); F.LIST = (int*)(ws + WS_LIST); F.GATE = (float*)(ws + WS_GATE);
    F.DS = (float*)(ws + WS_DS); F.GD = (float*)(ws + WS_GD); F.ROPE = (float*)(ws + WS_ROPE); F.VTA = (bf16*)(ws + WS_VTA); F.OPS = (bf16*)(ws + WS_OPS); F.STB = (bf16*)(ws + WS_STB); F.H8 = (unsigned char*)(ws + WS_H8); F.INV = (int*)(ws + WS_INV);
}
static_assert(offsetof(Args, out) == 184 && offsetof(Args, ws) == 192, "Args layout");

__device__ __forceinline__ void transpose_item(const float* W, int N, bf16* WT, int n0, int dst_row0, int k0, float scale, LAS float* scr, int lane) {
#pragma unroll 8
    for (int i = 0; i < 32; ++i) { const int kk = 2 * i + (lane >> 5); scr[kk * 33 + (lane & 31)] = W[(size_t)(k0 + kk) * N + n0 + (lane & 31)]; }
    LDS_WAIT(); asm volatile("" ::: "memory");
    const int c = lane & 7;
#pragma unroll
    for (int j = 0; j < 4; ++j) { const int n = (lane >> 3) + 8 * j; const LAS float* s = scr + (8 * c) * 33 + n;
        u32x4 o; o.x = pk2(s[0 * 33] * scale, s[1 * 33] * scale); o.y = pk2(s[2 * 33] * scale, s[3 * 33] * scale); o.z = pk2(s[4 * 33] * scale, s[5 * 33] * scale); o.w = pk2(s[6 * 33] * scale, s[7 * 33] * scale);
        *(u32x4*)(WT + (size_t)(dst_row0 + n) * DM + k0 + 8 * c) = o; }
    LDS_WAIT(); asm volatile("" ::: "memory");
}
__device__ __forceinline__ void transpose_item_fp8(const float* W, int N, unsigned char* WT, int n0, int dst_row0, int k0, LAS float* scr, int lane) {
#pragma unroll 8
    for (int i = 0; i < 32; ++i) { const int kk = 2 * i + (lane >> 5); scr[kk * 33 + (lane & 31)] = W[(size_t)(k0 + kk) * N + n0 + (lane & 31)]; }
    LDS_WAIT(); asm volatile("" ::: "memory");
    const int c = lane & 3;
#pragma unroll
    for (int j = 0; j < 2; ++j) { const int n = (lane >> 2) + 16 * j; const LAS float* s = scr + (16 * c) * 33 + n;
        u32x4 o;
        o.x = pk4_fp8(s[0 * 33] * W8_SCALE, s[1 * 33] * W8_SCALE, s[2 * 33] * W8_SCALE, s[3 * 33] * W8_SCALE); o.y = pk4_fp8(s[4 * 33] * W8_SCALE, s[5 * 33] * W8_SCALE, s[6 * 33] * W8_SCALE, s[7 * 33] * W8_SCALE);
        o.z = pk4_fp8(s[8 * 33] * W8_SCALE, s[9 * 33] * W8_SCALE, s[10 * 33] * W8_SCALE, s[11 * 33] * W8_SCALE); o.w = pk4_fp8(s[12 * 33] * W8_SCALE, s[13 * 33] * W8_SCALE, s[14 * 33] * W8_SCALE, s[15 * 33] * W8_SCALE);
        *(u32x4*)(WT + (size_t)(dst_row0 + n) * DM + k0 + 16 * c) = o; }
    LDS_WAIT(); asm volatile("" ::: "memory");
}
__device__ __forceinline__ void in_col_map(int n0, int& dst, float& scale) {
    scale = 1.f;
    if (n0 < 192) { dst = C_GQ + n0; scale = 0.14433756729740643f; }
    else if (n0 < 384) dst = C_GK + (n0 - 192);
    else if (n0 < 768) dst = C_GV + (n0 - 384);
    else if (n0 < 800) dst = C_AF + (n0 - 768);
    else if (n0 < 1184) dst = C_GG + (n0 - 800);
    else if (n0 < 1568) { dst = C_NAQ + (n0 - 1184); scale = 0.125f; }
    else if (n0 < 1952) dst = C_NAK + (n0 - 1568);
    else if (n0 < 2336) dst = C_NAV + (n0 - 1952);
    else dst = C_POOL + (n0 - 2336);
}
struct TItem { const float* src; int N; unsigned char* dst; int fp8; float scale; };
__device__ __forceinline__ TItem titem_decode(const Frame& F, int r) {
    constexpr int I_IN = DEPTH * 16 * 81, I_OUT = DEPTH * 16 * 32, I_GU = DEPTH * NE * 16 * 64;
    TItem t; t.fp8 = 0; t.scale = 1.f;
    if (r < I_IN) { const int l = r / (16 * 81), rr = r % (16 * 81), kb = rr / 81, nb = rr % 81; int dst; in_col_map(nb * 32, dst, t.scale);
        t.N = 2592; t.src = F.w_in + (size_t)l * DM * 2592 + (size_t)(kb * 64) * 2592 + nb * 32; t.dst = (unsigned char*)(F.Bin + ((size_t)l * NP + dst) * DM + kb * 64); return t; }
    r -= I_IN;
    if (r < I_OUT) { const int l = r / (16 * 32), rr = r % (16 * 32), kb = rr / 32, nb = rr % 32;
        t.N = DM; t.src = F.w_out + (size_t)l * DM * DM + (size_t)(kb * 64) * DM + nb * 32; t.dst = (unsigned char*)(F.Bout + ((size_t)l * DM + nb * 32) * DM + kb * 64); return t; }
    r -= I_OUT; t.fp8 = MOE_FP8; constexpr size_t EB = MOE_FP8 ? 1 : 2;
    if (r < I_GU) { const int le = r / (16 * 64), rr = r % (16 * 64), kb = rr / 64, nb = rr % 64; const int j0 = nb * 32;
        const int dst = j0 < DM ? (j0 / 128) * 256 + (j0 % 128) : ((j0 - DM) / 128) * 256 + 128 + ((j0 - DM) % 128);
        t.N = 2 * DM; t.src = F.w_gu + (size_t)le * DM * 2 * DM + (size_t)(kb * 64) * 2 * DM + j0; t.dst = (unsigned char*)F.Bgu + (((size_t)le * 2 * DM + dst) * DM + kb * 64) * EB; return t; }
    r -= I_GU;
    { const int le = r / (16 * 32), rr = r % (16 * 32), kb = rr / 32, nb = rr % 32;
        t.N = DM; t.src = F.w_down + (size_t)le * DM * DM + (size_t)(kb * 64) * DM + nb * 32; t.dst = (unsigned char*)F.Bdn + (((size_t)le * DM + nb * 32) * DM + kb * 64) * EB; return t; }
}
__device__ __forceinline__ void titem_load(const TItem& t, int lane, f32x4 (&r)[8]) {
#pragma unroll
    for (int i = 0; i < 8; ++i) r[i] = *(const f32x4*)(t.src + (size_t)((lane >> 3) + 8 * i) * t.N + 4 * (lane & 7));
}
__device__ __forceinline__ void titem_store(const TItem& t, const f32x4 (&r)[8], LAS float* scr, int lane) {
#pragma unroll
    for (int i = 0; i < 8; ++i) { LAS float* p = scr + ((lane >> 3) + 8 * i) * 33 + 4 * (lane & 7); p[0] = r[i].x; p[1] = r[i].y; p[2] = r[i].z; p[3] = r[i].w; }
    LDS_WAIT(); asm volatile("" ::: "memory");
    if (t.fp8) { const int c = lane & 3; const float sc = W8_SCALE;
#pragma unroll
        for (int j = 0; j < 2; ++j) { const int n = (lane >> 2) + 16 * j; const LAS float* s = scr + (16 * c) * 33 + n;
            u32x4 o;
            o.x = pk4_fp8(s[0 * 33] * sc, s[1 * 33] * sc, s[2 * 33] * sc, s[3 * 33] * sc); o.y = pk4_fp8(s[4 * 33] * sc, s[5 * 33] * sc, s[6 * 33] * sc, s[7 * 33] * sc);
            o.z = pk4_fp8(s[8 * 33] * sc, s[9 * 33] * sc, s[10 * 33] * sc, s[11 * 33] * sc); o.w = pk4_fp8(s[12 * 33] * sc, s[13 * 33] * sc, s[14 * 33] * sc, s[15 * 33] * sc);
            *(u32x4*)(t.dst + (size_t)n * DM + 16 * c) = o; }
    } else { const int c = lane & 7; const float sc = t.scale;
#pragma unroll
        for (int j = 0; j < 4; ++j) { const int n = (lane >> 3) + 8 * j; const LAS float* s = scr + (8 * c) * 33 + n;
            u32x4 o; o.x = pk2(s[0 * 33] * sc, s[1 * 33] * sc); o.y = pk2(s[2 * 33] * sc, s[3 * 33] * sc); o.z = pk2(s[4 * 33] * sc, s[5 * 33] * sc); o.w = pk2(s[6 * 33] * sc, s[7 * 33] * sc);
            *(u32x4*)(t.dst + ((size_t)n * DM + 8 * c) * 2) = o; }
    }
    LDS_WAIT(); asm volatile("" ::: "memory");
}
__device__ __forceinline__ int conv_item_id(int t, int lay, int nfix) {
    constexpr int I_IN = DEPTH * 16 * 81, I_OUT = DEPTH * 16 * 32, I_GU = DEPTH * NE * 16 * 64;
    if (t < nfix) return t;
    t -= nfix;
    return t < NE * 16 * 64 ? I_IN + I_OUT + lay * (NE * 16 * 64) + t : I_IN + I_OUT + I_GU + lay * (NE * 16 * 32) + (t - NE * 16 * 64);
}
__device__ __forceinline__ void convert_items(Frame& F, int lay, int ntot, int t0 = 0, int t1 = -1) {
    LAS float* scr = (LAS float*)(F.lds + F.wave * 16384);
    const int gw = F.vcu * NWAVES + F.wave, NGW = F.G * NWAVES, lane = F.lane;
    const int nfix = ntot - 3 * (NE * 16 * 32);
    if (t1 >= 0) ntot = t1;
    int it = t0 + gw; TItem cur = titem_decode(F, conv_item_id(it < ntot ? it : 0, lay, nfix)); f32x4 ra[8];
    if (it < ntot) titem_load(cur, lane, ra);
    while (it < ntot) {
        const int itn = it + NGW; const bool hn = itn < ntot;
        TItem nxt = titem_decode(F, conv_item_id(hn ? itn : 0, lay, nfix)); f32x4 rb[8];
        if (hn) titem_load(nxt, lane, rb);
        titem_store(cur, ra, scr, lane);
        it = itn; cur = nxt;
#pragma unroll
        for (int i = 0; i < 8; ++i) ra[i] = rb[i];
    }
}
__device__ __forceinline__ void ph_prologue(Frame& F) {
    const int gw = F.vcu * NWAVES + F.wave, NGW = F.G * NWAVES, lane = F.lane;
    constexpr int I_IN = DEPTH * 16 * 81, I_OUT = DEPTH * 16 * 32;
    for (int r = F.vcu; r < DEPTH * 24; r += F.G) {
        const int l = r / 24, j4 = (r % 24) * 256 + 4 * lane, k0 = F.wave * 128;
        const float* W = F.w_ada + (size_t)l * DM * 6 * DM + (size_t)k0 * 6 * DM + j4;
        f32x4 acc[9];
#pragma unroll
        for (int q = 0; q < 9; ++q) acc[q] = (f32x4){0.f, 0.f, 0.f, 0.f};
#pragma unroll 1
        for (int kh = 0; kh < 2; ++kh) {
            float cv[9];
#pragma unroll
            for (int q = 0; q < 8; ++q) cv[q] = silu_f(F.c[q * DM + k0 + 64 * kh + lane]);
            cv[8] = silu_f(F.c_ctx[k0 + 64 * kh + lane]);
#pragma unroll 8
            for (int kk = 0; kk < 64; ++kk) { const f32x4 w = *(const f32x4*)(W + (size_t)(64 * kh + kk) * 6 * DM);
#pragma unroll
                for (int q = 0; q < 9; ++q) acc[q] += __builtin_bit_cast(float, __builtin_amdgcn_readlane(__builtin_bit_cast(int, cv[q]), kk)) * w; }
        }
        LAS float* part = (LAS float*)F.lds;
#pragma unroll
        for (int q = 0; q < 9; ++q) *(LAS f32x4*)(part + (F.wave * 9 + q) * 256 + 4 * lane) = acc[q];
        __syncthreads();
        for (int o = F.tid; o < 9 * 256; o += NTHREADS) { const int q = o >> 8, cc = o & 255; float sum = F.b_ada[(size_t)l * 6 * DM + (r % 24) * 256 + cc];
#pragma unroll
            for (int w = 0; w < NWAVES; ++w) sum += part[(w * 9 + q) * 256 + cc];
            F.mod[((size_t)l * 9 + q) * 6 * DM + (r % 24) * 256 + cc] = sum; }
        __syncthreads();
    }
    convert_items(F, 0, I_IN + I_OUT + 3 * (NE * 16 * 32), 0, I_IN + I_OUT);
#if GLA_CHECK
    for (int lay = 0; lay < DEPTH; ++lay) convert_items(F, lay, 3 * (NE * 16 * 32));
#endif
    if (F.vcu == 0) for (int i = F.tid; i < 64 * 12; i += NTHREADS) { const int pos = i / 12, fi = i % 12;
        const float invf = expf(-((float)(2 * fi) / 24.f) * 9.210340371976184f); const float ang = (float)pos * invf; F.ROPE[i] = cosf(ang); F.ROPE[768 + i] = sinf(ang); }
    const size_t gt = (size_t)F.vcu * NTHREADS + F.tid, NGT = (size_t)F.G * NTHREADS;
    for (size_t i = gt; i < (size_t)DEPTH * 224 * DM / 8; i += NGT) { const size_t l = i / (224 * DM / 8), rr = i % (224 * DM / 8);
        *(u32x4*)(F.Bin + (l * NP + 2592) * DM + rr * 8) = (u32x4){0u, 0u, 0u, 0u}; }
    for (size_t i = gt; i < (size_t)256 * DM / 8; i += NGT) *(u32x4*)(F.H + (size_t)TT * DM + i * 8) = (u32x4){0u, 0u, 0u, 0u};
    for (size_t i = gt; i < (size_t)256 * DM / 16; i += NGT) *(u32x4*)(F.H8 + (size_t)TT * DM + i * 16) = (u32x4){0u, 0u, 0u, 0u};
}

__device__ __forceinline__ void norm_mod_store(const f32x4 (&v)[4], const float* gw, const float* sc, const float* sh, bf16* orow, int lane) {
    float s = 0.f;
#pragma unroll
    for (int j = 0; j < 4; ++j) s += (v[j].x * v[j].x + v[j].y * v[j].y) + (v[j].z * v[j].z + v[j].w * v[j].w);
    const float rinv = 1.f / sqrtf(wave_sum(s) * (1.f / DM) + EPS);
#pragma unroll
    for (int j = 0; j < 4; ++j) { const int c = 4 * lane + 256 * j;
        const f32x4 g = *(const f32x4*)(gw + c), a = *(const f32x4*)(sc + c), b = *(const f32x4*)(sh + c);
        const f32x4 y = (v[j] * rinv * g) * (a + 1.f) + b;
        u32x2 w; w.x = pk2(y.x, y.y); w.y = pk2(y.z, y.w);
        *(u32x2*)(orow + c) = w; }
}
__device__ __forceinline__ void ph_first_norm(Frame& F) {
    const int gw = F.vcu * NWAVES + F.wave, NGW = F.G * NWAVES, lane = F.lane;
    for (int m = gw; m < TT; m += NGW) {
        const float* src = m < TX ? F.x + (size_t)m * DM : F.ctx + (size_t)(m - TX) * DM;
        const int br = m < TX ? m / SEQ : NB;
        f32x4 v[4];
#pragma unroll
        for (int j = 0; j < 4; ++j) { v[j] = *(const f32x4*)(src + 4 * lane + 256 * j); *(f32x4*)(F.X + (size_t)m * DM + 4 * lane + 256 * j) = v[j]; }
        const float* md = F.mod + (size_t)br * 6 * DM;
        norm_mod_store(v, F.norm1_g, md + DM, md, F.H + (size_t)m * DM, lane);
    }
}
__device__ __forceinline__ void ph_combine(Frame& F, int l, bool dry = false) {
    const int gw = F.vcu * NWAVES + F.wave, NGW = F.G * NWAVES, lane = F.lane;
    float* Xo = dry ? (float*)F.ACT : F.X; bf16* Ho = dry ? (bf16*)F.P : F.H; float* Oo = dry ? (float*)F.ACT : F.out;
    const int M = (l == DEPTH - 1) ? TX : TT;
    const int cA = 8 * lane, cB = 512 + 8 * lane;
    for (int m0 = gw; m0 < M; m0 += 2 * NGW) {
        u32x4 yw[2][4][2]; f32x4 xv[2][4]; bool have[2]; int br[2];
#pragma unroll
        for (int rr = 0; rr < 2; ++rr) { const int m = m0 + rr * NGW; have[rr] = m < M; const int mm = have[rr] ? m : m0; br[rr] = mm < TX ? mm / SEQ : NB;
            const u32x4 sl4 = *(const u32x4*)(F.INV + (size_t)mm * 4); const unsigned slk[4] = {sl4.x, sl4.y, sl4.z, sl4.w};
#pragma unroll
            for (int k = 0; k < 4; ++k) { yw[rr][k][0] = *(const u32x4*)(F.YB + (size_t)slk[k] * DM + cA); yw[rr][k][1] = *(const u32x4*)(F.YB + (size_t)slk[k] * DM + cB); }
            const float* xr = F.X + (size_t)mm * DM;
            xv[rr][0] = *(const f32x4*)(xr + cA); xv[rr][1] = *(const f32x4*)(xr + cA + 4); xv[rr][2] = *(const f32x4*)(xr + cB); xv[rr][3] = *(const f32x4*)(xr + cB + 4); }
#pragma unroll
        for (int rr = 0; rr < 2; ++rr) { if (!have[rr]) continue;
            const int m = m0 + rr * NGW;
            const float* md = F.mod + ((size_t)l * 9 + br[rr]) * 6 * DM;
            f32x4 y[4];
#pragma unroll
            for (int j = 0; j < 4; ++j) y[j] = (f32x4){0.f, 0.f, 0.f, 0.f};
#pragma unroll
            for (int k = 0; k < 4; ++k) { const u32x4 a = yw[rr][k][0], b = yw[rr][k][1];
                y[0] += (f32x4){bflo(a.x), bfhi(a.x), bflo(a.y), bfhi(a.y)}; y[1] += (f32x4){bflo(a.z), bfhi(a.z), bflo(a.w), bfhi(a.w)};
                y[2] += (f32x4){bflo(b.x), bfhi(b.x), bflo(b.y), bfhi(b.y)}; y[3] += (f32x4){bflo(b.z), bfhi(b.z), bflo(b.w), bfhi(b.w)}; }
            const int cc[4] = {cA, cA + 4, cB, cB + 4};
            f32x4 v[4]; float ss = 0.f;
#pragma unroll
            for (int j = 0; j < 4; ++j) { v[j] = xv[rr][j] + *(const f32x4*)(md + 5 * DM + cc[j]) * y[j]; ss += (v[j].x * v[j].x + v[j].y * v[j].y) + (v[j].z * v[j].z + v[j].w * v[j].w); }
            const float rinv = 1.f / sqrtf(wave_sum(ss) * (1.f / DM) + EPS);
            if (l < DEPTH - 1) {
#pragma unroll
                for (int j = 0; j < 4; ++j) *(f32x4*)(Xo + (size_t)m * DM + cc[j]) = v[j];
                const float* mn = F.mod + ((size_t)(l + 1) * 9 + br[rr]) * 6 * DM; const float* gw1 = F.norm1_g + (size_t)(l + 1) * DM;
                f32x4 h[4];
#pragma unroll
                for (int j = 0; j < 4; ++j) h[j] = (v[j] * rinv * *(const f32x4*)(gw1 + cc[j])) * (*(const f32x4*)(mn + DM + cc[j]) + 1.f) + *(const f32x4*)(mn + cc[j]);
                u32x4 w0, w1; w0.x = pk2(h[0].x, h[0].y); w0.y = pk2(h[0].z, h[0].w); w0.z = pk2(h[1].x, h[1].y); w0.w = pk2(h[1].z, h[1].w);
                w1.x = pk2(h[2].x, h[2].y); w1.y = pk2(h[2].z, h[2].w); w1.z = pk2(h[3].x, h[3].y); w1.w = pk2(h[3].z, h[3].w);
                *(u32x4*)(Ho + (size_t)m * DM + cA) = w0; *(u32x4*)(Ho + (size_t)m * DM + cB) = w1;
            } else {
#pragma unroll
                for (int j = 0; j < 4; ++j) { f32x4 o = v[j] * rinv * *(const f32x4*)(F.final_g + cc[j]);
#if GLA_CHECK
                    if (__hip_atomic_load(F.ctl + 64, __ATOMIC_RELAXED, __HIP_MEMORY_SCOPE_AGENT) != 0u) { const float q = __builtin_nanf(""); o = (f32x4){q, q, q, q}; }
#endif
                    *(f32x4*)(Oo + (size_t)m * DM + cc[j]) = o; }
            }
        }
    }
}

__device__ __forceinline__ void vt_unit(Frame& F, int u) {
    LAS bf16* t = (LAS bf16*)(F.lds + F.wave * 9216);
    const int lane = F.lane;
    int b, h, tb, rowbase, tlen; bf16* dst;
    if (u < NB * NH * 64) { tb = u & 63; h = (u >> 6) % NH; b = u / (64 * NH); rowbase = b * SEQ + tb * 64; tlen = SEQ; dst = F.VTX + ((size_t)(b * NH + h) * NDH) * SEQ + tb * 64; }
    else { const int v = u - NB * NH * 64; tb = v & 3; h = (v >> 2) % NH; b = v / (4 * NH); rowbase = TX + b * CTXL + tb * 64; tlen = CTXL; dst = F.VTC + ((size_t)(b * NH + h) * NDH) * CTXL + tb * 64; }
#pragma unroll
    for (int i = 0; i < 8; ++i) { const int tok = (lane >> 3) + 8 * i, ch = lane & 7;
        const bf16x8 v = *(const bf16x8*)(F.P + (size_t)(rowbase + tok) * NP + C_NAV + h * NDH + ch * 8);
#pragma unroll
        for (int e = 0; e < 8; ++e) t[(ch * 8 + e) * 72 + tok] = (bf16)v[e]; }
    LDS_WAIT(); asm volatile("" ::: "memory");
#pragma unroll
    for (int i = 0; i < 8; ++i) { const int d = (lane >> 3) + 8 * i, ch = lane & 7;
        *(bf16x8*)(dst + (size_t)d * tlen + ch * 8) = *(const LAS bf16x8*)(t + d * 72 + ch * 8); }
    LDS_WAIT(); asm volatile("" ::: "memory");
}
constexpr int PL_U = 0, PL_P = 49152, PL_LD = 264, PREP_PW = 81920, PW_LD = 72, PREP_PS = PREP_PW + 4 * 64 * PW_LD * 2;
static_assert(PREP_PS + 1024 <= STAGE_BYTES && PL_P + 32 * PL_LD * 2 <= PREP_PW, "pool LDS map");
__device__ __forceinline__ void pool_unit(Frame& F, int l, int u) {
    LAS float* U = (LAS float*)(F.lds + PL_U);
    LAS bf16* PL = (LAS bf16*)(F.lds + PL_P);
    const LAS bf16* PW = (const LAS bf16*)(F.lds + PREP_PW); const LAS float* PS = (const LAS float*)(F.lds + PREP_PS);
    const int tid = F.tid;
    int s, tb, seqbase, tlen;
    if (u < NB * 128) { s = u / 128; tb = u % 128; seqbase = s * SEQ; tlen = SEQ; } else { const int v = u - NB * 128; s = v / 8; tb = v % 8; seqbase = TX + s * CTXL; tlen = CTXL; }
    const int t0 = tb * 32;
    for (int i = tid; i < 48 * 32; i += NTHREADS) { const int rr = i / 32, ch = i % 32, t = t0 - 8 + rr;
        f32x4 a = (f32x4){0.f, 0.f, 0.f, 0.f}, b = a;
        if (t >= 0 && t < tlen) { const u32x4 w = *(const u32x4*)(F.P + (size_t)(seqbase + t) * NP + C_POOL + ch * 8);
            a = (f32x4){bflo(w.x), bfhi(w.x), bflo(w.y), bfhi(w.y)}; b = (f32x4){bflo(w.z), bfhi(w.z), bflo(w.w), bfhi(w.w)}; }
        *(LAS f32x4*)(U + rr * 256 + ch * 8) = a; *(LAS f32x4*)(U + rr * 256 + ch * 8 + 4) = b; }
    __syncthreads();
    { const int tt = tid >> 4, cg = tid & 15, g = cg >> 2, w = 2 << g, t = t0 + tt;
      int lo = t - w / 2; if (lo < 0) lo = 0; int hi = t + w - w / 2; if (hi > tlen) hi = tlen;
      const float inv = 1.f / (float)(hi - lo);
      f32x4 sum[4];
#pragma unroll
      for (int q4 = 0; q4 < 4; ++q4) sum[q4] = (f32x4){0.f, 0.f, 0.f, 0.f};
      for (int jj = lo; jj < hi; ++jj) {
#pragma unroll
          for (int q4 = 0; q4 < 4; ++q4) sum[q4] += *(const LAS f32x4*)(U + (jj - t0 + 8) * 256 + cg * 16 + 4 * q4); }
      u32x4 w0, w1;
      { const f32x4 y0 = sum[0] * inv - *(const LAS f32x4*)(U + (tt + 8) * 256 + cg * 16), y1 = sum[1] * inv - *(const LAS f32x4*)(U + (tt + 8) * 256 + cg * 16 + 4);
        const f32x4 y2 = sum[2] * inv - *(const LAS f32x4*)(U + (tt + 8) * 256 + cg * 16 + 8), y3 = sum[3] * inv - *(const LAS f32x4*)(U + (tt + 8) * 256 + cg * 16 + 12);
        w0.x = pk2(y0.x, y0.y); w0.y = pk2(y0.z, y0.w); w0.z = pk2(y1.x, y1.y); w0.w = pk2(y1.z, y1.w);
        w1.x = pk2(y2.x, y2.y); w1.y = pk2(y2.z, y2.w); w1.z = pk2(y3.x, y3.y); w1.w = pk2(y3.z, y3.w); }
      *(LAS u32x4*)(PL + tt * PL_LD + cg * 16) = w0; *(LAS u32x4*)(PL + tt * PL_LD + cg * 16 + 8) = w1; }
    __syncthreads();
    { const int lane = F.lane, q = lane & 15, g4 = lane >> 4;
#pragma unroll
      for (int k = 0; k < 4; ++k) { const int ti = F.wave * 4 + k, mt = ti & 1, ct = ti >> 1, g = ct >> 2, ot = ct & 3;
          f32x4 acc = (f32x4){0.f, 0.f, 0.f, 0.f};
#pragma unroll
          for (int s2 = 0; s2 < 2; ++s2) { const bf16x8 a = *(const LAS bf16x8*)(PW + (g * 64 + 16 * ot + q) * PW_LD + 32 * s2 + 8 * g4), b = *(const LAS bf16x8*)(PL + (16 * mt + q) * PL_LD + g * 64 + 32 * s2 + 8 * g4);
              acc = __builtin_amdgcn_mfma_f32_16x16x32_bf16(a, b, acc, 0, 0, 0); }
          const f32x4 y = acc * *(const LAS f32x4*)(PS + g * 64 + 16 * ot + 4 * g4);
          u32x2 w; w.x = pk2(y.x, y.y); w.y = pk2(y.z, y.w);
          *(u32x2*)(F.MIX + (size_t)(seqbase + t0 + 16 * mt + q) * DM + 768 + g * 64 + 16 * ot + 4 * g4) = w; } }
    __syncthreads();
}
__device__ __forceinline__ void gla_chain(Frame& F, int l, int u) {
    const int tid = F.tid;
    const int dir = u & 1, hh = (u >> 1) & 3, b = u >> 3;
    LAS float* qs = (LAS float*)F.lds;
    LAS float* ks = qs + 64 * 48;
    LAS float* as = ks + 64 * 48;
    LAS float* vs = as + 64 * 48;
    LAS float* os = vs + 64 * 96;
    LAS float* rc = os + 64 * 96;
    LAS float* rs = rc + 64 * 12;
    LAS float* wa = rs + 64 * 12;
    LAS float* ba = wa + 16 * 48;
    for (int i = tid; i < 64 * 12; i += NTHREADS) { const int pos = i / 12, fi = i % 12;
        const float invf = expf(-((float)(2 * fi) / 24.f) * 9.210340371976184f);
        const float ang = (float)pos * invf; rc[i] = cosf(ang); rs[i] = sinf(ang); }
    for (int i = tid; i < 16 * 48; i += NTHREADS) { const int r = i / 48, d = i % 48; wa[i] = F.gla_wa2[(((size_t)l * 2 + dir) * 16 + r) * 192 + hh * 48 + d]; }
    if (tid < 48) ba[tid] = F.gla_ba[((size_t)l * 2 + dir) * 192 + hh * 48 + tid];
    __syncthreads();
    float S[12];
#pragma unroll
    for (int i = 0; i < 12; ++i) S[i] = 0.f;
    const int vv = tid >> 2, dg = tid & 3;
    float* Odir = dir ? F.OB : F.OF;
    const bool need_ctx = l < DEPTH - 1;
    for (int cidx = 0; cidx < 4 + 64; ++cidx) {
        const bool isctx = cidx < 4;
        const int nch = isctx ? 4 : 64, ci0 = isctx ? cidx : cidx - 4, ci = dir ? (nch - 1 - ci0) : ci0;
        const int seqbase = isctx ? TX + b * CTXL : b * SEQ, t0 = ci * 64;
        for (int i = tid; i < 64 * 2 * 2 * 12; i += NTHREADS) {
            const int fi = i % 12, hf = (i / 12) & 1, isk = (i / 24) & 1, j = i / 48;
            const bf16* row = F.P + (size_t)(seqbase + t0 + j) * NP + (isk ? C_GK : C_GQ) + hh * 48 + hf * 24;
            const float x1 = bf2f(row[fi]), x2 = bf2f(row[12 + fi]);
            float o1 = x1, o2 = x2;
            if (!isctx) { const int t = t0 + j, pos = hf ? (t % GRIDW) : (t / GRIDW); const float cs = rc[pos * 12 + fi], sn = rs[pos * 12 + fi]; o1 = x1 * cs - x2 * sn; o2 = x1 * sn + x2 * cs; }
            LAS float* dst = (isk ? ks : qs) + j * 48 + hf * 24;
            dst[fi] = o1; dst[12 + fi] = o2; }
        for (int i = tid; i < 64 * 48; i += NTHREADS) { const int j = i / 48, d = i % 48;
            const bf16* row = F.P + (size_t)(seqbase + t0 + j) * NP + (dir ? C_AB : C_AF);
            float z = ba[d];
#pragma unroll
            for (int r = 0; r < 16; ++r) z += bf2f(row[r]) * wa[r * 48 + d];
            const float ls = fminf(z, 0.f) - log1pf(expf(-fabsf(z)));
            as[i] = expf(ls * (1.f / 16.f)); }
        for (int i = tid; i < 64 * 96; i += NTHREADS) { const int j = i / 96, d = i % 96; vs[i] = bf2f(F.VTA[(size_t)(384 + hh * 96 + d) * VTS + seqbase + t0 + j]); }
        __syncthreads();
        if (tid < 384) {
            for (int st = 0; st < 64; ++st) {
                const int j = dir ? 63 - st : st;
                const float vj = vs[j * 96 + vv];
                float part = 0.f;
#pragma unroll
                for (int q4 = 0; q4 < 3; ++q4) {
                    const f32x4 a4 = *(const LAS f32x4*)(as + j * 48 + dg * 12 + q4 * 4), k4 = *(const LAS f32x4*)(ks + j * 48 + dg * 12 + q4 * 4), qq = *(const LAS f32x4*)(qs + j * 48 + dg * 12 + q4 * 4);
#pragma unroll
                    for (int e = 0; e < 4; ++e) { const float sn = a4[e] * S[q4 * 4 + e] + k4[e] * vj; S[q4 * 4 + e] = sn; part += qq[e] * sn; } }
                part += __shfl_xor(part, 1); part += __shfl_xor(part, 2);
                if (dg == 0) os[j * 96 + vv] = part;
            }
        }
        __syncthreads();
        if (!isctx || need_ctx)
            for (int i = tid; i < 64 * 96; i += NTHREADS) { const int j = i / 96, d = i % 96; Odir[(size_t)(seqbase + t0 + j) * 384 + hh * 96 + d] = os[i]; }
        __syncthreads();
    }
}

typedef float f32x16 __attribute__((ext_vector_type(16)));
constexpr int GL_BF = 0, GL_BB = 12288, GL_WA = 24576, GL_VT = 31232, GL_KEF = 45056, GL_KEB = 51968;
constexpr int GL_QF = 45056, GL_KF = 52224, GL_QB = 59392, GL_KB = 66560, GL_STF = 73728, GL_STB = 84480, GL_O = 95232;
constexpr int VT_LD = 72, QK_LD = 56, ST_LD = 56, O_LD = 100, NCH = 68;
struct GlaU { int b, hh, cpos, seqbase, t0, isctx; };
__device__ __forceinline__ GlaU gla_unit_geom(int u) { GlaU g; g.cpos = u % NCH; g.hh = (u / NCH) & 3; g.b = u / (NCH * 4); g.isctx = g.cpos < 4;
    const int ci = g.isctx ? g.cpos : g.cpos - 4; g.seqbase = g.isctx ? TX + g.b * CTXL : g.b * SEQ; g.t0 = ci * 64; return g; }
__device__ __forceinline__ void gla_rope_pair(const Frame& F, const GlaU& g, const bf16* row, int j, int hf, int fi, float& o1, float& o2) {
    const float x1 = bf2f(row[fi]), x2 = bf2f(row[12 + fi]); o1 = x1; o2 = x2;
    if (!g.isctx) { const int t = g.t0 + j, pos = hf ? (t % GRIDW) : (t / GRIDW); const float cs = F.ROPE[pos * 12 + fi], sn = F.ROPE[768 + pos * 12 + fi]; o1 = x1 * cs - x2 * sn; o2 = x1 * sn + x2 * cs; }
}
constexpr int G1_BF = 0, G1_BB = 12288, G1_KEF = 24576, G1_KEB = 31488, G1_OPS = 38400;
constexpr int PREP_WA = TAB_OFF;
__device__ __forceinline__ void gla_g1_unit(Frame& F, int l, int u) {
    const GlaU g = gla_unit_geom(u);
    LAS bf16* kef = (LAS bf16*)(F.lds + G1_KEF); LAS bf16* keb = (LAS bf16*)(F.lds + G1_KEB); LAS bf16* ops = (LAS bf16*)(F.lds + G1_OPS);
    const LAS float* wa = (const LAS float*)(F.lds + PREP_WA) + g.hh * 1536; const LAS float* ba = (const LAS float*)(F.lds + PREP_WA) + 6144 + g.hh * 96;
    const bf16* vtg = F.VTA + (size_t)(384 + g.hh * 96) * VTS + g.seqbase + g.t0;
    const int tid = F.tid, lane = F.lane, j = lane, w = F.wave;
    const bf16* prow = F.P + (size_t)(g.seqbase + g.t0 + j) * NP;
    u32x4 araw[4];
#pragma unroll
    for (int q4 = 0; q4 < 4; ++q4) araw[q4] = *(const u32x4*)(prow + C_AF + 8 * q4);
    float q1[3], q2[3], k1[3], k2[3], cs[3], sn[3];
#pragma unroll
    for (int e = 0; e < 3; ++e) { const int p = 3 * w + e, hf = p / 12, fi = p % 12, cb = g.hh * 48 + hf * 24 + fi;
        q1[e] = bf2f(prow[C_GQ + cb]); q2[e] = bf2f(prow[C_GQ + cb + 12]); k1[e] = bf2f(prow[C_GK + cb]); k2[e] = bf2f(prow[C_GK + cb + 12]);
        const int t = g.t0 + j, pos = hf ? (t % GRIDW) : (t / GRIDW);
        cs[e] = g.isctx ? 1.f : F.ROPE[pos * 12 + fi]; sn[e] = g.isctx ? 0.f : F.ROPE[768 + pos * 12 + fi]; }
    float a[32];
#pragma unroll
    for (int q4 = 0; q4 < 4; ++q4) { const u32x4 x = araw[q4]; a[q4 * 8 + 0] = bflo(x.x); a[q4 * 8 + 1] = bfhi(x.x); a[q4 * 8 + 2] = bflo(x.y); a[q4 * 8 + 3] = bfhi(x.y);
        a[q4 * 8 + 4] = bflo(x.z); a[q4 * 8 + 5] = bfhi(x.z); a[q4 * 8 + 6] = bflo(x.w); a[q4 * 8 + 7] = bfhi(x.w); }
    float bf[3][2], bb[3][2];
#pragma unroll
    for (int e = 0; e < 3; ++e)
#pragma unroll
        for (int wh = 0; wh < 2; ++wh) { const int p = 3 * w + e, d = (p / 12) * 24 + p % 12 + 12 * wh;
            float zf = ba[d], zb = ba[48 + d];
#pragma unroll
            for (int r = 0; r < 16; ++r) { zf += a[r] * wa[r * 48 + d]; zb += a[16 + r] * wa[(16 + r) * 48 + d]; }
            float xf = (fminf(zf, 0.f) - __logf(1.f + __expf(-fabsf(zf)))) * (1.f / 16.f), xb = (fminf(zb, 0.f) - __logf(1.f + __expf(-fabsf(zb)))) * (1.f / 16.f);
#pragma unroll
            for (int o = 1; o < 64; o <<= 1) { const float yf = __shfl_up(xf, o), yb = __shfl_down(xb, o); if (lane >= o) xf += yf; if (lane + o < 64) xb += yb; }
            bf[e][wh] = xf; bb[e][wh] = xb; }
#pragma unroll
    for (int e = 0; e < 3; ++e) { const int p = 3 * w + e, d1 = (p / 12) * 24 + p % 12, d2 = d1 + 12;
        const float qa = q1[e] * cs[e] - q2[e] * sn[e], qb = q1[e] * sn[e] + q2[e] * cs[e], ka = k1[e] * cs[e] - k2[e] * sn[e], kb = k1[e] * sn[e] + k2[e] * cs[e];
        const float f1 = bf[e][0], f2 = bf[e][1], b1 = bb[e][0], b2 = bb[e][1];
        const float fe1 = __builtin_bit_cast(float, __builtin_amdgcn_readlane(__builtin_bit_cast(int, f1), 63)), fe2 = __builtin_bit_cast(float, __builtin_amdgcn_readlane(__builtin_bit_cast(int, f2), 63));
        const float be1 = __builtin_bit_cast(float, __builtin_amdgcn_readlane(__builtin_bit_cast(int, b1), 0)), be2 = __builtin_bit_cast(float, __builtin_amdgcn_readlane(__builtin_bit_cast(int, b2), 0));
        const float ef1 = __expf(f1), ef2 = __expf(f2), eb1 = __expf(b1), eb2 = __expf(b2), nf1 = __expf(-f1), nf2 = __expf(-f2), nb1 = __expf(-b1), nb2 = __expf(-b2);
        ops[j * 48 + d1] = (bf16)f2bf(qa * ef1); ops[j * 48 + d2] = (bf16)f2bf(qb * ef2); ops[3072 + j * 48 + d1] = (bf16)f2bf(ka * nf1); ops[3072 + j * 48 + d2] = (bf16)f2bf(kb * nf2);
        ops[6144 + j * 48 + d1] = (bf16)f2bf(qa * eb1); ops[6144 + j * 48 + d2] = (bf16)f2bf(qb * eb2); ops[9216 + j * 48 + d1] = (bf16)f2bf(ka * nb1); ops[9216 + j * 48 + d2] = (bf16)f2bf(kb * nb2);
        const float ge1 = __expf(fe1), ge2 = __expf(fe2), he1 = __expf(be1), he2 = __expf(be2);
        kef[d1 * VT_LD + j] = (bf16)f2bf(ka * nf1 * ge1); kef[d2 * VT_LD + j] = (bf16)f2bf(kb * nf2 * ge2);
        keb[d1 * VT_LD + j] = (bf16)f2bf(ka * nb1 * he1); keb[d2 * VT_LD + j] = (bf16)f2bf(kb * nb2 * he2);
        if (lane == 0) { float* gd = F.GD + (((size_t)(g.b * 4 + g.hh) * 2) * NCH + g.cpos) * 48; gd[d1] = ge1; gd[d2] = ge2; gd[(size_t)NCH * 48 + d1] = he1; gd[(size_t)NCH * 48 + d2] = he2; } }
    __syncthreads();
    { const int q = lane & 15, g4 = lane >> 4;
      for (int ti = F.wave; ti < 36; ti += NWAVES) { const int dir = ti / 18, dt = (ti % 18) / 6, vtile = ti % 6;
          const LAS bf16* ke = dir ? keb : kef;
          f32x4 acc = (f32x4){0.f, 0.f, 0.f, 0.f};
#pragma unroll
          for (int s2 = 0; s2 < 2; ++s2) { const bf16x8 av = *(const LAS bf16x8*)(ke + (16 * dt + q) * VT_LD + 32 * s2 + 8 * g4), bv = *(const bf16x8*)(vtg + (size_t)(16 * vtile + q) * VTS + 32 * s2 + 8 * g4);
              acc = __builtin_amdgcn_mfma_f32_16x16x32_bf16(av, bv, acc, 0, 0, 0); }
          *(f32x4*)(F.DS + ((((size_t)(g.b * 4 + g.hh) * 2 + dir) * NCH + g.cpos) * 96 + 16 * vtile + q) * 48 + 16 * dt + 4 * g4) = acc; } }
    { u32x4* dst = (u32x4*)(F.OPS + (size_t)u * 12288);
      for (int i = tid; i < 1536; i += NTHREADS) dst[i] = *(const LAS u32x4*)(ops + i * 8); }
    __syncthreads();
}
__device__ __forceinline__ void gla_g2_unit(Frame& F, int u) {
    const int chain = u >> 2, qt = u & 3, dir = chain & 1, tid = F.tid;
    const float* ds = F.DS + (size_t)chain * NCH * 4608; const float* gd = F.GD + (size_t)chain * NCH * 48; bf16* stb = F.STB + (size_t)chain * NCH * 4608;
    const int e0 = qt * 1152 + 2 * tid, e1 = qt * 1152 + 1024 + 2 * tid; const bool h1 = tid < 64;
    const int d0 = e0 % 48, d1 = h1 ? e1 % 48 : 0;
    f32x2 S0 = (f32x2){0.f, 0.f}, S1 = (f32x2){0.f, 0.f};
    for (int st0 = 0; st0 < NCH; st0 += 4) {
        f32x2 x0[4], x1[4], g0[4], g1[4]; int cp[4];
#pragma unroll
        for (int k = 0; k < 4; ++k) { const int st = st0 + k; cp[k] = st < 4 ? (dir ? 3 - st : st) : (dir ? 4 + (67 - st) : st);
            const float* p = ds + (size_t)cp[k] * 4608; const float* gp = gd + cp[k] * 48;
            x0[k] = *(const f32x2*)(p + e0); g0[k] = *(const f32x2*)(gp + d0);
            if (h1) { x1[k] = *(const f32x2*)(p + e1); g1[k] = *(const f32x2*)(gp + d1); } else { x1[k] = (f32x2){0.f, 0.f}; g1[k] = x1[k]; } }
#pragma unroll
        for (int k = 0; k < 4; ++k) { bf16* p = stb + (size_t)cp[k] * 4608;
            *(unsigned*)(p + e0) = pk2(S0.x, S0.y); if (h1) *(unsigned*)(p + e1) = pk2(S1.x, S1.y);
            S0 = g0[k] * S0 + x0[k]; S1 = g1[k] * S1 + x1[k]; }
    }
}
__device__ __forceinline__ void gla_g3_wave(Frame& F, int l, int wu) {
    const int u = wu >> 1, it = wu & 1;
    const GlaU g = gla_unit_geom(u);
    const int lane = F.lane, r = lane & 31, h = lane >> 5;
    const bf16* ops = F.OPS + (size_t)u * 12288 + 16 * 0 + 8 * h;
    const bf16* vtg = F.VTA + (size_t)(384 + g.hh * 96) * VTS + g.seqbase + g.t0;
    const bf16* stf = F.STB + ((((size_t)(g.b * 4 + g.hh) * 2 + 0) * NCH + g.cpos) * 4608) + 8 * h; const bf16* stbk = stf + (size_t)NCH * 4608;
    LAS float* O = (LAS float*)(F.lds + F.wave * 16384);
    bf16x8 qf[3], qb[3];
#pragma unroll
    for (int s3 = 0; s3 < 3; ++s3) { qf[s3] = *(const bf16x8*)(ops + (32 * it + r) * 48 + 16 * s3); qb[s3] = *(const bf16x8*)(ops + 6144 + (32 * it + r) * 48 + 16 * s3); }
    f32x16 X[2];
#pragma unroll
    for (int jt = 0; jt < 2; ++jt) {
        f32x16 xf, xb;
#pragma unroll
        for (int e = 0; e < 16; ++e) { xf[e] = 0.f; xb[e] = 0.f; }
        if (jt <= it) {
#pragma unroll
            for (int s3 = 0; s3 < 3; ++s3) xf = __builtin_amdgcn_mfma_f32_32x32x16_bf16(*(const bf16x8*)(ops + 3072 + (32 * jt + r) * 48 + 16 * s3), qf[s3], xf, 0, 0, 0); }
        if (jt >= it) {
#pragma unroll
            for (int s3 = 0; s3 < 3; ++s3) xb = __builtin_amdgcn_mfma_f32_32x32x16_bf16(*(const bf16x8*)(ops + 9216 + (32 * jt + r) * 48 + 16 * s3), qb[s3], xb, 0, 0, 0); }
        if (jt == it) {
#pragma unroll
            for (int e = 0; e < 16; ++e) { const int jl = (e & 3) + 8 * (e >> 2) + 4 * h; X[jt][e] = (jl <= r ? xf[e] : 0.f) + (jl >= r ? xb[e] : 0.f); }
        } else X[jt] = jt < it ? xf : xb;
    }
    f32x16 o[3];
#pragma unroll
    for (int vt = 0; vt < 3; ++vt)
#pragma unroll
        for (int e = 0; e < 16; ++e) o[vt][e] = 0.f;
#pragma unroll
    for (int jt = 0; jt < 2; ++jt)
#pragma unroll
        for (int s2 = 0; s2 < 2; ++s2) {
            u32x4 aw; aw.x = pk2(X[jt][8 * s2 + 0], X[jt][8 * s2 + 1]); aw.y = pk2(X[jt][8 * s2 + 2], X[jt][8 * s2 + 3]); aw.z = pk2(X[jt][8 * s2 + 4], X[jt][8 * s2 + 5]); aw.w = pk2(X[jt][8 * s2 + 6], X[jt][8 * s2 + 7]);
#pragma unroll
            for (int vt = 0; vt < 3; ++vt) {
                const bf16* vr = vtg + (size_t)(32 * vt + r) * VTS + 32 * jt + 16 * s2 + 4 * h;
                const u32x2 lo = *(const u32x2*)vr, hi = *(const u32x2*)(vr + 8);
                const u32x4 bw = (u32x4){lo.x, lo.y, hi.x, hi.y};
                o[vt] = __builtin_amdgcn_mfma_f32_32x32x16_bf16(__builtin_bit_cast(bf16x8, aw), __builtin_bit_cast(bf16x8, bw), o[vt], 0, 0, 0); } }
#pragma unroll
    for (int s3 = 0; s3 < 3; ++s3)
#pragma unroll
        for (int vt = 0; vt < 3; ++vt) {
            o[vt] = __builtin_amdgcn_mfma_f32_32x32x16_bf16(qf[s3], *(const bf16x8*)(stf + (32 * vt + r) * 48 + 16 * s3), o[vt], 0, 0, 0);
            o[vt] = __builtin_amdgcn_mfma_f32_32x32x16_bf16(qb[s3], *(const bf16x8*)(stbk + (32 * vt + r) * 48 + 16 * s3), o[vt], 0, 0, 0); }
#pragma unroll
    for (int vt = 0; vt < 3; ++vt)
#pragma unroll
        for (int e = 0; e < 16; ++e) O[((e & 3) + 8 * (e >> 2) + 4 * h) * O_LD + 32 * vt + r] = o[vt][e];
    LDS_WAIT(); asm volatile("" ::: "memory");
    { const int i = lane >> 1, half = lane & 1; const size_t row = (size_t)(g.seqbase + g.t0 + 32 * it + i);
      f32x4 ov[12]; float ss = 0.f;
#pragma unroll
      for (int e = 0; e < 12; ++e) { ov[e] = *(const LAS f32x4*)(O + i * O_LD + half * 48 + 4 * e); ss += (ov[e].x * ov[e].x + ov[e].y * ov[e].y) + (ov[e].z * ov[e].z + ov[e].w * ov[e].w); }
      ss += __shfl_xor(ss, 1);
      const float rinv = 1.f / sqrtf(ss * (1.f / 96.f) + EPS);
      const float* ng = F.gla_norm_g + (size_t)l * 384 + g.hh * 96 + half * 48;
      const u32x4* gp = (const u32x4*)(F.P + row * NP + C_GG + g.hh * 96 + half * 48);
      u32x4* dst = (u32x4*)(F.MIX + row * DM + g.hh * 96 + half * 48);
#if GLA_CHECK
      { float sn = 0.f; const float* pf = F.OF + row * 384 + g.hh * 96 + half * 48; const float* pb = F.OB + row * 384 + g.hh * 96 + half * 48;
#pragma unroll
        for (int e = 0; e < 48; ++e) { const float on = pf[e] + pb[e]; sn += on * on; }
        sn += __shfl_xor(sn, 1);
        const float rms = sqrtf(sn * (1.f / 96.f)) + 1e-6f; int bad = 0;
#pragma unroll
        for (int e = 0; e < 48; ++e) { const float on = pf[e] + pb[e]; if (!(fabsf(ov[e >> 2][e & 3] - on) <= 0.03f * rms + 0.03f * fabsf(on))) ++bad; }
        if (bad) atomicAdd(F.ctl + 64, (unsigned)bad); }
#endif
#pragma unroll
      for (int q6 = 0; q6 < 6; ++q6) { const u32x4 gw = gp[q6]; const f32x4 n0 = *(const f32x4*)(ng + 8 * q6), n1 = *(const f32x4*)(ng + 8 * q6 + 4); const f32x4 a = ov[2 * q6], b = ov[2 * q6 + 1];
          u32x4 w;
          w.x = pk2(a.x * rinv * n0.x * silu_f(bflo(gw.x)), a.y * rinv * n0.y * silu_f(bfhi(gw.x))); w.y = pk2(a.z * rinv * n0.z * silu_f(bflo(gw.y)), a.w * rinv * n0.w * silu_f(bfhi(gw.y)));
          w.z = pk2(b.x * rinv * n1.x * silu_f(bflo(gw.z)), b.y * rinv * n1.y * silu_f(bfhi(gw.z))); w.w = pk2(b.z * rinv * n1.z * silu_f(bflo(gw.w)), b.w * rinv * n1.w * silu_f(bfhi(gw.w)));
          dst[q6] = w; } }
    LDS_WAIT(); asm volatile("" ::: "memory");
}
__device__ __forceinline__ void ph_gla3(Frame& F, int l) {
    const bool need_ctx = l < DEPTH - 1;
    const int gw = F.vcu * NWAVES + F.wave, NGW = F.G * NWAVES;
    for (int wu = gw; wu < NB * GH * NCH * 2; wu += NGW) { if (!need_ctx && ((wu >> 1) % NCH) < 4) continue; gla_g3_wave(F, l, wu); }
}
__device__ __forceinline__ void ph_prep(Frame& F, int l) {
    const bool need_ctx = l < DEPTH - 1;
    const int tid = F.tid;
#if GLA_CHECK
    for (int u = F.vcu; u < NB * GH * 2; u += F.G) gla_chain(F, l, u);
    __syncthreads();
#endif
    { LAS float* wa = (LAS float*)(F.lds + PREP_WA);
      for (int i = tid; i < 4 * 2 * 16 * 48; i += NTHREADS) { const int hh = i / 1536, dir = (i / 768) & 1, r = (i / 48) % 16, d = i % 48; wa[i] = F.gla_wa2[(((size_t)l * 2 + dir) * 16 + r) * 192 + hh * 48 + d]; }
      for (int i = tid; i < 4 * 2 * 48; i += NTHREADS) { const int hh = i / 96, dir = (i / 48) & 1, d = i % 48; wa[6144 + i] = F.gla_ba[((size_t)l * 2 + dir) * 192 + hh * 48 + d]; }
      LAS bf16* pw = (LAS bf16*)(F.lds + PREP_PW); LAS float* ps = (LAS float*)(F.lds + PREP_PS);
      for (int i = tid; i < 4 * 64 * 64; i += NTHREADS) { const int g = i >> 12, ii = (i >> 6) & 63, o = i & 63; pw[(g * 64 + o) * PW_LD + ii] = (bf16)f2bf(F.pool_w[(size_t)l * 16384 + i]); }
      if (tid < 256) ps[tid] = F.pool_scale[(size_t)l * 256 + tid]; }
    __syncthreads();
    for (int u = F.vcu; u < NB * GH * NCH; u += F.G) gla_g1_unit(F, l, u);
    const int NPOOL = NB * 128 + (need_ctx ? NB * 8 : 0);
    for (int u = F.vcu; u < NPOOL; u += F.G) pool_unit(F, l, u);
}

#define NA_LOG2E 1.4426950408889634f
struct NaCtx {
    __amdgpu_buffer_rsrc_t rP, rV; unsigned voffK, voffV; int b, cw, r0, krlo, nnb; const LAS float* rpb; unsigned bidx[2][4];
    bf16x8 qa[4][2]; float mrun[4], lsum[4]; f32x4 o[4][4];
};
__device__ __forceinline__ int na_segtok(const NaCtx& C, int sg) { return sg < C.nnb ? C.b * SEQ + (C.krlo + sg) * GRIDW + C.cw : TX + C.b * CTXL + 32 * (sg - C.nnb); }
__device__ __forceinline__ void na_load(const NaCtx& C, int sg, bf16x8 (&kb)[2][2], bf16x8 (&vb)[4]) {
    const int tok = na_segtok(C, sg);
#pragma unroll
    for (int par = 0; par < 2; ++par)
#pragma unroll
        for (int s2 = 0; s2 < 2; ++s2) kb[par][s2] = __builtin_bit_cast(bf16x8, __builtin_amdgcn_raw_buffer_load_b128(C.rP, C.voffK, (unsigned)((tok + 4 * par) * (NP * 2) + 64 * s2), 0));
#pragma unroll
    for (int dt = 0; dt < 4; ++dt) vb[dt] = __builtin_bit_cast(bf16x8, __builtin_amdgcn_raw_buffer_load_b128(C.rV, C.voffV, (unsigned)((16 * dt * VTS + tok) * 2), 0));
}
template <bool LATENT>
__device__ __forceinline__ void na_segment(NaCtx& C, int sg, int lane, const bf16x8 (&kb)[2][2], const bf16x8 (&vb)[4]) {
    const int g = lane >> 4;
    const bool nb = LATENT && sg < C.nnb;
    const int kr = C.krlo + sg;
#pragma unroll
    for (int i = 0; i < 4; ++i) {
        if (nb) { const int ri = C.r0 + i, rsi = ri - 4 < 0 ? 0 : (ri - 4 > 56 ? 56 : ri - 4); if (kr < rsi || kr > rsi + 7) continue; }
        float bv[2][4];
        if (nb) { const unsigned rowoff = (unsigned)((kr - (C.r0 + i) + 7) * 32 * 4);
#pragma unroll
            for (int par = 0; par < 2; ++par)
#pragma unroll
                for (int rg = 0; rg < 4; ++rg) bv[par][rg] = *(const LAS float*)((const LAS char*)C.rpb + rowoff + C.bidx[par][rg]); }
        f32x4 st[2];
#pragma unroll
        for (int par = 0; par < 2; ++par) {
            f32x4 a = (f32x4){0.f, 0.f, 0.f, 0.f};
#pragma unroll
            for (int s2 = 0; s2 < 2; ++s2) a = __builtin_amdgcn_mfma_f32_16x16x32_bf16(kb[par][s2], C.qa[i][s2], a, 0, 0, 0);
#pragma unroll
            for (int rg = 0; rg < 4; ++rg) a[rg] = nb ? __builtin_fmaf(a[rg], NA_LOG2E, bv[par][rg]) : a[rg] * NA_LOG2E;
            st[par] = a;
        }
        float mx = fmaxf(fmaxf(fmaxf(st[0][0], st[0][1]), fmaxf(st[0][2], st[0][3])), fmaxf(fmaxf(st[1][0], st[1][1]), fmaxf(st[1][2], st[1][3])));
        mx = fmaxf(mx, __shfl_xor(mx, 16)); mx = fmaxf(mx, __shfl_xor(mx, 32));
        const float mnew = fmaxf(C.mrun[i], mx), alpha = __builtin_amdgcn_exp2f(C.mrun[i] - mnew);
        float psum = 0.f;
#pragma unroll
        for (int par = 0; par < 2; ++par)
#pragma unroll
            for (int rg = 0; rg < 4; ++rg) { const float p = __builtin_amdgcn_exp2f(st[par][rg] - mnew); st[par][rg] = p; psum += p; }
        psum += __shfl_xor(psum, 16); psum += __shfl_xor(psum, 32);
        C.lsum[i] = C.lsum[i] * alpha + psum; C.mrun[i] = mnew;
#pragma unroll
        for (int rg = 0; rg < 4; ++rg) { const float ar = __shfl(alpha, 4 * g + rg);
#pragma unroll
            for (int dt = 0; dt < 4; ++dt) C.o[i][dt][rg] *= ar; }
        u32x4 pw; pw.x = cvt_pk_bf16(st[0][0], st[0][1]); pw.y = cvt_pk_bf16(st[0][2], st[0][3]); pw.z = cvt_pk_bf16(st[1][0], st[1][1]); pw.w = cvt_pk_bf16(st[1][2], st[1][3]);
        const bf16x8 pa = __builtin_bit_cast(bf16x8, pw);
#pragma unroll
        for (int dt = 0; dt < 4; ++dt) C.o[i][dt] = __builtin_amdgcn_mfma_f32_16x16x32_bf16(pa, vb[dt], C.o[i][dt], 0, 0, 0);
    }
}
#ifndef NA_DRYMODE
#define NA_DRYMODE 0
#endif
template <bool LATENT>
__device__ __forceinline__ void na_unit(Frame& F, int l, int u, const LAS float* rpb_lds, bool dry = false) {
    const int lane = F.lane, q = lane & 15, g = lane >> 4;
    NaCtx C;
    int hh, c0 = 0, qrow0, qstep;
    if (LATENT) { const int cb = u & 3, rg4 = (u >> 2) & 15; hh = (u >> 6) % NH; C.b = u / (64 * NH); c0 = cb * 16; C.r0 = rg4 * 4; qrow0 = C.b * SEQ + C.r0 * GRIDW + c0; qstep = GRIDW;
        const int rs0 = C.r0 - 4 < 0 ? 0 : (C.r0 - 4 > 56 ? 56 : C.r0 - 4), r3 = C.r0 + 3, rs3 = r3 - 4 < 0 ? 0 : (r3 - 4 > 56 ? 56 : r3 - 4);
        C.krlo = rs0; C.nnb = rs3 + 7 - rs0 + 1; }
    else { const int qi = u & 3; hh = (u >> 2) % NH; C.b = u / (4 * NH); qrow0 = TX + C.b * CTXL + qi * 64; qstep = 16; C.r0 = 0; C.krlo = 0; C.nnb = 0; }
    C.cw = c0 == 0 ? 0 : (c0 == 48 ? 32 : c0 - 8);
    const int c = c0 + q; const int start = c - 8 < 0 ? 0 : (c - 8 > 48 ? 48 : c - 8);
    C.rpb = rpb_lds + hh * 15 * 32;
    C.rP = __builtin_amdgcn_make_buffer_rsrc((void*)F.P, 0, (int)((size_t)TT * NP * 2), 0x00020000);
    C.rV = __builtin_amdgcn_make_buffer_rsrc((void*)F.VTA, 0, (int)((size_t)VT_NC * VTS * 2), 0x00020000);
    const int koff = 8 * (q >> 2) + (q & 3);
    C.voffK = (unsigned)((koff * NP + C_NAK + hh * NDH + 8 * g) * 2);
    C.voffV = (unsigned)(((hh * NDH + q) * VTS + 8 * g) * 2);
#pragma unroll
    for (int par = 0; par < 2; ++par)
#pragma unroll
        for (int rg = 0; rg < 4; ++rg) { const int kc = C.cw + 8 * g + rg + 4 * par; const bool valid = (kc >= start) && (kc < start + 16);
            C.bidx[par][rg] = (unsigned)((valid ? kc - c + 15 : 31) * 4); }
#pragma unroll
    for (int i = 0; i < 4; ++i) {
#pragma unroll
        for (int s2 = 0; s2 < 2; ++s2) C.qa[i][s2] = *(const bf16x8*)(F.P + (size_t)(qrow0 + i * qstep + q) * NP + C_NAQ + hh * NDH + 32 * s2 + 8 * g);
        C.mrun[i] = -1e30f; C.lsum[i] = 0.f;
#pragma unroll
        for (int dt = 0; dt < 4; ++dt) C.o[i][dt] = (f32x4){0.f, 0.f, 0.f, 0.f}; }
    const int nseg = C.nnb + 8;
    bf16x8 k0[2][2], v0[4], k1[2][2], v1[4];
    na_load(C, 0, k0, v0);
#pragma unroll 1
    for (int sg = 0; sg < nseg; sg += 2) {
        if (sg + 1 < nseg) na_load(C, sg + 1, k1, v1);
        na_segment<LATENT>(C, sg, lane, k0, v0);
        if (sg + 2 < nseg) na_load(C, sg + 2, k0, v0);
        if (sg + 1 < nseg) na_segment<LATENT>(C, sg + 1, lane, k1, v1);
    }
    bf16* mixb = dry ? (bf16*)F.VTC : F.MIX;
#pragma unroll
    for (int i = 0; i < 4; ++i)
#pragma unroll
        for (int rg = 0; rg < 4; ++rg) { const float li = 1.f / __shfl(C.lsum[i], 4 * g + rg);
            bf16* orow = mixb + (size_t)(dry ? 0 : (qrow0 + i * qstep + 4 * g + rg)) * DM + 384 + hh * NDH + q;
#pragma unroll
            for (int dt = 0; dt < 4; ++dt) orow[16 * dt] = (bf16)f2bf(C.o[i][dt][rg] * li); }
}
__device__ __forceinline__ void gla_out_row(Frame& F, int l, int m) {
    const int lane = F.lane, hh = lane >> 4, sub = lane & 15, c = hh * 96 + sub * 6;
    float o[6]; float ss = 0.f;
#pragma unroll
    for (int i = 0; i < 3; ++i) { const f32x2 a = *(const f32x2*)(F.OF + (size_t)m * 384 + c + 2 * i), b = *(const f32x2*)(F.OB + (size_t)m * 384 + c + 2 * i);
        o[2 * i] = a.x + b.x; o[2 * i + 1] = a.y + b.y; ss += o[2 * i] * o[2 * i] + o[2 * i + 1] * o[2 * i + 1]; }
    ss += __shfl_xor(ss, 1); ss += __shfl_xor(ss, 2); ss += __shfl_xor(ss, 4); ss += __shfl_xor(ss, 8);
    const float rinv = 1.f / sqrtf(ss * (1.f / 96.f) + EPS);
    const float* ng = F.gla_norm_g + (size_t)l * 384 + c;
    const bf16* gp = F.P + (size_t)m * NP + C_GG + c;
    unsigned w[3];
#pragma unroll
    for (int i = 0; i < 3; ++i) { const unsigned gw = *(const unsigned*)(gp + 2 * i);
        const float y0 = o[2 * i] * rinv * ng[2 * i] * silu_f(bflo(gw)), y1 = o[2 * i + 1] * rinv * ng[2 * i + 1] * silu_f(bfhi(gw));
        w[i] = pk2(y0, y1); }
    unsigned* dst = (unsigned*)(F.MIX + (size_t)m * DM + c);
    dst[0] = w[0]; dst[1] = w[1]; dst[2] = w[2];
}
__device__ __forceinline__ void ph_attn(Frame& F, int l) {
    const bool need_ctx = l < DEPTH - 1;
    const int gw = F.vcu * NWAVES + F.wave, NGW = F.G * NWAVES;
    LAS float* rpb = (LAS float*)(F.lds + TAB_OFF);
    for (int i = F.tid; i < NH * 15 * 32; i += NTHREADS) { const int col = i & 31, hr = i >> 5; rpb[i] = col < 31 ? F.na_rpb[((size_t)l * NH * 15 + hr) * 31 + col] * NA_LOG2E : -1e30f; }
    __syncthreads();
    for (int rep = 0; rep < REPS(11); ++rep)
    for (int u = F.vcu; u < NB * GH * 2 * 4; u += F.G) gla_g2_unit(F, u);
    const bool bg = !GLA_CHECK;
    if (bg && (F.wave & 1)) convert_items(F, l, 3 * (NE * 16 * 32));
    for (int rep = 0; rep < REPS(12); ++rep) {
    for (int u = gw; u < NB * NH * 16 * 4; u += NGW) na_unit<true>(F, l, u, rpb, rep + 1 < REPS(12));
    if (need_ctx) for (int u = gw; u < NB * NH * 4; u += NGW) na_unit<false>(F, l, u, rpb, rep + 1 < REPS(12)); }
    if (bg && !(F.wave & 1)) convert_items(F, l, 3 * (NE * 16 * 32));
}
constexpr int RW_LD = 1032;
static_assert(2 * NE * RW_LD * 2 <= STAGE_BYTES, "router LDS");
__device__ __forceinline__ unsigned f2key(float f, int e) { unsigned u = __builtin_bit_cast(unsigned, f); u = (u & 0x80000000u) ? ~u : (u | 0x80000000u); return (u & ~31u) | (unsigned)(31 - e); }
__device__ __forceinline__ float key2f(unsigned k) { unsigned u = k & ~31u; u = (u & 0x80000000u) ? (u & 0x7fffffffu) : ~u; return __builtin_bit_cast(float, u); }
__device__ __forceinline__ void ph_router(Frame& F, int l, bool dry = false) {
    const int tid = F.tid, lane = F.lane, q = lane & 15, g = lane >> 4;
    LAS bf16* WH = (LAS bf16*)F.lds; LAS bf16* WL = WH + NE * RW_LD;
    LAS int* lcount = (LAS int*)(F.lds + MISC_OFF + 64 * 4);
    volatile LAS int* lbase = (volatile LAS int*)(F.MISC + 96);
    LAS int* apos = (LAS int*)(F.lds + TAB_OFF);
    const float* rw = F.router_w + (size_t)l * DM * NE;
    for (int i = tid; i < DM * NE; i += NTHREADS) { const int c = i >> 5, e = i & 31; const float w = rw[i]; const unsigned hi = f2bf(w); const unsigned lo = f2bf(w - bf2f(hi));
        WH[e * RW_LD + c] = (bf16)hi; WL[e * RW_LD + c] = (bf16)lo; }
    if (tid < NE) lcount[tid] = 0;
    __syncthreads();
    const int M = (l == DEPTH - 1) ? TX : TT;
    const int per = (M + F.G - 1) / F.G, tok0 = F.vcu * per, tok1 = (tok0 + per < M) ? tok0 + per : M;
    const int ntile = tok1 > tok0 ? (tok1 - tok0 + 15) >> 4 : 0;
    const float* g2w = F.norm2_g + (size_t)l * DM + 8 * g;
    const float rb0 = F.router_b[(size_t)l * NE + q], rb1 = F.router_b[(size_t)l * NE + 16 + q];
    for (int tile = F.wave; tile < ntile; tile += NWAVES) {
        const int tbase = tok0 + 16 * tile, t = tbase + q, tq = t < tok1 ? t : tok1 - 1; const bool valid = t < tok1;
        const float* xr = F.X + (size_t)tq * DM + 8 * g;
        float ss = 0.f;
#pragma unroll 8
        for (int s = 0; s < 32; ++s) { const f32x4 a = *(const f32x4*)(xr + 32 * s), b = *(const f32x4*)(xr + 32 * s + 4); ss += (a.x * a.x + a.y * a.y) + (a.z * a.z + a.w * a.w) + (b.x * b.x + b.y * b.y) + (b.z * b.z + b.w * b.w); }
        ss += __shfl_xor(ss, 16); ss += __shfl_xor(ss, 32);
        const float rinv = 1.f / sqrtf(ss * (1.f / DM) + EPS);
        const int br = tq < TX ? tq / SEQ : NB;
        const float* md = F.mod + ((size_t)l * 9 + br) * 6 * DM + 8 * g;
        unsigned char* hrow = MOE_FP8 ? F.H8 + (size_t)tq * DM + 8 * g : (unsigned char*)(F.H + (size_t)tq * DM + 8 * g);
        f32x4 acc[2]; acc[0] = (f32x4){0.f, 0.f, 0.f, 0.f}; acc[1] = acc[0];
#pragma unroll 2
        for (int s = 0; s < 32; ++s) { const int c = 32 * s;
            const f32x4 xa = *(const f32x4*)(xr + c), xb = *(const f32x4*)(xr + c + 4), ga = *(const f32x4*)(g2w + c), gb = *(const f32x4*)(g2w + c + 4);
            const f32x4 ca = *(const f32x4*)(md + 4 * DM + c), cb = *(const f32x4*)(md + 4 * DM + c + 4), sa = *(const f32x4*)(md + 3 * DM + c), sb = *(const f32x4*)(md + 3 * DM + c + 4);
            const f32x4 ha = (xa * rinv * ga) * (ca + 1.f) + sa, hb = (xb * rinv * gb) * (cb + 1.f) + sb;
            u32x4 hw; hw.x = cvt_pk_bf16(ha.x, ha.y); hw.y = cvt_pk_bf16(ha.z, ha.w); hw.z = cvt_pk_bf16(hb.x, hb.y); hw.w = cvt_pk_bf16(hb.z, hb.w);
            u32x4 lw; lw.x = cvt_pk_bf16(ha.x - bflo(hw.x), ha.y - bfhi(hw.x)); lw.y = cvt_pk_bf16(ha.z - bflo(hw.y), ha.w - bfhi(hw.y));
            lw.z = cvt_pk_bf16(hb.x - bflo(hw.z), hb.y - bfhi(hw.z)); lw.w = cvt_pk_bf16(hb.z - bflo(hw.w), hb.w - bfhi(hw.w));
            if (valid) { if (MOE_FP8) { u32x2 h8; h8.x = pk4_fp8(ha.x, ha.y, ha.z, ha.w); h8.y = pk4_fp8(hb.x, hb.y, hb.z, hb.w); *(u32x2*)(hrow + c) = h8; } else *(u32x4*)(hrow + 2 * c) = hw; }
            const bf16x8 ah = __builtin_bit_cast(bf16x8, hw), al = __builtin_bit_cast(bf16x8, lw);
#pragma unroll
            for (int tt = 0; tt < 2; ++tt) { const bf16x8 bh = *(const LAS bf16x8*)(WH + (16 * tt + q) * RW_LD + c + 8 * g), bl = *(const LAS bf16x8*)(WL + (16 * tt + q) * RW_LD + c + 8 * g);
                acc[tt] = __builtin_amdgcn_mfma_f32_16x16x32_bf16(ah, bh, acc[tt], 0, 0, 0);
                acc[tt] = __builtin_amdgcn_mfma_f32_16x16x32_bf16(ah, bl, acc[tt], 0, 0, 0);
                acc[tt] = __builtin_amdgcn_mfma_f32_16x16x32_bf16(al, bh, acc[tt], 0, 0, 0); } }
        unsigned k0[4], k1[4], win[4][4];
#pragma unroll
        for (int rg = 0; rg < 4; ++rg) { k0[rg] = f2key(acc[0][rg] + rb0, q); k1[rg] = f2key(acc[1][rg] + rb1, 16 + q); }
#pragma unroll
        for (int k = 0; k < 4; ++k)
#pragma unroll
            for (int rg = 0; rg < 4; ++rg) { unsigned m = k0[rg] > k1[rg] ? k0[rg] : k1[rg];
#pragma unroll
                for (int o = 1; o < 16; o <<= 1) { const unsigned y = (unsigned)__shfl_xor((int)m, o); m = y > m ? y : m; }
                win[rg][k] = m; if (k0[rg] == m) k0[rg] = 0u; if (k1[rg] == m) k1[rg] = 0u; }
        { const int rsel = q >> 2, ksel = q & 3;
          unsigned w4[4];
#pragma unroll
          for (int k = 0; k < 4; ++k) w4[k] = rsel == 0 ? win[0][k] : rsel == 1 ? win[1][k] : rsel == 2 ? win[2][k] : win[3][k];
          const float v0 = key2f(w4[0]), e1 = __expf(key2f(w4[1]) - v0), e2 = __expf(key2f(w4[2]) - v0), e3 = __expf(key2f(w4[3]) - v0);
          const float inv = 1.f / (1.f + e1 + e2 + e3);
          const float gt = (ksel == 0 ? 1.f : ksel == 1 ? e1 : ksel == 2 ? e2 : e3) * inv;
          const unsigned wk = ksel == 0 ? w4[0] : ksel == 1 ? w4[1] : ksel == 2 ? w4[2] : w4[3];
          const int e = 31 - (int)(wk & 31u), tt2 = tbase + 4 * g + rsel;
          if (tt2 < tok1 && !dry) { F.GATE[(size_t)tt2 * 4 + ksel] = gt;
              const int pos = __hip_atomic_fetch_add(lcount + e, 1, __ATOMIC_RELAXED, __HIP_MEMORY_SCOPE_WORKGROUP);
              apos[(tt2 - tok0) * 4 + ksel] = (e << 16) | pos; } }
    }
    __syncthreads();
    if (dry) return;
    if (tid < NE) lbase[tid] = (int)__hip_atomic_fetch_add(F.ctl + CW_CNT + (l * NE + tid) * 64, (unsigned)__hip_atomic_load(lcount + tid, __ATOMIC_RELAXED, __HIP_MEMORY_SCOPE_WORKGROUP), __ATOMIC_RELAXED, __HIP_MEMORY_SCOPE_AGENT);
    __syncthreads();
    const int nas = (tok1 > tok0 ? (tok1 - tok0) : 0) * 4;
    for (int i = tid; i < nas; i += NTHREADS) { const int w = apos[i], e = w >> 16, pos = w & 0xffff; F.LIST[(size_t)e * TT + lbase[e] + pos] = tok0 * 4 + i; }
    __syncthreads();
}
__device__ __forceinline__ void moe_tables(Frame& F, int l, int npn) {
    volatile LAS int* tp = (volatile LAS int*)(F.MISC + 16);
    LAS int* tab = (LAS int*)(F.lds + TAB_OFF);
    const int tid = F.tid;
    volatile LAS int* eb = (volatile LAS int*)(F.MISC + 128);
    if (tid == 0) { int acc = 0, sb = 0;
        for (int e = 0; e < NE; ++e) { tp[e] = acc; eb[e] = sb; const int cnt = (int)__hip_atomic_load(F.ctl + CW_CNT + (l * NE + e) * 64, __ATOMIC_RELAXED, __HIP_MEMORY_SCOPE_AGENT); acc += (cnt + 255) >> 8; sb += cnt; }
        tp[NE] = acc; }
    __syncthreads();
#pragma unroll 1
    for (int i2 = 0; i2 < MAXU; i2 += 2) {
        const int i = i2 + (tid >> 8), rr = tid & 255;
        g8::Unit u;
        if (i < MAXU && g8::moe_unit((long)i * F.G + F.vcu, npn, tp, u)) {
            const int cnt = (int)__hip_atomic_load(F.ctl + CW_CNT + (l * NE + u.e) * 64, __ATOMIC_RELAXED, __HIP_MEMORY_SCOPE_AGENT);
            const int idx = u.pm * 256 + rr;
            const int a = idx < cnt ? F.LIST[(size_t)u.e * TT + idx] : -1;
            tab[i * 256 + rr] = a;
            if (npn == 8 && u.pn == 0 && a >= 0) F.INV[a] = eb[u.e] + idx;
        }
    }
    __syncthreads();
}

__global__ void __launch_bounds__(NTHREADS, 2) mk_fwd(Args args) {
    extern __shared__ __attribute__((aligned(16))) unsigned char lds_raw[];
    Frame F;
    F.lds = (LAS unsigned char*)lds_raw;
    F.MISC = (volatile LAS unsigned*)(F.lds + MISC_OFF);
    F.tid = threadIdx.x; F.lane = F.tid & 63; F.wave = __builtin_amdgcn_readfirstlane(F.tid >> 6);
    F.G = gridDim.x; { const int bx = blockIdx.x; F.vcu = (F.G % 8 == 0) ? (bx % 8) * (F.G / 8) + bx / 8 : bx; }
    frame_ptrs(F);
    for (int u = F.tid; u < 256; u += NTHREADS) F.MISC[u] = 0u;
    __syncthreads();
    const int lo = args.ph_lo, hi = args.ph_hi;
    const bool one_launch = (hi - lo) > 1;
    XcdBarrier bar; bar.bar = F.ctl + CW_BAR; bar.x = 0; bar.st = nullptr;
    if (one_launch) bar = xcd_barrier_post(F.ctl + CW_BAR, F.MISC);
#ifndef PHMASK
#define PHMASK 0xFFFFFFFF
#endif
#define IN(k) (lo <= (k) && (k) < hi)
#define PHON(b) ((PHMASK >> (b)) & 1)
#define STAGGER() do { if (STAG_TICKS > 0 && (blockIdx.x & 8)) { const unsigned long long t0_ = __builtin_amdgcn_s_memrealtime(); while (__builtin_amdgcn_s_memrealtime() - t0_ < (unsigned long long)STAG_TICKS) __builtin_amdgcn_s_sleep(8); } } while (0)
#define REFRESH() do { int tz_ = threadIdx.x; asm volatile("" : "+v"(tz_)); F.tid = tz_; F.lane = tz_ & 63; frame_ptrs(F); } while (0)
#define SEAM(k) do { if (IN(k) && IN((k) + 1)) xcd_barrier(bar); } while (0)

    if (PHON(0) && IN(0)) { for (int rep = 0; rep < REPS(0); ++rep) { REFRESH(); ph_prologue(F); } } SEAM(0);
    if (PHON(1) && IN(1)) { REFRESH(); ph_first_norm(F); } SEAM(1);
    for (int l = 0; l < DEPTH; ++l) {
        const int pb = 2 + PPL * l;
        const bool lastl = (l == DEPTH - 1);
        if (PHON(2) && IN(pb + 0)) for (int rep = 0; rep < REPS(2); ++rep) {
            REFRESH(); STAGGER();
            g8::ProbIn Pb{(const char*)F.H, (const char*)(F.Bin + (size_t)l * NP * DM), F.P, F.VTA, F.G, (int)blockIdx.x, (rep + 1 < REPS(2)) ? 1 : 0};
            g8::gemm_phase(F.lds, Pb);
        }
        SEAM(pb + 0);
        if (PHON(3) && IN(pb + 1)) { for (int rep = 0; rep < REPS(3); ++rep) { REFRESH(); ph_prep(F, l); } } SEAM(pb + 1);
        if (PHON(4) && IN(pb + 2)) { for (int rep = 0; rep < REPS(4); ++rep) { REFRESH(); ph_attn(F, l); } } SEAM(pb + 2);
        if (PHON(10) && IN(pb + 3)) { for (int rep = 0; rep < REPS(10); ++rep) { REFRESH(); ph_gla3(F, l); } } SEAM(pb + 3);
        if (PHON(5) && IN(pb + 4)) for (int rep = 0; rep < REPS(5); ++rep) {
            REFRESH(); STAGGER();
            g8::ProbOut Pb{(const char*)F.MIX, (const char*)(F.Bout + (size_t)l * DM * DM), (rep + 1 < REPS(5)) ? (float*)F.ACT : F.X, F.mod + (size_t)l * 9 * 6 * DM, F.G, (int)blockIdx.x, (lastl ? TX : TT) / 256};
            g8::gemm_phase(F.lds, Pb);
        }
        SEAM(pb + 4);
        if (PHON(6) && IN(pb + 5)) { for (int rep = 0; rep < REPS(6); ++rep) { REFRESH(); ph_router(F, l, rep + 1 < REPS(6)); __syncthreads(); } } SEAM(pb + 5);
        if (PHON(7) && IN(pb + 6)) for (int rep = 0; rep < REPS(7); ++rep) {
            REFRESH(); moe_tables(F, l, 8); STAGGER();
            g8::ProbGU Pb{MOE_FP8 ? (const char*)F.H8 : (const char*)F.H, (const char*)F.Bgu + (size_t)l * NE * 2 * DM * DM * (MOE_FP8 ? 1 : 2), (unsigned char*)F.ACT, F.b_gu + (size_t)l * NE * 2 * DM, (volatile LAS int*)(F.MISC + 16), (const LAS int*)(F.lds + TAB_OFF), F.G, F.vcu, (rep + 1 < REPS(7)) ? 1 : 0, (volatile LAS int*)(F.MISC + 128)};
            g8::gemm_phase(F.lds, Pb);
        }
        SEAM(pb + 6);
        if (PHON(8) && IN(pb + 7)) for (int rep = 0; rep < REPS(8); ++rep) {
            REFRESH(); moe_tables(F, l, 4); STAGGER();
            g8::ProbDN Pb{(const char*)F.ACT, (const char*)F.Bdn + (size_t)l * NE * DM * DM * (MOE_FP8 ? 1 : 2), F.YB, F.b_down + (size_t)l * NE * DM, F.GATE, (volatile LAS int*)(F.MISC + 16), (const LAS int*)(F.lds + TAB_OFF), F.G, F.vcu, (rep + 1 < REPS(8)) ? 1 : 0, (volatile LAS int*)(F.MISC + 128)};
            g8::gemm_phase(F.lds, Pb);
        }
        SEAM(pb + 7);
        if (PHON(9) && IN(pb + 8)) { for (int rep = 0; rep < REPS(9); ++rep) { REFRESH(); ph_combine(F, l, rep + 1 < REPS(9)); } }
        if (!lastl) SEAM(pb + 8);
    }
#undef IN
#undef SEAM
}

extern "C" void kernel_launch(void* const* d_in, const int* in_sizes, int n_in, void* d_out, int out_size, void* d_ws, size_t ws_size, hipStream_t stream) {
    static int grid = 0;
    if (grid == 0) {
        if (n_in != 23 || in_sizes[0] != TX * DM || out_size != TX * DM || ws_size < WS_END) {
            fprintf(stderr, "kernel_launch: unexpected problem (n_in %d, in0 %d, out %d, ws %zu; need ws >= %zu); nothing launched\n", n_in, n_in > 0 ? in_sizes[0] : -1, out_size, ws_size, (size_t)WS_END); grid = -1; return; }
        int dev = 0, cus = 0, per_cu = 0;
        if (hipGetDevice(&dev) != hipSuccess || hipDeviceGetAttribute(&cus, hipDeviceAttributeMultiprocessorCount, dev) != hipSuccess) { fprintf(stderr, "kernel_launch: device query failed\n"); grid = -1; return; }
        if (hipFuncSetAttribute((const void*)mk_fwd, hipFuncAttributeMaxDynamicSharedMemorySize, LDS_BYTES) != hipSuccess) { fprintf(stderr, "kernel_launch: hipFuncSetAttribute failed\n"); grid = -1; return; }
        if (hipOccupancyMaxActiveBlocksPerMultiprocessor(&per_cu, (const void*)mk_fwd, NTHREADS, LDS_BYTES) != hipSuccess || per_cu < 1)
            fprintf(stderr, "kernel_launch: note: occupancy query reports %d workgroups per CU\n", per_cu);
        (void)hipGetLastError();
        grid = cus;
        if ((long)grid * MAXU < (long)(NASG / 256 + NE) * 8) { fprintf(stderr, "kernel_launch: grid %d too small for the MoE unit tables\n", grid); grid = -1; return; }
    }
    if (grid < 0) return;
    if (hipMemsetAsync((char*)d_ws + WS_CTL, 0, CTL_ZERO_BYTES, stream) != hipSuccess) { fprintf(stderr, "kernel_launch: memset failed\n"); return; }
    Args a{};
    for (int i = 0; i < 23; ++i) a.in[i] = (const float*)d_in[i];
    a.out = (float*)d_out; a.ws = (unsigned char*)d_ws;
#if MK_N_LAUNCHES == 1
    a.ph_lo = 0; a.ph_hi = NPHASES;
    hipLaunchKernelGGL(mk_fwd, dim3(grid), dim3(NTHREADS), LDS_BYTES, stream, a);
#else
    for (int p = 0; p < NPHASES; ++p) { a.ph_lo = p; a.ph_hi = p + 1; hipLaunchKernelGGL(mk_fwd, dim3(grid), dim3(NTHREADS), LDS_BYTES, stream, a); }
#endif
    const hipError_t le = hipPeekAtLastError();
    if (le != hipSuccess) fprintf(stderr, "kernel_launch: launch failed: %s\n", hipGetErrorName(le));
}
```

```cpp
#include <hip/hip_runtime.h>
#include <cstdio>
#include <cstdint>
#include <cstddef>

#ifndef MK_N_LAUNCHES
#define MK_N_LAUNCHES 1
#endif

#define GAS __attribute__((address_space(1)))
#define LAS __attribute__((address_space(3)))
typedef unsigned short bf16;
typedef short bf16x8 __attribute__((ext_vector_type(8)));
typedef short bf16x4 __attribute__((ext_vector_type(4)));
typedef float f32x4 __attribute__((ext_vector_type(4)));
typedef float f32x2 __attribute__((ext_vector_type(2)));
typedef unsigned u32x4 __attribute__((ext_vector_type(4)));
typedef unsigned u32x2 __attribute__((ext_vector_type(2)));

constexpr int NB = 8, SEQ = 4096, DM = 1024, CTXL = 256, DEPTH = 4, GRIDW = 64;
constexpr int TX = NB * SEQ, TC = NB * CTXL, TT = TX + TC;
constexpr int NP = 2816;
constexpr int C_NAQ = 0, C_NAK = 384, C_NAV = 768, C_GV = 1152, C_GQ = 1536, C_GK = 1728, C_GG = 1920, C_POOL = 2304, C_AF = 2560, C_AB = 2576;
constexpr int VT_C0 = 768, VT_NC = 768, VTS = TT + 128;
constexpr int NE = 32, TOPK = 4, NASG = TT * TOPK;
constexpr int SLOT_DUMMY = NASG + 256;
constexpr int GH = 4, GDK = 48, GDV = 96, NH = 6, NDH = 64;
constexpr float EPS = 1e-6f;
constexpr int NWAVES = 8, NTHREADS = 512;
constexpr int PPL = 9;
constexpr int NPHASES = 2 + PPL * DEPTH;
#ifndef MOE_FP8
#define MOE_FP8 1
#endif
#ifndef REPMASK
#define REPMASK 0
#endif
#define REPS(b) (1 + ((REPMASK >> (b)) & 1))
#ifndef GLA_CHECK
#define GLA_CHECK 0
#endif

constexpr size_t MiB = 1u << 20;
constexpr size_t WS_CTL = 0, CTL_ZERO_BYTES = 128 * 1024;
constexpr size_t WS_MOD = 2 * MiB;
constexpr size_t WS_BIN = 4 * MiB;
constexpr size_t WS_BOUT = 26 * MiB;
constexpr size_t WS_BGU = 34 * MiB;
constexpr size_t WS_BDN = 546 * MiB;
constexpr size_t WS_X = 802 * MiB;
constexpr size_t WS_H = 938 * MiB;
constexpr size_t WS_P = 1008 * MiB;
constexpr size_t WS_VTX = 1196 * MiB;
constexpr size_t WS_VTC = 1220 * MiB;
constexpr size_t WS_MIX = 1222 * MiB;
constexpr size_t WS_OF = 1290 * MiB;
constexpr size_t WS_OB = 1341 * MiB;
constexpr size_t WS_ACT = 1392 * MiB;
constexpr size_t WS_YB = 1665 * MiB;
constexpr size_t WS_LIST = 1938 * MiB;
constexpr size_t WS_GATE = 1943 * MiB;
constexpr size_t WS_DS = 1944 * MiB;
constexpr size_t WS_GD = 2025 * MiB;
constexpr size_t WS_ROPE = 2026 * MiB;
constexpr size_t WS_VTA = 2027 * MiB;
constexpr size_t WS_OPS = 2080 * MiB;
constexpr size_t WS_STB = 2132 * MiB;
constexpr size_t WS_H8 = 2172 * MiB;
constexpr size_t WS_INV = 2208 * MiB;
constexpr size_t WS_END = 2209 * MiB;
constexpr int CW_BAR = 4096;
constexpr int CW_CNT = 16384;

constexpr int STAGE_BYTES = 132096;
constexpr int MISC_OFF = STAGE_BYTES;
constexpr int TAB_OFF = MISC_OFF + 1024;
constexpr int MAXU = 28;
constexpr int LDS_BYTES = TAB_OFF + MAXU * 1024;
static_assert(LDS_BYTES <= 163840, "LDS");

#define LDS_WAIT() asm volatile("s_waitcnt lgkmcnt(0)" ::: "memory")
#define VM_WAIT() asm volatile("s_waitcnt vmcnt(0)" ::: "memory")
__device__ __forceinline__ unsigned f2bf(float f) { unsigned u = __builtin_bit_cast(unsigned, f); return (u + 0x7fffu + ((u >> 16) & 1u)) >> 16; }
__device__ __forceinline__ unsigned pk2(float lo, float hi) { return f2bf(lo) | (f2bf(hi) << 16); }
__device__ __forceinline__ float bf2f(unsigned b) { return __builtin_bit_cast(float, (b & 0xffffu) << 16); }
__device__ __forceinline__ float bflo(unsigned w) { return __builtin_bit_cast(float, w << 16); }
__device__ __forceinline__ float bfhi(unsigned w) { return __builtin_bit_cast(float, w & 0xffff0000u); }
__device__ __forceinline__ unsigned cvt_pk_bf16(float lo, float hi) { unsigned r; asm volatile("v_cvt_pk_bf16_f32 %0, %1, %2" : "=v"(r) : "v"(lo), "v"(hi)); return r; }
__device__ __forceinline__ unsigned pk4_fp8(float a, float b, float c, float d) { int p = __builtin_amdgcn_cvt_pk_fp8_f32(a, b, 0, false); p = __builtin_amdgcn_cvt_pk_fp8_f32(c, d, p, true); return (unsigned)p; }
constexpr float W8_SCALE = 64.f, W8_INV = 1.f / 64.f;
__device__ __forceinline__ float wave_sum(float v) {
#pragma unroll
    for (int o = 1; o < 64; o <<= 1) v += __shfl_xor(v, o);
    return v;
}
__device__ __forceinline__ float silu_f(float x) { return x / (1.f + __expf(-x)); }

#define XB_TMO      128
#define XB_XCNT(j)  (256  + 64 * (j))
#define XB_XSUB(j)  (1280 + 64 * (j))
#define XB_XGEN(j)  (2304 + 64 * (j))
#define XB_TOP      3328
#define XB_TOPGEN   3392
#define XCD_BAR_WORDS 3456
#define XB_SPIN_CAP (1u << 18)
__device__ __forceinline__ unsigned xb_ld(unsigned* p)              { return __hip_atomic_load(p, __ATOMIC_RELAXED, __HIP_MEMORY_SCOPE_AGENT); }
__device__ __forceinline__ unsigned xb_add(unsigned* p, unsigned v) { return __hip_atomic_fetch_add(p, v, __ATOMIC_RELAXED, __HIP_MEMORY_SCOPE_AGENT); }
__device__ __forceinline__ unsigned xb_xcc_id() { return (unsigned)__builtin_amdgcn_s_getreg((3 << 11) | 20) & 0xFu; }
#define XB_SPIN(cond, bar) do { unsigned _sp = 0; while (cond) { __builtin_amdgcn_s_sleep(1); \
    if ((++_sp & 255u) == 0u) { if (xb_ld(&(bar)[XB_TMO])) break; if (_sp > XB_SPIN_CAP) { atomicAdd(&(bar)[XB_TMO], 1u); break; } } } } while (0)
struct XcdBarrier { unsigned* bar; unsigned x; volatile LAS unsigned* st; };
__device__ __forceinline__ XcdBarrier xcd_barrier_post(unsigned* bar, volatile LAS unsigned* st) {
    XcdBarrier b; b.bar = bar; b.x = xb_xcc_id(); b.st = st;
    if (threadIdx.x == 0) (void)xb_add(&bar[XB_XCNT(b.x)], 1u);
    return b;
}
__device__ __forceinline__ void xcd_barrier_complete(unsigned* bar, unsigned x, unsigned& nloc, unsigned& nx) {
    const unsigned G = gridDim.x * gridDim.y * gridDim.z;
    unsigned sum, cnt, mine, sp = 0u;
    for (;;) {
        sum = 0u; cnt = 0u; mine = 0u;
#pragma unroll
        for (unsigned j = 0; j < 16; ++j) { const unsigned c = xb_ld(&bar[XB_XCNT(j)]); sum += c; cnt += (c > 0u) ? 1u : 0u; mine = (j == x) ? c : mine; }
        if (sum == G) break;
        __builtin_amdgcn_s_sleep(1);
        if ((++sp & 255u) == 0u) { if (xb_ld(&bar[XB_TMO])) break; if (sp > XB_SPIN_CAP) { atomicAdd(&bar[XB_TMO], 1u); break; } }
    }
    nloc = mine > 0u ? mine : 1u; nx = cnt > 0u ? cnt : 1u;
}
__device__ __forceinline__ void xcd_barrier(const XcdBarrier& b) {
    asm volatile("s_waitcnt vmcnt(0)" ::: "memory");
    __syncthreads();
    if (threadIdx.x == 0) {
        unsigned* bar = b.bar;
        __builtin_amdgcn_s_waitcnt(0);
        unsigned nloc = b.st[0], nx = b.st[1];
        if (nloc == 0u) { xcd_barrier_complete(bar, b.x, nloc, nx); b.st[0] = nloc; b.st[1] = nx; }
        const unsigned old = xb_add(&bar[XB_XSUB(b.x)], 1u);
        const unsigned gen = old / nloc;
        if (old + 1u == (gen + 1u) * nloc) {
            __builtin_amdgcn_fence(__ATOMIC_RELEASE, "agent");
            asm volatile("s_waitcnt vmcnt(0)" ::: "memory");
            const unsigned og = xb_add(&bar[XB_TOP], 1u);
            const unsigned tg = og / nx;
            if (og + 1u == (tg + 1u) * nx) xb_add(&bar[XB_TOPGEN], 1u);
            else XB_SPIN(xb_ld(&bar[XB_TOPGEN]) == tg, bar);
            __builtin_amdgcn_fence(__ATOMIC_ACQUIRE, "agent");
            xb_add(&bar[XB_XGEN(b.x)], 1u);
            asm volatile("s_waitcnt vmcnt(0)" ::: "memory");
        } else {
            XB_SPIN(xb_ld(&bar[XB_XGEN(b.x)]) == gen, bar);
            __builtin_amdgcn_fence(__ATOMIC_ACQUIRE, "agent");
            asm volatile("s_waitcnt vmcnt(0)" ::: "memory");
        }
    }
    __syncthreads();
}

namespace g8 {
constexpr int BM = 256, BK = 64, HALF = 128, HTB = HALF * BK * 2, NXCD = 8, WGM = 8, KD = 1024;
__device__ __forceinline__ int lds_byte(int r, int c) { const int st = (r >> 4) * 2 + (c >> 5), rr = r & 15, cc = c & 31, ob = rr * 64 + cc * 2; return st * 1024 + (ob ^ (((ob >> 9) & 1) << 5)); }
__device__ __forceinline__ void stage_rc(int b, int& R, int& C) { const int st = b / 1024, sb = b % 1024, swz = sb ^ (((sb >> 9) & 1) << 5); R = (st >> 1) * 16 + swz / 64; C = (st & 1) * 32 + (swz % 64) / 2; }
__device__ __forceinline__ int perm32(int rho) { const int n = rho >> 4, i = rho & 15; return 8 * (i >> 2) + 4 * n + (i & 3); }
struct Unit { int pm, pn, e; };
typedef int i32x8 __attribute__((ext_vector_type(8)));
typedef int i32x4 __attribute__((ext_vector_type(4)));
__device__ __forceinline__ i32x8 cat8(bf16x8 a, bf16x8 b) { const i32x4 x = __builtin_bit_cast(i32x4, a), y = __builtin_bit_cast(i32x4, b); return (i32x8){x.x, x.y, x.z, x.w, y.x, y.y, y.z, y.w}; }
__device__ __forceinline__ bool static_unit(long L, int nM, int nN, Unit& u) {
    const int nwg = nM * nN; if (L >= nwg) return false;
    int wgid = (int)L; { const int q = nwg / NXCD, r = nwg % NXCD, xcd = wgid % NXCD, off = wgid / NXCD; wgid = (xcd < r ? xcd * (q + 1) : r * (q + 1) + (xcd - r) * q) + off; }
    const int nig = WGM * nN, gid = wgid / nig, fm = gid * WGM, gsz = (nM - fm) < WGM ? (nM - fm) : WGM;
    u.pm = fm + ((wgid % nig) % gsz); u.pn = (wgid % nig) / gsz; u.e = 0; return true;
}

#ifndef PROBE_DRY
#define PROBE_DRY 0
#endif
#ifndef STAG_TICKS
#define STAG_TICKS 0
#endif
template <class Prob>
__device__ __forceinline__ void gemm_phase(LAS unsigned char* lds, const Prob& P) {

    int tid_ = threadIdx.x; asm volatile("" : "+v"(tid_));
    const int tid = tid_, wid = __builtin_amdgcn_readfirstlane(tid >> 6), lane = tid & 63, wr = wid >> 2, wc = wid & 3, fr = lane & 15, fq = lane >> 4;
    constexpr int RPB = Prob::FP8 ? KD : KD * 2, nt = RPB / (BK * 2);
    unsigned voffB[2];
    { int R0, C0, R1, C1; stage_rc(tid * 16, R0, C0); stage_rc(tid * 16 + 8192, R1, C1); const int Rb0 = Prob::PERM ? ((R0 & ~31) + perm32(R0 & 31)) : R0, Rb1 = Prob::PERM ? ((R1 & ~31) + perm32(R1 & 31)) : R1;
      voffB[0] = (unsigned)(Rb0 * RPB + C0 * 2); voffB[1] = (unsigned)(Rb1 * RPB + C1 * 2); }
    const size_t kstep = (size_t)(BK * 2), hstepB = (size_t)HALF * RPB;
    const unsigned ldsw = (unsigned)wid * 1024u;
    const int aoff = lds_byte(wr * 64 + fr, fq * 8), boff = lds_byte(wc * 32 + fr, fq * 8);
#define G8_SA(b, h) (((b) * 2 + (h)) * HTB)
#define G8_SB(b, h) ((4 + (b) * 2 + (h)) * HTB)
#define G8_STAGE(bufoff, gbase, voff) do { _Pragma("unroll") for (int _i = 0; _i < 2; ++_i) \
        __builtin_amdgcn_global_load_lds((const unsigned*)((const char*)(gbase) + (voff)[_i]), (LAS unsigned*)(lds + (bufoff) + ldsw + _i * 8192), 16, 0, 0); } while (0)
#define G8_LDA(dst, b, h) do { _Pragma("unroll") for (int m = 0; m < 4; ++m) _Pragma("unroll") for (int k = 0; k < 2; ++k) dst[m][k] = *(const LAS bf16x8*)(lds + G8_SA(b, h) + aoff + m * 2048 + k * 1024); } while (0)
#define G8_LDB(dst, b, h) do { _Pragma("unroll") for (int n = 0; n < 2; ++n) _Pragma("unroll") for (int k = 0; k < 2; ++k) dst[n][k] = *(const LAS bf16x8*)(lds + G8_SB(b, h) + boff + n * 2048 + k * 1024); } while (0)
#define G8_MMA(ai, bj, At, Bt) do { __builtin_amdgcn_s_setprio(1); if constexpr (Prob::FP8) { \
        _Pragma("unroll") for (int m = 0; m < 4; ++m) _Pragma("unroll") for (int n = 0; n < 2; ++n) \
        acc[ai][bj][m][n] = __builtin_amdgcn_mfma_scale_f32_16x16x128_f8f6f4(cat8(Bt[n][0], Bt[n][1]), cat8(At[m][0], At[m][1]), acc[ai][bj][m][n], 0, 0, 0, 0x7f7f7f7f, 0, 0x7f7f7f7f); } else { \
        _Pragma("unroll") for (int m = 0; m < 4; ++m) _Pragma("unroll") for (int n = 0; n < 2; ++n) _Pragma("unroll") for (int k = 0; k < 2; ++k) \
        acc[ai][bj][m][n] = __builtin_amdgcn_mfma_f32_16x16x32_bf16(Bt[n][k], At[m][k], acc[ai][bj][m][n], 0, 0, 0); } __builtin_amdgcn_s_setprio(0); } while (0)
#define G8_WAIT_V(n) asm volatile("s_waitcnt vmcnt(" #n ")" ::: "memory")
#define G8_WAIT_L(n) asm volatile("s_waitcnt lgkmcnt(" #n ")" ::: "memory")
#define G8_BAR __builtin_amdgcn_s_barrier()
#define G8_SCHED __builtin_amdgcn_sched_barrier(0)
    Unit cur, nxt; int ui = 0;
    if (!P.next(0, cur)) return;
    f32x4 acc[2][2][4][2];
#pragma unroll
    for (int a = 0; a < 2; ++a)
#pragma unroll
        for (int b = 0; b < 2; ++b)
#pragma unroll
            for (int m = 0; m < 4; ++m)
#pragma unroll
                for (int n = 0; n < 2; ++n) acc[a][b][m][n] = (f32x4){0.f, 0.f, 0.f, 0.f};
    bf16x8 At[4][2], B0[2][2], B1[2][2];
    unsigned cvA[2][2];
    P.a_off(cur, 0, tid, cvA);
    const char* cA = P.a_base(cur);
    const char* cB = P.b_ptr(cur);
    G8_STAGE(G8_SB(0, 0), cB, voffB); G8_STAGE(G8_SB(0, 1), cB + hstepB, voffB); G8_STAGE(G8_SA(0, 0), cA, cvA[0]); G8_STAGE(G8_SA(0, 1), cA, cvA[1]);
    if (wr == 1) G8_BAR;
    G8_WAIT_V(2); G8_BAR;
    G8_STAGE(G8_SB(1, 0), cB + kstep, voffB); G8_STAGE(G8_SA(1, 0), cA + kstep, cvA[0]); G8_STAGE(G8_SB(1, 1), cB + hstepB + kstep, voffB);
    G8_WAIT_V(6); G8_BAR;
    for (;;) {
        const bool has_next = P.next(ui + 1, nxt);
        const char* nB = has_next ? P.b_ptr(nxt) : cB;
        const char* nA = has_next ? P.a_base(nxt) : cA;
        for (int t = 0; t < nt; t += 2) {
            const bool last = (t == nt - 2);
            const char* a1 = cA + (size_t)(t + 1) * kstep;
            const char* a2 = last ? nA : cA + (size_t)(t + 2) * kstep; const char* b2 = last ? nB : cB + (size_t)(t + 2) * kstep;
            const char* a3 = a2 + kstep; const char* b3 = b2 + kstep;
            G8_LDB(B0, 0, 0); G8_LDB(B1, 0, 1); G8_SCHED; G8_LDA(At, 0, 0); G8_STAGE(G8_SA(1, 1), a1, cvA[1]);
            G8_WAIT_V(8); G8_WAIT_L(0); G8_BAR; G8_MMA(0, 0, At, B0); G8_MMA(0, 1, At, B1); G8_BAR; G8_SCHED;
            if (last && has_next) { int tz = threadIdx.x; asm volatile("" : "+v"(tz)); P.a_off(nxt, ui + 1, tz, cvA); }
            G8_LDA(At, 0, 1); G8_STAGE(G8_SB(0, 0), b2, voffB); G8_STAGE(G8_SB(0, 1), b2 + hstepB, voffB); G8_STAGE(G8_SA(0, 0), a2, cvA[0]);
            G8_WAIT_V(8); G8_WAIT_L(0); G8_BAR; G8_MMA(1, 0, At, B0); G8_MMA(1, 1, At, B1); G8_BAR; G8_SCHED;
            G8_LDB(B0, 1, 0); G8_LDB(B1, 1, 1); G8_SCHED; G8_LDA(At, 1, 0); G8_STAGE(G8_SA(0, 1), a2, cvA[1]);
            G8_WAIT_V(8); G8_WAIT_L(0); G8_BAR; G8_MMA(0, 0, At, B0); G8_MMA(0, 1, At, B1); G8_BAR; G8_SCHED;
            G8_LDA(At, 1, 1); G8_STAGE(G8_SB(1, 0), b3, voffB); G8_STAGE(G8_SB(1, 1), b3 + hstepB, voffB); G8_STAGE(G8_SA(1, 0), a3, cvA[0]);
            G8_WAIT_V(8); G8_WAIT_L(0); G8_BAR; G8_MMA(1, 0, At, B0); G8_MMA(1, 1, At, B1); G8_BAR; G8_SCHED;
        }
        if (wr == 0) G8_BAR;
        P.epi(acc, cur, ui, wr, wc, fr, fq);
        if (!has_next) break;
#pragma unroll
        for (int a = 0; a < 2; ++a)
#pragma unroll
            for (int b = 0; b < 2; ++b)
#pragma unroll
                for (int m = 0; m < 4; ++m)
#pragma unroll
                    for (int n = 0; n < 2; ++n) acc[a][b][m][n] = (f32x4){0.f, 0.f, 0.f, 0.f};
        cur = nxt; cB = nB; cA = nA; ++ui;
        if (wr == 1) G8_BAR;
    }
    G8_WAIT_V(0);
    G8_BAR;
#undef G8_SA
#undef G8_SB
#undef G8_STAGE
#undef G8_LDA
#undef G8_LDB
#undef G8_MMA
#undef G8_WAIT_V
#undef G8_WAIT_L
#undef G8_BAR
#undef G8_SCHED
}


struct ProbIn {
    static constexpr bool PERM = true, FP8 = false;
    const char* A; const char* Bt; bf16* O; bf16* VT; int G, c; int dry;
    __device__ __forceinline__ static bool swapped(const Unit& u) { return u.pn >= 3 && u.pn <= 5; }
    __device__ __forceinline__ bool next(int i, Unit& u) const { return static_unit((long)i * G + c, TT / 256, NP / 256, u); }
    __device__ __forceinline__ void a_off(const Unit& u, int, int tid, unsigned (&v)[2][2]) const {
        int R0, C0, R1, C1; stage_rc(tid * 16, R0, C0); stage_rc(tid * 16 + 8192, R1, C1);
        const int rt = swapped(u) ? u.pn : u.pm;
#pragma unroll
        for (int h = 0; h < 2; ++h) { v[h][0] = (unsigned)((rt * 256 + h * 128 + R0) * KD + C0) * 2u; v[h][1] = (unsigned)((rt * 256 + h * 128 + R1) * KD + C1) * 2u; }
    }
    __device__ __forceinline__ const char* a_base(const Unit& u) const { return swapped(u) ? Bt : A; }
    __device__ __forceinline__ const char* b_ptr(const Unit& u) const { return swapped(u) ? A + (size_t)u.pm * 256 * KD * 2 : Bt + (size_t)u.pn * 256 * KD * 2; }
    __device__ __forceinline__ void epi(const f32x4 (&acc)[2][2][4][2], const Unit& u, int, int wr, int wc, int fr, int fq) const {
        if (PROBE_DRY && dry) { asm volatile("" :: "v"(acc[0][0][0][0][0]), "v"(acc[1][1][3][1][3]), "v"(acc[0][1][2][0][1]), "v"(acc[1][0][1][1][2])); return; }
        const bool sw = swapped(u);
        bf16* base = sw ? VT + (size_t)(u.pn * 256 - VT_C0 + wr * 64 + fr) * VTS + u.pm * 256 + wc * 32 + 8 * fq
                        : O + (size_t)(u.pm * 256 + wr * 64 + fr) * NP + u.pn * 256 + wc * 32 + 8 * fq;
        const size_t ld = sw ? (size_t)VTS : (size_t)NP;
#pragma unroll
        for (int ai = 0; ai < 2; ++ai)
#pragma unroll
            for (int m = 0; m < 4; ++m) { bf16* rowp = base + (size_t)(ai * 128 + m * 16) * ld;
#pragma unroll
                for (int bj = 0; bj < 2; ++bj) { const f32x4 v0 = acc[ai][bj][m][0], v1 = acc[ai][bj][m][1];
                    u32x4 w; w.x = cvt_pk_bf16(v0[0], v0[1]); w.y = cvt_pk_bf16(v0[2], v0[3]); w.z = cvt_pk_bf16(v1[0], v1[1]); w.w = cvt_pk_bf16(v1[2], v1[3]);
                    *(u32x4*)(rowp + bj * 128) = w; } }
    }
};
struct ProbOut {
    static constexpr bool PERM = false, FP8 = false;
    const char* A; const char* Bt; float* X; const float* modl  ; int G, c, nM;
    __device__ __forceinline__ bool next(int i, Unit& u) const { return static_unit((long)i * G + c, nM, DM / 256, u); }
    __device__ __forceinline__ void a_off(const Unit& u, int, int tid, unsigned (&v)[2][2]) const {
        int R0, C0, R1, C1; stage_rc(tid * 16, R0, C0); stage_rc(tid * 16 + 8192, R1, C1);
#pragma unroll
        for (int h = 0; h < 2; ++h) { v[h][0] = (unsigned)((u.pm * 256 + h * 128 + R0) * KD + C0) * 2u; v[h][1] = (unsigned)((u.pm * 256 + h * 128 + R1) * KD + C1) * 2u; }
    }
    __device__ __forceinline__ const char* a_base(const Unit&) const { return A; }
    __device__ __forceinline__ const char* b_ptr(const Unit& u) const { return Bt + (size_t)u.pn * 256 * KD * 2; }
    __device__ __forceinline__ void epi(const f32x4 (&acc)[2][2][4][2], const Unit& u, int, int wr, int wc, int fr, int fq) const {
        const int r0 = u.pm * 256, br = r0 < TX ? (r0 / SEQ) : NB;
        const float* g1 = modl + (size_t)br * 6 * DM + 2 * DM;
        const int row0 = r0 + wr * 64 + fr, col0 = u.pn * 256 + wc * 32 + 4 * fq;
        f32x4 gv[2][2];
#pragma unroll
        for (int bj = 0; bj < 2; ++bj)
#pragma unroll
            for (int n = 0; n < 2; ++n) gv[bj][n] = *(const f32x4*)(g1 + col0 + bj * 128 + n * 16);
#pragma unroll
        for (int ai = 0; ai < 2; ++ai) {
            f32x4 xv[4][2][2];
#pragma unroll
            for (int m = 0; m < 4; ++m)
#pragma unroll
                for (int bj = 0; bj < 2; ++bj)
#pragma unroll
                    for (int n = 0; n < 2; ++n) xv[m][bj][n] = *(const f32x4*)(X + (size_t)(row0 + ai * 128 + m * 16) * DM + col0 + bj * 128 + n * 16);
#pragma unroll
            for (int m = 0; m < 4; ++m)
#pragma unroll
                for (int bj = 0; bj < 2; ++bj)
#pragma unroll
                    for (int n = 0; n < 2; ++n) *(f32x4*)(X + (size_t)(row0 + ai * 128 + m * 16) * DM + col0 + bj * 128 + n * 16) = xv[m][bj][n] + gv[bj][n] * acc[ai][bj][m][n];
        }
    }
};
__device__ __forceinline__ bool moe_unit(long L, int npn, const volatile LAS int* tp, Unit& u) {
    const int q = (int)(L / npn); if (q >= tp[NE]) return false;
    int e = 0;
#pragma unroll 1
    while (tp[e + 1] <= q) ++e;
    u.e = e; u.pm = q - tp[e]; u.pn = (int)(L % npn); return true;
}
struct ProbGU {
    static constexpr bool PERM = true, FP8 = (MOE_FP8 != 0); static constexpr unsigned EB = FP8 ? 1u : 2u;
    const char* A; const char* Bt  ; unsigned char* ACT; const float* bgu  ; const volatile LAS int* tp; const LAS int* tab; int G, c; int dry; const volatile LAS int* eb;
    __device__ __forceinline__ bool next(int i, Unit& u) const { return i < MAXU && moe_unit((long)i * G + c, 8, tp, u); }
    __device__ __forceinline__ void a_off(const Unit&, int ui, int tid, unsigned (&v)[2][2]) const {
        int R0, C0, R1, C1; stage_rc(tid * 16, R0, C0); stage_rc(tid * 16 + 8192, R1, C1);
#pragma unroll
        for (int h = 0; h < 2; ++h) { const int a0 = tab[ui * 256 + h * 128 + R0], a1 = tab[ui * 256 + h * 128 + R1];
            v[h][0] = (unsigned)(a0 < 0 ? TT : (a0 >> 2)) * (unsigned)KD * EB + (unsigned)C0 * 2u; v[h][1] = (unsigned)(a1 < 0 ? TT : (a1 >> 2)) * (unsigned)KD * EB + (unsigned)C1 * 2u; }
    }
    __device__ __forceinline__ const char* a_base(const Unit&) const { return A; }
    __device__ __forceinline__ const char* b_ptr(const Unit& u) const { return Bt + ((size_t)u.e * 2 * DM + (size_t)u.pn * 256) * KD * EB; }
    __device__ __forceinline__ void epi(const f32x4 (&acc)[2][2][4][2], const Unit& u, int ui, int wr, int wc, int fr, int fq) const {
        if (PROBE_DRY && dry) { asm volatile("" :: "v"(acc[0][0][0][0][0]), "v"(acc[1][1][3][1][3]), "v"(acc[0][1][2][0][1]), "v"(acc[1][0][1][1][2])); return; }
        const int cb = u.pn * 128 + wc * 32 + 8 * fq;
        const float* bg = bgu + (size_t)u.e * 2 * DM + cb; const float* bu = bg + DM;
        const f32x4 bg0 = *(const f32x4*)bg, bg1 = *(const f32x4*)(bg + 4), bu0 = *(const f32x4*)bu, bu1 = *(const f32x4*)(bu + 4);
        const int ebu = eb[u.e] + u.pm * 256;
#pragma unroll
        for (int ai = 0; ai < 2; ++ai)
#pragma unroll
            for (int m = 0; m < 4; ++m) {
                const int a = tab[ui * 256 + ai * 128 + wr * 64 + m * 16 + fr];
                unsigned char* rowp = ACT + ((size_t)(a < 0 ? SLOT_DUMMY : ebu + ai * 128 + wr * 64 + m * 16 + fr) * DM + cb) * EB;
                float o[8];
#pragma unroll
                for (int n = 0; n < 2; ++n) { const f32x4 gb = n ? bg1 : bg0, ub = n ? bu1 : bu0;
#pragma unroll
                    for (int j = 0; j < 4; ++j) { float g = acc[ai][0][m][n][j] * (FP8 ? W8_INV : 1.f) + gb[j], uu = acc[ai][1][m][n][j] * (FP8 ? W8_INV : 1.f) + ub[j];
                        g = fminf(g, 7.f); uu = fminf(fmaxf(uu, -7.f), 7.f);
                        o[n * 4 + j] = g * __builtin_amdgcn_rcpf(1.f + __expf(-1.702f * g)) * (uu + 1.f); } }
                if constexpr (FP8) { u32x2 w; w.x = pk4_fp8(o[0], o[1], o[2], o[3]); w.y = pk4_fp8(o[4], o[5], o[6], o[7]); *(u32x2*)rowp = w; }
                else { u32x4 w; w.x = cvt_pk_bf16(o[0], o[1]); w.y = cvt_pk_bf16(o[2], o[3]); w.z = cvt_pk_bf16(o[4], o[5]); w.w = cvt_pk_bf16(o[6], o[7]); *(u32x4*)rowp = w; } }
    }
};
struct ProbDN {
    static constexpr bool PERM = true, FP8 = (MOE_FP8 != 0); static constexpr unsigned EB = FP8 ? 1u : 2u;
    const char* A; const char* Bt  ; bf16* YB; const float* bdn  ; const float* gate; const volatile LAS int* tp; const LAS int* tab; int G, c; int dry; const volatile LAS int* eb;
    __device__ __forceinline__ bool next(int i, Unit& u) const { return i < MAXU && moe_unit((long)i * G + c, 4, tp, u); }
    __device__ __forceinline__ void a_off(const Unit& u, int, int tid, unsigned (&v)[2][2]) const {
        int R0, C0, R1, C1; stage_rc(tid * 16, R0, C0); stage_rc(tid * 16 + 8192, R1, C1);
        const int r0 = eb[u.e] + u.pm * 256;
#pragma unroll
        for (int h = 0; h < 2; ++h) { v[h][0] = (unsigned)(r0 + h * 128 + R0) * (unsigned)KD * EB + (unsigned)C0 * 2u; v[h][1] = (unsigned)(r0 + h * 128 + R1) * (unsigned)KD * EB + (unsigned)C1 * 2u; }
    }
    __device__ __forceinline__ const char* a_base(const Unit&) const { return A; }
    __device__ __forceinline__ const char* b_ptr(const Unit& u) const { return Bt + ((size_t)u.e * DM + (size_t)u.pn * 256) * KD * EB; }
    __device__ __forceinline__ void epi(const f32x4 (&acc)[2][2][4][2], const Unit& u, int ui, int wr, int wc, int fr, int fq) const {
        if (PROBE_DRY && dry) { asm volatile("" :: "v"(acc[0][0][0][0][0]), "v"(acc[1][1][3][1][3]), "v"(acc[0][1][2][0][1]), "v"(acc[1][0][1][1][2])); return; }
        const int col0 = u.pn * 256 + wc * 32 + 8 * fq;
        const float* bd = bdn + (size_t)u.e * DM + col0;
        f32x4 bv[2][2];
#pragma unroll
        for (int bj = 0; bj < 2; ++bj)
#pragma unroll
            for (int n = 0; n < 2; ++n) bv[bj][n] = *(const f32x4*)(bd + bj * 128 + 4 * n);
        int ar[2][4], sl[2][4]; float gt[2][4]; const int ebu = eb[u.e] + u.pm * 256;
#pragma unroll
        for (int ai = 0; ai < 2; ++ai)
#pragma unroll
            for (int m = 0; m < 4; ++m) { const int a = tab[ui * 256 + ai * 128 + wr * 64 + m * 16 + fr]; ar[ai][m] = a < 0 ? NASG : a; sl[ai][m] = a < 0 ? SLOT_DUMMY : ebu + ai * 128 + wr * 64 + m * 16 + fr; }
#pragma unroll
        for (int ai = 0; ai < 2; ++ai)
#pragma unroll
            for (int m = 0; m < 4; ++m) gt[ai][m] = gate[ar[ai][m]];
#pragma unroll
        for (int ai = 0; ai < 2; ++ai)
#pragma unroll
            for (int m = 0; m < 4; ++m) {
                bf16* rowp = YB + (size_t)sl[ai][m] * DM + col0;
#pragma unroll
                for (int bj = 0; bj < 2; ++bj) { const f32x4 v0 = (acc[ai][bj][m][0] * (FP8 ? W8_INV : 1.f) + bv[bj][0]) * gt[ai][m], v1 = (acc[ai][bj][m][1] * (FP8 ? W8_INV : 1.f) + bv[bj][1]) * gt[ai][m];
                    u32x4 w; w.x = cvt_pk_bf16(v0[0], v0[1]); w.y = cvt_pk_bf16(v0[2], v0[3]); w.z = cvt_pk_bf16(v1[0], v1[1]); w.w = cvt_pk_bf16(v1[2], v1[3]);
                    *(u32x4*)(rowp + bj * 128) = w; } }
    }
};
}

struct Args { const float* in[23]; float* out; unsigned char* ws; int ph_lo, ph_hi; };
struct Frame {
    LAS unsigned char* lds; volatile LAS unsigned* MISC;
    int tid, lane, wave, G, vcu;
    const float *x, *c, *ctx, *c_ctx, *norm1_g, *norm2_g, *w_ada, *b_ada, *w_in, *gla_wa2, *gla_ba, *gla_norm_g, *na_rpb, *pool_w, *pool_scale, *w_out, *router_w, *router_b, *w_gu, *b_gu, *w_down, *b_down, *final_g;
    float* out; unsigned char* ws; unsigned* ctl;
    float* mod; bf16 *Bin, *Bout, *Bgu, *Bdn; float* X; bf16 *H, *P, *VTX, *VTC, *MIX; float *OF, *OB; bf16 *ACT, *YB; int* LIST; float* GATE; float *DS, *GD, *ROPE; bf16 *VTA, *OPS, *STB; unsigned char* H8; int* INV;
};


#define CAS __attribute__((address_space(4)))
__device__ __forceinline__ void frame_ptrs(Frame& F) {
    const CAS unsigned char* ka = (const CAS unsigned char*)__builtin_amdgcn_kernarg_segment_ptr();
    asm volatile("" : "+s"(ka));
    typedef const GAS float* gfp;
    const CAS gfp* in = (const CAS gfp*)ka;
    F.x = (const float*)in[0]; F.c = (const float*)in[1]; F.ctx = (const float*)in[2]; F.c_ctx = (const float*)in[3]; F.norm1_g = (const float*)in[4]; F.norm2_g = (const float*)in[5];
    F.w_ada = (const float*)in[6]; F.b_ada = (const float*)in[7]; F.w_in = (const float*)in[8]; F.gla_wa2 = (const float*)in[9]; F.gla_ba = (const float*)in[10]; F.gla_norm_g = (const float*)in[11];
    F.na_rpb = (const float*)in[12]; F.pool_w = (const float*)in[13]; F.pool_scale = (const float*)in[14]; F.w_out = (const float*)in[15]; F.router_w = (const float*)in[16]; F.router_b = (const float*)in[17];
    F.w_gu = (const float*)in[18]; F.b_gu = (const float*)in[19]; F.w_down = (const float*)in[20]; F.b_down = (const float*)in[21]; F.final_g = (const float*)in[22];
    F.out = (float*)*(GAS float* const CAS*)(ka + 184);
    GAS unsigned char* ws = *(GAS unsigned char* const CAS*)(ka + 192);
    F.ws = (unsigned char*)ws; F.ctl = (unsigned*)(ws + WS_CTL);
    F.mod = (float*)(ws + WS_MOD); F.Bin = (bf16*)(ws + WS_BIN); F.Bout = (bf16*)(ws + WS_BOUT); F.Bgu = (bf16*)(ws + WS_BGU); F.Bdn = (bf16*)(ws + WS_BDN);
    F.X = (float*)(ws + WS_X); F.H = (bf16*)(ws + WS_H); F.P = (bf16*)(ws + WS_P); F.VTX = (bf16*)(ws + WS_VTX); F.VTC = (bf16*)(ws + WS_VTC); F.MIX = (bf16*)(ws + WS_MIX);
    F.OF = (float*)(ws + WS_OF); F.OB = (float*)(ws + WS_OB); F.ACT = (bf16*)(ws + WS_ACT); F.YB = (bf16*)(ws + WS_YB); F.LIST = (int*)(ws + WS_LIST); F.GATE = (float*)(ws + WS_GATE);
    F.DS = (float*)(ws + WS_DS); F.GD = (float*)(ws + WS_GD); F.ROPE = (float*)(ws + WS_ROPE); F.VTA = (bf16*)(ws + WS_VTA); F.OPS = (bf16*)(ws + WS_OPS); F.STB = (bf16*)(ws + WS_STB); F.H8 = (unsigned char*)(ws + WS_H8); F.INV = (int*)(ws + WS_INV);
}
static_assert(offsetof(Args, out) == 184 && offsetof(Args, ws) == 192, "Args layout");

__device__ __forceinline__ void transpose_item(const float* W, int N, bf16* WT, int n0, int dst_row0, int k0, float scale, LAS float* scr, int lane) {
#pragma unroll 8
    for (int i = 0; i < 32; ++i) { const int kk = 2 * i + (lane >> 5); scr[kk * 33 + (lane & 31)] = W[(size_t)(k0 + kk) * N + n0 + (lane & 31)]; }
    LDS_WAIT(); asm volatile("" ::: "memory");
    const int c = lane & 7;
#pragma unroll
    for (int j = 0; j < 4; ++j) { const int n = (lane >> 3) + 8 * j; const LAS float* s = scr + (8 * c) * 33 + n;
        u32x4 o; o.x = pk2(s[0 * 33] * scale, s[1 * 33] * scale); o.y = pk2(s[2 * 33] * scale, s[3 * 33] * scale); o.z = pk2(s[4 * 33] * scale, s[5 * 33] * scale); o.w = pk2(s[6 * 33] * scale, s[7 * 33] * scale);
        *(u32x4*)(WT + (size_t)(dst_row0 + n) * DM + k0 + 8 * c) = o; }
    LDS_WAIT(); asm volatile("" ::: "memory");
}
__device__ __forceinline__ void transpose_item_fp8(const float* W, int N, unsigned char* WT, int n0, int dst_row0, int k0, LAS float* scr, int lane) {
#pragma unroll 8
    for (int i = 0; i < 32; ++i) { const int kk = 2 * i + (lane >> 5); scr[kk * 33 + (lane & 31)] = W[(size_t)(k0 + kk) * N + n0 + (lane & 31)]; }
    LDS_WAIT(); asm volatile("" ::: "memory");
    const int c = lane & 3;
#pragma unroll
    for (int j = 0; j < 2; ++j) { const int n = (lane >> 2) + 16 * j; const LAS float* s = scr + (16 * c) * 33 + n;
        u32x4 o;
        o.x = pk4_fp8(s[0 * 33] * W8_SCALE, s[1 * 33] * W8_SCALE, s[2 * 33] * W8_SCALE, s[3 * 33] * W8_SCALE); o.y = pk4_fp8(s[4 * 33] * W8_SCALE, s[5 * 33] * W8_SCALE, s[6 * 33] * W8_SCALE, s[7 * 33] * W8_SCALE);
        o.z = pk4_fp8(s[8 * 33] * W8_SCALE, s[9 * 33] * W8_SCALE, s[10 * 33] * W8_SCALE, s[11 * 33] * W8_SCALE); o.w = pk4_fp8(s[12 * 33] * W8_SCALE, s[13 * 33] * W8_SCALE, s[14 * 33] * W8_SCALE, s[15 * 33] * W8_SCALE);
        *(u32x4*)(WT + (size_t)(dst_row0 + n) * DM + k0 + 16 * c) = o; }
    LDS_WAIT(); asm volatile("" ::: "memory");
}
__device__ __forceinline__ void in_col_map(int n0, int& dst, float& scale) {
    scale = 1.f;
    if (n0 < 192) { dst = C_GQ + n0; scale = 0.14433756729740643f; }
    else if (n0 < 384) dst = C_GK + (n0 - 192);
    else if (n0 < 768) dst = C_GV + (n0 - 384);
    else if (n0 < 800) dst = C_AF + (n0 - 768);
    else if (n0 < 1184) dst = C_GG + (n0 - 800);
    else if (n0 < 1568) { dst = C_NAQ + (n0 - 1184); scale = 0.125f; }
    else if (n0 < 1952) dst = C_NAK + (n0 - 1568);
    else if (n0 < 2336) dst = C_NAV + (n0 - 1952);
    else dst = C_POOL + (n0 - 2336);
}
struct TItem { const float* src; int N; unsigned char* dst; int fp8; float scale; };
__device__ __forceinline__ TItem titem_decode(const Frame& F, int r) {
    constexpr int I_IN = DEPTH * 16 * 81, I_OUT = DEPTH * 16 * 32, I_GU = DEPTH * NE * 16 * 64;
    TItem t; t.fp8 = 0; t.scale = 1.f;
    if (r < I_IN) { const int l = r / (16 * 81), rr = r % (16 * 81), kb = rr / 81, nb = rr % 81; int dst; in_col_map(nb * 32, dst, t.scale);
        t.N = 2592; t.src = F.w_in + (size_t)l * DM * 2592 + (size_t)(kb * 64) * 2592 + nb * 32; t.dst = (unsigned char*)(F.Bin + ((size_t)l * NP + dst) * DM + kb * 64); return t; }
    r -= I_IN;
    if (r < I_OUT) { const int l = r / (16 * 32), rr = r % (16 * 32), kb = rr / 32, nb = rr % 32;
        t.N = DM; t.src = F.w_out + (size_t)l * DM * DM + (size_t)(kb * 64) * DM + nb * 32; t.dst = (unsigned char*)(F.Bout + ((size_t)l * DM + nb * 32) * DM + kb * 64); return t; }
    r -= I_OUT; t.fp8 = MOE_FP8; constexpr size_t EB = MOE_FP8 ? 1 : 2;
    if (r < I_GU) { const int le = r / (16 * 64), rr = r % (16 * 64), kb = rr / 64, nb = rr % 64; const int j0 = nb * 32;
        const int dst = j0 < DM ? (j0 / 128) * 256 + (j0 % 128) : ((j0 - DM) / 128) * 256 + 128 + ((j0 - DM) % 128);
        t.N = 2 * DM; t.src = F.w_gu + (size_t)le * DM * 2 * DM + (size_t)(kb * 64) * 2 * DM + j0; t.dst = (unsigned char*)F.Bgu + (((size_t)le * 2 * DM + dst) * DM + kb * 64) * EB; return t; }
    r -= I_GU;
    { const int le = r / (16 * 32), rr = r % (16 * 32), kb = rr / 32, nb = rr % 32;
        t.N = DM; t.src = F.w_down + (size_t)le * DM * DM + (size_t)(kb * 64) * DM + nb * 32; t.dst = (unsigned char*)F.Bdn + (((size_t)le * DM + nb * 32) * DM + kb * 64) * EB; return t; }
}
__device__ __forceinline__ void titem_load(const TItem& t, int lane, f32x4 (&r)[8]) {
#pragma unroll
    for (int i = 0; i < 8; ++i) r[i] = *(const f32x4*)(t.src + (size_t)((lane >> 3) + 8 * i) * t.N + 4 * (lane & 7));
}
__device__ __forceinline__ void titem_store(const TItem& t, const f32x4 (&r)[8], LAS float* scr, int lane) {
#pragma unroll
    for (int i = 0; i < 8; ++i) { LAS float* p = scr + ((lane >> 3) + 8 * i) * 33 + 4 * (lane & 7); p[0] = r[i].x; p[1] = r[i].y; p[2] = r[i].z; p[3] = r[i].w; }
    LDS_WAIT(); asm volatile("" ::: "memory");
    if (t.fp8) { const int c = lane & 3; const float sc = W8_SCALE;
#pragma unroll
        for (int j = 0; j < 2; ++j) { const int n = (lane >> 2) + 16 * j; const LAS float* s = scr + (16 * c) * 33 + n;
            u32x4 o;
            o.x = pk4_fp8(s[0 * 33] * sc, s[1 * 33] * sc, s[2 * 33] * sc, s[3 * 33] * sc); o.y = pk4_fp8(s[4 * 33] * sc, s[5 * 33] * sc, s[6 * 33] * sc, s[7 * 33] * sc);
            o.z = pk4_fp8(s[8 * 33] * sc, s[9 * 33] * sc, s[10 * 33] * sc, s[11 * 33] * sc); o.w = pk4_fp8(s[12 * 33] * sc, s[13 * 33] * sc, s[14 * 33] * sc, s[15 * 33] * sc);
            *(u32x4*)(t.dst + (size_t)n * DM + 16 * c) = o; }
    } else { const int c = lane & 7; const float sc = t.scale;
#pragma unroll
        for (int j = 0; j < 4; ++j) { const int n = (lane >> 3) + 8 * j; const LAS float* s = scr + (8 * c) * 33 + n;
            u32x4 o; o.x = pk2(s[0 * 33] * sc, s[1 * 33] * sc); o.y = pk2(s[2 * 33] * sc, s[3 * 33] * sc); o.z = pk2(s[4 * 33] * sc, s[5 * 33] * sc); o.w = pk2(s[6 * 33] * sc, s[7 * 33] * sc);
            *(u32x4*)(t.dst + ((size_t)n * DM + 8 * c) * 2) = o; }
    }
    LDS_WAIT(); asm volatile("" ::: "memory");
}
__device__ __forceinline__ int conv_item_id(int t, int lay, int nfix) {
    constexpr int I_IN = DEPTH * 16 * 81, I_OUT = DEPTH * 16 * 32, I_GU = DEPTH * NE * 16 * 64;
    if (t < nfix) return t;
    t -= nfix;
    return t < NE * 16 * 64 ? I_IN + I_OUT + lay * (NE * 16 * 64) + t : I_IN + I_OUT + I_GU + lay * (NE * 16 * 32) + (t - NE * 16 * 64);
}
__device__ __forceinline__ void convert_items(Frame& F, int lay, int ntot, int t0 = 0, int t1 = -1) {
    LAS float* scr = (LAS float*)(F.lds + F.wave * 16384);
    const int gw = F.vcu * NWAVES + F.wave, NGW = F.G * NWAVES, lane = F.lane;
    const int nfix = ntot - 3 * (NE * 16 * 32);
    if (t1 >= 0) ntot = t1;
    int it = t0 + gw; TItem cur = titem_decode(F, conv_item_id(it < ntot ? it : 0, lay, nfix)); f32x4 ra[8];
    if (it < ntot) titem_load(cur, lane, ra);
    while (it < ntot) {
        const int itn = it + NGW; const bool hn = itn < ntot;
        TItem nxt = titem_decode(F, conv_item_id(hn ? itn : 0, lay, nfix)); f32x4 rb[8];
        if (hn) titem_load(nxt, lane, rb);
        titem_store(cur, ra, scr, lane);
        it = itn; cur = nxt;
#pragma unroll
        for (int i = 0; i < 8; ++i) ra[i] = rb[i];
    }
}
__device__ __forceinline__ void ph_prologue(Frame& F) {
    const int gw = F.vcu * NWAVES + F.wave, NGW = F.G * NWAVES, lane = F.lane;
    constexpr int I_IN = DEPTH * 16 * 81, I_OUT = DEPTH * 16 * 32;
    for (int r = F.vcu; r < DEPTH * 24; r += F.G) {
        const int l = r / 24, j4 = (r % 24) * 256 + 4 * lane, k0 = F.wave * 128;
        const float* W = F.w_ada + (size_t)l * DM * 6 * DM + (size_t)k0 * 6 * DM + j4;
        f32x4 acc[9];
#pragma unroll
        for (int q = 0; q < 9; ++q) acc[q] = (f32x4){0.f, 0.f, 0.f, 0.f};
#pragma unroll 1
        for (int kh = 0; kh < 2; ++kh) {
            float cv[9];
#pragma unroll
            for (int q = 0; q < 8; ++q) cv[q] = silu_f(F.c[q * DM + k0 + 64 * kh + lane]);
            cv[8] = silu_f(F.c_ctx[k0 + 64 * kh + lane]);
#pragma unroll 8
            for (int kk = 0; kk < 64; ++kk) { const f32x4 w = *(const f32x4*)(W + (size_t)(64 * kh + kk) * 6 * DM);
#pragma unroll
                for (int q = 0; q < 9; ++q) acc[q] += __builtin_bit_cast(float, __builtin_amdgcn_readlane(__builtin_bit_cast(int, cv[q]), kk)) * w; }
        }
        LAS float* part = (LAS float*)F.lds;
#pragma unroll
        for (int q = 0; q < 9; ++q) *(LAS f32x4*)(part + (F.wave * 9 + q) * 256 + 4 * lane) = acc[q];
        __syncthreads();
        for (int o = F.tid; o < 9 * 256; o += NTHREADS) { const int q = o >> 8, cc = o & 255; float sum = F.b_ada[(size_t)l * 6 * DM + (r % 24) * 256 + cc];
#pragma unroll
            for (int w = 0; w < NWAVES; ++w) sum += part[(w * 9 + q) * 256 + cc];
            F.mod[((size_t)l * 9 + q) * 6 * DM + (r % 24) * 256 + cc] = sum; }
        __syncthreads();
    }
    convert_items(F, 0, I_IN + I_OUT + 3 * (NE * 16 * 32), 0, I_IN + I_OUT);
#if GLA_CHECK
    for (int lay = 0; lay < DEPTH; ++lay) convert_items(F, lay, 3 * (NE * 16 * 32));
#endif
    if (F.vcu == 0) for (int i = F.tid; i < 64 * 12; i += NTHREADS) { const int pos = i / 12, fi = i % 12;
        const float invf = expf(-((float)(2 * fi) / 24.f) * 9.210340371976184f); const float ang = (float)pos * invf; F.ROPE[i] = cosf(ang); F.ROPE[768 + i] = sinf(ang); }
    const size_t gt = (size_t)F.vcu * NTHREADS + F.tid, NGT = (size_t)F.G * NTHREADS;
    for (size_t i = gt; i < (size_t)DEPTH * 224 * DM / 8; i += NGT) { const size_t l = i / (224 * DM / 8), rr = i % (224 * DM / 8);
        *(u32x4*)(F.Bin + (l * NP + 2592) * DM + rr * 8) = (u32x4){0u, 0u, 0u, 0u}; }
    for (size_t i = gt; i < (size_t)256 * DM / 8; i += NGT) *(u32x4*)(F.H + (size_t)TT * DM + i * 8) = (u32x4){0u, 0u, 0u, 0u};
    for (size_t i = gt; i < (size_t)256 * DM / 16; i += NGT) *(u32x4*)(F.H8 + (size_t)TT * DM + i * 16) = (u32x4){0u, 0u, 0u, 0u};
}

__device__ __forceinline__ void norm_mod_store(const f32x4 (&v)[4], const float* gw, const float* sc, const float* sh, bf16* orow, int lane) {
    float s = 0.f;
#pragma unroll
    for (int j = 0; j < 4; ++j) s += (v[j].x * v[j].x + v[j].y * v[j].y) + (v[j].z * v[j].z + v[j].w * v[j].w);
    const float rinv = 1.f / sqrtf(wave_sum(s) * (1.f / DM) + EPS);
#pragma unroll
    for (int j = 0; j < 4; ++j) { const int c = 4 * lane + 256 * j;
        const f32x4 g = *(const f32x4*)(gw + c), a = *(const f32x4*)(sc + c), b = *(const f32x4*)(sh + c);
        const f32x4 y = (v[j] * rinv * g) * (a + 1.f) + b;
        u32x2 w; w.x = pk2(y.x, y.y); w.y = pk2(y.z, y.w);
        *(u32x2*)(orow + c) = w; }
}
__device__ __forceinline__ void ph_first_norm(Frame& F) {
    const int gw = F.vcu * NWAVES + F.wave, NGW = F.G * NWAVES, lane = F.lane;
    for (int m = gw; m < TT; m += NGW) {
        const float* src = m < TX ? F.x + (size_t)m * DM : F.ctx + (size_t)(m - TX) * DM;
        const int br = m < TX ? m / SEQ : NB;
        f32x4 v[4];
#pragma unroll
        for (int j = 0; j < 4; ++j) { v[j] = *(const f32x4*)(src + 4 * lane + 256 * j); *(f32x4*)(F.X + (size_t)m * DM + 4 * lane + 256 * j) = v[j]; }
        const float* md = F.mod + (size_t)br * 6 * DM;
        norm_mod_store(v, F.norm1_g, md + DM, md, F.H + (size_t)m * DM, lane);
    }
}
__device__ __forceinline__ void ph_combine(Frame& F, int l, bool dry = false) {
    const int gw = F.vcu * NWAVES + F.wave, NGW = F.G * NWAVES, lane = F.lane;
    float* Xo = dry ? (float*)F.ACT : F.X; bf16* Ho = dry ? (bf16*)F.P : F.H; float* Oo = dry ? (float*)F.ACT : F.out;
    const int M = (l == DEPTH - 1) ? TX : TT;
    const int cA = 8 * lane, cB = 512 + 8 * lane;
    for (int m0 = gw; m0 < M; m0 += 2 * NGW) {
        u32x4 yw[2][4][2]; f32x4 xv[2][4]; bool have[2]; int br[2];
#pragma unroll
        for (int rr = 0; rr < 2; ++rr) { const int m = m0 + rr * NGW; have[rr] = m < M; const int mm = have[rr] ? m : m0; br[rr] = mm < TX ? mm / SEQ : NB;
            const u32x4 sl4 = *(const u32x4*)(F.INV + (size_t)mm * 4); const unsigned slk[4] = {sl4.x, sl4.y, sl4.z, sl4.w};
#pragma unroll
            for (int k = 0; k < 4; ++k) { yw[rr][k][0] = *(const u32x4*)(F.YB + (size_t)slk[k] * DM + cA); yw[rr][k][1] = *(const u32x4*)(F.YB + (size_t)slk[k] * DM + cB); }
            const float* xr = F.X + (size_t)mm * DM;
            xv[rr][0] = *(const f32x4*)(xr + cA); xv[rr][1] = *(const f32x4*)(xr + cA + 4); xv[rr][2] = *(const f32x4*)(xr + cB); xv[rr][3] = *(const f32x4*)(xr + cB + 4); }
#pragma unroll
        for (int rr = 0; rr < 2; ++rr) { if (!have[rr]) continue;
            const int m = m0 + rr * NGW;
            const float* md = F.mod + ((size_t)l * 9 + br[rr]) * 6 * DM;
            f32x4 y[4];
#pragma unroll
            for (int j = 0; j < 4; ++j) y[j] = (f32x4){0.f, 0.f, 0.f, 0.f};
#pragma unroll
            for (int k = 0; k < 4; ++k) { const u32x4 a = yw[rr][k][0], b = yw[rr][k][1];
                y[0] += (f32x4){bflo(a.x), bfhi(a.x), bflo(a.y), bfhi(a.y)}; y[1] += (f32x4){bflo(a.z), bfhi(a.z), bflo(a.w), bfhi(a.w)};
                y[2] += (f32x4){bflo(b.x), bfhi(b.x), bflo(b.y), bfhi(b.y)}; y[3] += (f32x4){bflo(b.z), bfhi(b.z), bflo(b.w), bfhi(b.w)}; }
            const int cc[4] = {cA, cA + 4, cB, cB + 4};
            f32x4 v[4]; float ss = 0.f;
#pragma unroll
            for (int j = 0; j < 4; ++j) { v[j] = xv[rr][j] + *(const f32x4*)(md + 5 * DM + cc[j]) * y[j]; ss += (v[j].x * v[j].x + v[j].y * v[j].y) + (v[j].z * v[j].z + v[j].w * v[j].w); }
            const float rinv = 1.f / sqrtf(wave_sum(ss) * (1.f / DM) + EPS);
            if (l < DEPTH - 1) {
#pragma unroll
                for (int j = 0; j < 4; ++j) *(f32x4*)(Xo + (size_t)m * DM + cc[j]) = v[j];
                const float* mn = F.mod + ((size_t)(l + 1) * 9 + br[rr]) * 6 * DM; const float* gw1 = F.norm1_g + (size_t)(l + 1) * DM;
                f32x4 h[4];
#pragma unroll
                for (int j = 0; j < 4; ++j) h[j] = (v[j] * rinv * *(const f32x4*)(gw1 + cc[j])) * (*(const f32x4*)(mn + DM + cc[j]) + 1.f) + *(const f32x4*)(mn + cc[j]);
                u32x4 w0, w1; w0.x = pk2(h[0].x, h[0].y); w0.y = pk2(h[0].z, h[0].w); w0.z = pk2(h[1].x, h[1].y); w0.w = pk2(h[1].z, h[1].w);
                w1.x = pk2(h[2].x, h[2].y); w1.y = pk2(h[2].z, h[2].w); w1.z = pk2(h[3].x, h[3].y); w1.w = pk2(h[3].z, h[3].w);
                *(u32x4*)(Ho + (size_t)m * DM + cA) = w0; *(u32x4*)(Ho + (size_t)m * DM + cB) = w1;
            } else {
#pragma unroll
                for (int j = 0; j < 4; ++j) { f32x4 o = v[j] * rinv * *(const f32x4*)(F.final_g + cc[j]);
#if GLA_CHECK
                    if (__hip_atomic_load(F.ctl + 64, __ATOMIC_RELAXED, __HIP_MEMORY_SCOPE_AGENT) != 0u) { const float q = __builtin_nanf(""); o = (f32x4){q, q, q, q}; }
#endif
                    *(f32x4*)(Oo + (size_t)m * DM + cc[j]) = o; }
            }
        }
    }
}

__device__ __forceinline__ void vt_unit(Frame& F, int u) {
    LAS bf16* t = (LAS bf16*)(F.lds + F.wave * 9216);
    const int lane = F.lane;
    int b, h, tb, rowbase, tlen; bf16* dst;
    if (u < NB * NH * 64) { tb = u & 63; h = (u >> 6) % NH; b = u / (64 * NH); rowbase = b * SEQ + tb * 64; tlen = SEQ; dst = F.VTX + ((size_t)(b * NH + h) * NDH) * SEQ + tb * 64; }
    else { const int v = u - NB * NH * 64; tb = v & 3; h = (v >> 2) % NH; b = v / (4 * NH); rowbase = TX + b * CTXL + tb * 64; tlen = CTXL; dst = F.VTC + ((size_t)(b * NH + h) * NDH) * CTXL + tb * 64; }
#pragma unroll
    for (int i = 0; i < 8; ++i) { const int tok = (lane >> 3) + 8 * i, ch = lane & 7;
        const bf16x8 v = *(const bf16x8*)(F.P + (size_t)(rowbase + tok) * NP + C_NAV + h * NDH + ch * 8);
#pragma unroll
        for (int e = 0; e < 8; ++e) t[(ch * 8 + e) * 72 + tok] = (bf16)v[e]; }
    LDS_WAIT(); asm volatile("" ::: "memory");
#pragma unroll
    for (int i = 0; i < 8; ++i) { const int d = (lane >> 3) + 8 * i, ch = lane & 7;
        *(bf16x8*)(dst + (size_t)d * tlen + ch * 8) = *(const LAS bf16x8*)(t + d * 72 + ch * 8); }
    LDS_WAIT(); asm volatile("" ::: "memory");
}
constexpr int PL_U = 0, PL_P = 49152, PL_LD = 264, PREP_PW = 81920, PW_LD = 72, PREP_PS = PREP_PW + 4 * 64 * PW_LD * 2;
static_assert(PREP_PS + 1024 <= STAGE_BYTES && PL_P + 32 * PL_LD * 2 <= PREP_PW, "pool LDS map");
__device__ __forceinline__ void pool_unit(Frame& F, int l, int u) {
    LAS float* U = (LAS float*)(F.lds + PL_U);
    LAS bf16* PL = (LAS bf16*)(F.lds + PL_P);
    const LAS bf16* PW = (const LAS bf16*)(F.lds + PREP_PW); const LAS float* PS = (const LAS float*)(F.lds + PREP_PS);
    const int tid = F.tid;
    int s, tb, seqbase, tlen;
    if (u < NB * 128) { s = u / 128; tb = u % 128; seqbase = s * SEQ; tlen = SEQ; } else { const int v = u - NB * 128; s = v / 8; tb = v % 8; seqbase = TX + s * CTXL; tlen = CTXL; }
    const int t0 = tb * 32;
    for (int i = tid; i < 48 * 32; i += NTHREADS) { const int rr = i / 32, ch = i % 32, t = t0 - 8 + rr;
        f32x4 a = (f32x4){0.f, 0.f, 0.f, 0.f}, b = a;
        if (t >= 0 && t < tlen) { const u32x4 w = *(const u32x4*)(F.P + (size_t)(seqbase + t) * NP + C_POOL + ch * 8);
            a = (f32x4){bflo(w.x), bfhi(w.x), bflo(w.y), bfhi(w.y)}; b = (f32x4){bflo(w.z), bfhi(w.z), bflo(w.w), bfhi(w.w)}; }
        *(LAS f32x4*)(U + rr * 256 + ch * 8) = a; *(LAS f32x4*)(U + rr * 256 + ch * 8 + 4) = b; }
    __syncthreads();
    { const int tt = tid >> 4, cg = tid & 15, g = cg >> 2, w = 2 << g, t = t0 + tt;
      int lo = t - w / 2; if (lo < 0) lo = 0; int hi = t + w - w / 2; if (hi > tlen) hi = tlen;
      const float inv = 1.f / (float)(hi - lo);
      f32x4 sum[4];
#pragma unroll
      for (int q4 = 0; q4 < 4; ++q4) sum[q4] = (f32x4){0.f, 0.f, 0.f, 0.f};
      for (int jj = lo; jj < hi; ++jj) {
#pragma unroll
          for (int q4 = 0; q4 < 4; ++q4) sum[q4] += *(const LAS f32x4*)(U + (jj - t0 + 8) * 256 + cg * 16 + 4 * q4); }
      u32x4 w0, w1;
      { const f32x4 y0 = sum[0] * inv - *(const LAS f32x4*)(U + (tt + 8) * 256 + cg * 16), y1 = sum[1] * inv - *(const LAS f32x4*)(U + (tt + 8) * 256 + cg * 16 + 4);
        const f32x4 y2 = sum[2] * inv - *(const LAS f32x4*)(U + (tt + 8) * 256 + cg * 16 + 8), y3 = sum[3] * inv - *(const LAS f32x4*)(U + (tt + 8) * 256 + cg * 16 + 12);
        w0.x = pk2(y0.x, y0.y); w0.y = pk2(y0.z, y0.w); w0.z = pk2(y1.x, y1.y); w0.w = pk2(y1.z, y1.w);
        w1.x = pk2(y2.x, y2.y); w1.y = pk2(y2.z, y2.w); w1.z = pk2(y3.x, y3.y); w1.w = pk2(y3.z, y3.w); }
      *(LAS u32x4*)(PL + tt * PL_LD + cg * 16) = w0; *(LAS u32x4*)(PL + tt * PL_LD + cg * 16 + 8) = w1; }
    __syncthreads();
    { const int lane = F.lane, q = lane & 15, g4 = lane >> 4;
#pragma unroll
      for (int k = 0; k < 4; ++k) { const int ti = F.wave * 4 + k, mt = ti & 1, ct = ti >> 1, g = ct >> 2, ot = ct & 3;
          f32x4 acc = (f32x4){0.f, 0.f, 0.f, 0.f};
#pragma unroll
          for (int s2 = 0; s2 < 2; ++s2) { const bf16x8 a = *(const LAS bf16x8*)(PW + (g * 64 + 16 * ot + q) * PW_LD + 32 * s2 + 8 * g4), b = *(const LAS bf16x8*)(PL + (16 * mt + q) * PL_LD + g * 64 + 32 * s2 + 8 * g4);
              acc = __builtin_amdgcn_mfma_f32_16x16x32_bf16(a, b, acc, 0, 0, 0); }
          const f32x4 y = acc * *(const LAS f32x4*)(PS + g * 64 + 16 * ot + 4 * g4);
          u32x2 w; w.x = pk2(y.x, y.y); w.y = pk2(y.z, y.w);
          *(u32x2*)(F.MIX + (size_t)(seqbase + t0 + 16 * mt + q) * DM + 768 + g * 64 + 16 * ot + 4 * g4) = w; } }
    __syncthreads();
}
__device__ __forceinline__ void gla_chain(Frame& F, int l, int u) {
    const int tid = F.tid;
    const int dir = u & 1, hh = (u >> 1) & 3, b = u >> 3;
    LAS float* qs = (LAS float*)F.lds;
    LAS float* ks = qs + 64 * 48;
    LAS float* as = ks + 64 * 48;
    LAS float* vs = as + 64 * 48;
    LAS float* os = vs + 64 * 96;
    LAS float* rc = os + 64 * 96;
    LAS float* rs = rc + 64 * 12;
    LAS float* wa = rs + 64 * 12;
    LAS float* ba = wa + 16 * 48;
    for (int i = tid; i < 64 * 12; i += NTHREADS) { const int pos = i / 12, fi = i % 12;
        const float invf = expf(-((float)(2 * fi) / 24.f) * 9.210340371976184f);
        const float ang = (float)pos * invf; rc[i] = cosf(ang); rs[i] = sinf(ang); }
    for (int i = tid; i < 16 * 48; i += NTHREADS) { const int r = i / 48, d = i % 48; wa[i] = F.gla_wa2[(((size_t)l * 2 + dir) * 16 + r) * 192 + hh * 48 + d]; }
    if (tid < 48) ba[tid] = F.gla_ba[((size_t)l * 2 + dir) * 192 + hh * 48 + tid];
    __syncthreads();
    float S[12];
#pragma unroll
    for (int i = 0; i < 12; ++i) S[i] = 0.f;
    const int vv = tid >> 2, dg = tid & 3;
    float* Odir = dir ? F.OB : F.OF;
    const bool need_ctx = l < DEPTH - 1;
    for (int cidx = 0; cidx < 4 + 64; ++cidx) {
        const bool isctx = cidx < 4;
        const int nch = isctx ? 4 : 64, ci0 = isctx ? cidx : cidx - 4, ci = dir ? (nch - 1 - ci0) : ci0;
        const int seqbase = isctx ? TX + b * CTXL : b * SEQ, t0 = ci * 64;
        for (int i = tid; i < 64 * 2 * 2 * 12; i += NTHREADS) {
            const int fi = i % 12, hf = (i / 12) & 1, isk = (i / 24) & 1, j = i / 48;
            const bf16* row = F.P + (size_t)(seqbase + t0 + j) * NP + (isk ? C_GK : C_GQ) + hh * 48 + hf * 24;
            const float x1 = bf2f(row[fi]), x2 = bf2f(row[12 + fi]);
            float o1 = x1, o2 = x2;
            if (!isctx) { const int t = t0 + j, pos = hf ? (t % GRIDW) : (t / GRIDW); const float cs = rc[pos * 12 + fi], sn = rs[pos * 12 + fi]; o1 = x1 * cs - x2 * sn; o2 = x1 * sn + x2 * cs; }
            LAS float* dst = (isk ? ks : qs) + j * 48 + hf * 24;
            dst[fi] = o1; dst[12 + fi] = o2; }
        for (int i = tid; i < 64 * 48; i += NTHREADS) { const int j = i / 48, d = i % 48;
            const bf16* row = F.P + (size_t)(seqbase + t0 + j) * NP + (dir ? C_AB : C_AF);
            float z = ba[d];
#pragma unroll
            for (int r = 0; r < 16; ++r) z += bf2f(row[r]) * wa[r * 48 + d];
            const float ls = fminf(z, 0.f) - log1pf(expf(-fabsf(z)));
            as[i] = expf(ls * (1.f / 16.f)); }
        for (int i = tid; i < 64 * 96; i += NTHREADS) { const int j = i / 96, d = i % 96; vs[i] = bf2f(F.VTA[(size_t)(384 + hh * 96 + d) * VTS + seqbase + t0 + j]); }
        __syncthreads();
        if (tid < 384) {
            for (int st = 0; st < 64; ++st) {
                const int j = dir ? 63 - st : st;
                const float vj = vs[j * 96 + vv];
                float part = 0.f;
#pragma unroll
                for (int q4 = 0; q4 < 3; ++q4) {
                    const f32x4 a4 = *(const LAS f32x4*)(as + j * 48 + dg * 12 + q4 * 4), k4 = *(const LAS f32x4*)(ks + j * 48 + dg * 12 + q4 * 4), qq = *(const LAS f32x4*)(qs + j * 48 + dg * 12 + q4 * 4);
#pragma unroll
                    for (int e = 0; e < 4; ++e) { const float sn = a4[e] * S[q4 * 4 + e] + k4[e] * vj; S[q4 * 4 + e] = sn; part += qq[e] * sn; } }
                part += __shfl_xor(part, 1); part += __shfl_xor(part, 2);
                if (dg == 0) os[j * 96 + vv] = part;
            }
        }
        __syncthreads();
        if (!isctx || need_ctx)
            for (int i = tid; i < 64 * 96; i += NTHREADS) { const int j = i / 96, d = i % 96; Odir[(size_t)(seqbase + t0 + j) * 384 + hh * 96 + d] = os[i]; }
        __syncthreads();
    }
}

typedef float f32x16 __attribute__((ext_vector_type(16)));
constexpr int GL_BF = 0, GL_BB = 12288, GL_WA = 24576, GL_VT = 31232, GL_KEF = 45056, GL_KEB = 51968;
constexpr int GL_QF = 45056, GL_KF = 52224, GL_QB = 59392, GL_KB = 66560, GL_STF = 73728, GL_STB = 84480, GL_O = 95232;
constexpr int VT_LD = 72, QK_LD = 56, ST_LD = 56, O_LD = 100, NCH = 68;
struct GlaU { int b, hh, cpos, seqbase, t0, isctx; };
__device__ __forceinline__ GlaU gla_unit_geom(int u) { GlaU g; g.cpos = u % NCH; g.hh = (u / NCH) & 3; g.b = u / (NCH * 4); g.isctx = g.cpos < 4;
    const int ci = g.isctx ? g.cpos : g.cpos - 4; g.seqbase = g.isctx ? TX + g.b * CTXL : g.b * SEQ; g.t0 = ci * 64; return g; }
__device__ __forceinline__ void gla_rope_pair(const Frame& F, const GlaU& g, const bf16* row, int j, int hf, int fi, float& o1, float& o2) {
    const float x1 = bf2f(row[fi]), x2 = bf2f(row[12 + fi]); o1 = x1; o2 = x2;
    if (!g.isctx) { const int t = g.t0 + j, pos = hf ? (t % GRIDW) : (t / GRIDW); const float cs = F.ROPE[pos * 12 + fi], sn = F.ROPE[768 + pos * 12 + fi]; o1 = x1 * cs - x2 * sn; o2 = x1 * sn + x2 * cs; }
}
constexpr int G1_BF = 0, G1_BB = 12288, G1_KEF = 24576, G1_KEB = 31488, G1_OPS = 38400;
constexpr int PREP_WA = TAB_OFF;
__device__ __forceinline__ void gla_g1_unit(Frame& F, int l, int u) {
    const GlaU g = gla_unit_geom(u);
    LAS bf16* kef = (LAS bf16*)(F.lds + G1_KEF); LAS bf16* keb = (LAS bf16*)(F.lds + G1_KEB); LAS bf16* ops = (LAS bf16*)(F.lds + G1_OPS);
    const LAS float* wa = (const LAS float*)(F.lds + PREP_WA) + g.hh * 1536; const LAS float* ba = (const LAS float*)(F.lds + PREP_WA) + 6144 + g.hh * 96;
    const bf16* vtg = F.VTA + (size_t)(384 + g.hh * 96) * VTS + g.seqbase + g.t0;
    const int tid = F.tid, lane = F.lane, j = lane, w = F.wave;
    const bf16* prow = F.P + (size_t)(g.seqbase + g.t0 + j) * NP;
    u32x4 araw[4];
#pragma unroll
    for (int q4 = 0; q4 < 4; ++q4) araw[q4] = *(const u32x4*)(prow + C_AF + 8 * q4);
    float q1[3], q2[3], k1[3], k2[3], cs[3], sn[3];
#pragma unroll
    for (int e = 0; e < 3; ++e) { const int p = 3 * w + e, hf = p / 12, fi = p % 12, cb = g.hh * 48 + hf * 24 + fi;
        q1[e] = bf2f(prow[C_GQ + cb]); q2[e] = bf2f(prow[C_GQ + cb + 12]); k1[e] = bf2f(prow[C_GK + cb]); k2[e] = bf2f(prow[C_GK + cb + 12]);
        const int t = g.t0 + j, pos = hf ? (t % GRIDW) : (t / GRIDW);
        cs[e] = g.isctx ? 1.f : F.ROPE[pos * 12 + fi]; sn[e] = g.isctx ? 0.f : F.ROPE[768 + pos * 12 + fi]; }
    float a[32];
#pragma unroll
    for (int q4 = 0; q4 < 4; ++q4) { const u32x4 x = araw[q4]; a[q4 * 8 + 0] = bflo(x.x); a[q4 * 8 + 1] = bfhi(x.x); a[q4 * 8 + 2] = bflo(x.y); a[q4 * 8 + 3] = bfhi(x.y);
        a[q4 * 8 + 4] = bflo(x.z); a[q4 * 8 + 5] = bfhi(x.z); a[q4 * 8 + 6] = bflo(x.w); a[q4 * 8 + 7] = bfhi(x.w); }
    float bf[3][2], bb[3][2];
#pragma unroll
    for (int e = 0; e < 3; ++e)
#pragma unroll
        for (int wh = 0; wh < 2; ++wh) { const int p = 3 * w + e, d = (p / 12) * 24 + p % 12 + 12 * wh;
            float zf = ba[d], zb = ba[48 + d];
#pragma unroll
            for (int r = 0; r < 16; ++r) { zf += a[r] * wa[r * 48 + d]; zb += a[16 + r] * wa[(16 + r) * 48 + d]; }
            float xf = (fminf(zf, 0.f) - __logf(1.f + __expf(-fabsf(zf)))) * (1.f / 16.f), xb = (fminf(zb, 0.f) - __logf(1.f + __expf(-fabsf(zb)))) * (1.f / 16.f);
#pragma unroll
            for (int o = 1; o < 64; o <<= 1) { const float yf = __shfl_up(xf, o), yb = __shfl_down(xb, o); if (lane >= o) xf += yf; if (lane + o < 64) xb += yb; }
            bf[e][wh] = xf; bb[e][wh] = xb; }
#pragma unroll
    for (int e = 0; e < 3; ++e) { const int p = 3 * w + e, d1 = (p / 12) * 24 + p % 12, d2 = d1 + 12;
        const float qa = q1[e] * cs[e] - q2[e] * sn[e], qb = q1[e] * sn[e] + q2[e] * cs[e], ka = k1[e] * cs[e] - k2[e] * sn[e], kb = k1[e] * sn[e] + k2[e] * cs[e];
        const float f1 = bf[e][0], f2 = bf[e][1], b1 = bb[e][0], b2 = bb[e][1];
        const float fe1 = __builtin_bit_cast(float, __builtin_amdgcn_readlane(__builtin_bit_cast(int, f1), 63)), fe2 = __builtin_bit_cast(float, __builtin_amdgcn_readlane(__builtin_bit_cast(int, f2), 63));
        const float be1 = __builtin_bit_cast(float, __builtin_amdgcn_readlane(__builtin_bit_cast(int, b1), 0)), be2 = __builtin_bit_cast(float, __builtin_amdgcn_readlane(__builtin_bit_cast(int, b2), 0));
        const float ef1 = __expf(f1), ef2 = __expf(f2), eb1 = __expf(b1), eb2 = __expf(b2), nf1 = __expf(-f1), nf2 = __expf(-f2), nb1 = __expf(-b1), nb2 = __expf(-b2);
        ops[j * 48 + d1] = (bf16)f2bf(qa * ef1); ops[j * 48 + d2] = (bf16)f2bf(qb * ef2); ops[3072 + j * 48 + d1] = (bf16)f2bf(ka * nf1); ops[3072 + j * 48 + d2] = (bf16)f2bf(kb * nf2);
        ops[6144 + j * 48 + d1] = (bf16)f2bf(qa * eb1); ops[6144 + j * 48 + d2] = (bf16)f2bf(qb * eb2); ops[9216 + j * 48 + d1] = (bf16)f2bf(ka * nb1); ops[9216 + j * 48 + d2] = (bf16)f2bf(kb * nb2);
        const float ge1 = __expf(fe1), ge2 = __expf(fe2), he1 = __expf(be1), he2 = __expf(be2);
        kef[d1 * VT_LD + j] = (bf16)f2bf(ka * nf1 * ge1); kef[d2 * VT_LD + j] = (bf16)f2bf(kb * nf2 * ge2);
        keb[d1 * VT_LD + j] = (bf16)f2bf(ka * nb1 * he1); keb[d2 * VT_LD + j] = (bf16)f2bf(kb * nb2 * he2);
        if (lane == 0) { float* gd = F.GD + (((size_t)(g.b * 4 + g.hh) * 2) * NCH + g.cpos) * 48; gd[d1] = ge1; gd[d2] = ge2; gd[(size_t)NCH * 48 + d1] = he1; gd[(size_t)NCH * 48 + d2] = he2; } }
    __syncthreads();
    { const int q = lane & 15, g4 = lane >> 4;
      for (int ti = F.wave; ti < 36; ti += NWAVES) { const int dir = ti / 18, dt = (ti % 18) / 6, vtile = ti % 6;
          const LAS bf16* ke = dir ? keb : kef;
          f32x4 acc = (f32x4){0.f, 0.f, 0.f, 0.f};
#pragma unroll
          for (int s2 = 0; s2 < 2; ++s2) { const bf16x8 av = *(const LAS bf16x8*)(ke + (16 * dt + q) * VT_LD + 32 * s2 + 8 * g4), bv = *(const bf16x8*)(vtg + (size_t)(16 * vtile + q) * VTS + 32 * s2 + 8 * g4);
              acc = __builtin_amdgcn_mfma_f32_16x16x32_bf16(av, bv, acc, 0, 0, 0); }
          *(f32x4*)(F.DS + ((((size_t)(g.b * 4 + g.hh) * 2 + dir) * NCH + g.cpos) * 96 + 16 * vtile + q) * 48 + 16 * dt + 4 * g4) = acc; } }
    { u32x4* dst = (u32x4*)(F.OPS + (size_t)u * 12288);
      for (int i = tid; i < 1536; i += NTHREADS) dst[i] = *(const LAS u32x4*)(ops + i * 8); }
    __syncthreads();
}
__device__ __forceinline__ void gla_g2_unit(Frame& F, int u) {
    const int chain = u >> 2, qt = u & 3, dir = chain & 1, tid = F.tid;
    const float* ds = F.DS + (size_t)chain * NCH * 4608; const float* gd = F.GD + (size_t)chain * NCH * 48; bf16* stb = F.STB + (size_t)chain * NCH * 4608;
    const int e0 = qt * 1152 + 2 * tid, e1 = qt * 1152 + 1024 + 2 * tid; const bool h1 = tid < 64;
    const int d0 = e0 % 48, d1 = h1 ? e1 % 48 : 0;
    f32x2 S0 = (f32x2){0.f, 0.f}, S1 = (f32x2){0.f, 0.f};
    for (int st0 = 0; st0 < NCH; st0 += 4) {
        f32x2 x0[4], x1[4], g0[4], g1[4]; int cp[4];
#pragma unroll
        for (int k = 0; k < 4; ++k) { const int st = st0 + k; cp[k] = st < 4 ? (dir ? 3 - st : st) : (dir ? 4 + (67 - st) : st);
            const float* p = ds + (size_t)cp[k] * 4608; const float* gp = gd + cp[k] * 48;
            x0[k] = *(const f32x2*)(p + e0); g0[k] = *(const f32x2*)(gp + d0);
            if (h1) { x1[k] = *(const f32x2*)(p + e1); g1[k] = *(const f32x2*)(gp + d1); } else { x1[k] = (f32x2){0.f, 0.f}; g1[k] = x1[k]; } }
#pragma unroll
        for (int k = 0; k < 4; ++k) { bf16* p = stb + (size_t)cp[k] * 4608;
            *(unsigned*)(p + e0) = pk2(S0.x, S0.y); if (h1) *(unsigned*)(p + e1) = pk2(S1.x, S1.y);
            S0 = g0[k] * S0 + x0[k]; S1 = g1[k] * S1 + x1[k]; }
    }
}
__device__ __forceinline__ void gla_g3_wave(Frame& F, int l, int wu) {
    const int u = wu >> 1, it = wu & 1;
    const GlaU g = gla_unit_geom(u);
    const int lane = F.lane, r = lane & 31, h = lane >> 5;
    const bf16* ops = F.OPS + (size_t)u * 12288 + 16 * 0 + 8 * h;
    const bf16* vtg = F.VTA + (size_t)(384 + g.hh * 96) * VTS + g.seqbase + g.t0;
    const bf16* stf = F.STB + ((((size_t)(g.b * 4 + g.hh) * 2 + 0) * NCH + g.cpos) * 4608) + 8 * h; const bf16* stbk = stf + (size_t)NCH * 4608;
    LAS float* O = (LAS float*)(F.lds + F.wave * 16384);
    bf16x8 qf[3], qb[3];
#pragma unroll
    for (int s3 = 0; s3 < 3; ++s3) { qf[s3] = *(const bf16x8*)(ops + (32 * it + r) * 48 + 16 * s3); qb[s3] = *(const bf16x8*)(ops + 6144 + (32 * it + r) * 48 + 16 * s3); }
    f32x16 X[2];
#pragma unroll
    for (int jt = 0; jt < 2; ++jt) {
        f32x16 xf, xb;
#pragma unroll
        for (int e = 0; e < 16; ++e) { xf[e] = 0.f; xb[e] = 0.f; }
        if (jt <= it) {
#pragma unroll
            for (int s3 = 0; s3 < 3; ++s3) xf = __builtin_amdgcn_mfma_f32_32x32x16_bf16(*(const bf16x8*)(ops + 3072 + (32 * jt + r) * 48 + 16 * s3), qf[s3], xf, 0, 0, 0); }
        if (jt >= it) {
#pragma unroll
            for (int s3 = 0; s3 < 3; ++s3) xb = __builtin_amdgcn_mfma_f32_32x32x16_bf16(*(const bf16x8*)(ops + 9216 + (32 * jt + r) * 48 + 16 * s3), qb[s3], xb, 0, 0, 0); }
        if (jt == it) {
#pragma unroll
            for (int e = 0; e < 16; ++e) { const int jl = (e & 3) + 8 * (e >> 2) + 4 * h; X[jt][e] = (jl <= r ? xf[e] : 0.f) + (jl >= r ? xb[e] : 0.f); }
        } else X[jt] = jt < it ? xf : xb;
    }
    f32x16 o[3];
#pragma unroll
    for (int vt = 0; vt < 3; ++vt)
#pragma unroll
        for (int e = 0; e < 16; ++e) o[vt][e] = 0.f;
#pragma unroll
    for (int jt = 0; jt < 2; ++jt)
#pragma unroll
        for (int s2 = 0; s2 < 2; ++s2) {
            u32x4 aw; aw.x = pk2(X[jt][8 * s2 + 0], X[jt][8 * s2 + 1]); aw.y = pk2(X[jt][8 * s2 + 2], X[jt][8 * s2 + 3]); aw.z = pk2(X[jt][8 * s2 + 4], X[jt][8 * s2 + 5]); aw.w = pk2(X[jt][8 * s2 + 6], X[jt][8 * s2 + 7]);
#pragma unroll
            for (int vt = 0; vt < 3; ++vt) {
                const bf16* vr = vtg + (size_t)(32 * vt + r) * VTS + 32 * jt + 16 * s2 + 4 * h;
                const u32x2 lo = *(const u32x2*)vr, hi = *(const u32x2*)(vr + 8);
                const u32x4 bw = (u32x4){lo.x, lo.y, hi.x, hi.y};
                o[vt] = __builtin_amdgcn_mfma_f32_32x32x16_bf16(__builtin_bit_cast(bf16x8, aw), __builtin_bit_cast(bf16x8, bw), o[vt], 0, 0, 0); } }
#pragma unroll
    for (int s3 = 0; s3 < 3; ++s3)
#pragma unroll
        for (int vt = 0; vt < 3; ++vt) {
            o[vt] = __builtin_amdgcn_mfma_f32_32x32x16_bf16(qf[s3], *(const bf16x8*)(stf + (32 * vt + r) * 48 + 16 * s3), o[vt], 0, 0, 0);
            o[vt] = __builtin_amdgcn_mfma_f32_32x32x16_bf16(qb[s3], *(const bf16x8*)(stbk + (32 * vt + r) * 48 + 16 * s3), o[vt], 0, 0, 0); }
#pragma unroll
    for (int vt = 0; vt < 3; ++vt)
#pragma unroll
        for (int e = 0; e < 16; ++e) O[((e & 3) + 8 * (e >> 2) + 4 * h) * O_LD + 32 * vt + r] = o[vt][e];
    LDS_WAIT(); asm volatile("" ::: "memory");
    { const int i = lane >> 1, half = lane & 1; const size_t row = (size_t)(g.seqbase + g.t0 + 32 * it + i);
      f32x4 ov[12]; float ss = 0.f;
#pragma unroll
      for (int e = 0; e < 12; ++e) { ov[e] = *(const LAS f32x4*)(O + i * O_LD + half * 48 + 4 * e); ss += (ov[e].x * ov[e].x + ov[e].y * ov[e].y) + (ov[e].z * ov[e].z + ov[e].w * ov[e].w); }
      ss += __shfl_xor(ss, 1);
      const float rinv = 1.f / sqrtf(ss * (1.f / 96.f) + EPS);
      const float* ng = F.gla_norm_g + (size_t)l * 384 + g.hh * 96 + half * 48;
      const u32x4* gp = (const u32x4*)(F.P + row * NP + C_GG + g.hh * 96 + half * 48);
      u32x4* dst = (u32x4*)(F.MIX + row * DM + g.hh * 96 + half * 48);
#if GLA_CHECK
      { float sn = 0.f; const float* pf = F.OF + row * 384 + g.hh * 96 + half * 48; const float* pb = F.OB + row * 384 + g.hh * 96 + half * 48;
#pragma unroll
        for (int e = 0; e < 48; ++e) { const float on = pf[e] + pb[e]; sn += on * on; }
        sn += __shfl_xor(sn, 1);
        const float rms = sqrtf(sn * (1.f / 96.f)) + 1e-6f; int bad = 0;
#pragma unroll
        for (int e = 0; e < 48; ++e) { const float on = pf[e] + pb[e]; if (!(fabsf(ov[e >> 2][e & 3] - on) <= 0.03f * rms + 0.03f * fabsf(on))) ++bad; }
        if (bad) atomicAdd(F.ctl + 64, (unsigned)bad); }
#endif
#pragma unroll
      for (int q6 = 0; q6 < 6; ++q6) { const u32x4 gw = gp[q6]; const f32x4 n0 = *(const f32x4*)(ng + 8 * q6), n1 = *(const f32x4*)(ng + 8 * q6 + 4); const f32x4 a = ov[2 * q6], b = ov[2 * q6 + 1];
          u32x4 w;
          w.x = pk2(a.x * rinv * n0.x * silu_f(bflo(gw.x)), a.y * rinv * n0.y * silu_f(bfhi(gw.x))); w.y = pk2(a.z * rinv * n0.z * silu_f(bflo(gw.y)), a.w * rinv * n0.w * silu_f(bfhi(gw.y)));
          w.z = pk2(b.x * rinv * n1.x * silu_f(bflo(gw.z)), b.y * rinv * n1.y * silu_f(bfhi(gw.z))); w.w = pk2(b.z * rinv * n1.z * silu_f(bflo(gw.w)), b.w * rinv * n1.w * silu_f(bfhi(gw.w)));
          dst[q6] = w; } }
    LDS_WAIT(); asm volatile("" ::: "memory");
}
__device__ __forceinline__ void ph_gla3(Frame& F, int l) {
    const bool need_ctx = l < DEPTH - 1;
    const int gw = F.vcu * NWAVES + F.wave, NGW = F.G * NWAVES;
    for (int wu = gw; wu < NB * GH * NCH * 2; wu += NGW) { if (!need_ctx && ((wu >> 1) % NCH) < 4) continue; gla_g3_wave(F, l, wu); }
}
__device__ __forceinline__ void ph_prep(Frame& F, int l) {
    const bool need_ctx = l < DEPTH - 1;
    const int tid = F.tid;
#if GLA_CHECK
    for (int u = F.vcu; u < NB * GH * 2; u += F.G) gla_chain(F, l, u);
    __syncthreads();
#endif
    { LAS float* wa = (LAS float*)(F.lds + PREP_WA);
      for (int i = tid; i < 4 * 2 * 16 * 48; i += NTHREADS) { const int hh = i / 1536, dir = (i / 768) & 1, r = (i / 48) % 16, d = i % 48; wa[i] = F.gla_wa2[(((size_t)l * 2 + dir) * 16 + r) * 192 + hh * 48 + d]; }
      for (int i = tid; i < 4 * 2 * 48; i += NTHREADS) { const int hh = i / 96, dir = (i / 48) & 1, d = i % 48; wa[6144 + i] = F.gla_ba[((size_t)l * 2 + dir) * 192 + hh * 48 + d]; }
      LAS bf16* pw = (LAS bf16*)(F.lds + PREP_PW); LAS float* ps = (LAS float*)(F.lds + PREP_PS);
      for (int i = tid; i < 4 * 64 * 64; i += NTHREADS) { const int g = i >> 12, ii = (i >> 6) & 63, o = i & 63; pw[(g * 64 + o) * PW_LD + ii] = (bf16)f2bf(F.pool_w[(size_t)l * 16384 + i]); }
      if (tid < 256) ps[tid] = F.pool_scale[(size_t)l * 256 + tid]; }
    __syncthreads();
    for (int u = F.vcu; u < NB * GH * NCH; u += F.G) gla_g1_unit(F, l, u);
    const int NPOOL = NB * 128 + (need_ctx ? NB * 8 : 0);
    for (int u = F.vcu; u < NPOOL; u += F.G) pool_unit(F, l, u);
}

#define NA_LOG2E 1.4426950408889634f
struct NaCtx {
    __amdgpu_buffer_rsrc_t rP, rV; unsigned voffK, voffV; int b, cw, r0, krlo, nnb; const LAS float* rpb; unsigned bidx[2][4];
    bf16x8 qa[4][2]; float mrun[4], lsum[4]; f32x4 o[4][4];
};
__device__ __forceinline__ int na_segtok(const NaCtx& C, int sg) { return sg < C.nnb ? C.b * SEQ + (C.krlo + sg) * GRIDW + C.cw : TX + C.b * CTXL + 32 * (sg - C.nnb); }
__device__ __forceinline__ void na_load(const NaCtx& C, int sg, bf16x8 (&kb)[2][2], bf16x8 (&vb)[4]) {
    const int tok = na_segtok(C, sg);
#pragma unroll
    for (int par = 0; par < 2; ++par)
#pragma unroll
        for (int s2 = 0; s2 < 2; ++s2) kb[par][s2] = __builtin_bit_cast(bf16x8, __builtin_amdgcn_raw_buffer_load_b128(C.rP, C.voffK, (unsigned)((tok + 4 * par) * (NP * 2) + 64 * s2), 0));
#pragma unroll
    for (int dt = 0; dt < 4; ++dt) vb[dt] = __builtin_bit_cast(bf16x8, __builtin_amdgcn_raw_buffer_load_b128(C.rV, C.voffV, (unsigned)((16 * dt * VTS + tok) * 2), 0));
}
template <bool LATENT>
__device__ __forceinline__ void na_segment(NaCtx& C, int sg, int lane, const bf16x8 (&kb)[2][2], const bf16x8 (&vb)[4]) {
    const int g = lane >> 4;
    const bool nb = LATENT && sg < C.nnb;
    const int kr = C.krlo + sg;
#pragma unroll
    for (int i = 0; i < 4; ++i) {
        if (nb) { const int ri = C.r0 + i, rsi = ri - 4 < 0 ? 0 : (ri - 4 > 56 ? 56 : ri - 4); if (kr < rsi || kr > rsi + 7) continue; }
        float bv[2][4];
        if (nb) { const unsigned rowoff = (unsigned)((kr - (C.r0 + i) + 7) * 32 * 4);
#pragma unroll
            for (int par = 0; par < 2; ++par)
#pragma unroll
                for (int rg = 0; rg < 4; ++rg) bv[par][rg] = *(const LAS float*)((const LAS char*)C.rpb + rowoff + C.bidx[par][rg]); }
        f32x4 st[2];
#pragma unroll
        for (int par = 0; par < 2; ++par) {
            f32x4 a = (f32x4){0.f, 0.f, 0.f, 0.f};
#pragma unroll
            for (int s2 = 0; s2 < 2; ++s2) a = __builtin_amdgcn_mfma_f32_16x16x32_bf16(kb[par][s2], C.qa[i][s2], a, 0, 0, 0);
#pragma unroll
            for (int rg = 0; rg < 4; ++rg) a[rg] = nb ? __builtin_fmaf(a[rg], NA_LOG2E, bv[par][rg]) : a[rg] * NA_LOG2E;
            st[par] = a;
        }
        float mx = fmaxf(fmaxf(fmaxf(st[0][0], st[0][1]), fmaxf(st[0][2], st[0][3])), fmaxf(fmaxf(st[1][0], st[1][1]), fmaxf(st[1][2], st[1][3])));
        mx = fmaxf(mx, __shfl_xor(mx, 16)); mx = fmaxf(mx, __shfl_xor(mx, 32));
        const float mnew = fmaxf(C.mrun[i], mx), alpha = __builtin_amdgcn_exp2f(C.mrun[i] - mnew);
        float psum = 0.f;
#pragma unroll
        for (int par = 0; par < 2; ++par)
#pragma unroll
            for (int rg = 0; rg < 4; ++rg) { const float p = __builtin_amdgcn_exp2f(st[par][rg] - mnew); st[par][rg] = p; psum += p; }
        psum += __shfl_xor(psum, 16); psum += __shfl_xor(psum, 32);
        C.lsum[i] = C.lsum[i] * alpha + psum; C.mrun[i] = mnew;
#pragma unroll
        for (int rg = 0; rg < 4; ++rg) { const float ar = __shfl(alpha, 4 * g + rg);
#pragma unroll
            for (int dt = 0; dt < 4; ++dt) C.o[i][dt][rg] *= ar; }
        u32x4 pw; pw.x = cvt_pk_bf16(st[0][0], st[0][1]); pw.y = cvt_pk_bf16(st[0][2], st[0][3]); pw.z = cvt_pk_bf16(st[1][0], st[1][1]); pw.w = cvt_pk_bf16(st[1][2], st[1][3]);
        const bf16x8 pa = __builtin_bit_cast(bf16x8, pw);
#pragma unroll
        for (int dt = 0; dt < 4; ++dt) C.o[i][dt] = __builtin_amdgcn_mfma_f32_16x16x32_bf16(pa, vb[dt], C.o[i][dt], 0, 0, 0);
    }
}
#ifndef NA_DRYMODE
#define NA_DRYMODE 0
#endif
template <bool LATENT>
__device__ __forceinline__ void na_unit(Frame& F, int l, int u, const LAS float* rpb_lds, bool dry = false) {
    const int lane = F.lane, q = lane & 15, g = lane >> 4;
    NaCtx C;
    int hh, c0 = 0, qrow0, qstep;
    if (LATENT) { const int cb = u & 3, rg4 = (u >> 2) & 15; hh = (u >> 6) % NH; C.b = u / (64 * NH); c0 = cb * 16; C.r0 = rg4 * 4; qrow0 = C.b * SEQ + C.r0 * GRIDW + c0; qstep = GRIDW;
        const int rs0 = C.r0 - 4 < 0 ? 0 : (C.r0 - 4 > 56 ? 56 : C.r0 - 4), r3 = C.r0 + 3, rs3 = r3 - 4 < 0 ? 0 : (r3 - 4 > 56 ? 56 : r3 - 4);
        C.krlo = rs0; C.nnb = rs3 + 7 - rs0 + 1; }
    else { const int qi = u & 3; hh = (u >> 2) % NH; C.b = u / (4 * NH); qrow0 = TX + C.b * CTXL + qi * 64; qstep = 16; C.r0 = 0; C.krlo = 0; C.nnb = 0; }
    C.cw = c0 == 0 ? 0 : (c0 == 48 ? 32 : c0 - 8);
    const int c = c0 + q; const int start = c - 8 < 0 ? 0 : (c - 8 > 48 ? 48 : c - 8);
    C.rpb = rpb_lds + hh * 15 * 32;
    C.rP = __builtin_amdgcn_make_buffer_rsrc((void*)F.P, 0, (int)((size_t)TT * NP * 2), 0x00020000);
    C.rV = __builtin_amdgcn_make_buffer_rsrc((void*)F.VTA, 0, (int)((size_t)VT_NC * VTS * 2), 0x00020000);
    const int koff = 8 * (q >> 2) + (q & 3);
    C.voffK = (unsigned)((koff * NP + C_NAK + hh * NDH + 8 * g) * 2);
    C.voffV = (unsigned)(((hh * NDH + q) * VTS + 8 * g) * 2);
#pragma unroll
    for (int par = 0; par < 2; ++par)
#pragma unroll
        for (int rg = 0; rg < 4; ++rg) { const int kc = C.cw + 8 * g + rg + 4 * par; const bool valid = (kc >= start) && (kc < start + 16);
            C.bidx[par][rg] = (unsigned)((valid ? kc - c + 15 : 31) * 4); }
#pragma unroll
    for (int i = 0; i < 4; ++i) {
#pragma unroll
        for (int s2 = 0; s2 < 2; ++s2) C.qa[i][s2] = *(const bf16x8*)(F.P + (size_t)(qrow0 + i * qstep + q) * NP + C_NAQ + hh * NDH + 32 * s2 + 8 * g);
        C.mrun[i] = -1e30f; C.lsum[i] = 0.f;
#pragma unroll
        for (int dt = 0; dt < 4; ++dt) C.o[i][dt] = (f32x4){0.f, 0.f, 0.f, 0.f}; }
    const int nseg = C.nnb + 8;
    bf16x8 k0[2][2], v0[4], k1[2][2], v1[4];
    na_load(C, 0, k0, v0);
#pragma unroll 1
    for (int sg = 0; sg < nseg; sg += 2) {
        if (sg + 1 < nseg) na_load(C, sg + 1, k1, v1);
        na_segment<LATENT>(C, sg, lane, k0, v0);
        if (sg + 2 < nseg) na_load(C, sg + 2, k0, v0);
        if (sg + 1 < nseg) na_segment<LATENT>(C, sg + 1, lane, k1, v1);
    }
    bf16* mixb = dry ? (bf16*)F.VTC : F.MIX;
#pragma unroll
    for (int i = 0; i < 4; ++i)
#pragma unroll
        for (int rg = 0; rg < 4; ++rg) { const float li = 1.f / __shfl(C.lsum[i], 4 * g + rg);
            bf16* orow = mixb + (size_t)(dry ? 0 : (qrow0 + i * qstep + 4 * g + rg)) * DM + 384 + hh * NDH + q;
#pragma unroll
            for (int dt = 0; dt < 4; ++dt) orow[16 * dt] = (bf16)f2bf(C.o[i][dt][rg] * li); }
}
__device__ __forceinline__ void gla_out_row(Frame& F, int l, int m) {
    const int lane = F.lane, hh = lane >> 4, sub = lane & 15, c = hh * 96 + sub * 6;
    float o[6]; float ss = 0.f;
#pragma unroll
    for (int i = 0; i < 3; ++i) { const f32x2 a = *(const f32x2*)(F.OF + (size_t)m * 384 + c + 2 * i), b = *(const f32x2*)(F.OB + (size_t)m * 384 + c + 2 * i);
        o[2 * i] = a.x + b.x; o[2 * i + 1] = a.y + b.y; ss += o[2 * i] * o[2 * i] + o[2 * i + 1] * o[2 * i + 1]; }
    ss += __shfl_xor(ss, 1); ss += __shfl_xor(ss, 2); ss += __shfl_xor(ss, 4); ss += __shfl_xor(ss, 8);
    const float rinv = 1.f / sqrtf(ss * (1.f / 96.f) + EPS);
    const float* ng = F.gla_norm_g + (size_t)l * 384 + c;
    const bf16* gp = F.P + (size_t)m * NP + C_GG + c;
    unsigned w[3];
#pragma unroll
    for (int i = 0; i < 3; ++i) { const unsigned gw = *(const unsigned*)(gp + 2 * i);
        const float y0 = o[2 * i] * rinv * ng[2 * i] * silu_f(bflo(gw)), y1 = o[2 * i + 1] * rinv * ng[2 * i + 1] * silu_f(bfhi(gw));
        w[i] = pk2(y0, y1); }
    unsigned* dst = (unsigned*)(F.MIX + (size_t)m * DM + c);
    dst[0] = w[0]; dst[1] = w[1]; dst[2] = w[2];
}
__device__ __forceinline__ void ph_attn(Frame& F, int l) {
    const bool need_ctx = l < DEPTH - 1;
    const int gw = F.vcu * NWAVES + F.wave, NGW = F.G * NWAVES;
    LAS float* rpb = (LAS float*)(F.lds + TAB_OFF);
    for (int i = F.tid; i < NH * 15 * 32; i += NTHREADS) { const int col = i & 31, hr = i >> 5; rpb[i] = col < 31 ? F.na_rpb[((size_t)l * NH * 15 + hr) * 31 + col] * NA_LOG2E : -1e30f; }
    __syncthreads();
    for (int rep = 0; rep < REPS(11); ++rep)
    for (int u = F.vcu; u < NB * GH * 2 * 4; u += F.G) gla_g2_unit(F, u);
    const bool bg = !GLA_CHECK;
    if (bg && (F.wave & 1)) convert_items(F, l, 3 * (NE * 16 * 32));
    for (int rep = 0; rep < REPS(12); ++rep) {
    for (int u = gw; u < NB * NH * 16 * 4; u += NGW) na_unit<true>(F, l, u, rpb, rep + 1 < REPS(12));
    if (need_ctx) for (int u = gw; u < NB * NH * 4; u += NGW) na_unit<false>(F, l, u, rpb, rep + 1 < REPS(12)); }
    if (bg && !(F.wave & 1)) convert_items(F, l, 3 * (NE * 16 * 32));
}
constexpr int RW_LD = 1032;
static_assert(2 * NE * RW_LD * 2 <= STAGE_BYTES, "router LDS");
__device__ __forceinline__ unsigned f2key(float f, int e) { unsigned u = __builtin_bit_cast(unsigned, f); u = (u & 0x80000000u) ? ~u : (u | 0x80000000u); return (u & ~31u) | (unsigned)(31 - e); }
__device__ __forceinline__ float key2f(unsigned k) { unsigned u = k & ~31u; u = (u & 0x80000000u) ? (u & 0x7fffffffu) : ~u; return __builtin_bit_cast(float, u); }
__device__ __forceinline__ void ph_router(Frame& F, int l, bool dry = false) {
    const int tid = F.tid, lane = F.lane, q = lane & 15, g = lane >> 4;
    LAS bf16* WH = (LAS bf16*)F.lds; LAS bf16* WL = WH + NE * RW_LD;
    LAS int* lcount = (LAS int*)(F.lds + MISC_OFF + 64 * 4);
    volatile LAS int* lbase = (volatile LAS int*)(F.MISC + 96);
    LAS int* apos = (LAS int*)(F.lds + TAB_OFF);
    const float* rw = F.router_w + (size_t)l * DM * NE;
    for (int i = tid; i < DM * NE; i += NTHREADS) { const int c = i >> 5, e = i & 31; const float w = rw[i]; const unsigned hi = f2bf(w); const unsigned lo = f2bf(w - bf2f(hi));
        WH[e * RW_LD + c] = (bf16)hi; WL[e * RW_LD + c] = (bf16)lo; }
    if (tid < NE) lcount[tid] = 0;
    __syncthreads();
    const int M = (l == DEPTH - 1) ? TX : TT;
    const int per = (M + F.G - 1) / F.G, tok0 = F.vcu * per, tok1 = (tok0 + per < M) ? tok0 + per : M;
    const int ntile = tok1 > tok0 ? (tok1 - tok0 + 15) >> 4 : 0;
    const float* g2w = F.norm2_g + (size_t)l * DM + 8 * g;
    const float rb0 = F.router_b[(size_t)l * NE + q], rb1 = F.router_b[(size_t)l * NE + 16 + q];
    for (int tile = F.wave; tile < ntile; tile += NWAVES) {
        const int tbase = tok0 + 16 * tile, t = tbase + q, tq = t < tok1 ? t : tok1 - 1; const bool valid = t < tok1;
        const float* xr = F.X + (size_t)tq * DM + 8 * g;
        float ss = 0.f;
#pragma unroll 8
        for (int s = 0; s < 32; ++s) { const f32x4 a = *(const f32x4*)(xr + 32 * s), b = *(const f32x4*)(xr + 32 * s + 4); ss += (a.x * a.x + a.y * a.y) + (a.z * a.z + a.w * a.w) + (b.x * b.x + b.y * b.y) + (b.z * b.z + b.w * b.w); }
        ss += __shfl_xor(ss, 16); ss += __shfl_xor(ss, 32);
        const float rinv = 1.f / sqrtf(ss * (1.f / DM) + EPS);
        const int br = tq < TX ? tq / SEQ : NB;
        const float* md = F.mod + ((size_t)l * 9 + br) * 6 * DM + 8 * g;
        unsigned char* hrow = MOE_FP8 ? F.H8 + (size_t)tq * DM + 8 * g : (unsigned char*)(F.H + (size_t)tq * DM + 8 * g);
        f32x4 acc[2]; acc[0] = (f32x4){0.f, 0.f, 0.f, 0.f}; acc[1] = acc[0];
#pragma unroll 2
        for (int s = 0; s < 32; ++s) { const int c = 32 * s;
            const f32x4 xa = *(const f32x4*)(xr + c), xb = *(const f32x4*)(xr + c + 4), ga = *(const f32x4*)(g2w + c), gb = *(const f32x4*)(g2w + c + 4);
            const f32x4 ca = *(const f32x4*)(md + 4 * DM + c), cb = *(const f32x4*)(md + 4 * DM + c + 4), sa = *(const f32x4*)(md + 3 * DM + c), sb = *(const f32x4*)(md + 3 * DM + c + 4);
            const f32x4 ha = (xa * rinv * ga) * (ca + 1.f) + sa, hb = (xb * rinv * gb) * (cb + 1.f) + sb;
            u32x4 hw; hw.x = cvt_pk_bf16(ha.x, ha.y); hw.y = cvt_pk_bf16(ha.z, ha.w); hw.z = cvt_pk_bf16(hb.x, hb.y); hw.w = cvt_pk_bf16(hb.z, hb.w);
            u32x4 lw; lw.x = cvt_pk_bf16(ha.x - bflo(hw.x), ha.y - bfhi(hw.x)); lw.y = cvt_pk_bf16(ha.z - bflo(hw.y), ha.w - bfhi(hw.y));
            lw.z = cvt_pk_bf16(hb.x - bflo(hw.z), hb.y - bfhi(hw.z)); lw.w = cvt_pk_bf16(hb.z - bflo(hw.w), hb.w - bfhi(hw.w));
            if (valid) { if (MOE_FP8) { u32x2 h8; h8.x = pk4_fp8(ha.x, ha.y, ha.z, ha.w); h8.y = pk4_fp8(hb.x, hb.y, hb.z, hb.w); *(u32x2*)(hrow + c) = h8; } else *(u32x4*)(hrow + 2 * c) = hw; }
            const bf16x8 ah = __builtin_bit_cast(bf16x8, hw), al = __builtin_bit_cast(bf16x8, lw);
#pragma unroll
            for (int tt = 0; tt < 2; ++tt) { const bf16x8 bh = *(const LAS bf16x8*)(WH + (16 * tt + q) * RW_LD + c + 8 * g), bl = *(const LAS bf16x8*)(WL + (16 * tt + q) * RW_LD + c + 8 * g);
                acc[tt] = __builtin_amdgcn_mfma_f32_16x16x32_bf16(ah, bh, acc[tt], 0, 0, 0);
                acc[tt] = __builtin_amdgcn_mfma_f32_16x16x32_bf16(ah, bl, acc[tt], 0, 0, 0);
                acc[tt] = __builtin_amdgcn_mfma_f32_16x16x32_bf16(al, bh, acc[tt], 0, 0, 0); } }
        unsigned k0[4], k1[4], win[4][4];
#pragma unroll
        for (int rg = 0; rg < 4; ++rg) { k0[rg] = f2key(acc[0][rg] + rb0, q); k1[rg] = f2key(acc[1][rg] + rb1, 16 + q); }
#pragma unroll
        for (int k = 0; k < 4; ++k)
#pragma unroll
            for (int rg = 0; rg < 4; ++rg) { unsigned m = k0[rg] > k1[rg] ? k0[rg] : k1[rg];
#pragma unroll
                for (int o = 1; o < 16; o <<= 1) { const unsigned y = (unsigned)__shfl_xor((int)m, o); m = y > m ? y : m; }
                win[rg][k] = m; if (k0[rg] == m) k0[rg] = 0u; if (k1[rg] == m) k1[rg] = 0u; }
        { const int rsel = q >> 2, ksel = q & 3;
          unsigned w4[4];
#pragma unroll
          for (int k = 0; k < 4; ++k) w4[k] = rsel == 0 ? win[0][k] : rsel == 1 ? win[1][k] : rsel == 2 ? win[2][k] : win[3][k];
          const float v0 = key2f(w4[0]), e1 = __expf(key2f(w4[1]) - v0), e2 = __expf(key2f(w4[2]) - v0), e3 = __expf(key2f(w4[3]) - v0);
          const float inv = 1.f / (1.f + e1 + e2 + e3);
          const float gt = (ksel == 0 ? 1.f : ksel == 1 ? e1 : ksel == 2 ? e2 : e3) * inv;
          const unsigned wk = ksel == 0 ? w4[0] : ksel == 1 ? w4[1] : ksel == 2 ? w4[2] : w4[3];
          const int e = 31 - (int)(wk & 31u), tt2 = tbase + 4 * g + rsel;
          if (tt2 < tok1 && !dry) { F.GATE[(size_t)tt2 * 4 + ksel] = gt;
              const int pos = __hip_atomic_fetch_add(lcount + e, 1, __ATOMIC_RELAXED, __HIP_MEMORY_SCOPE_WORKGROUP);
              apos[(tt2 - tok0) * 4 + ksel] = (e << 16) | pos; } }
    }
    __syncthreads();
    if (dry) return;
    if (tid < NE) lbase[tid] = (int)__hip_atomic_fetch_add(F.ctl + CW_CNT + (l * NE + tid) * 64, (unsigned)__hip_atomic_load(lcount + tid, __ATOMIC_RELAXED, __HIP_MEMORY_SCOPE_WORKGROUP), __ATOMIC_RELAXED, __HIP_MEMORY_SCOPE_AGENT);
    __syncthreads();
    const int nas = (tok1 > tok0 ? (tok1 - tok0) : 0) * 4;
    for (int i = tid; i < nas; i += NTHREADS) { const int w = apos[i], e = w >> 16, pos = w & 0xffff; F.LIST[(size_t)e * TT + lbase[e] + pos] = tok0 * 4 + i; }
    __syncthreads();
}
__device__ __forceinline__ void moe_tables(Frame& F, int l, int npn) {
    volatile LAS int* tp = (volatile LAS int*)(F.MISC + 16);
    LAS int* tab = (LAS int*)(F.lds + TAB_OFF);
    const int tid = F.tid;
    volatile LAS int* eb = (volatile LAS int*)(F.MISC + 128);
    if (tid == 0) { int acc = 0, sb = 0;
        for (int e = 0; e < NE; ++e) { tp[e] = acc; eb[e] = sb; const int cnt = (int)__hip_atomic_load(F.ctl + CW_CNT + (l * NE + e) * 64, __ATOMIC_RELAXED, __HIP_MEMORY_SCOPE_AGENT); acc += (cnt + 255) >> 8; sb += cnt; }
        tp[NE] = acc; }
    __syncthreads();
#pragma unroll 1
    for (int i2 = 0; i2 < MAXU; i2 += 2) {
        const int i = i2 + (tid >> 8), rr = tid & 255;
        g8::Unit u;
        if (i < MAXU && g8::moe_unit((long)i * F.G + F.vcu, npn, tp, u)) {
            const int cnt = (int)__hip_atomic_load(F.ctl + CW_CNT + (l * NE + u.e) * 64, __ATOMIC_RELAXED, __HIP_MEMORY_SCOPE_AGENT);
            const int idx = u.pm * 256 + rr;
            const int a = idx < cnt ? F.LIST[(size_t)u.e * TT + idx] : -1;
            tab[i * 256 + rr] = a;
            if (npn == 8 && u.pn == 0 && a >= 0) F.INV[a] = eb[u.e] + idx;
        }
    }
    __syncthreads();
}

__global__ void __launch_bounds__(NTHREADS, 2) mk_fwd(Args args) {
    extern __shared__ __attribute__((aligned(16))) unsigned char lds_raw[];
    Frame F;
    F.lds = (LAS unsigned char*)lds_raw;
    F.MISC = (volatile LAS unsigned*)(F.lds + MISC_OFF);
    F.tid = threadIdx.x; F.lane = F.tid & 63; F.wave = __builtin_amdgcn_readfirstlane(F.tid >> 6);
    F.G = gridDim.x; { const int bx = blockIdx.x; F.vcu = (F.G % 8 == 0) ? (bx % 8) * (F.G / 8) + bx / 8 : bx; }
    frame_ptrs(F);
    for (int u = F.tid; u < 256; u += NTHREADS) F.MISC[u] = 0u;
    __syncthreads();
    const int lo = args.ph_lo, hi = args.ph_hi;
    const bool one_launch = (hi - lo) > 1;
    XcdBarrier bar; bar.bar = F.ctl + CW_BAR; bar.x = 0; bar.st = nullptr;
    if (one_launch) bar = xcd_barrier_post(F.ctl + CW_BAR, F.MISC);
#ifndef PHMASK
#define PHMASK 0xFFFFFFFF
#endif
#define IN(k) (lo <= (k) && (k) < hi)
#define PHON(b) ((PHMASK >> (b)) & 1)
#define STAGGER() do { if (STAG_TICKS > 0 && (blockIdx.x & 8)) { const unsigned long long t0_ = __builtin_amdgcn_s_memrealtime(); while (__builtin_amdgcn_s_memrealtime() - t0_ < (unsigned long long)STAG_TICKS) __builtin_amdgcn_s_sleep(8); } } while (0)
#define REFRESH() do { int tz_ = threadIdx.x; asm volatile("" : "+v"(tz_)); F.tid = tz_; F.lane = tz_ & 63; frame_ptrs(F); } while (0)
#define SEAM(k) do { if (IN(k) && IN((k) + 1)) xcd_barrier(bar); } while (0)

    if (PHON(0) && IN(0)) { for (int rep = 0; rep < REPS(0); ++rep) { REFRESH(); ph_prologue(F); } } SEAM(0);
    if (PHON(1) && IN(1)) { REFRESH(); ph_first_norm(F); } SEAM(1);
    for (int l = 0; l < DEPTH; ++l) {
        const int pb = 2 + PPL * l;
        const bool lastl = (l == DEPTH - 1);
        if (PHON(2) && IN(pb + 0)) for (int rep = 0; rep < REPS(2); ++rep) {
            REFRESH(); STAGGER();
            g8::ProbIn Pb{(const char*)F.H, (const char*)(F.Bin + (size_t)l * NP * DM), F.P, F.VTA, F.G, (int)blockIdx.x, (rep + 1 < REPS(2)) ? 1 : 0};
            g8::gemm_phase(F.lds, Pb);
        }
        SEAM(pb + 0);
        if (PHON(3) && IN(pb + 1)) { for (int rep = 0; rep < REPS(3); ++rep) { REFRESH(); ph_prep(F, l); } } SEAM(pb + 1);
        if (PHON(4) && IN(pb + 2)) { for (int rep = 0; rep < REPS(4); ++rep) { REFRESH(); ph_attn(F, l); } } SEAM(pb + 2);
        if (PHON(10) && IN(pb + 3)) { for (int rep = 0; rep < REPS(10); ++rep) { REFRESH(); ph_gla3(F, l); } } SEAM(pb + 3);
        if (PHON(5) && IN(pb + 4)) for (int rep = 0; rep < REPS(5); ++rep) {
            REFRESH(); STAGGER();
            g8::ProbOut Pb{(const char*)F.MIX, (const char*)(F.Bout + (size_t)l * DM * DM), (rep + 1 < REPS(5)) ? (float*)F.ACT : F.X, F.mod + (size_t)l * 9 * 6 * DM, F.G, (int)blockIdx.x, (lastl ? TX : TT) / 256};
            g8::gemm_phase(F.lds, Pb);
        }
        SEAM(pb + 4);
        if (PHON(6) && IN(pb + 5)) { for (int rep = 0; rep < REPS(6); ++rep) { REFRESH(); ph_router(F, l, rep + 1 < REPS(6)); __syncthreads(); } } SEAM(pb + 5);
        if (PHON(7) && IN(pb + 6)) for (int rep = 0; rep < REPS(7); ++rep) {
            REFRESH(); moe_tables(F, l, 8); STAGGER();
            g8::ProbGU Pb{MOE_FP8 ? (const char*)F.H8 : (const char*)F.H, (const char*)F.Bgu + (size_t)l * NE * 2 * DM * DM * (MOE_FP8 ? 1 : 2), (unsigned char*)F.ACT, F.b_gu + (size_t)l * NE * 2 * DM, (volatile LAS int*)(F.MISC + 16), (const LAS int*)(F.lds + TAB_OFF), F.G, F.vcu, (rep + 1 < REPS(7)) ? 1 : 0, (volatile LAS int*)(F.MISC + 128)};
            g8::gemm_phase(F.lds, Pb);
        }
        SEAM(pb + 6);
        if (PHON(8) && IN(pb + 7)) for (int rep = 0; rep < REPS(8); ++rep) {
            REFRESH(); moe_tables(F, l, 4); STAGGER();
            g8::ProbDN Pb{(const char*)F.ACT, (const char*)F.Bdn + (size_t)l * NE * DM * DM * (MOE_FP8 ? 1 : 2), F.YB, F.b_down + (size_t)l * NE * DM, F.GATE, (volatile LAS int*)(F.MISC + 16), (const LAS int*)(F.lds + TAB_OFF), F.G, F.vcu, (rep + 1 < REPS(8)) ? 1 : 0, (volatile LAS int*)(F.MISC + 128)};
            g8::gemm_phase(F.lds, Pb);
        }
        SEAM(pb + 7);
        if (PHON(9) && IN(pb + 8)) { for (int rep = 0; rep < REPS(9); ++rep) { REFRESH(); ph_combine(F, l, rep + 1 < REPS(9)); } }
        if (!lastl) SEAM(pb + 8);
    }
#undef IN
#undef SEAM
}

extern "C" void kernel_launch(void* const* d_in, const int* in_sizes, int n_in, void* d_out, int out_size, void* d_ws, size_t ws_size, hipStream_t stream) {
    static int grid = 0;
    if (grid == 0) {
        if (n_in != 23 || in_sizes[0] != TX * DM || out_size != TX * DM || ws_size < WS_END) {
            fprintf(stderr, "kernel_launch: unexpected problem (n_in %d, in0 %d, out %d, ws %zu; need ws >= %zu); nothing launched\n", n_in, n_in > 0 ? in_sizes[0] : -1, out_size, ws_size, (size_t)WS_END); grid = -1; return; }
        int dev = 0, cus = 0, per_cu = 0;
        if (hipGetDevice(&dev) != hipSuccess || hipDeviceGetAttribute(&cus, hipDeviceAttributeMultiprocessorCount, dev) != hipSuccess) { fprintf(stderr, "kernel_launch: device query failed\n"); grid = -1; return; }
        if (hipFuncSetAttribute((const void*)mk_fwd, hipFuncAttributeMaxDynamicSharedMemorySize, LDS_BYTES) != hipSuccess) { fprintf(stderr, "kernel_launch: hipFuncSetAttribute failed\n"); grid = -1; return; }
        if (hipOccupancyMaxActiveBlocksPerMultiprocessor(&per_cu, (const void*)mk_fwd, NTHREADS, LDS_BYTES) != hipSuccess || per_cu < 1)
            fprintf(stderr, "kernel_launch: note: occupancy query reports %d workgroups per CU\n", per_cu);
        (void)hipGetLastError();
        grid = cus;
        if ((long)grid * MAXU < (long)(NASG / 256 + NE) * 8) { fprintf(stderr, "kernel_launch: grid %d too small for the MoE unit tables\n", grid); grid = -1; return; }
    }
    if (grid < 0) return;
    if (hipMemsetAsync((char*)d_ws + WS_CTL, 0, CTL_ZERO_BYTES, stream) != hipSuccess) { fprintf(stderr, "kernel_launch: memset failed\n"); return; }
    Args a{};
    for (int i = 0; i < 23; ++i) a.in[i] = (const float*)d_in[i];
    a.out = (float*)d_out; a.ws = (unsigned char*)d_ws;
#if MK_N_LAUNCHES == 1
    a.ph_lo = 0; a.ph_hi = NPHASES;
    hipLaunchKernelGGL(mk_fwd, dim3(grid), dim3(NTHREADS), LDS_BYTES, stream, a);
#else
    for (int p = 0; p < NPHASES; ++p) { a.ph_lo = p; a.ph_hi = p + 1; hipLaunchKernelGGL(mk_fwd, dim3(grid), dim3(NTHREADS), LDS_BYTES, stream, a); }
#endif
    const hipError_t le = hipPeekAtLastError();
    if (le != hipSuccess) fprintf(stderr, "kernel_launch: launch failed: %s\n", hipGetErrorName(le));
}
```

```cpp
#include <hip/hip_runtime.h>
#include <cstdio>
#include <cstdint>
#include <cstddef>

#ifndef MK_N_LAUNCHES
#define MK_N_LAUNCHES 1
#endif

#define GAS __attribute__((address_space(1)))
#define LAS __attribute__((address_space(3)))
typedef unsigned short bf16;
typedef short bf16x8 __attribute__((ext_vector_type(8)));
typedef short bf16x4 __attribute__((ext_vector_type(4)));
typedef float f32x4 __attribute__((ext_vector_type(4)));
typedef float f32x2 __attribute__((ext_vector_type(2)));
typedef unsigned u32x4 __attribute__((ext_vector_type(4)));
typedef unsigned u32x2 __attribute__((ext_vector_type(2)));

constexpr int NB = 8, SEQ = 4096, DM = 1024, CTXL = 256, DEPTH = 4, GRIDW = 64;
constexpr int TX = NB * SEQ, TC = NB * CTXL, TT = TX + TC;
constexpr int NP = 2816;
constexpr int C_NAQ = 0, C_NAK = 384, C_NAV = 768, C_GV = 1152, C_GQ = 1536, C_GK = 1728, C_GG = 1920, C_POOL = 2304, C_AF = 2560, C_AB = 2576;
constexpr int VT_C0 = 768, VT_NC = 768, VTS = TT + 128;
constexpr int NE = 32, TOPK = 4, NASG = TT * TOPK;
constexpr int SLOT_DUMMY = NASG + 256;
constexpr int GH = 4, GDK = 48, GDV = 96, NH = 6, NDH = 64;
constexpr float EPS = 1e-6f;
constexpr int NWAVES = 8, NTHREADS = 512;
constexpr int PPL = 9;
constexpr int NPHASES = 2 + PPL * DEPTH;
#ifndef MOE_FP8
#define MOE_FP8 1
#endif
#ifndef REPMASK
#define REPMASK 0
#endif
#define REPS(b) (1 + ((REPMASK >> (b)) & 1))
#ifndef GLA_CHECK
#define GLA_CHECK 0
#endif

constexpr size_t MiB = 1u << 20;
constexpr size_t WS_CTL = 0, CTL_ZERO_BYTES = 128 * 1024;
constexpr size_t WS_MOD = 2 * MiB;
constexpr size_t WS_BIN = 4 * MiB;
constexpr size_t WS_BOUT = 26 * MiB;
constexpr size_t WS_BGU = 34 * MiB;
constexpr size_t WS_BDN = 546 * MiB;
constexpr size_t WS_X = 802 * MiB;
constexpr size_t WS_H = 938 * MiB;
constexpr size_t WS_P = 1008 * MiB;
constexpr size_t WS_VTX = 1196 * MiB;
constexpr size_t WS_VTC = 1220 * MiB;
constexpr size_t WS_MIX = 1222 * MiB;
constexpr size_t WS_OF = 1290 * MiB;
constexpr size_t WS_OB = 1341 * MiB;
constexpr size_t WS_ACT = 1392 * MiB;
constexpr size_t WS_YB = 1665 * MiB;
constexpr size_t WS_LIST = 1938 * MiB;
constexpr size_t WS_GATE = 1943 * MiB;
constexpr size_t WS_DS = 1944 * MiB;
constexpr size_t WS_GD = 2025 * MiB;
constexpr size_t WS_ROPE = 2026 * MiB;
constexpr size_t WS_VTA = 2027 * MiB;
constexpr size_t WS_OPS = 2080 * MiB;
constexpr size_t WS_STB = 2132 * MiB;
constexpr size_t WS_H8 = 2172 * MiB;
constexpr size_t WS_INV = 2208 * MiB;
constexpr size_t WS_GATES = 2209 * MiB;
constexpr size_t WS_END = 2210 * MiB;
constexpr int CW_BAR = 4096;
constexpr int CW_CNT = 16384;

constexpr int STAGE_BYTES = 132096;
constexpr int MISC_OFF = STAGE_BYTES;
constexpr int TAB_OFF = MISC_OFF + 1024;
constexpr int MAXU = 28;
constexpr int LDS_BYTES = TAB_OFF + MAXU * 1024;
static_assert(LDS_BYTES <= 163840, "LDS");

#define LDS_WAIT() asm volatile("s_waitcnt lgkmcnt(0)" ::: "memory")
#define VM_WAIT() asm volatile("s_waitcnt vmcnt(0)" ::: "memory")
__device__ __forceinline__ unsigned f2bf(float f) { unsigned u = __builtin_bit_cast(unsigned, f); return (u + 0x7fffu + ((u >> 16) & 1u)) >> 16; }
__device__ __forceinline__ unsigned pk2(float lo, float hi) { return f2bf(lo) | (f2bf(hi) << 16); }
__device__ __forceinline__ float bf2f(unsigned b) { return __builtin_bit_cast(float, (b & 0xffffu) << 16); }
__device__ __forceinline__ float bflo(unsigned w) { return __builtin_bit_cast(float, w << 16); }
__device__ __forceinline__ float bfhi(unsigned w) { return __builtin_bit_cast(float, w & 0xffff0000u); }
__device__ __forceinline__ unsigned cvt_pk_bf16(float lo, float hi) { unsigned r; asm volatile("v_cvt_pk_bf16_f32 %0, %1, %2" : "=v"(r) : "v"(lo), "v"(hi)); return r; }
__device__ __forceinline__ unsigned pk4_fp8(float a, float b, float c, float d) { int p = __builtin_amdgcn_cvt_pk_fp8_f32(a, b, 0, false); p = __builtin_amdgcn_cvt_pk_fp8_f32(c, d, p, true); return (unsigned)p; }
constexpr float W8_SCALE = 64.f, W8_INV = 1.f / 64.f;
__device__ __forceinline__ float wave_sum(float v) {
#pragma unroll
    for (int o = 1; o < 64; o <<= 1) v += __shfl_xor(v, o);
    return v;
}
__device__ __forceinline__ float silu_f(float x) { return x / (1.f + __expf(-x)); }

#define XB_TMO      128
#define XB_XCNT(j)  (256  + 64 * (j))
#define XB_XSUB(j)  (1280 + 64 * (j))
#define XB_XGEN(j)  (2304 + 64 * (j))
#define XB_TOP      3328
#define XB_TOPGEN   3392
#define XCD_BAR_WORDS 3456
#define XB_SPIN_CAP (1u << 18)
__device__ __forceinline__ unsigned xb_ld(unsigned* p)              { return __hip_atomic_load(p, __ATOMIC_RELAXED, __HIP_MEMORY_SCOPE_AGENT); }
__device__ __forceinline__ unsigned xb_add(unsigned* p, unsigned v) { return __hip_atomic_fetch_add(p, v, __ATOMIC_RELAXED, __HIP_MEMORY_SCOPE_AGENT); }
__device__ __forceinline__ unsigned xb_xcc_id() { return (unsigned)__builtin_amdgcn_s_getreg((3 << 11) | 20) & 0xFu; }
#define XB_SPIN(cond, bar) do { unsigned _sp = 0; while (cond) { __builtin_amdgcn_s_sleep(1); \
    if ((++_sp & 255u) == 0u) { if (xb_ld(&(bar)[XB_TMO])) break; if (_sp > XB_SPIN_CAP) { atomicAdd(&(bar)[XB_TMO], 1u); break; } } } } while (0)
struct XcdBarrier { unsigned* bar; unsigned x; volatile LAS unsigned* st; };
__device__ __forceinline__ XcdBarrier xcd_barrier_post(unsigned* bar, volatile LAS unsigned* st) {
    XcdBarrier b; b.bar = bar; b.x = xb_xcc_id(); b.st = st;
    if (threadIdx.x == 0) (void)xb_add(&bar[XB_XCNT(b.x)], 1u);
    return b;
}
__device__ __forceinline__ void xcd_barrier_complete(unsigned* bar, unsigned x, unsigned& nloc, unsigned& nx) {
    const unsigned G = gridDim.x * gridDim.y * gridDim.z;
    unsigned sum, cnt, mine, sp = 0u;
    for (;;) {
        sum = 0u; cnt = 0u; mine = 0u;
#pragma unroll
        for (unsigned j = 0; j < 16; ++j) { const unsigned c = xb_ld(&bar[XB_XCNT(j)]); sum += c; cnt += (c > 0u) ? 1u : 0u; mine = (j == x) ? c : mine; }
        if (sum == G) break;
        __builtin_amdgcn_s_sleep(1);
        if ((++sp & 255u) == 0u) { if (xb_ld(&bar[XB_TMO])) break; if (sp > XB_SPIN_CAP) { atomicAdd(&bar[XB_TMO], 1u); break; } }
    }
    nloc = mine > 0u ? mine : 1u; nx = cnt > 0u ? cnt : 1u;
}
__device__ __forceinline__ void xcd_barrier(const XcdBarrier& b) {
    asm volatile("s_waitcnt vmcnt(0)" ::: "memory");
    __syncthreads();
    if (threadIdx.x == 0) {
        unsigned* bar = b.bar;
        __builtin_amdgcn_s_waitcnt(0);
        unsigned nloc = b.st[0], nx = b.st[1];
        if (nloc == 0u) { xcd_barrier_complete(bar, b.x, nloc, nx); b.st[0] = nloc; b.st[1] = nx; }
        const unsigned old = xb_add(&bar[XB_XSUB(b.x)], 1u);
        const unsigned gen = old / nloc;
        if (old + 1u == (gen + 1u) * nloc) {
            __builtin_amdgcn_fence(__ATOMIC_RELEASE, "agent");
            asm volatile("s_waitcnt vmcnt(0)" ::: "memory");
            const unsigned og = xb_add(&bar[XB_TOP], 1u);
            const unsigned tg = og / nx;
            if (og + 1u == (tg + 1u) * nx) xb_add(&bar[XB_TOPGEN], 1u);
            else XB_SPIN(xb_ld(&bar[XB_TOPGEN]) == tg, bar);
            __builtin_amdgcn_fence(__ATOMIC_ACQUIRE, "agent");
            xb_add(&bar[XB_XGEN(b.x)], 1u);
            asm volatile("s_waitcnt vmcnt(0)" ::: "memory");
        } else {
            XB_SPIN(xb_ld(&bar[XB_XGEN(b.x)]) == gen, bar);
            __builtin_amdgcn_fence(__ATOMIC_ACQUIRE, "agent");
            asm volatile("s_waitcnt vmcnt(0)" ::: "memory");
        }
    }
    __syncthreads();
}

namespace g8 {
constexpr int BM = 256, BK = 64, HALF = 128, HTB = HALF * BK * 2, NXCD = 8, WGM = 8, KD = 1024;
__device__ __forceinline__ int lds_byte(int r, int c) { const int st = (r >> 4) * 2 + (c >> 5), rr = r & 15, cc = c & 31, ob = rr * 64 + cc * 2; return st * 1024 + (ob ^ (((ob >> 9) & 1) << 5)); }
__device__ __forceinline__ void stage_rc(int b, int& R, int& C) { const int st = b / 1024, sb = b % 1024, swz = sb ^ (((sb >> 9) & 1) << 5); R = (st >> 1) * 16 + swz / 64; C = (st & 1) * 32 + (swz % 64) / 2; }
__device__ __forceinline__ int perm32(int rho) { const int n = rho >> 4, i = rho & 15; return 8 * (i >> 2) + 4 * n + (i & 3); }
struct Unit { int pm, pn, e; };
typedef int i32x8 __attribute__((ext_vector_type(8)));
typedef int i32x4 __attribute__((ext_vector_type(4)));
__device__ __forceinline__ i32x8 cat8(bf16x8 a, bf16x8 b) { const i32x4 x = __builtin_bit_cast(i32x4, a), y = __builtin_bit_cast(i32x4, b); return (i32x8){x.x, x.y, x.z, x.w, y.x, y.y, y.z, y.w}; }
__device__ __forceinline__ bool static_unit(long L, int nM, int nN, Unit& u) {
    const int nwg = nM * nN; if (L >= nwg) return false;
    int wgid = (int)L; { const int q = nwg / NXCD, r = nwg % NXCD, xcd = wgid % NXCD, off = wgid / NXCD; wgid = (xcd < r ? xcd * (q + 1) : r * (q + 1) + (xcd - r) * q) + off; }
    const int nig = WGM * nN, gid = wgid / nig, fm = gid * WGM, gsz = (nM - fm) < WGM ? (nM - fm) : WGM;
    u.pm = fm + ((wgid % nig) % gsz); u.pn = (wgid % nig) / gsz; u.e = 0; return true;
}

#ifndef PROBE_DRY
#define PROBE_DRY 0
#endif
#ifndef STAG_TICKS
#define STAG_TICKS 0
#endif
template <class Prob>
__device__ __forceinline__ void gemm_phase(LAS unsigned char* lds, const Prob& P) {

    int tid_ = threadIdx.x; asm volatile("" : "+v"(tid_));
    const int tid = tid_, wid = __builtin_amdgcn_readfirstlane(tid >> 6), lane = tid & 63, wr = wid >> 2, wc = wid & 3, fr = lane & 15, fq = lane >> 4;
    constexpr int RPB = Prob::FP8 ? KD : KD * 2, nt = RPB / (BK * 2);
    unsigned voffB[2];
    { int R0, C0, R1, C1; stage_rc(tid * 16, R0, C0); stage_rc(tid * 16 + 8192, R1, C1); const int Rb0 = Prob::PERM ? ((R0 & ~31) + perm32(R0 & 31)) : R0, Rb1 = Prob::PERM ? ((R1 & ~31) + perm32(R1 & 31)) : R1;
      voffB[0] = (unsigned)(Rb0 * RPB + C0 * 2); voffB[1] = (unsigned)(Rb1 * RPB + C1 * 2); }
    const size_t kstep = (size_t)(BK * 2), hstepB = (size_t)HALF * RPB;
    const unsigned ldsw = (unsigned)wid * 1024u;
    const int aoff = lds_byte(wr * 64 + fr, fq * 8), boff = lds_byte(wc * 32 + fr, fq * 8);
#define G8_SA(b, h) (((b) * 2 + (h)) * HTB)
#define G8_SB(b, h) ((4 + (b) * 2 + (h)) * HTB)
#define G8_STAGE(bufoff, gbase, voff) do { _Pragma("unroll") for (int _i = 0; _i < 2; ++_i) \
        __builtin_amdgcn_global_load_lds((const unsigned*)((const char*)(gbase) + (voff)[_i]), (LAS unsigned*)(lds + (bufoff) + ldsw + _i * 8192), 16, 0, 0); } while (0)
#define G8_LDA(dst, b, h) do { _Pragma("unroll") for (int m = 0; m < 4; ++m) _Pragma("unroll") for (int k = 0; k < 2; ++k) dst[m][k] = *(const LAS bf16x8*)(lds + G8_SA(b, h) + aoff + m * 2048 + k * 1024); } while (0)
#define G8_LDB(dst, b, h) do { _Pragma("unroll") for (int n = 0; n < 2; ++n) _Pragma("unroll") for (int k = 0; k < 2; ++k) dst[n][k] = *(const LAS bf16x8*)(lds + G8_SB(b, h) + boff + n * 2048 + k * 1024); } while (0)
#define G8_MMA(ai, bj, At, Bt) do { __builtin_amdgcn_s_setprio(1); if constexpr (Prob::FP8) { \
        _Pragma("unroll") for (int m = 0; m < 4; ++m) _Pragma("unroll") for (int n = 0; n < 2; ++n) \
        acc[ai][bj][m][n] = __builtin_amdgcn_mfma_scale_f32_16x16x128_f8f6f4(cat8(Bt[n][0], Bt[n][1]), cat8(At[m][0], At[m][1]), acc[ai][bj][m][n], 0, 0, 0, 0x7f7f7f7f, 0, 0x7f7f7f7f); } else { \
        _Pragma("unroll") for (int m = 0; m < 4; ++m) _Pragma("unroll") for (int n = 0; n < 2; ++n) _Pragma("unroll") for (int k = 0; k < 2; ++k) \
        acc[ai][bj][m][n] = __builtin_amdgcn_mfma_f32_16x16x32_bf16(Bt[n][k], At[m][k], acc[ai][bj][m][n], 0, 0, 0); } __builtin_amdgcn_s_setprio(0); } while (0)
#define G8_WAIT_V(n) asm volatile("s_waitcnt vmcnt(" #n ")" ::: "memory")
#define G8_WAIT_L(n) asm volatile("s_waitcnt lgkmcnt(" #n ")" ::: "memory")
#define G8_BAR __builtin_amdgcn_s_barrier()
#define G8_SCHED __builtin_amdgcn_sched_barrier(0)
    Unit cur, nxt; int ui = 0;
    if (!P.next(0, cur)) return;
    f32x4 acc[2][2][4][2];
#pragma unroll
    for (int a = 0; a < 2; ++a)
#pragma unroll
        for (int b = 0; b < 2; ++b)
#pragma unroll
            for (int m = 0; m < 4; ++m)
#pragma unroll
                for (int n = 0; n < 2; ++n) acc[a][b][m][n] = (f32x4){0.f, 0.f, 0.f, 0.f};
    bf16x8 At[4][2], B0[2][2], B1[2][2];
    unsigned cvA[2][2];
    P.a_off(cur, 0, tid, cvA);
    const char* cA = P.a_base(cur);
    const char* cB = P.b_ptr(cur);
    G8_STAGE(G8_SB(0, 0), cB, voffB); G8_STAGE(G8_SB(0, 1), cB + hstepB, voffB); G8_STAGE(G8_SA(0, 0), cA, cvA[0]); G8_STAGE(G8_SA(0, 1), cA, cvA[1]);
    if (wr == 1) G8_BAR;
    G8_WAIT_V(2); G8_BAR;
    G8_STAGE(G8_SB(1, 0), cB + kstep, voffB); G8_STAGE(G8_SA(1, 0), cA + kstep, cvA[0]); G8_STAGE(G8_SB(1, 1), cB + hstepB + kstep, voffB);
    G8_WAIT_V(6); G8_BAR;
    for (;;) {
        const bool has_next = P.next(ui + 1, nxt);
        const char* nB = has_next ? P.b_ptr(nxt) : cB;
        const char* nA = has_next ? P.a_base(nxt) : cA;
        for (int t = 0; t < nt; t += 2) {
            const bool last = (t == nt - 2);
            const char* a1 = cA + (size_t)(t + 1) * kstep;
            const char* a2 = last ? nA : cA + (size_t)(t + 2) * kstep; const char* b2 = last ? nB : cB + (size_t)(t + 2) * kstep;
            const char* a3 = a2 + kstep; const char* b3 = b2 + kstep;
            G8_LDB(B0, 0, 0); G8_LDB(B1, 0, 1); G8_SCHED; G8_LDA(At, 0, 0); G8_STAGE(G8_SA(1, 1), a1, cvA[1]);
            G8_WAIT_V(8); G8_WAIT_L(0); G8_BAR; G8_MMA(0, 0, At, B0); G8_MMA(0, 1, At, B1); G8_BAR; G8_SCHED;
            if (last && has_next) { int tz = threadIdx.x; asm volatile("" : "+v"(tz)); P.a_off(nxt, ui + 1, tz, cvA); }
            G8_LDA(At, 0, 1); G8_STAGE(G8_SB(0, 0), b2, voffB); G8_STAGE(G8_SB(0, 1), b2 + hstepB, voffB); G8_STAGE(G8_SA(0, 0), a2, cvA[0]);
            G8_WAIT_V(8); G8_WAIT_L(0); G8_BAR; G8_MMA(1, 0, At, B0); G8_MMA(1, 1, At, B1); G8_BAR; G8_SCHED;
            G8_LDB(B0, 1, 0); G8_LDB(B1, 1, 1); G8_SCHED; G8_LDA(At, 1, 0); G8_STAGE(G8_SA(0, 1), a2, cvA[1]);
            G8_WAIT_V(8); G8_WAIT_L(0); G8_BAR; G8_MMA(0, 0, At, B0); G8_MMA(0, 1, At, B1); G8_BAR; G8_SCHED;
            G8_LDA(At, 1, 1); G8_STAGE(G8_SB(1, 0), b3, voffB); G8_STAGE(G8_SB(1, 1), b3 + hstepB, voffB); G8_STAGE(G8_SA(1, 0), a3, cvA[0]);
            G8_WAIT_V(8); G8_WAIT_L(0); G8_BAR; G8_MMA(1, 0, At, B0); G8_MMA(1, 1, At, B1); G8_BAR; G8_SCHED;
        }
        if (wr == 0) G8_BAR;
        P.epi(acc, cur, ui, wr, wc, fr, fq);
        if (!has_next) break;
#pragma unroll
        for (int a = 0; a < 2; ++a)
#pragma unroll
            for (int b = 0; b < 2; ++b)
#pragma unroll
                for (int m = 0; m < 4; ++m)
#pragma unroll
                    for (int n = 0; n < 2; ++n) acc[a][b][m][n] = (f32x4){0.f, 0.f, 0.f, 0.f};
        cur = nxt; cB = nB; cA = nA; ++ui;
        if (wr == 1) G8_BAR;
    }
    G8_WAIT_V(0);
    G8_BAR;
#undef G8_SA
#undef G8_SB
#undef G8_STAGE
#undef G8_LDA
#undef G8_LDB
#undef G8_MMA
#undef G8_WAIT_V
#undef G8_WAIT_L
#undef G8_BAR
#undef G8_SCHED
}


struct ProbIn {
    static constexpr bool PERM = true, FP8 = false;
    const char* A; const char* Bt; bf16* O; bf16* VT; int G, c; int dry;
    __device__ __forceinline__ static bool swapped(const Unit& u) { return u.pn >= 3 && u.pn <= 5; }
    __device__ __forceinline__ bool next(int i, Unit& u) const { return static_unit((long)i * G + c, TT / 256, NP / 256, u); }
    __device__ __forceinline__ void a_off(const Unit& u, int, int tid, unsigned (&v)[2][2]) const {
        int R0, C0, R1, C1; stage_rc(tid * 16, R0, C0); stage_rc(tid * 16 + 8192, R1, C1);
        const int rt = swapped(u) ? u.pn : u.pm;
#pragma unroll
        for (int h = 0; h < 2; ++h) { v[h][0] = (unsigned)((rt * 256 + h * 128 + R0) * KD + C0) * 2u; v[h][1] = (unsigned)((rt * 256 + h * 128 + R1) * KD + C1) * 2u; }
    }
    __device__ __forceinline__ const char* a_base(const Unit& u) const { return swapped(u) ? Bt : A; }
    __device__ __forceinline__ const char* b_ptr(const Unit& u) const { return swapped(u) ? A + (size_t)u.pm * 256 * KD * 2 : Bt + (size_t)u.pn * 256 * KD * 2; }
    __device__ __forceinline__ void epi(const f32x4 (&acc)[2][2][4][2], const Unit& u, int, int wr, int wc, int fr, int fq) const {
        if (PROBE_DRY && dry) { asm volatile("" :: "v"(acc[0][0][0][0][0]), "v"(acc[1][1][3][1][3]), "v"(acc[0][1][2][0][1]), "v"(acc[1][0][1][1][2])); return; }
        const bool sw = swapped(u);
        bf16* base = sw ? VT + (size_t)(u.pn * 256 - VT_C0 + wr * 64 + fr) * VTS + u.pm * 256 + wc * 32 + 8 * fq
                        : O + (size_t)(u.pm * 256 + wr * 64 + fr) * NP + u.pn * 256 + wc * 32 + 8 * fq;
        const size_t ld = sw ? (size_t)VTS : (size_t)NP;
#pragma unroll
        for (int ai = 0; ai < 2; ++ai)
#pragma unroll
            for (int m = 0; m < 4; ++m) { bf16* rowp = base + (size_t)(ai * 128 + m * 16) * ld;
#pragma unroll
                for (int bj = 0; bj < 2; ++bj) { const f32x4 v0 = acc[ai][bj][m][0], v1 = acc[ai][bj][m][1];
                    u32x4 w; w.x = cvt_pk_bf16(v0[0], v0[1]); w.y = cvt_pk_bf16(v0[2], v0[3]); w.z = cvt_pk_bf16(v1[0], v1[1]); w.w = cvt_pk_bf16(v1[2], v1[3]);
                    *(u32x4*)(rowp + bj * 128) = w; } }
    }
};
struct ProbOut {
    static constexpr bool PERM = false, FP8 = false;
    const char* A; const char* Bt; float* X; const float* modl  ; int G, c, nM;
    __device__ __forceinline__ bool next(int i, Unit& u) const { return static_unit((long)i * G + c, nM, DM / 256, u); }
    __device__ __forceinline__ void a_off(const Unit& u, int, int tid, unsigned (&v)[2][2]) const {
        int R0, C0, R1, C1; stage_rc(tid * 16, R0, C0); stage_rc(tid * 16 + 8192, R1, C1);
#pragma unroll
        for (int h = 0; h < 2; ++h) { v[h][0] = (unsigned)((u.pm * 256 + h * 128 + R0) * KD + C0) * 2u; v[h][1] = (unsigned)((u.pm * 256 + h * 128 + R1) * KD + C1) * 2u; }
    }
    __device__ __forceinline__ const char* a_base(const Unit&) const { return A; }
    __device__ __forceinline__ const char* b_ptr(const Unit& u) const { return Bt + (size_t)u.pn * 256 * KD * 2; }
    __device__ __forceinline__ void epi(const f32x4 (&acc)[2][2][4][2], const Unit& u, int, int wr, int wc, int fr, int fq) const {
        const int r0 = u.pm * 256, br = r0 < TX ? (r0 / SEQ) : NB;
        const float* g1 = modl + (size_t)br * 6 * DM + 2 * DM;
        const int row0 = r0 + wr * 64 + fr, col0 = u.pn * 256 + wc * 32 + 4 * fq;
        f32x4 gv[2][2];
#pragma unroll
        for (int bj = 0; bj < 2; ++bj)
#pragma unroll
            for (int n = 0; n < 2; ++n) gv[bj][n] = *(const f32x4*)(g1 + col0 + bj * 128 + n * 16);
#pragma unroll
        for (int ai = 0; ai < 2; ++ai) {
            f32x4 xv[4][2][2];
#pragma unroll
            for (int m = 0; m < 4; ++m)
#pragma unroll
                for (int bj = 0; bj < 2; ++bj)
#pragma unroll
                    for (int n = 0; n < 2; ++n) xv[m][bj][n] = *(const f32x4*)(X + (size_t)(row0 + ai * 128 + m * 16) * DM + col0 + bj * 128 + n * 16);
#pragma unroll
            for (int m = 0; m < 4; ++m)
#pragma unroll
                for (int bj = 0; bj < 2; ++bj)
#pragma unroll
                    for (int n = 0; n < 2; ++n) *(f32x4*)(X + (size_t)(row0 + ai * 128 + m * 16) * DM + col0 + bj * 128 + n * 16) = xv[m][bj][n] + gv[bj][n] * acc[ai][bj][m][n];
        }
    }
};
__device__ __forceinline__ bool moe_unit(long L, int npn, const volatile LAS int* tp, Unit& u) {
    const int q = (int)(L / npn); if (q >= tp[NE]) return false;
    int e = 0;
#pragma unroll 1
    while (tp[e + 1] <= q) ++e;
    u.e = e; u.pm = q - tp[e]; u.pn = (int)(L % npn); return true;
}
struct ProbGU {
    static constexpr bool PERM = true, FP8 = (MOE_FP8 != 0); static constexpr unsigned EB = FP8 ? 1u : 2u;
    const char* A; const char* Bt  ; unsigned char* ACT; const float* bgu  ; const volatile LAS int* tp; const LAS int* tab; int G, c; int dry; const volatile LAS int* eb;
    __device__ __forceinline__ bool next(int i, Unit& u) const { return i < MAXU && moe_unit((long)i * G + c, 8, tp, u); }
    __device__ __forceinline__ void a_off(const Unit&, int ui, int tid, unsigned (&v)[2][2]) const {
        int R0, C0, R1, C1; stage_rc(tid * 16, R0, C0); stage_rc(tid * 16 + 8192, R1, C1);
#pragma unroll
        for (int h = 0; h < 2; ++h) { const int a0 = tab[ui * 256 + h * 128 + R0], a1 = tab[ui * 256 + h * 128 + R1];
            v[h][0] = (unsigned)(a0 < 0 ? TT : (a0 >> 2)) * (unsigned)KD * EB + (unsigned)C0 * 2u; v[h][1] = (unsigned)(a1 < 0 ? TT : (a1 >> 2)) * (unsigned)KD * EB + (unsigned)C1 * 2u; }
    }
    __device__ __forceinline__ const char* a_base(const Unit&) const { return A; }
    __device__ __forceinline__ const char* b_ptr(const Unit& u) const { return Bt + ((size_t)u.e * 2 * DM + (size_t)u.pn * 256) * KD * EB; }
    __device__ __forceinline__ void epi(const f32x4 (&acc)[2][2][4][2], const Unit& u, int ui, int wr, int wc, int fr, int fq) const {
        if (PROBE_DRY && dry) { asm volatile("" :: "v"(acc[0][0][0][0][0]), "v"(acc[1][1][3][1][3]), "v"(acc[0][1][2][0][1]), "v"(acc[1][0][1][1][2])); return; }
        const int cb = u.pn * 128 + wc * 32 + 8 * fq;
        const float* bg = bgu + (size_t)u.e * 2 * DM + cb; const float* bu = bg + DM;
        const f32x4 bg0 = *(const f32x4*)bg, bg1 = *(const f32x4*)(bg + 4), bu0 = *(const f32x4*)bu, bu1 = *(const f32x4*)(bu + 4);
        const int ebu = eb[u.e] + u.pm * 256;
#pragma unroll
        for (int ai = 0; ai < 2; ++ai)
#pragma unroll
            for (int m = 0; m < 4; ++m) {
                const int a = tab[ui * 256 + ai * 128 + wr * 64 + m * 16 + fr];
                unsigned char* rowp = ACT + ((size_t)(a < 0 ? SLOT_DUMMY : ebu + ai * 128 + wr * 64 + m * 16 + fr) * DM + cb) * EB;
                float o[8];
#pragma unroll
                for (int n = 0; n < 2; ++n) { const f32x4 gb = n ? bg1 : bg0, ub = n ? bu1 : bu0;
#pragma unroll
                    for (int j = 0; j < 4; ++j) { float g = acc[ai][0][m][n][j] * (FP8 ? W8_INV : 1.f) + gb[j], uu = acc[ai][1][m][n][j] * (FP8 ? W8_INV : 1.f) + ub[j];
                        g = fminf(g, 7.f); uu = fminf(fmaxf(uu, -7.f), 7.f);
                        o[n * 4 + j] = g * __builtin_amdgcn_rcpf(1.f + __expf(-1.702f * g)) * (uu + 1.f); } }
                if constexpr (FP8) { u32x2 w; w.x = pk4_fp8(o[0], o[1], o[2], o[3]); w.y = pk4_fp8(o[4], o[5], o[6], o[7]); *(u32x2*)rowp = w; }
                else { u32x4 w; w.x = cvt_pk_bf16(o[0], o[1]); w.y = cvt_pk_bf16(o[2], o[3]); w.z = cvt_pk_bf16(o[4], o[5]); w.w = cvt_pk_bf16(o[6], o[7]); *(u32x4*)rowp = w; } }
    }
};
struct ProbDN {
    static constexpr bool PERM = true, FP8 = (MOE_FP8 != 0); static constexpr unsigned EB = FP8 ? 1u : 2u;
    const char* A; const char* Bt  ; bf16* YB; const float* bdn  ; const float* gates  ; const volatile LAS int* tp; int G, c; int dry; const volatile LAS int* eb; const volatile LAS int* cntl;
    __device__ __forceinline__ bool next(int i, Unit& u) const { return i < MAXU && moe_unit((long)i * G + c, 4, tp, u); }
    __device__ __forceinline__ void a_off(const Unit& u, int, int tid, unsigned (&v)[2][2]) const {
        int R0, C0, R1, C1; stage_rc(tid * 16, R0, C0); stage_rc(tid * 16 + 8192, R1, C1);
        const int r0 = eb[u.e] + u.pm * 256;
#pragma unroll
        for (int h = 0; h < 2; ++h) { v[h][0] = (unsigned)(r0 + h * 128 + R0) * (unsigned)KD * EB + (unsigned)C0 * 2u; v[h][1] = (unsigned)(r0 + h * 128 + R1) * (unsigned)KD * EB + (unsigned)C1 * 2u; }
    }
    __device__ __forceinline__ const char* a_base(const Unit&) const { return A; }
    __device__ __forceinline__ const char* b_ptr(const Unit& u) const { return Bt + ((size_t)u.e * DM + (size_t)u.pn * 256) * KD * EB; }
    __device__ __forceinline__ void epi(const f32x4 (&acc)[2][2][4][2], const Unit& u, int ui, int wr, int wc, int fr, int fq) const {
        if (PROBE_DRY && dry) { asm volatile("" :: "v"(acc[0][0][0][0][0]), "v"(acc[1][1][3][1][3]), "v"(acc[0][1][2][0][1]), "v"(acc[1][0][1][1][2])); return; }
        const int col0 = u.pn * 256 + wc * 32 + 8 * fq;
        const float* bd = bdn + (size_t)u.e * DM + col0;
        f32x4 bv[2][2];
#pragma unroll
        for (int bj = 0; bj < 2; ++bj)
#pragma unroll
            for (int n = 0; n < 2; ++n) bv[bj][n] = *(const f32x4*)(bd + bj * 128 + 4 * n);
        int sl[2][4]; float gt[2][4]; const int ebu = eb[u.e] + u.pm * 256, nval = cntl[u.e] - u.pm * 256;
#pragma unroll
        for (int ai = 0; ai < 2; ++ai)
#pragma unroll
            for (int m = 0; m < 4; ++m) { const int rl = ai * 128 + wr * 64 + m * 16 + fr; sl[ai][m] = rl < nval ? ebu + rl : SLOT_DUMMY; gt[ai][m] = gates[sl[ai][m]]; }
#pragma unroll
        for (int ai = 0; ai < 2; ++ai)
#pragma unroll
            for (int m = 0; m < 4; ++m) {
                bf16* rowp = YB + (size_t)sl[ai][m] * DM + col0;
#pragma unroll
                for (int bj = 0; bj < 2; ++bj) { const f32x4 v0 = (acc[ai][bj][m][0] * (FP8 ? W8_INV : 1.f) + bv[bj][0]) * gt[ai][m], v1 = (acc[ai][bj][m][1] * (FP8 ? W8_INV : 1.f) + bv[bj][1]) * gt[ai][m];
                    u32x4 w; w.x = cvt_pk_bf16(v0[0], v0[1]); w.y = cvt_pk_bf16(v0[2], v0[3]); w.z = cvt_pk_bf16(v1[0], v1[1]); w.w = cvt_pk_bf16(v1[2], v1[3]);
                    *(u32x4*)(rowp + bj * 128) = w; } }
    }
};
}

struct Args { const float* in[23]; float* out; unsigned char* ws; int ph_lo, ph_hi; };
struct Frame {
    LAS unsigned char* lds; volatile LAS unsigned* MISC;
    int tid, lane, wave, G, vcu;
    const float *x, *c, *ctx, *c_ctx, *norm1_g, *norm2_g, *w_ada, *b_ada, *w_in, *gla_wa2, *gla_ba, *gla_norm_g, *na_rpb, *pool_w, *pool_scale, *w_out, *router_w, *router_b, *w_gu, *b_gu, *w_down, *b_down, *final_g;
    float* out; unsigned char* ws; unsigned* ctl;
    float* mod; bf16 *Bin, *Bout, *Bgu, *Bdn; float* X; bf16 *H, *P, *VTX, *VTC, *MIX; float *OF, *OB; bf16 *ACT, *YB; int* LIST; float* GATE; float *DS, *GD, *ROPE; bf16 *VTA, *OPS, *STB; unsigned char* H8; int* INV; float* GATES;
};


#define CAS __attribute__((address_space(4)))
__device__ __forceinline__ void frame_ptrs(Frame& F) {
    const CAS unsigned char* ka = (const CAS unsigned char*)__builtin_amdgcn_kernarg_segment_ptr();
    asm volatile("" : "+s"(ka));
    typedef const GAS float* gfp;
    const CAS gfp* in = (const CAS gfp*)ka;
    F.x = (const float*)in[0]; F.c = (const float*)in[1]; F.ctx = (const float*)in[2]; F.c_ctx = (const float*)in[3]; F.norm1_g = (const float*)in[4]; F.norm2_g = (const float*)in[5];
    F.w_ada = (const float*)in[6]; F.b_ada = (const float*)in[7]; F.w_in = (const float*)in[8]; F.gla_wa2 = (const float*)in[9]; F.gla_ba = (const float*)in[10]; F.gla_norm_g = (const float*)in[11];
    F.na_rpb = (const float*)in[12]; F.pool_w = (const float*)in[13]; F.pool_scale = (const float*)in[14]; F.w_out = (const float*)in[15]; F.router_w = (const float*)in[16]; F.router_b = (const float*)in[17];
    F.w_gu = (const float*)in[18]; F.b_gu = (const float*)in[19]; F.w_down = (const float*)in[20]; F.b_down = (const float*)in[21]; F.final_g = (const float*)in[22];
    F.out = (float*)*(GAS float* const CAS*)(ka + 184);
    GAS unsigned char* ws = *(GAS unsigned char* const CAS*)(ka + 192);
    F.ws = (unsigned char*)ws; F.ctl = (unsigned*)(ws + WS_CTL);
    F.mod = (float*)(ws + WS_MOD); F.Bin = (bf16*)(ws + WS_BIN); F.Bout = (bf16*)(ws + WS_BOUT); F.Bgu = (bf16*)(ws + WS_BGU); F.Bdn = (bf16*)(ws + WS_BDN);
    F.X = (float*)(ws + WS_X); F.H = (bf16*)(ws + WS_H); F.P = (bf16*)(ws + WS_P); F.VTX = (bf16*)(ws + WS_VTX); F.VTC = (bf16*)(ws + WS_VTC); F.MIX = (bf16*)(ws + WS_MIX);
    F.OF = (float*)(ws + WS_OF); F.OB = (float*)(ws + WS_OB); F.ACT = (bf16*)(ws + WS_ACT); F.YB = (bf16*)(ws + WS_YB); F.LIST = (int*)(ws + WS_LIST); F.GATE = (float*)(ws + WS_GATE);
    F.DS = (float*)(ws + WS_DS); F.GD = (float*)(ws + WS_GD); F.ROPE = (float*)(ws + WS_ROPE); F.VTA = (bf16*)(ws + WS_VTA); F.OPS = (bf16*)(ws + WS_OPS); F.STB = (bf16*)(ws + WS_STB); F.H8 = (unsigned char*)(ws + WS_H8); F.INV = (int*)(ws + WS_INV); F.GATES = (float*)(ws + WS_GATES);
}
static_assert(offsetof(Args, out) == 184 && offsetof(Args, ws) == 192, "Args layout");

__device__ __forceinline__ void in_col_map(int n0, int& dst, float& scale) {
    scale = 1.f;
    if (n0 < 192) { dst = C_GQ + n0; scale = 0.14433756729740643f; }
    else if (n0 < 384) dst = C_GK + (n0 - 192);
    else if (n0 < 768) dst = C_GV + (n0 - 384);
    else if (n0 < 800) dst = C_AF + (n0 - 768);
    else if (n0 < 1184) dst = C_GG + (n0 - 800);
    else if (n0 < 1568) { dst = C_NAQ + (n0 - 1184); scale = 0.125f; }
    else if (n0 < 1952) dst = C_NAK + (n0 - 1568);
    else if (n0 < 2336) dst = C_NAV + (n0 - 1952);
    else dst = C_POOL + (n0 - 2336);
}
struct TItem { const float* src; int N; unsigned char* dst; int fp8; float scale; };
__device__ __forceinline__ TItem titem_decode(const Frame& F, int r) {
    constexpr int I_IN = DEPTH * 16 * 81, I_OUT = DEPTH * 16 * 32, I_GU = DEPTH * NE * 16 * 64;
    TItem t; t.fp8 = 0; t.scale = 1.f;
    if (r < I_IN) { const int l = r / (16 * 81), rr = r % (16 * 81), kb = rr / 81, nb = rr % 81; int dst; in_col_map(nb * 32, dst, t.scale);
        t.N = 2592; t.src = F.w_in + (size_t)l * DM * 2592 + (size_t)(kb * 64) * 2592 + nb * 32; t.dst = (unsigned char*)(F.Bin + ((size_t)l * NP + dst) * DM + kb * 64); return t; }
    r -= I_IN;
    if (r < I_OUT) { const int l = r / (16 * 32), rr = r % (16 * 32), kb = rr / 32, nb = rr % 32;
        t.N = DM; t.src = F.w_out + (size_t)l * DM * DM + (size_t)(kb * 64) * DM + nb * 32; t.dst = (unsigned char*)(F.Bout + ((size_t)l * DM + nb * 32) * DM + kb * 64); return t; }
    r -= I_OUT; t.fp8 = MOE_FP8; constexpr size_t EB = MOE_FP8 ? 1 : 2;
    if (r < I_GU) { const int le = r / (16 * 64), rr = r % (16 * 64), kb = rr / 64, nb = rr % 64; const int j0 = nb * 32;
        const int dst = j0 < DM ? (j0 / 128) * 256 + (j0 % 128) : ((j0 - DM) / 128) * 256 + 128 + ((j0 - DM) % 128);
        t.N = 2 * DM; t.src = F.w_gu + (size_t)le * DM * 2 * DM + (size_t)(kb * 64) * 2 * DM + j0; t.dst = (unsigned char*)F.Bgu + (((size_t)le * 2 * DM + dst) * DM + kb * 64) * EB; return t; }
    r -= I_GU;
    { const int le = r / (16 * 32), rr = r % (16 * 32), kb = rr / 32, nb = rr % 32;
        t.N = DM; t.src = F.w_down + (size_t)le * DM * DM + (size_t)(kb * 64) * DM + nb * 32; t.dst = (unsigned char*)F.Bdn + (((size_t)le * DM + nb * 32) * DM + kb * 64) * EB; return t; }
}
__device__ __forceinline__ void titem_load(const TItem& t, int lane, f32x4 (&r)[8]) {
#pragma unroll
    for (int i = 0; i < 8; ++i) r[i] = *(const f32x4*)(t.src + (size_t)((lane >> 3) + 8 * i) * t.N + 4 * (lane & 7));
}
__device__ __forceinline__ void titem_store(const TItem& t, const f32x4 (&r)[8], LAS float* scr, int lane) {
#pragma unroll
    for (int i = 0; i < 8; ++i) { LAS float* p = scr + ((lane >> 3) + 8 * i) * 33 + 4 * (lane & 7); p[0] = r[i].x; p[1] = r[i].y; p[2] = r[i].z; p[3] = r[i].w; }
    LDS_WAIT(); asm volatile("" ::: "memory");
    if (t.fp8) { const int c = lane & 3; const float sc = W8_SCALE;
#pragma unroll
        for (int j = 0; j < 2; ++j) { const int n = (lane >> 2) + 16 * j; const LAS float* s = scr + (16 * c) * 33 + n;
            u32x4 o;
            o.x = pk4_fp8(s[0 * 33] * sc, s[1 * 33] * sc, s[2 * 33] * sc, s[3 * 33] * sc); o.y = pk4_fp8(s[4 * 33] * sc, s[5 * 33] * sc, s[6 * 33] * sc, s[7 * 33] * sc);
            o.z = pk4_fp8(s[8 * 33] * sc, s[9 * 33] * sc, s[10 * 33] * sc, s[11 * 33] * sc); o.w = pk4_fp8(s[12 * 33] * sc, s[13 * 33] * sc, s[14 * 33] * sc, s[15 * 33] * sc);
            *(u32x4*)(t.dst + (size_t)n * DM + 16 * c) = o; }
    } else { const int c = lane & 7; const float sc = t.scale;
#pragma unroll
        for (int j = 0; j < 4; ++j) { const int n = (lane >> 3) + 8 * j; const LAS float* s = scr + (8 * c) * 33 + n;
            u32x4 o; o.x = pk2(s[0 * 33] * sc, s[1 * 33] * sc); o.y = pk2(s[2 * 33] * sc, s[3 * 33] * sc); o.z = pk2(s[4 * 33] * sc, s[5 * 33] * sc); o.w = pk2(s[6 * 33] * sc, s[7 * 33] * sc);
            *(u32x4*)(t.dst + ((size_t)n * DM + 8 * c) * 2) = o; }
    }
    LDS_WAIT(); asm volatile("" ::: "memory");
}
__device__ __forceinline__ int conv_item_id(int t, int lay, int nfix) {
    constexpr int I_IN = DEPTH * 16 * 81, I_OUT = DEPTH * 16 * 32, I_GU = DEPTH * NE * 16 * 64;
    if (t < nfix) return t;
    t -= nfix;
    return t < NE * 16 * 64 ? I_IN + I_OUT + lay * (NE * 16 * 64) + t : I_IN + I_OUT + I_GU + lay * (NE * 16 * 32) + (t - NE * 16 * 64);
}
__device__ __forceinline__ void convert_items(Frame& F, int lay, int ntot, int t0 = 0, int t1 = -1) {
    LAS float* scr = (LAS float*)(F.lds + F.wave * 16384);
    const int gw = F.vcu * NWAVES + F.wave, NGW = F.G * NWAVES, lane = F.lane;
    const int nfix = ntot - 3 * (NE * 16 * 32);
    if (t1 >= 0) ntot = t1;
    int it = t0 + gw; TItem cur = titem_decode(F, conv_item_id(it < ntot ? it : 0, lay, nfix)); f32x4 ra[8];
    if (it < ntot) titem_load(cur, lane, ra);
    while (it < ntot) {
        const int itn = it + NGW; const bool hn = itn < ntot;
        TItem nxt = titem_decode(F, conv_item_id(hn ? itn : 0, lay, nfix)); f32x4 rb[8];
        if (hn) titem_load(nxt, lane, rb);
        titem_store(cur, ra, scr, lane);
        it = itn; cur = nxt;
#pragma unroll
        for (int i = 0; i < 8; ++i) ra[i] = rb[i];
    }
}
__device__ __forceinline__ void ph_prologue(Frame& F) {
    const int gw = F.vcu * NWAVES + F.wave, NGW = F.G * NWAVES, lane = F.lane;
    constexpr int I_IN = DEPTH * 16 * 81, I_OUT = DEPTH * 16 * 32;
    for (int r = F.vcu; r < DEPTH * 24; r += F.G) {
        const int l = r / 24, j4 = (r % 24) * 256 + 4 * lane, k0 = F.wave * 128;
        const float* W = F.w_ada + (size_t)l * DM * 6 * DM + (size_t)k0 * 6 * DM + j4;
        f32x4 acc[9];
#pragma unroll
        for (int q = 0; q < 9; ++q) acc[q] = (f32x4){0.f, 0.f, 0.f, 0.f};
#pragma unroll 1
        for (int kh = 0; kh < 2; ++kh) {
            float cv[9];
#pragma unroll
            for (int q = 0; q < 8; ++q) cv[q] = silu_f(F.c[q * DM + k0 + 64 * kh + lane]);
            cv[8] = silu_f(F.c_ctx[k0 + 64 * kh + lane]);
#pragma unroll 8
            for (int kk = 0; kk < 64; ++kk) { const f32x4 w = *(const f32x4*)(W + (size_t)(64 * kh + kk) * 6 * DM);
#pragma unroll
                for (int q = 0; q < 9; ++q) acc[q] += __builtin_bit_cast(float, __builtin_amdgcn_readlane(__builtin_bit_cast(int, cv[q]), kk)) * w; }
        }
        LAS float* part = (LAS float*)F.lds;
#pragma unroll
        for (int q = 0; q < 9; ++q) *(LAS f32x4*)(part + (F.wave * 9 + q) * 256 + 4 * lane) = acc[q];
        __syncthreads();
        for (int o = F.tid; o < 9 * 256; o += NTHREADS) { const int q = o >> 8, cc = o & 255; float sum = F.b_ada[(size_t)l * 6 * DM + (r % 24) * 256 + cc];
#pragma unroll
            for (int w = 0; w < NWAVES; ++w) sum += part[(w * 9 + q) * 256 + cc];
            F.mod[((size_t)l * 9 + q) * 6 * DM + (r % 24) * 256 + cc] = sum; }
        __syncthreads();
    }
    convert_items(F, 0, I_IN + I_OUT + 3 * (NE * 16 * 32), 0, I_IN + I_OUT);
#if GLA_CHECK
    for (int lay = 0; lay < DEPTH; ++lay) convert_items(F, lay, 3 * (NE * 16 * 32));
#endif
    if (F.vcu == 0) for (int i = F.tid; i < 64 * 12; i += NTHREADS) { const int pos = i / 12, fi = i % 12;
        const float invf = expf(-((float)(2 * fi) / 24.f) * 9.210340371976184f); const float ang = (float)pos * invf; F.ROPE[i] = cosf(ang); F.ROPE[768 + i] = sinf(ang); }
    const size_t gt = (size_t)F.vcu * NTHREADS + F.tid, NGT = (size_t)F.G * NTHREADS;
    for (size_t i = gt; i < (size_t)DEPTH * 224 * DM / 8; i += NGT) { const size_t l = i / (224 * DM / 8), rr = i % (224 * DM / 8);
        *(u32x4*)(F.Bin + (l * NP + 2592) * DM + rr * 8) = (u32x4){0u, 0u, 0u, 0u}; }
    for (size_t i = gt; i < (size_t)256 * DM / 8; i += NGT) *(u32x4*)(F.H + (size_t)TT * DM + i * 8) = (u32x4){0u, 0u, 0u, 0u};
    for (size_t i = gt; i < (size_t)256 * DM / 16; i += NGT) *(u32x4*)(F.H8 + (size_t)TT * DM + i * 16) = (u32x4){0u, 0u, 0u, 0u};
}

__device__ __forceinline__ void norm_mod_store(const f32x4 (&v)[4], const float* gw, const float* sc, const float* sh, bf16* orow, int lane) {
    float s = 0.f;
#pragma unroll
    for (int j = 0; j < 4; ++j) s += (v[j].x * v[j].x + v[j].y * v[j].y) + (v[j].z * v[j].z + v[j].w * v[j].w);
    const float rinv = 1.f / sqrtf(wave_sum(s) * (1.f / DM) + EPS);
#pragma unroll
    for (int j = 0; j < 4; ++j) { const int c = 4 * lane + 256 * j;
        const f32x4 g = *(const f32x4*)(gw + c), a = *(const f32x4*)(sc + c), b = *(const f32x4*)(sh + c);
        const f32x4 y = (v[j] * rinv * g) * (a + 1.f) + b;
        u32x2 w; w.x = pk2(y.x, y.y); w.y = pk2(y.z, y.w);
        *(u32x2*)(orow + c) = w; }
}
__device__ __forceinline__ void ph_first_norm(Frame& F) {
    const int gw = F.vcu * NWAVES + F.wave, NGW = F.G * NWAVES, lane = F.lane;
    for (int m = gw; m < TT; m += NGW) {
        const float* src = m < TX ? F.x + (size_t)m * DM : F.ctx + (size_t)(m - TX) * DM;
        const int br = m < TX ? m / SEQ : NB;
        f32x4 v[4];
#pragma unroll
        for (int j = 0; j < 4; ++j) { v[j] = *(const f32x4*)(src + 4 * lane + 256 * j); *(f32x4*)(F.X + (size_t)m * DM + 4 * lane + 256 * j) = v[j]; }
        const float* md = F.mod + (size_t)br * 6 * DM;
        norm_mod_store(v, F.norm1_g, md + DM, md, F.H + (size_t)m * DM, lane);
    }
}
__device__ __forceinline__ void ph_combine(Frame& F, int l, bool dry = false) {
    const int gw = F.vcu * NWAVES + F.wave, NGW = F.G * NWAVES, lane = F.lane;
    float* Xo = dry ? (float*)F.ACT : F.X; bf16* Ho = dry ? (bf16*)F.P : F.H; float* Oo = dry ? (float*)F.ACT : F.out;
    const int M = (l == DEPTH - 1) ? TX : TT;
    const int cA = 8 * lane, cB = 512 + 8 * lane;
    for (int m0 = gw; m0 < M; m0 += 2 * NGW) {
        u32x4 yw[2][4][2]; f32x4 xv[2][4]; bool have[2]; int br[2];
#pragma unroll
        for (int rr = 0; rr < 2; ++rr) { const int m = m0 + rr * NGW; have[rr] = m < M; const int mm = have[rr] ? m : m0; br[rr] = mm < TX ? mm / SEQ : NB;
            const u32x4 sl4 = *(const u32x4*)(F.INV + (size_t)mm * 4); const unsigned slk[4] = {sl4.x, sl4.y, sl4.z, sl4.w};
#pragma unroll
            for (int k = 0; k < 4; ++k) { yw[rr][k][0] = *(const u32x4*)(F.YB + (size_t)slk[k] * DM + cA); yw[rr][k][1] = *(const u32x4*)(F.YB + (size_t)slk[k] * DM + cB); }
            const float* xr = F.X + (size_t)mm * DM;
            xv[rr][0] = *(const f32x4*)(xr + cA); xv[rr][1] = *(const f32x4*)(xr + cA + 4); xv[rr][2] = *(const f32x4*)(xr + cB); xv[rr][3] = *(const f32x4*)(xr + cB + 4); }
#pragma unroll
        for (int rr = 0; rr < 2; ++rr) { if (!have[rr]) continue;
            const int m = m0 + rr * NGW;
            const float* md = F.mod + ((size_t)l * 9 + br[rr]) * 6 * DM;
            f32x4 y[4];
#pragma unroll
            for (int j = 0; j < 4; ++j) y[j] = (f32x4){0.f, 0.f, 0.f, 0.f};
#pragma unroll
            for (int k = 0; k < 4; ++k) { const u32x4 a = yw[rr][k][0], b = yw[rr][k][1];
                y[0] += (f32x4){bflo(a.x), bfhi(a.x), bflo(a.y), bfhi(a.y)}; y[1] += (f32x4){bflo(a.z), bfhi(a.z), bflo(a.w), bfhi(a.w)};
                y[2] += (f32x4){bflo(b.x), bfhi(b.x), bflo(b.y), bfhi(b.y)}; y[3] += (f32x4){bflo(b.z), bfhi(b.z), bflo(b.w), bfhi(b.w)}; }
            const int cc[4] = {cA, cA + 4, cB, cB + 4};
            f32x4 v[4]; float ss = 0.f;
#pragma unroll
            for (int j = 0; j < 4; ++j) { v[j] = xv[rr][j] + *(const f32x4*)(md + 5 * DM + cc[j]) * y[j]; ss += (v[j].x * v[j].x + v[j].y * v[j].y) + (v[j].z * v[j].z + v[j].w * v[j].w); }
            const float rinv = 1.f / sqrtf(wave_sum(ss) * (1.f / DM) + EPS);
            if (l < DEPTH - 1) {
#pragma unroll
                for (int j = 0; j < 4; ++j) *(f32x4*)(Xo + (size_t)m * DM + cc[j]) = v[j];
                const float* mn = F.mod + ((size_t)(l + 1) * 9 + br[rr]) * 6 * DM; const float* gw1 = F.norm1_g + (size_t)(l + 1) * DM;
                f32x4 h[4];
#pragma unroll
                for (int j = 0; j < 4; ++j) h[j] = (v[j] * rinv * *(const f32x4*)(gw1 + cc[j])) * (*(const f32x4*)(mn + DM + cc[j]) + 1.f) + *(const f32x4*)(mn + cc[j]);
                u32x4 w0, w1; w0.x = pk2(h[0].x, h[0].y); w0.y = pk2(h[0].z, h[0].w); w0.z = pk2(h[1].x, h[1].y); w0.w = pk2(h[1].z, h[1].w);
                w1.x = pk2(h[2].x, h[2].y); w1.y = pk2(h[2].z, h[2].w); w1.z = pk2(h[3].x, h[3].y); w1.w = pk2(h[3].z, h[3].w);
                *(u32x4*)(Ho + (size_t)m * DM + cA) = w0; *(u32x4*)(Ho + (size_t)m * DM + cB) = w1;
            } else {
#pragma unroll
                for (int j = 0; j < 4; ++j) { f32x4 o = v[j] * rinv * *(const f32x4*)(F.final_g + cc[j]);
#if GLA_CHECK
                    if (__hip_atomic_load(F.ctl + 64, __ATOMIC_RELAXED, __HIP_MEMORY_SCOPE_AGENT) != 0u) { const float q = __builtin_nanf(""); o = (f32x4){q, q, q, q}; }
#endif
                    *(f32x4*)(Oo + (size_t)m * DM + cc[j]) = o; }
            }
        }
    }
}

constexpr int PL_U = 0, PL_P = 49152, PL_LD = 264, PREP_PW = 81920, PW_LD = 72, PREP_PS = PREP_PW + 4 * 64 * PW_LD * 2;
static_assert(PREP_PS + 1024 <= STAGE_BYTES && PL_P + 32 * PL_LD * 2 <= PREP_PW, "pool LDS map");
__device__ __forceinline__ void pool_unit(Frame& F, int l, int u) {
    LAS float* U = (LAS float*)(F.lds + PL_U);
    LAS bf16* PL = (LAS bf16*)(F.lds + PL_P);
    const LAS bf16* PW = (const LAS bf16*)(F.lds + PREP_PW); const LAS float* PS = (const LAS float*)(F.lds + PREP_PS);
    const int tid = F.tid;
    int s, tb, seqbase, tlen;
    if (u < NB * 128) { s = u / 128; tb = u % 128; seqbase = s * SEQ; tlen = SEQ; } else { const int v = u - NB * 128; s = v / 8; tb = v % 8; seqbase = TX + s * CTXL; tlen = CTXL; }
    const int t0 = tb * 32;
    for (int i = tid; i < 48 * 32; i += NTHREADS) { const int rr = i / 32, ch = i % 32, t = t0 - 8 + rr;
        f32x4 a = (f32x4){0.f, 0.f, 0.f, 0.f}, b = a;
        if (t >= 0 && t < tlen) { const u32x4 w = *(const u32x4*)(F.P + (size_t)(seqbase + t) * NP + C_POOL + ch * 8);
            a = (f32x4){bflo(w.x), bfhi(w.x), bflo(w.y), bfhi(w.y)}; b = (f32x4){bflo(w.z), bfhi(w.z), bflo(w.w), bfhi(w.w)}; }
        *(LAS f32x4*)(U + rr * 256 + ch * 8) = a; *(LAS f32x4*)(U + rr * 256 + ch * 8 + 4) = b; }
    __syncthreads();
    { const int tt = tid >> 4, cg = tid & 15, g = cg >> 2, w = 2 << g, t = t0 + tt;
      int lo = t - w / 2; if (lo < 0) lo = 0; int hi = t + w - w / 2; if (hi > tlen) hi = tlen;
      const float inv = 1.f / (float)(hi - lo);
      f32x4 sum[4];
#pragma unroll
      for (int q4 = 0; q4 < 4; ++q4) sum[q4] = (f32x4){0.f, 0.f, 0.f, 0.f};
      for (int jj = lo; jj < hi; ++jj) {
#pragma unroll
          for (int q4 = 0; q4 < 4; ++q4) sum[q4] += *(const LAS f32x4*)(U + (jj - t0 + 8) * 256 + cg * 16 + 4 * q4); }
      u32x4 w0, w1;
      { const f32x4 y0 = sum[0] * inv - *(const LAS f32x4*)(U + (tt + 8) * 256 + cg * 16), y1 = sum[1] * inv - *(const LAS f32x4*)(U + (tt + 8) * 256 + cg * 16 + 4);
        const f32x4 y2 = sum[2] * inv - *(const LAS f32x4*)(U + (tt + 8) * 256 + cg * 16 + 8), y3 = sum[3] * inv - *(const LAS f32x4*)(U + (tt + 8) * 256 + cg * 16 + 12);
        w0.x = pk2(y0.x, y0.y); w0.y = pk2(y0.z, y0.w); w0.z = pk2(y1.x, y1.y); w0.w = pk2(y1.z, y1.w);
        w1.x = pk2(y2.x, y2.y); w1.y = pk2(y2.z, y2.w); w1.z = pk2(y3.x, y3.y); w1.w = pk2(y3.z, y3.w); }
      *(LAS u32x4*)(PL + tt * PL_LD + cg * 16) = w0; *(LAS u32x4*)(PL + tt * PL_LD + cg * 16 + 8) = w1; }
    __syncthreads();
    { const int lane = F.lane, q = lane & 15, g4 = lane >> 4;
#pragma unroll
      for (int k = 0; k < 4; ++k) { const int ti = F.wave * 4 + k, mt = ti & 1, ct = ti >> 1, g = ct >> 2, ot = ct & 3;
          f32x4 acc = (f32x4){0.f, 0.f, 0.f, 0.f};
#pragma unroll
          for (int s2 = 0; s2 < 2; ++s2) { const bf16x8 a = *(const LAS bf16x8*)(PW + (g * 64 + 16 * ot + q) * PW_LD + 32 * s2 + 8 * g4), b = *(const LAS bf16x8*)(PL + (16 * mt + q) * PL_LD + g * 64 + 32 * s2 + 8 * g4);
              acc = __builtin_amdgcn_mfma_f32_16x16x32_bf16(a, b, acc, 0, 0, 0); }
          const f32x4 y = acc * *(const LAS f32x4*)(PS + g * 64 + 16 * ot + 4 * g4);
          u32x2 w; w.x = pk2(y.x, y.y); w.y = pk2(y.z, y.w);
          *(u32x2*)(F.MIX + (size_t)(seqbase + t0 + 16 * mt + q) * DM + 768 + g * 64 + 16 * ot + 4 * g4) = w; } }
    __syncthreads();
}
#if GLA_CHECK
__device__ __forceinline__ void gla_chain(Frame& F, int l, int u) {
    const int tid = F.tid;
    const int dir = u & 1, hh = (u >> 1) & 3, b = u >> 3;
    LAS float* qs = (LAS float*)F.lds;
    LAS float* ks = qs + 64 * 48;
    LAS float* as = ks + 64 * 48;
    LAS float* vs = as + 64 * 48;
    LAS float* os = vs + 64 * 96;
    LAS float* rc = os + 64 * 96;
    LAS float* rs = rc + 64 * 12;
    LAS float* wa = rs + 64 * 12;
    LAS float* ba = wa + 16 * 48;
    for (int i = tid; i < 64 * 12; i += NTHREADS) { const int pos = i / 12, fi = i % 12;
        const float invf = expf(-((float)(2 * fi) / 24.f) * 9.210340371976184f);
        const float ang = (float)pos * invf; rc[i] = cosf(ang); rs[i] = sinf(ang); }
    for (int i = tid; i < 16 * 48; i += NTHREADS) { const int r = i / 48, d = i % 48; wa[i] = F.gla_wa2[(((size_t)l * 2 + dir) * 16 + r) * 192 + hh * 48 + d]; }
    if (tid < 48) ba[tid] = F.gla_ba[((size_t)l * 2 + dir) * 192 + hh * 48 + tid];
    __syncthreads();
    float S[12];
#pragma unroll
    for (int i = 0; i < 12; ++i) S[i] = 0.f;
    const int vv = tid >> 2, dg = tid & 3;
    float* Odir = dir ? F.OB : F.OF;
    const bool need_ctx = l < DEPTH - 1;
    for (int cidx = 0; cidx < 4 + 64; ++cidx) {
        const bool isctx = cidx < 4;
        const int nch = isctx ? 4 : 64, ci0 = isctx ? cidx : cidx - 4, ci = dir ? (nch - 1 - ci0) : ci0;
        const int seqbase = isctx ? TX + b * CTXL : b * SEQ, t0 = ci * 64;
        for (int i = tid; i < 64 * 2 * 2 * 12; i += NTHREADS) {
            const int fi = i % 12, hf = (i / 12) & 1, isk = (i / 24) & 1, j = i / 48;
            const bf16* row = F.P + (size_t)(seqbase + t0 + j) * NP + (isk ? C_GK : C_GQ) + hh * 48 + hf * 24;
            const float x1 = bf2f(row[fi]), x2 = bf2f(row[12 + fi]);
            float o1 = x1, o2 = x2;
            if (!isctx) { const int t = t0 + j, pos = hf ? (t % GRIDW) : (t / GRIDW); const float cs = rc[pos * 12 + fi], sn = rs[pos * 12 + fi]; o1 = x1 * cs - x2 * sn; o2 = x1 * sn + x2 * cs; }
            LAS float* dst = (isk ? ks : qs) + j * 48 + hf * 24;
            dst[fi] = o1; dst[12 + fi] = o2; }
        for (int i = tid; i < 64 * 48; i += NTHREADS) { const int j = i / 48, d = i % 48;
            const bf16* row = F.P + (size_t)(seqbase + t0 + j) * NP + (dir ? C_AB : C_AF);
            float z = ba[d];
#pragma unroll
            for (int r = 0; r < 16; ++r) z += bf2f(row[r]) * wa[r * 48 + d];
            const float ls = fminf(z, 0.f) - log1pf(expf(-fabsf(z)));
            as[i] = expf(ls * (1.f / 16.f)); }
        for (int i = tid; i < 64 * 96; i += NTHREADS) { const int j = i / 96, d = i % 96; vs[i] = bf2f(F.VTA[(size_t)(384 + hh * 96 + d) * VTS + seqbase + t0 + j]); }
        __syncthreads();
        if (tid < 384) {
            for (int st = 0; st < 64; ++st) {
                const int j = dir ? 63 - st : st;
                const float vj = vs[j * 96 + vv];
                float part = 0.f;
#pragma unroll
                for (int q4 = 0; q4 < 3; ++q4) {
                    const f32x4 a4 = *(const LAS f32x4*)(as + j * 48 + dg * 12 + q4 * 4), k4 = *(const LAS f32x4*)(ks + j * 48 + dg * 12 + q4 * 4), qq = *(const LAS f32x4*)(qs + j * 48 + dg * 12 + q4 * 4);
#pragma unroll
                    for (int e = 0; e < 4; ++e) { const float sn = a4[e] * S[q4 * 4 + e] + k4[e] * vj; S[q4 * 4 + e] = sn; part += qq[e] * sn; } }
                part += __shfl_xor(part, 1); part += __shfl_xor(part, 2);
                if (dg == 0) os[j * 96 + vv] = part;
            }
        }
        __syncthreads();
        if (!isctx || need_ctx)
            for (int i = tid; i < 64 * 96; i += NTHREADS) { const int j = i / 96, d = i % 96; Odir[(size_t)(seqbase + t0 + j) * 384 + hh * 96 + d] = os[i]; }
        __syncthreads();
    }
}

#endif
typedef float f32x16 __attribute__((ext_vector_type(16)));
constexpr int GL_BF = 0, GL_BB = 12288, GL_WA = 24576, GL_VT = 31232, GL_KEF = 45056, GL_KEB = 51968;
constexpr int GL_QF = 45056, GL_KF = 52224, GL_QB = 59392, GL_KB = 66560, GL_STF = 73728, GL_STB = 84480, GL_O = 95232;
constexpr int VT_LD = 72, QK_LD = 56, ST_LD = 56, O_LD = 100, NCH = 68;
struct GlaU { int b, hh, cpos, seqbase, t0, isctx; };
__device__ __forceinline__ GlaU gla_unit_geom(int u) { GlaU g; g.cpos = u % NCH; g.hh = (u / NCH) & 3; g.b = u / (NCH * 4); g.isctx = g.cpos < 4;
    const int ci = g.isctx ? g.cpos : g.cpos - 4; g.seqbase = g.isctx ? TX + g.b * CTXL : g.b * SEQ; g.t0 = ci * 64; return g; }
__device__ __forceinline__ void gla_rope_pair(const Frame& F, const GlaU& g, const bf16* row, int j, int hf, int fi, float& o1, float& o2) {
    const float x1 = bf2f(row[fi]), x2 = bf2f(row[12 + fi]); o1 = x1; o2 = x2;
    if (!g.isctx) { const int t = g.t0 + j, pos = hf ? (t % GRIDW) : (t / GRIDW); const float cs = F.ROPE[pos * 12 + fi], sn = F.ROPE[768 + pos * 12 + fi]; o1 = x1 * cs - x2 * sn; o2 = x1 * sn + x2 * cs; }
}
constexpr int G1_BF = 0, G1_BB = 12288, G1_KEF = 24576, G1_KEB = 31488, G1_OPS = 38400;
constexpr int PREP_WA = TAB_OFF;
__device__ __forceinline__ void gla_g1_unit(Frame& F, int l, int u) {
    const GlaU g = gla_unit_geom(u);
    LAS bf16* kef = (LAS bf16*)(F.lds + G1_KEF); LAS bf16* keb = (LAS bf16*)(F.lds + G1_KEB); LAS bf16* ops = (LAS bf16*)(F.lds + G1_OPS);
    const LAS float* wa = (const LAS float*)(F.lds + PREP_WA) + g.hh * 1536; const LAS float* ba = (const LAS float*)(F.lds + PREP_WA) + 6144 + g.hh * 96;
    const bf16* vtg = F.VTA + (size_t)(384 + g.hh * 96) * VTS + g.seqbase + g.t0;
    const int tid = F.tid, lane = F.lane, j = lane, w = F.wave;
    const bf16* prow = F.P + (size_t)(g.seqbase + g.t0 + j) * NP;
    u32x4 araw[4];
#pragma unroll
    for (int q4 = 0; q4 < 4; ++q4) araw[q4] = *(const u32x4*)(prow + C_AF + 8 * q4);
    float q1[3], q2[3], k1[3], k2[3], cs[3], sn[3];
#pragma unroll
    for (int e = 0; e < 3; ++e) { const int p = 3 * w + e, hf = p / 12, fi = p % 12, cb = g.hh * 48 + hf * 24 + fi;
        q1[e] = bf2f(prow[C_GQ + cb]); q2[e] = bf2f(prow[C_GQ + cb + 12]); k1[e] = bf2f(prow[C_GK + cb]); k2[e] = bf2f(prow[C_GK + cb + 12]);
        const int t = g.t0 + j, pos = hf ? (t % GRIDW) : (t / GRIDW);
        cs[e] = g.isctx ? 1.f : F.ROPE[pos * 12 + fi]; sn[e] = g.isctx ? 0.f : F.ROPE[768 + pos * 12 + fi]; }
    float a[32];
#pragma unroll
    for (int q4 = 0; q4 < 4; ++q4) { const u32x4 x = araw[q4]; a[q4 * 8 + 0] = bflo(x.x); a[q4 * 8 + 1] = bfhi(x.x); a[q4 * 8 + 2] = bflo(x.y); a[q4 * 8 + 3] = bfhi(x.y);
        a[q4 * 8 + 4] = bflo(x.z); a[q4 * 8 + 5] = bfhi(x.z); a[q4 * 8 + 6] = bflo(x.w); a[q4 * 8 + 7] = bfhi(x.w); }
    float bf[3][2], bb[3][2];
#pragma unroll
    for (int e = 0; e < 3; ++e)
#pragma unroll
        for (int wh = 0; wh < 2; ++wh) { const int p = 3 * w + e, d = (p / 12) * 24 + p % 12 + 12 * wh;
            float zf = ba[d], zb = ba[48 + d];
#pragma unroll
            for (int r = 0; r < 16; ++r) { zf += a[r] * wa[r * 48 + d]; zb += a[16 + r] * wa[(16 + r) * 48 + d]; }
            float xf = (fminf(zf, 0.f) - __logf(1.f + __expf(-fabsf(zf)))) * (1.f / 16.f), xb = (fminf(zb, 0.f) - __logf(1.f + __expf(-fabsf(zb)))) * (1.f / 16.f);
#pragma unroll
            for (int o = 1; o < 64; o <<= 1) { const float yf = __shfl_up(xf, o), yb = __shfl_down(xb, o); if (lane >= o) xf += yf; if (lane + o < 64) xb += yb; }
            bf[e][wh] = xf; bb[e][wh] = xb; }
#pragma unroll
    for (int e = 0; e < 3; ++e) { const int p = 3 * w + e, d1 = (p / 12) * 24 + p % 12, d2 = d1 + 12;
        const float qa = q1[e] * cs[e] - q2[e] * sn[e], qb = q1[e] * sn[e] + q2[e] * cs[e], ka = k1[e] * cs[e] - k2[e] * sn[e], kb = k1[e] * sn[e] + k2[e] * cs[e];
        const float f1 = bf[e][0], f2 = bf[e][1], b1 = bb[e][0], b2 = bb[e][1];
        const float fe1 = __builtin_bit_cast(float, __builtin_amdgcn_readlane(__builtin_bit_cast(int, f1), 63)), fe2 = __builtin_bit_cast(float, __builtin_amdgcn_readlane(__builtin_bit_cast(int, f2), 63));
        const float be1 = __builtin_bit_cast(float, __builtin_amdgcn_readlane(__builtin_bit_cast(int, b1), 0)), be2 = __builtin_bit_cast(float, __builtin_amdgcn_readlane(__builtin_bit_cast(int, b2), 0));
        const float ef1 = __expf(f1), ef2 = __expf(f2), eb1 = __expf(b1), eb2 = __expf(b2), nf1 = __expf(-f1), nf2 = __expf(-f2), nb1 = __expf(-b1), nb2 = __expf(-b2);
        ops[j * 48 + d1] = (bf16)f2bf(qa * ef1); ops[j * 48 + d2] = (bf16)f2bf(qb * ef2); ops[3072 + j * 48 + d1] = (bf16)f2bf(ka * nf1); ops[3072 + j * 48 + d2] = (bf16)f2bf(kb * nf2);
        ops[6144 + j * 48 + d1] = (bf16)f2bf(qa * eb1); ops[6144 + j * 48 + d2] = (bf16)f2bf(qb * eb2); ops[9216 + j * 48 + d1] = (bf16)f2bf(ka * nb1); ops[9216 + j * 48 + d2] = (bf16)f2bf(kb * nb2);
        const float ge1 = __expf(fe1), ge2 = __expf(fe2), he1 = __expf(be1), he2 = __expf(be2);
        kef[d1 * VT_LD + j] = (bf16)f2bf(ka * nf1 * ge1); kef[d2 * VT_LD + j] = (bf16)f2bf(kb * nf2 * ge2);
        keb[d1 * VT_LD + j] = (bf16)f2bf(ka * nb1 * he1); keb[d2 * VT_LD + j] = (bf16)f2bf(kb * nb2 * he2);
        if (lane == 0) { float* gd = F.GD + (((size_t)(g.b * 4 + g.hh) * 2) * NCH + g.cpos) * 48; gd[d1] = ge1; gd[d2] = ge2; gd[(size_t)NCH * 48 + d1] = he1; gd[(size_t)NCH * 48 + d2] = he2; } }
    __syncthreads();
    { const int q = lane & 15, g4 = lane >> 4;
      for (int ti = F.wave; ti < 36; ti += NWAVES) { const int dir = ti / 18, dt = (ti % 18) / 6, vtile = ti % 6;
          const LAS bf16* ke = dir ? keb : kef;
          f32x4 acc = (f32x4){0.f, 0.f, 0.f, 0.f};
#pragma unroll
          for (int s2 = 0; s2 < 2; ++s2) { const bf16x8 av = *(const LAS bf16x8*)(ke + (16 * dt + q) * VT_LD + 32 * s2 + 8 * g4), bv = *(const bf16x8*)(vtg + (size_t)(16 * vtile + q) * VTS + 32 * s2 + 8 * g4);
              acc = __builtin_amdgcn_mfma_f32_16x16x32_bf16(av, bv, acc, 0, 0, 0); }
          *(f32x4*)(F.DS + ((((size_t)(g.b * 4 + g.hh) * 2 + dir) * NCH + g.cpos) * 96 + 16 * vtile + q) * 48 + 16 * dt + 4 * g4) = acc; } }
    { u32x4* dst = (u32x4*)(F.OPS + (size_t)u * 12288);
      for (int i = tid; i < 1536; i += NTHREADS) dst[i] = *(const LAS u32x4*)(ops + i * 8); }
    __syncthreads();
}
__device__ __forceinline__ void gla_g2_unit(Frame& F, int u) {
    const int chain = u >> 2, qt = u & 3, dir = chain & 1, tid = F.tid;
    const float* ds = F.DS + (size_t)chain * NCH * 4608; const float* gd = F.GD + (size_t)chain * NCH * 48; bf16* stb = F.STB + (size_t)chain * NCH * 4608;
    const int e0 = qt * 1152 + 2 * tid, e1 = qt * 1152 + 1024 + 2 * tid; const bool h1 = tid < 64;
    const int d0 = e0 % 48, d1 = h1 ? e1 % 48 : 0;
    f32x2 S0 = (f32x2){0.f, 0.f}, S1 = (f32x2){0.f, 0.f};
    for (int st0 = 0; st0 < NCH; st0 += 4) {
        f32x2 x0[4], x1[4], g0[4], g1[4]; int cp[4];
#pragma unroll
        for (int k = 0; k < 4; ++k) { const int st = st0 + k; cp[k] = st < 4 ? (dir ? 3 - st : st) : (dir ? 4 + (67 - st) : st);
            const float* p = ds + (size_t)cp[k] * 4608; const float* gp = gd + cp[k] * 48;
            x0[k] = *(const f32x2*)(p + e0); g0[k] = *(const f32x2*)(gp + d0);
            if (h1) { x1[k] = *(const f32x2*)(p + e1); g1[k] = *(const f32x2*)(gp + d1); } else { x1[k] = (f32x2){0.f, 0.f}; g1[k] = x1[k]; } }
#pragma unroll
        for (int k = 0; k < 4; ++k) { bf16* p = stb + (size_t)cp[k] * 4608;
            *(unsigned*)(p + e0) = pk2(S0.x, S0.y); if (h1) *(unsigned*)(p + e1) = pk2(S1.x, S1.y);
            S0 = g0[k] * S0 + x0[k]; S1 = g1[k] * S1 + x1[k]; }
    }
}
__device__ __forceinline__ void gla_g3_wave(Frame& F, int l, int wu) {
    const int u = wu >> 1, it = wu & 1;
    const GlaU g = gla_unit_geom(u);
    const int lane = F.lane, r = lane & 31, h = lane >> 5;
    const bf16* ops = F.OPS + (size_t)u * 12288 + 16 * 0 + 8 * h;
    const bf16* vtg = F.VTA + (size_t)(384 + g.hh * 96) * VTS + g.seqbase + g.t0;
    const bf16* stf = F.STB + ((((size_t)(g.b * 4 + g.hh) * 2 + 0) * NCH + g.cpos) * 4608) + 8 * h; const bf16* stbk = stf + (size_t)NCH * 4608;
    LAS float* O = (LAS float*)(F.lds + F.wave * 16384);
    bf16x8 qf[3], qb[3];
#pragma unroll
    for (int s3 = 0; s3 < 3; ++s3) { qf[s3] = *(const bf16x8*)(ops + (32 * it + r) * 48 + 16 * s3); qb[s3] = *(const bf16x8*)(ops + 6144 + (32 * it + r) * 48 + 16 * s3); }
    f32x16 X[2];
#pragma unroll
    for (int jt = 0; jt < 2; ++jt) {
        f32x16 xf, xb;
#pragma unroll
        for (int e = 0; e < 16; ++e) { xf[e] = 0.f; xb[e] = 0.f; }
        if (jt <= it) {
#pragma unroll
            for (int s3 = 0; s3 < 3; ++s3) xf = __builtin_amdgcn_mfma_f32_32x32x16_bf16(*(const bf16x8*)(ops + 3072 + (32 * jt + r) * 48 + 16 * s3), qf[s3], xf, 0, 0, 0); }
        if (jt >= it) {
#pragma unroll
            for (int s3 = 0; s3 < 3; ++s3) xb = __builtin_amdgcn_mfma_f32_32x32x16_bf16(*(const bf16x8*)(ops + 9216 + (32 * jt + r) * 48 + 16 * s3), qb[s3], xb, 0, 0, 0); }
        if (jt == it) {
#pragma unroll
            for (int e = 0; e < 16; ++e) { const int jl = (e & 3) + 8 * (e >> 2) + 4 * h; X[jt][e] = (jl <= r ? xf[e] : 0.f) + (jl >= r ? xb[e] : 0.f); }
        } else X[jt] = jt < it ? xf : xb;
    }
    f32x16 o[3];
#pragma unroll
    for (int vt = 0; vt < 3; ++vt)
#pragma unroll
        for (int e = 0; e < 16; ++e) o[vt][e] = 0.f;
#pragma unroll
    for (int jt = 0; jt < 2; ++jt)
#pragma unroll
        for (int s2 = 0; s2 < 2; ++s2) {
            u32x4 aw; aw.x = pk2(X[jt][8 * s2 + 0], X[jt][8 * s2 + 1]); aw.y = pk2(X[jt][8 * s2 + 2], X[jt][8 * s2 + 3]); aw.z = pk2(X[jt][8 * s2 + 4], X[jt][8 * s2 + 5]); aw.w = pk2(X[jt][8 * s2 + 6], X[jt][8 * s2 + 7]);
#pragma unroll
            for (int vt = 0; vt < 3; ++vt) {
                const bf16* vr = vtg + (size_t)(32 * vt + r) * VTS + 32 * jt + 16 * s2 + 4 * h;
                const u32x2 lo = *(const u32x2*)vr, hi = *(const u32x2*)(vr + 8);
                const u32x4 bw = (u32x4){lo.x, lo.y, hi.x, hi.y};
                o[vt] = __builtin_amdgcn_mfma_f32_32x32x16_bf16(__builtin_bit_cast(bf16x8, aw), __builtin_bit_cast(bf16x8, bw), o[vt], 0, 0, 0); } }
#pragma unroll
    for (int s3 = 0; s3 < 3; ++s3)
#pragma unroll
        for (int vt = 0; vt < 3; ++vt) {
            o[vt] = __builtin_amdgcn_mfma_f32_32x32x16_bf16(qf[s3], *(const bf16x8*)(stf + (32 * vt + r) * 48 + 16 * s3), o[vt], 0, 0, 0);
            o[vt] = __builtin_amdgcn_mfma_f32_32x32x16_bf16(qb[s3], *(const bf16x8*)(stbk + (32 * vt + r) * 48 + 16 * s3), o[vt], 0, 0, 0); }
#pragma unroll
    for (int vt = 0; vt < 3; ++vt)
#pragma unroll
        for (int e = 0; e < 16; ++e) O[((e & 3) + 8 * (e >> 2) + 4 * h) * O_LD + 32 * vt + r] = o[vt][e];
    LDS_WAIT(); asm volatile("" ::: "memory");
    { const int i = lane >> 1, half = lane & 1; const size_t row = (size_t)(g.seqbase + g.t0 + 32 * it + i);
      f32x4 ov[12]; float ss = 0.f;
#pragma unroll
      for (int e = 0; e < 12; ++e) { ov[e] = *(const LAS f32x4*)(O + i * O_LD + half * 48 + 4 * e); ss += (ov[e].x * ov[e].x + ov[e].y * ov[e].y) + (ov[e].z * ov[e].z + ov[e].w * ov[e].w); }
      ss += __shfl_xor(ss, 1);
      const float rinv = 1.f / sqrtf(ss * (1.f / 96.f) + EPS);
      const float* ng = F.gla_norm_g + (size_t)l * 384 + g.hh * 96 + half * 48;
      const u32x4* gp = (const u32x4*)(F.P + row * NP + C_GG + g.hh * 96 + half * 48);
      u32x4* dst = (u32x4*)(F.MIX + row * DM + g.hh * 96 + half * 48);
#if GLA_CHECK
      { float sn = 0.f; const float* pf = F.OF + row * 384 + g.hh * 96 + half * 48; const float* pb = F.OB + row * 384 + g.hh * 96 + half * 48;
#pragma unroll
        for (int e = 0; e < 48; ++e) { const float on = pf[e] + pb[e]; sn += on * on; }
        sn += __shfl_xor(sn, 1);
        const float rms = sqrtf(sn * (1.f / 96.f)) + 1e-6f; int bad = 0;
#pragma unroll
        for (int e = 0; e < 48; ++e) { const float on = pf[e] + pb[e]; if (!(fabsf(ov[e >> 2][e & 3] - on) <= 0.03f * rms + 0.03f * fabsf(on))) ++bad; }
        if (bad) atomicAdd(F.ctl + 64, (unsigned)bad); }
#endif
#pragma unroll
      for (int q6 = 0; q6 < 6; ++q6) { const u32x4 gw = gp[q6]; const f32x4 n0 = *(const f32x4*)(ng + 8 * q6), n1 = *(const f32x4*)(ng + 8 * q6 + 4); const f32x4 a = ov[2 * q6], b = ov[2 * q6 + 1];
          u32x4 w;
          w.x = pk2(a.x * rinv * n0.x * silu_f(bflo(gw.x)), a.y * rinv * n0.y * silu_f(bfhi(gw.x))); w.y = pk2(a.z * rinv * n0.z * silu_f(bflo(gw.y)), a.w * rinv * n0.w * silu_f(bfhi(gw.y)));
          w.z = pk2(b.x * rinv * n1.x * silu_f(bflo(gw.z)), b.y * rinv * n1.y * silu_f(bfhi(gw.z))); w.w = pk2(b.z * rinv * n1.z * silu_f(bflo(gw.w)), b.w * rinv * n1.w * silu_f(bfhi(gw.w)));
          dst[q6] = w; } }
    LDS_WAIT(); asm volatile("" ::: "memory");
}
__device__ __forceinline__ void ph_gla3(Frame& F, int l) {
    const bool need_ctx = l < DEPTH - 1;
    const int gw = F.vcu * NWAVES + F.wave, NGW = F.G * NWAVES;
    for (int wu = gw; wu < NB * GH * NCH * 2; wu += NGW) { if (!need_ctx && ((wu >> 1) % NCH) < 4) continue; gla_g3_wave(F, l, wu); }
}
__device__ __forceinline__ void ph_prep(Frame& F, int l) {
    const bool need_ctx = l < DEPTH - 1;
    const int tid = F.tid;
#if GLA_CHECK
    for (int u = F.vcu; u < NB * GH * 2; u += F.G) gla_chain(F, l, u);
    __syncthreads();
#endif
    { LAS float* wa = (LAS float*)(F.lds + PREP_WA);
      for (int i = tid; i < 4 * 2 * 16 * 48; i += NTHREADS) { const int hh = i / 1536, dir = (i / 768) & 1, r = (i / 48) % 16, d = i % 48; wa[i] = F.gla_wa2[(((size_t)l * 2 + dir) * 16 + r) * 192 + hh * 48 + d]; }
      for (int i = tid; i < 4 * 2 * 48; i += NTHREADS) { const int hh = i / 96, dir = (i / 48) & 1, d = i % 48; wa[6144 + i] = F.gla_ba[((size_t)l * 2 + dir) * 192 + hh * 48 + d]; }
      LAS bf16* pw = (LAS bf16*)(F.lds + PREP_PW); LAS float* ps = (LAS float*)(F.lds + PREP_PS);
      for (int i = tid; i < 4 * 64 * 64; i += NTHREADS) { const int g = i >> 12, ii = (i >> 6) & 63, o = i & 63; pw[(g * 64 + o) * PW_LD + ii] = (bf16)f2bf(F.pool_w[(size_t)l * 16384 + i]); }
      if (tid < 256) ps[tid] = F.pool_scale[(size_t)l * 256 + tid]; }
    __syncthreads();
    for (int u = F.vcu; u < NB * GH * NCH; u += F.G) gla_g1_unit(F, l, u);
    const int NPOOL = NB * 128 + (need_ctx ? NB * 8 : 0);
    for (int u = F.vcu; u < NPOOL; u += F.G) pool_unit(F, l, u);
}

#define NA_LOG2E 1.4426950408889634f
struct NaCtx {
    __amdgpu_buffer_rsrc_t rP, rV; unsigned voffK, voffV; int b, cw, r0, krlo, nnb; const LAS float* rpb; unsigned bidx[2][4];
    bf16x8 qa[4][2]; float mrun[4], lsum[4]; f32x4 o[4][4];
};
__device__ __forceinline__ int na_segtok(const NaCtx& C, int sg) { return sg < C.nnb ? C.b * SEQ + (C.krlo + sg) * GRIDW + C.cw : TX + C.b * CTXL + 32 * (sg - C.nnb); }
__device__ __forceinline__ void na_load(const NaCtx& C, int sg, bf16x8 (&kb)[2][2], bf16x8 (&vb)[4]) {
    const int tok = na_segtok(C, sg);
#pragma unroll
    for (int par = 0; par < 2; ++par)
#pragma unroll
        for (int s2 = 0; s2 < 2; ++s2) kb[par][s2] = __builtin_bit_cast(bf16x8, __builtin_amdgcn_raw_buffer_load_b128(C.rP, C.voffK, (unsigned)((tok + 4 * par) * (NP * 2) + 64 * s2), 0));
#pragma unroll
    for (int dt = 0; dt < 4; ++dt) vb[dt] = __builtin_bit_cast(bf16x8, __builtin_amdgcn_raw_buffer_load_b128(C.rV, C.voffV, (unsigned)((16 * dt * VTS + tok) * 2), 0));
}
template <bool LATENT>
__device__ __forceinline__ void na_segment(NaCtx& C, int sg, int lane, const bf16x8 (&kb)[2][2], const bf16x8 (&vb)[4]) {
    const int g = lane >> 4;
    const bool nb = LATENT && sg < C.nnb;
    const int kr = C.krlo + sg;
#pragma unroll
    for (int i = 0; i < 4; ++i) {
        if (nb) { const int ri = C.r0 + i, rsi = ri - 4 < 0 ? 0 : (ri - 4 > 56 ? 56 : ri - 4); if (kr < rsi || kr > rsi + 7) continue; }
        float bv[2][4];
        if (nb) { const unsigned rowoff = (unsigned)((kr - (C.r0 + i) + 7) * 32 * 4);
#pragma unroll
            for (int par = 0; par < 2; ++par)
#pragma unroll
                for (int rg = 0; rg < 4; ++rg) bv[par][rg] = *(const LAS float*)((const LAS char*)C.rpb + rowoff + C.bidx[par][rg]); }
        f32x4 st[2];
#pragma unroll
        for (int par = 0; par < 2; ++par) {
            f32x4 a = (f32x4){0.f, 0.f, 0.f, 0.f};
#pragma unroll
            for (int s2 = 0; s2 < 2; ++s2) a = __builtin_amdgcn_mfma_f32_16x16x32_bf16(kb[par][s2], C.qa[i][s2], a, 0, 0, 0);
#pragma unroll
            for (int rg = 0; rg < 4; ++rg) a[rg] = nb ? __builtin_fmaf(a[rg], NA_LOG2E, bv[par][rg]) : a[rg] * NA_LOG2E;
            st[par] = a;
        }
        float mx = fmaxf(fmaxf(fmaxf(st[0][0], st[0][1]), fmaxf(st[0][2], st[0][3])), fmaxf(fmaxf(st[1][0], st[1][1]), fmaxf(st[1][2], st[1][3])));
        mx = fmaxf(mx, __shfl_xor(mx, 16)); mx = fmaxf(mx, __shfl_xor(mx, 32));
        const float mnew = fmaxf(C.mrun[i], mx), alpha = __builtin_amdgcn_exp2f(C.mrun[i] - mnew);
        float psum = 0.f;
#pragma unroll
        for (int par = 0; par < 2; ++par)
#pragma unroll
            for (int rg = 0; rg < 4; ++rg) { const float p = __builtin_amdgcn_exp2f(st[par][rg] - mnew); st[par][rg] = p; psum += p; }
        psum += __shfl_xor(psum, 16); psum += __shfl_xor(psum, 32);
        C.lsum[i] = C.lsum[i] * alpha + psum; C.mrun[i] = mnew;
#pragma unroll
        for (int rg = 0; rg < 4; ++rg) { const float ar = __shfl(alpha, 4 * g + rg);
#pragma unroll
            for (int dt = 0; dt < 4; ++dt) C.o[i][dt][rg] *= ar; }
        u32x4 pw; pw.x = cvt_pk_bf16(st[0][0], st[0][1]); pw.y = cvt_pk_bf16(st[0][2], st[0][3]); pw.z = cvt_pk_bf16(st[1][0], st[1][1]); pw.w = cvt_pk_bf16(st[1][2], st[1][3]);
        const bf16x8 pa = __builtin_bit_cast(bf16x8, pw);
#pragma unroll
        for (int dt = 0; dt < 4; ++dt) C.o[i][dt] = __builtin_amdgcn_mfma_f32_16x16x32_bf16(pa, vb[dt], C.o[i][dt], 0, 0, 0);
    }
}
#ifndef NA_DRYMODE
#define NA_DRYMODE 0
#endif
template <bool LATENT>
__device__ __forceinline__ void na_unit(Frame& F, int l, int u, const LAS float* rpb_lds, bool dry = false) {
    const int lane = F.lane, q = lane & 15, g = lane >> 4;
    NaCtx C;
    int hh, c0 = 0, qrow0, qstep;
    if (LATENT) { const int cb = u & 3, rg4 = (u >> 2) & 15; hh = (u >> 6) % NH; C.b = u / (64 * NH); c0 = cb * 16; C.r0 = rg4 * 4; qrow0 = C.b * SEQ + C.r0 * GRIDW + c0; qstep = GRIDW;
        const int rs0 = C.r0 - 4 < 0 ? 0 : (C.r0 - 4 > 56 ? 56 : C.r0 - 4), r3 = C.r0 + 3, rs3 = r3 - 4 < 0 ? 0 : (r3 - 4 > 56 ? 56 : r3 - 4);
        C.krlo = rs0; C.nnb = rs3 + 7 - rs0 + 1; }
    else { const int qi = u & 3; hh = (u >> 2) % NH; C.b = u / (4 * NH); qrow0 = TX + C.b * CTXL + qi * 64; qstep = 16; C.r0 = 0; C.krlo = 0; C.nnb = 0; }
    C.cw = c0 == 0 ? 0 : (c0 == 48 ? 32 : c0 - 8);
    const int c = c0 + q; const int start = c - 8 < 0 ? 0 : (c - 8 > 48 ? 48 : c - 8);
    C.rpb = rpb_lds + hh * 15 * 32;
    C.rP = __builtin_amdgcn_make_buffer_rsrc((void*)F.P, 0, (int)((size_t)TT * NP * 2), 0x00020000);
    C.rV = __builtin_amdgcn_make_buffer_rsrc((void*)F.VTA, 0, (int)((size_t)VT_NC * VTS * 2), 0x00020000);
    const int koff = 8 * (q >> 2) + (q & 3);
    C.voffK = (unsigned)((koff * NP + C_NAK + hh * NDH + 8 * g) * 2);
    C.voffV = (unsigned)(((hh * NDH + q) * VTS + 8 * g) * 2);
#pragma unroll
    for (int par = 0; par < 2; ++par)
#pragma unroll
        for (int rg = 0; rg < 4; ++rg) { const int kc = C.cw + 8 * g + rg + 4 * par; const bool valid = (kc >= start) && (kc < start + 16);
            C.bidx[par][rg] = (unsigned)((valid ? kc - c + 15 : 31) * 4); }
#pragma unroll
    for (int i = 0; i < 4; ++i) {
#pragma unroll
        for (int s2 = 0; s2 < 2; ++s2) C.qa[i][s2] = *(const bf16x8*)(F.P + (size_t)(qrow0 + i * qstep + q) * NP + C_NAQ + hh * NDH + 32 * s2 + 8 * g);
        C.mrun[i] = -1e30f; C.lsum[i] = 0.f;
#pragma unroll
        for (int dt = 0; dt < 4; ++dt) C.o[i][dt] = (f32x4){0.f, 0.f, 0.f, 0.f}; }
    const int nseg = C.nnb + 8;
    bf16x8 k0[2][2], v0[4], k1[2][2], v1[4];
    na_load(C, 0, k0, v0);
#pragma unroll 1
    for (int sg = 0; sg < nseg; sg += 2) {
        if (sg + 1 < nseg) na_load(C, sg + 1, k1, v1);
        na_segment<LATENT>(C, sg, lane, k0, v0);
        if (sg + 2 < nseg) na_load(C, sg + 2, k0, v0);
        if (sg + 1 < nseg) na_segment<LATENT>(C, sg + 1, lane, k1, v1);
    }
    bf16* mixb = dry ? (bf16*)F.VTC : F.MIX;
#pragma unroll
    for (int i = 0; i < 4; ++i)
#pragma unroll
        for (int rg = 0; rg < 4; ++rg) { const float li = 1.f / __shfl(C.lsum[i], 4 * g + rg);
            bf16* orow = mixb + (size_t)(dry ? 0 : (qrow0 + i * qstep + 4 * g + rg)) * DM + 384 + hh * NDH + q;
#pragma unroll
            for (int dt = 0; dt < 4; ++dt) orow[16 * dt] = (bf16)f2bf(C.o[i][dt][rg] * li); }
}
__device__ __forceinline__ void ph_attn(Frame& F, int l) {
    const bool need_ctx = l < DEPTH - 1;
    const int gw = F.vcu * NWAVES + F.wave, NGW = F.G * NWAVES;
    LAS float* rpb = (LAS float*)(F.lds + TAB_OFF);
    for (int i = F.tid; i < NH * 15 * 32; i += NTHREADS) { const int col = i & 31, hr = i >> 5; rpb[i] = col < 31 ? F.na_rpb[((size_t)l * NH * 15 + hr) * 31 + col] * NA_LOG2E : -1e30f; }
    __syncthreads();
    for (int rep = 0; rep < REPS(11); ++rep)
    for (int u = F.vcu; u < NB * GH * 2 * 4; u += F.G) gla_g2_unit(F, u);
    const bool bg = !GLA_CHECK;
    if (bg && (F.wave & 1)) convert_items(F, l, 3 * (NE * 16 * 32));
    for (int rep = 0; rep < REPS(12); ++rep) {
    for (int u = gw; u < NB * NH * 16 * 4; u += NGW) na_unit<true>(F, l, u, rpb, rep + 1 < REPS(12));
    if (need_ctx) for (int u = gw; u < NB * NH * 4; u += NGW) na_unit<false>(F, l, u, rpb, rep + 1 < REPS(12)); }
    if (bg && !(F.wave & 1)) convert_items(F, l, 3 * (NE * 16 * 32));
}
constexpr int RW_LD = 1032;
static_assert(2 * NE * RW_LD * 2 <= STAGE_BYTES, "router LDS");
__device__ __forceinline__ unsigned f2key(float f, int e) { unsigned u = __builtin_bit_cast(unsigned, f); u = (u & 0x80000000u) ? ~u : (u | 0x80000000u); return (u & ~31u) | (unsigned)(31 - e); }
__device__ __forceinline__ float key2f(unsigned k) { unsigned u = k & ~31u; u = (u & 0x80000000u) ? (u & 0x7fffffffu) : ~u; return __builtin_bit_cast(float, u); }
__device__ __forceinline__ void ph_router(Frame& F, int l, bool dry = false) {
    const int tid = F.tid, lane = F.lane, q = lane & 15, g = lane >> 4;
    LAS bf16* WH = (LAS bf16*)F.lds; LAS bf16* WL = WH + NE * RW_LD;
    LAS int* lcount = (LAS int*)(F.lds + MISC_OFF + 64 * 4);
    volatile LAS int* lbase = (volatile LAS int*)(F.MISC + 96);
    LAS int* apos = (LAS int*)(F.lds + TAB_OFF);
    const float* rw = F.router_w + (size_t)l * DM * NE;
    for (int i = tid; i < DM * NE; i += NTHREADS) { const int c = i >> 5, e = i & 31; const float w = rw[i]; const unsigned hi = f2bf(w); const unsigned lo = f2bf(w - bf2f(hi));
        WH[e * RW_LD + c] = (bf16)hi; WL[e * RW_LD + c] = (bf16)lo; }
    if (tid < NE) lcount[tid] = 0;
    __syncthreads();
    const int M = (l == DEPTH - 1) ? TX : TT;
    const int per = (M + F.G - 1) / F.G, tok0 = F.vcu * per, tok1 = (tok0 + per < M) ? tok0 + per : M;
    const int ntile = tok1 > tok0 ? (tok1 - tok0 + 15) >> 4 : 0;
    const float* g2w = F.norm2_g + (size_t)l * DM + 8 * g;
    const float rb0 = F.router_b[(size_t)l * NE + q], rb1 = F.router_b[(size_t)l * NE + 16 + q];
    for (int tile = F.wave; tile < ntile; tile += NWAVES) {
        const int tbase = tok0 + 16 * tile, t = tbase + q, tq = t < tok1 ? t : tok1 - 1; const bool valid = t < tok1;
        const float* xr = F.X + (size_t)tq * DM + 8 * g;
        float ss = 0.f;
#pragma unroll 8
        for (int s = 0; s < 32; ++s) { const f32x4 a = *(const f32x4*)(xr + 32 * s), b = *(const f32x4*)(xr + 32 * s + 4); ss += (a.x * a.x + a.y * a.y) + (a.z * a.z + a.w * a.w) + (b.x * b.x + b.y * b.y) + (b.z * b.z + b.w * b.w); }
        ss += __shfl_xor(ss, 16); ss += __shfl_xor(ss, 32);
        const float rinv = 1.f / sqrtf(ss * (1.f / DM) + EPS);
        const int br = tq < TX ? tq / SEQ : NB;
        const float* md = F.mod + ((size_t)l * 9 + br) * 6 * DM + 8 * g;
        unsigned char* hrow = MOE_FP8 ? F.H8 + (size_t)tq * DM + 8 * g : (unsigned char*)(F.H + (size_t)tq * DM + 8 * g);
        f32x4 acc[2]; acc[0] = (f32x4){0.f, 0.f, 0.f, 0.f}; acc[1] = acc[0];
#pragma unroll 2
        for (int s = 0; s < 32; ++s) { const int c = 32 * s;
            const f32x4 xa = *(const f32x4*)(xr + c), xb = *(const f32x4*)(xr + c + 4), ga = *(const f32x4*)(g2w + c), gb = *(const f32x4*)(g2w + c + 4);
            const f32x4 ca = *(const f32x4*)(md + 4 * DM + c), cb = *(const f32x4*)(md + 4 * DM + c + 4), sa = *(const f32x4*)(md + 3 * DM + c), sb = *(const f32x4*)(md + 3 * DM + c + 4);
            const f32x4 ha = (xa * rinv * ga) * (ca + 1.f) + sa, hb = (xb * rinv * gb) * (cb + 1.f) + sb;
            u32x4 hw; hw.x = cvt_pk_bf16(ha.x, ha.y); hw.y = cvt_pk_bf16(ha.z, ha.w); hw.z = cvt_pk_bf16(hb.x, hb.y); hw.w = cvt_pk_bf16(hb.z, hb.w);
            u32x4 lw; lw.x = cvt_pk_bf16(ha.x - bflo(hw.x), ha.y - bfhi(hw.x)); lw.y = cvt_pk_bf16(ha.z - bflo(hw.y), ha.w - bfhi(hw.y));
            lw.z = cvt_pk_bf16(hb.x - bflo(hw.z), hb.y - bfhi(hw.z)); lw.w = cvt_pk_bf16(hb.z - bflo(hw.w), hb.w - bfhi(hw.w));
            if (valid) { if (MOE_FP8) { u32x2 h8; h8.x = pk4_fp8(ha.x, ha.y, ha.z, ha.w); h8.y = pk4_fp8(hb.x, hb.y, hb.z, hb.w); *(u32x2*)(hrow + c) = h8; } else *(u32x4*)(hrow + 2 * c) = hw; }
            const bf16x8 ah = __builtin_bit_cast(bf16x8, hw), al = __builtin_bit_cast(bf16x8, lw);
#pragma unroll
            for (int tt = 0; tt < 2; ++tt) { const bf16x8 bh = *(const LAS bf16x8*)(WH + (16 * tt + q) * RW_LD + c + 8 * g), bl = *(const LAS bf16x8*)(WL + (16 * tt + q) * RW_LD + c + 8 * g);
                acc[tt] = __builtin_amdgcn_mfma_f32_16x16x32_bf16(ah, bh, acc[tt], 0, 0, 0);
                acc[tt] = __builtin_amdgcn_mfma_f32_16x16x32_bf16(ah, bl, acc[tt], 0, 0, 0);
                acc[tt] = __builtin_amdgcn_mfma_f32_16x16x32_bf16(al, bh, acc[tt], 0, 0, 0); } }
        unsigned k0[4], k1[4], win[4][4];
#pragma unroll
        for (int rg = 0; rg < 4; ++rg) { k0[rg] = f2key(acc[0][rg] + rb0, q); k1[rg] = f2key(acc[1][rg] + rb1, 16 + q); }
#pragma unroll
        for (int k = 0; k < 4; ++k)
#pragma unroll
            for (int rg = 0; rg < 4; ++rg) { unsigned m = k0[rg] > k1[rg] ? k0[rg] : k1[rg];
#pragma unroll
                for (int o = 1; o < 16; o <<= 1) { const unsigned y = (unsigned)__shfl_xor((int)m, o); m = y > m ? y : m; }
                win[rg][k] = m; if (k0[rg] == m) k0[rg] = 0u; if (k1[rg] == m) k1[rg] = 0u; }
        { const int rsel = q >> 2, ksel = q & 3;
          unsigned w4[4];
#pragma unroll
          for (int k = 0; k < 4; ++k) w4[k] = rsel == 0 ? win[0][k] : rsel == 1 ? win[1][k] : rsel == 2 ? win[2][k] : win[3][k];
          const float v0 = key2f(w4[0]), e1 = __expf(key2f(w4[1]) - v0), e2 = __expf(key2f(w4[2]) - v0), e3 = __expf(key2f(w4[3]) - v0);
          const float inv = 1.f / (1.f + e1 + e2 + e3);
          const float gt = (ksel == 0 ? 1.f : ksel == 1 ? e1 : ksel == 2 ? e2 : e3) * inv;
          const unsigned wk = ksel == 0 ? w4[0] : ksel == 1 ? w4[1] : ksel == 2 ? w4[2] : w4[3];
          const int e = 31 - (int)(wk & 31u), tt2 = tbase + 4 * g + rsel;
          if (tt2 < tok1 && !dry) { F.GATE[(size_t)tt2 * 4 + ksel] = gt;
              const int pos = __hip_atomic_fetch_add(lcount + e, 1, __ATOMIC_RELAXED, __HIP_MEMORY_SCOPE_WORKGROUP);
              apos[(tt2 - tok0) * 4 + ksel] = (e << 16) | pos; } }
    }
    __syncthreads();
    if (dry) return;
    if (tid < NE) lbase[tid] = (int)__hip_atomic_fetch_add(F.ctl + CW_CNT + (l * NE + tid) * 64, (unsigned)__hip_atomic_load(lcount + tid, __ATOMIC_RELAXED, __HIP_MEMORY_SCOPE_WORKGROUP), __ATOMIC_RELAXED, __HIP_MEMORY_SCOPE_AGENT);
    __syncthreads();
    const int nas = (tok1 > tok0 ? (tok1 - tok0) : 0) * 4;
    for (int i = tid; i < nas; i += NTHREADS) { const int w = apos[i], e = w >> 16, pos = w & 0xffff; F.LIST[(size_t)e * TT + lbase[e] + pos] = tok0 * 4 + i; }
    __syncthreads();
}
__device__ __forceinline__ void moe_tables(Frame& F, int l, int npn) {
    volatile LAS int* tp = (volatile LAS int*)(F.MISC + 16);
    LAS int* tab = (LAS int*)(F.lds + TAB_OFF);
    const int tid = F.tid;
    volatile LAS int* eb = (volatile LAS int*)(F.MISC + 128);
    volatile LAS int* cntl = (volatile LAS int*)(F.MISC + 168);
    if (tid == 0) { int acc = 0, sb = 0;
        for (int e = 0; e < NE; ++e) { tp[e] = acc; eb[e] = sb; const int cnt = (int)__hip_atomic_load(F.ctl + CW_CNT + (l * NE + e) * 64, __ATOMIC_RELAXED, __HIP_MEMORY_SCOPE_AGENT); cntl[e] = cnt; acc += (cnt + 255) >> 8; sb += cnt; }
        tp[NE] = acc; }
    __syncthreads();
    if (npn != 8) return;
#pragma unroll 1
    for (int i2 = 0; i2 < MAXU; i2 += 2) {
        const int i = i2 + (tid >> 8), rr = tid & 255;
        g8::Unit u;
        if (i < MAXU && g8::moe_unit((long)i * F.G + F.vcu, npn, tp, u)) {
            const int cnt = (int)__hip_atomic_load(F.ctl + CW_CNT + (l * NE + u.e) * 64, __ATOMIC_RELAXED, __HIP_MEMORY_SCOPE_AGENT);
            const int idx = u.pm * 256 + rr;
            const int a = idx < cnt ? F.LIST[(size_t)u.e * TT + idx] : -1;
            tab[i * 256 + rr] = a;
            if (u.pn == 0 && a >= 0) { F.INV[a] = eb[u.e] + idx; F.GATES[eb[u.e] + idx] = F.GATE[a]; }
        }
    }
    __syncthreads();
}

__global__ void __launch_bounds__(NTHREADS, 2) mk_fwd(Args args) {
    extern __shared__ __attribute__((aligned(16))) unsigned char lds_raw[];
    Frame F;
    F.lds = (LAS unsigned char*)lds_raw;
    F.MISC = (volatile LAS unsigned*)(F.lds + MISC_OFF);
    F.tid = threadIdx.x; F.lane = F.tid & 63; F.wave = __builtin_amdgcn_readfirstlane(F.tid >> 6);
    F.G = gridDim.x; { const int bx = blockIdx.x; F.vcu = (F.G % 8 == 0) ? (bx % 8) * (F.G / 8) + bx / 8 : bx; }
    frame_ptrs(F);
    for (int u = F.tid; u < 256; u += NTHREADS) F.MISC[u] = 0u;
    __syncthreads();
    const int lo = args.ph_lo, hi = args.ph_hi;
    const bool one_launch = (hi - lo) > 1;
    XcdBarrier bar; bar.bar = F.ctl + CW_BAR; bar.x = 0; bar.st = nullptr;
    if (one_launch) bar = xcd_barrier_post(F.ctl + CW_BAR, F.MISC);
#ifndef PHMASK
#define PHMASK 0xFFFFFFFF
#endif
#define IN(k) (lo <= (k) && (k) < hi)
#define PHON(b) ((PHMASK >> (b)) & 1)
#define STAGGER() do { if (STAG_TICKS > 0 && (blockIdx.x & 8)) { const unsigned long long t0_ = __builtin_amdgcn_s_memrealtime(); while (__builtin_amdgcn_s_memrealtime() - t0_ < (unsigned long long)STAG_TICKS) __builtin_amdgcn_s_sleep(8); } } while (0)
#define REFRESH() do { int tz_ = threadIdx.x; asm volatile("" : "+v"(tz_)); F.tid = tz_; F.lane = tz_ & 63; frame_ptrs(F); } while (0)
#define SEAM(k) do { if (IN(k) && IN((k) + 1)) xcd_barrier(bar); } while (0)

    if (PHON(0) && IN(0)) { for (int rep = 0; rep < REPS(0); ++rep) { REFRESH(); ph_prologue(F); } } SEAM(0);
    if (PHON(1) && IN(1)) { REFRESH(); ph_first_norm(F); } SEAM(1);
    for (int l = 0; l < DEPTH; ++l) {
        const int pb = 2 + PPL * l;
        const bool lastl = (l == DEPTH - 1);
        if (PHON(2) && IN(pb + 0)) for (int rep = 0; rep < REPS(2); ++rep) {
            REFRESH(); STAGGER();
            g8::ProbIn Pb{(const char*)F.H, (const char*)(F.Bin + (size_t)l * NP * DM), F.P, F.VTA, F.G, (int)blockIdx.x, (rep + 1 < REPS(2)) ? 1 : 0};
            g8::gemm_phase(F.lds, Pb);
        }
        SEAM(pb + 0);
        if (PHON(3) && IN(pb + 1)) { for (int rep = 0; rep < REPS(3); ++rep) { REFRESH(); ph_prep(F, l); } } SEAM(pb + 1);
        if (PHON(4) && IN(pb + 2)) { for (int rep = 0; rep < REPS(4); ++rep) { REFRESH(); ph_attn(F, l); } } SEAM(pb + 2);
        if (PHON(10) && IN(pb + 3)) { for (int rep = 0; rep < REPS(10); ++rep) { REFRESH(); ph_gla3(F, l); } } SEAM(pb + 3);
        if (PHON(5) && IN(pb + 4)) for (int rep = 0; rep < REPS(5); ++rep) {
            REFRESH(); STAGGER();
            g8::ProbOut Pb{(const char*)F.MIX, (const char*)(F.Bout + (size_t)l * DM * DM), (rep + 1 < REPS(5)) ? (float*)F.ACT : F.X, F.mod + (size_t)l * 9 * 6 * DM, F.G, (int)blockIdx.x, (lastl ? TX : TT) / 256};
            g8::gemm_phase(F.lds, Pb);
        }
        SEAM(pb + 4);
        if (PHON(6) && IN(pb + 5)) { for (int rep = 0; rep < REPS(6); ++rep) { REFRESH(); ph_router(F, l, rep + 1 < REPS(6)); __syncthreads(); } } SEAM(pb + 5);
        if (PHON(7) && IN(pb + 6)) for (int rep = 0; rep < REPS(7); ++rep) {
            REFRESH(); moe_tables(F, l, 8); STAGGER();
            g8::ProbGU Pb{MOE_FP8 ? (const char*)F.H8 : (const char*)F.H, (const char*)F.Bgu + (size_t)l * NE * 2 * DM * DM * (MOE_FP8 ? 1 : 2), (unsigned char*)F.ACT, F.b_gu + (size_t)l * NE * 2 * DM, (volatile LAS int*)(F.MISC + 16), (const LAS int*)(F.lds + TAB_OFF), F.G, F.vcu, (rep + 1 < REPS(7)) ? 1 : 0, (volatile LAS int*)(F.MISC + 128)};
            g8::gemm_phase(F.lds, Pb);
        }
        SEAM(pb + 6);
        if (PHON(8) && IN(pb + 7)) for (int rep = 0; rep < REPS(8); ++rep) {
            REFRESH(); moe_tables(F, l, 4); STAGGER();
            g8::ProbDN Pb{(const char*)F.ACT, (const char*)F.Bdn + (size_t)l * NE * DM * DM * (MOE_FP8 ? 1 : 2), F.YB, F.b_down + (size_t)l * NE * DM, F.GATES, (volatile LAS int*)(F.MISC + 16), F.G, F.vcu, (rep + 1 < REPS(8)) ? 1 : 0, (volatile LAS int*)(F.MISC + 128), (volatile LAS int*)(F.MISC + 168)};
            g8::gemm_phase(F.lds, Pb);
        }
        SEAM(pb + 7);
        if (PHON(9) && IN(pb + 8)) { for (int rep = 0; rep < REPS(9); ++rep) { REFRESH(); ph_combine(F, l, rep + 1 < REPS(9)); } }
        if (!lastl) SEAM(pb + 8);
    }
#undef IN
#undef SEAM
}

extern "C" void kernel_launch(void* const* d_in, const int* in_sizes, int n_in, void* d_out, int out_size, void* d_ws, size_t ws_size, hipStream_t stream) {
    static int grid = 0;
    if (grid == 0) {
        if (n_in != 23 || in_sizes[0] != TX * DM || out_size != TX * DM || ws_size < WS_END) {
            fprintf(stderr, "kernel_launch: unexpected problem (n_in %d, in0 %d, out %d, ws %zu; need ws >= %zu); nothing launched\n", n_in, n_in > 0 ? in_sizes[0] : -1, out_size, ws_size, (size_t)WS_END); grid = -1; return; }
        int dev = 0, cus = 0, per_cu = 0;
        if (hipGetDevice(&dev) != hipSuccess || hipDeviceGetAttribute(&cus, hipDeviceAttributeMultiprocessorCount, dev) != hipSuccess) { fprintf(stderr, "kernel_launch: device query failed\n"); grid = -1; return; }
        if (hipFuncSetAttribute((const void*)mk_fwd, hipFuncAttributeMaxDynamicSharedMemorySize, LDS_BYTES) != hipSuccess) { fprintf(stderr, "kernel_launch: hipFuncSetAttribute failed\n"); grid = -1; return; }
        if (hipOccupancyMaxActiveBlocksPerMultiprocessor(&per_cu, (const void*)mk_fwd, NTHREADS, LDS_BYTES) != hipSuccess || per_cu < 1)
            fprintf(stderr, "kernel_launch: note: occupancy query reports %d workgroups per CU\n", per_cu);
        (void)hipGetLastError();
        grid = cus;
        if ((long)grid * MAXU < (long)(NASG / 256 + NE) * 8) { fprintf(stderr, "kernel_launch: grid %d too small for the MoE unit tables\n", grid); grid = -1; return; }
    }
    if (grid < 0) return;
    if (hipMemsetAsync((char*)d_ws + WS_CTL, 0, CTL_ZERO_BYTES, stream) != hipSuccess) { fprintf(stderr, "kernel_launch: memset failed\n"); return; }
    Args a{};
    for (int i = 0; i < 23; ++i) a.in[i] = (const float*)d_in[i];
    a.out = (float*)d_out; a.ws = (unsigned char*)d_ws;
#if MK_N_LAUNCHES == 1
    a.ph_lo = 0; a.ph_hi = NPHASES;
    hipLaunchKernelGGL(mk_fwd, dim3(grid), dim3(NTHREADS), LDS_BYTES, stream, a);
#else
    for (int p = 0; p < NPHASES; ++p) { a.ph_lo = p; a.ph_hi = p + 1; hipLaunchKernelGGL(mk_fwd, dim3(grid), dim3(NTHREADS), LDS_BYTES, stream, a); }
#endif
    const hipError_t le = hipPeekAtLastError();
    if (le != hipSuccess) fprintf(stderr, "kernel_launch: launch failed: %s\n", hipGetErrorName(le));
}
```

```cpp
#include <hip/hip_runtime.h>
#include <cstdio>
#include <cstdint>
#include <cstddef>

#ifndef MK_N_LAUNCHES
#define MK_N_LAUNCHES 1
#endif

#define GAS __attribute__((address_space(1)))
#define LAS __attribute__((address_space(3)))
typedef unsigned short bf16;
typedef short bf16x8 __attribute__((ext_vector_type(8)));
typedef short bf16x4 __attribute__((ext_vector_type(4)));
typedef float f32x4 __attribute__((ext_vector_type(4)));
typedef float f32x2 __attribute__((ext_vector_type(2)));
typedef unsigned u32x4 __attribute__((ext_vector_type(4)));
typedef unsigned u32x2 __attribute__((ext_vector_type(2)));

constexpr int NB = 8, SEQ = 4096, DM = 1024, CTXL = 256, DEPTH = 4, GRIDW = 64;
constexpr int TX = NB * SEQ, TC = NB * CTXL, TT = TX + TC;
constexpr int NP = 2816;
constexpr int C_NAQ = 0, C_NAK = 384, C_NAV = 768, C_GV = 1152, C_GQ = 1536, C_GK = 1728, C_GG = 1920, C_POOL = 2304, C_AF = 2560, C_AB = 2576;
constexpr int VT_C0 = 768, VT_NC = 768, VTS = TT + 128;
constexpr int NE = 32, TOPK = 4, NASG = TT * TOPK;
constexpr int SLOT_DUMMY = NASG + 256;
constexpr int GH = 4, GDK = 48, GDV = 96, NH = 6, NDH = 64;
constexpr float EPS = 1e-6f;
constexpr int NWAVES = 8, NTHREADS = 512;
constexpr int PPL = 9;
constexpr int NPHASES = 2 + PPL * DEPTH;
#ifndef MOE_FP8
#define MOE_FP8 1
#endif
#ifndef REPMASK
#define REPMASK 0
#endif
#define REPS(b) (1 + ((REPMASK >> (b)) & 1))
#ifndef GLA_CHECK
#define GLA_CHECK 0
#endif

constexpr size_t MiB = 1u << 20;
constexpr size_t WS_CTL = 0, CTL_ZERO_BYTES = 128 * 1024;
constexpr size_t WS_MOD = 2 * MiB;
constexpr size_t WS_BIN = 4 * MiB;
constexpr size_t WS_BOUT = 26 * MiB;
constexpr size_t WS_BGU = 34 * MiB;
constexpr size_t WS_BDN = 546 * MiB;
constexpr size_t WS_X = 802 * MiB;
constexpr size_t WS_H = 938 * MiB;
constexpr size_t WS_P = 1008 * MiB;
constexpr size_t WS_VTX = 1196 * MiB;
constexpr size_t WS_VTC = 1220 * MiB;
constexpr size_t WS_MIX = 1222 * MiB;
constexpr size_t WS_OF = 1290 * MiB;
constexpr size_t WS_OB = 1341 * MiB;
constexpr size_t WS_ACT = 1392 * MiB;
constexpr size_t WS_YB = 1665 * MiB;
constexpr size_t WS_LIST = 1938 * MiB;
constexpr size_t WS_GATE = 1943 * MiB;
constexpr size_t WS_DS = 1944 * MiB;
constexpr size_t WS_GD = 2025 * MiB;
constexpr size_t WS_ROPE = 2026 * MiB;
constexpr size_t WS_VTA = 2027 * MiB;
constexpr size_t WS_OPS = 2080 * MiB;
constexpr size_t WS_STB = 2132 * MiB;
constexpr size_t WS_H8 = 2172 * MiB;
constexpr size_t WS_INV = 2208 * MiB;
constexpr size_t WS_GATES = 2209 * MiB;
constexpr size_t WS_END = 2210 * MiB;
constexpr int CW_BAR = 4096;
constexpr int CW_CNT = 16384;

constexpr int STAGE_BYTES = 132096;
constexpr int MISC_OFF = STAGE_BYTES;
constexpr int TAB_OFF = MISC_OFF + 1024;
constexpr int MAXU = 28;
constexpr int LDS_BYTES = TAB_OFF + MAXU * 1024;
static_assert(LDS_BYTES <= 163840, "LDS");

#define LDS_WAIT() asm volatile("s_waitcnt lgkmcnt(0)" ::: "memory")
#define VM_WAIT() asm volatile("s_waitcnt vmcnt(0)" ::: "memory")
__device__ __forceinline__ unsigned f2bf(float f) { unsigned u = __builtin_bit_cast(unsigned, f); return (u + 0x7fffu + ((u >> 16) & 1u)) >> 16; }
__device__ __forceinline__ unsigned pk2(float lo, float hi) { return f2bf(lo) | (f2bf(hi) << 16); }
__device__ __forceinline__ float bf2f(unsigned b) { return __builtin_bit_cast(float, (b & 0xffffu) << 16); }
__device__ __forceinline__ float bflo(unsigned w) { return __builtin_bit_cast(float, w << 16); }
__device__ __forceinline__ float bfhi(unsigned w) { return __builtin_bit_cast(float, w & 0xffff0000u); }
__device__ __forceinline__ unsigned cvt_pk_bf16(float lo, float hi) { unsigned r; asm volatile("v_cvt_pk_bf16_f32 %0, %1, %2" : "=v"(r) : "v"(lo), "v"(hi)); return r; }
__device__ __forceinline__ unsigned pk4_fp8(float a, float b, float c, float d) { int p = __builtin_amdgcn_cvt_pk_fp8_f32(a, b, 0, false); p = __builtin_amdgcn_cvt_pk_fp8_f32(c, d, p, true); return (unsigned)p; }
constexpr float Y8_SCALE = 16.f, Y8_INV = 1.f / 16.f;
constexpr float W8_SCALE = 64.f, W8_INV = 1.f / 64.f;
__device__ __forceinline__ float wave_sum(float v) {
#pragma unroll
    for (int o = 1; o < 64; o <<= 1) v += __shfl_xor(v, o);
    return v;
}
__device__ __forceinline__ float silu_f(float x) { return x / (1.f + __expf(-x)); }

#define XB_TMO      128
#define XB_XCNT(j)  (256  + 64 * (j))
#define XB_XSUB(j)  (1280 + 64 * (j))
#define XB_XGEN(j)  (2304 + 64 * (j))
#define XB_TOP      3328
#define XB_TOPGEN   3392
#define XCD_BAR_WORDS 3456
#define XB_SPIN_CAP (1u << 18)
__device__ __forceinline__ unsigned xb_ld(unsigned* p)              { return __hip_atomic_load(p, __ATOMIC_RELAXED, __HIP_MEMORY_SCOPE_AGENT); }
__device__ __forceinline__ unsigned xb_add(unsigned* p, unsigned v) { return __hip_atomic_fetch_add(p, v, __ATOMIC_RELAXED, __HIP_MEMORY_SCOPE_AGENT); }
__device__ __forceinline__ unsigned xb_xcc_id() { return (unsigned)__builtin_amdgcn_s_getreg((3 << 11) | 20) & 0xFu; }
#define XB_SPIN(cond, bar) do { unsigned _sp = 0; while (cond) { __builtin_amdgcn_s_sleep(1); \
    if ((++_sp & 255u) == 0u) { if (xb_ld(&(bar)[XB_TMO])) break; if (_sp > XB_SPIN_CAP) { atomicAdd(&(bar)[XB_TMO], 1u); break; } } } } while (0)
struct XcdBarrier { unsigned* bar; unsigned x; volatile LAS unsigned* st; };
__device__ __forceinline__ XcdBarrier xcd_barrier_post(unsigned* bar, volatile LAS unsigned* st) {
    XcdBarrier b; b.bar = bar; b.x = xb_xcc_id(); b.st = st;
    if (threadIdx.x == 0) (void)xb_add(&bar[XB_XCNT(b.x)], 1u);
    return b;
}
__device__ __forceinline__ void xcd_barrier_complete(unsigned* bar, unsigned x, unsigned& nloc, unsigned& nx) {
    const unsigned G = gridDim.x * gridDim.y * gridDim.z;
    unsigned sum, cnt, mine, sp = 0u;
    for (;;) {
        sum = 0u; cnt = 0u; mine = 0u;
#pragma unroll
        for (unsigned j = 0; j < 16; ++j) { const unsigned c = xb_ld(&bar[XB_XCNT(j)]); sum += c; cnt += (c > 0u) ? 1u : 0u; mine = (j == x) ? c : mine; }
        if (sum == G) break;
        __builtin_amdgcn_s_sleep(1);
        if ((++sp & 255u) == 0u) { if (xb_ld(&bar[XB_TMO])) break; if (sp > XB_SPIN_CAP) { atomicAdd(&bar[XB_TMO], 1u); break; } }
    }
    nloc = mine > 0u ? mine : 1u; nx = cnt > 0u ? cnt : 1u;
}
__device__ __forceinline__ void xcd_barrier(const XcdBarrier& b) {
    asm volatile("s_waitcnt vmcnt(0)" ::: "memory");
    __syncthreads();
    if (threadIdx.x == 0) {
        unsigned* bar = b.bar;
        __builtin_amdgcn_s_waitcnt(0);
        unsigned nloc = b.st[0], nx = b.st[1];
        if (nloc == 0u) { xcd_barrier_complete(bar, b.x, nloc, nx); b.st[0] = nloc; b.st[1] = nx; }
        const unsigned old = xb_add(&bar[XB_XSUB(b.x)], 1u);
        const unsigned gen = old / nloc;
        if (old + 1u == (gen + 1u) * nloc) {
            __builtin_amdgcn_fence(__ATOMIC_RELEASE, "agent");
            asm volatile("s_waitcnt vmcnt(0)" ::: "memory");
            const unsigned og = xb_add(&bar[XB_TOP], 1u);
            const unsigned tg = og / nx;
            if (og + 1u == (tg + 1u) * nx) xb_add(&bar[XB_TOPGEN], 1u);
            else XB_SPIN(xb_ld(&bar[XB_TOPGEN]) == tg, bar);
            __builtin_amdgcn_fence(__ATOMIC_ACQUIRE, "agent");
            xb_add(&bar[XB_XGEN(b.x)], 1u);
            asm volatile("s_waitcnt vmcnt(0)" ::: "memory");
        } else {
            XB_SPIN(xb_ld(&bar[XB_XGEN(b.x)]) == gen, bar);
            __builtin_amdgcn_fence(__ATOMIC_ACQUIRE, "agent");
            asm volatile("s_waitcnt vmcnt(0)" ::: "memory");
        }
    }
    __syncthreads();
}

namespace g8 {
constexpr int BM = 256, BK = 64, HALF = 128, HTB = HALF * BK * 2, NXCD = 8, WGM = 8, KD = 1024;
__device__ __forceinline__ int lds_byte(int r, int c) { const int st = (r >> 4) * 2 + (c >> 5), rr = r & 15, cc = c & 31, ob = rr * 64 + cc * 2; return st * 1024 + (ob ^ (((ob >> 9) & 1) << 5)); }
__device__ __forceinline__ void stage_rc(int b, int& R, int& C) { const int st = b / 1024, sb = b % 1024, swz = sb ^ (((sb >> 9) & 1) << 5); R = (st >> 1) * 16 + swz / 64; C = (st & 1) * 32 + (swz % 64) / 2; }
__device__ __forceinline__ int perm32(int rho) { const int n = rho >> 4, i = rho & 15; return 8 * (i >> 2) + 4 * n + (i & 3); }
struct Unit { int pm, pn, e; };
typedef int i32x8 __attribute__((ext_vector_type(8)));
typedef int i32x4 __attribute__((ext_vector_type(4)));
__device__ __forceinline__ i32x8 cat8(bf16x8 a, bf16x8 b) { const i32x4 x = __builtin_bit_cast(i32x4, a), y = __builtin_bit_cast(i32x4, b); return (i32x8){x.x, x.y, x.z, x.w, y.x, y.y, y.z, y.w}; }
__device__ __forceinline__ bool static_unit(long L, int nM, int nN, Unit& u) {
    const int nwg = nM * nN; if (L >= nwg) return false;
    int wgid = (int)L; { const int q = nwg / NXCD, r = nwg % NXCD, xcd = wgid % NXCD, off = wgid / NXCD; wgid = (xcd < r ? xcd * (q + 1) : r * (q + 1) + (xcd - r) * q) + off; }
    const int nig = WGM * nN, gid = wgid / nig, fm = gid * WGM, gsz = (nM - fm) < WGM ? (nM - fm) : WGM;
    u.pm = fm + ((wgid % nig) % gsz); u.pn = (wgid % nig) / gsz; u.e = 0; return true;
}

#ifndef PROBE_DRY
#define PROBE_DRY 0
#endif
#ifndef STAG_TICKS
#define STAG_TICKS 0
#endif
template <class Prob>
__device__ __forceinline__ void gemm_phase(LAS unsigned char* lds, const Prob& P) {

    int tid_ = threadIdx.x; asm volatile("" : "+v"(tid_));
    const int tid = tid_, wid = __builtin_amdgcn_readfirstlane(tid >> 6), lane = tid & 63, wr = wid >> 2, wc = wid & 3, fr = lane & 15, fq = lane >> 4;
    constexpr int RPB = Prob::FP8 ? KD : KD * 2, nt = RPB / (BK * 2);
    unsigned voffB[2];
    { int R0, C0, R1, C1; stage_rc(tid * 16, R0, C0); stage_rc(tid * 16 + 8192, R1, C1); const int Rb0 = Prob::PERM ? ((R0 & ~31) + perm32(R0 & 31)) : R0, Rb1 = Prob::PERM ? ((R1 & ~31) + perm32(R1 & 31)) : R1;
      voffB[0] = (unsigned)(Rb0 * RPB + C0 * 2); voffB[1] = (unsigned)(Rb1 * RPB + C1 * 2); }
    const size_t kstep = (size_t)(BK * 2), hstepB = (size_t)HALF * RPB;
    const unsigned ldsw = (unsigned)wid * 1024u;
    const int aoff = lds_byte(wr * 64 + fr, fq * 8), boff = lds_byte(wc * 32 + fr, fq * 8);
#define G8_SA(b, h) (((b) * 2 + (h)) * HTB)
#define G8_SB(b, h) ((4 + (b) * 2 + (h)) * HTB)
#define G8_STAGE(bufoff, gbase, voff) do { _Pragma("unroll") for (int _i = 0; _i < 2; ++_i) \
        __builtin_amdgcn_global_load_lds((const unsigned*)((const char*)(gbase) + (voff)[_i]), (LAS unsigned*)(lds + (bufoff) + ldsw + _i * 8192), 16, 0, 0); } while (0)
#define G8_LDA(dst, b, h) do { _Pragma("unroll") for (int m = 0; m < 4; ++m) _Pragma("unroll") for (int k = 0; k < 2; ++k) dst[m][k] = *(const LAS bf16x8*)(lds + G8_SA(b, h) + aoff + m * 2048 + k * 1024); } while (0)
#define G8_LDB(dst, b, h) do { _Pragma("unroll") for (int n = 0; n < 2; ++n) _Pragma("unroll") for (int k = 0; k < 2; ++k) dst[n][k] = *(const LAS bf16x8*)(lds + G8_SB(b, h) + boff + n * 2048 + k * 1024); } while (0)
#define G8_MMA(ai, bj, At, Bt) do { __builtin_amdgcn_s_setprio(1); if constexpr (Prob::FP8) { \
        _Pragma("unroll") for (int m = 0; m < 4; ++m) _Pragma("unroll") for (int n = 0; n < 2; ++n) \
        acc[ai][bj][m][n] = __builtin_amdgcn_mfma_scale_f32_16x16x128_f8f6f4(cat8(Bt[n][0], Bt[n][1]), cat8(At[m][0], At[m][1]), acc[ai][bj][m][n], 0, 0, 0, 0x7f7f7f7f, 0, 0x7f7f7f7f); } else { \
        _Pragma("unroll") for (int m = 0; m < 4; ++m) _Pragma("unroll") for (int n = 0; n < 2; ++n) _Pragma("unroll") for (int k = 0; k < 2; ++k) \
        acc[ai][bj][m][n] = __builtin_amdgcn_mfma_f32_16x16x32_bf16(Bt[n][k], At[m][k], acc[ai][bj][m][n], 0, 0, 0); } __builtin_amdgcn_s_setprio(0); } while (0)
#define G8_WAIT_V(n) asm volatile("s_waitcnt vmcnt(" #n ")" ::: "memory")
#define G8_WAIT_L(n) asm volatile("s_waitcnt lgkmcnt(" #n ")" ::: "memory")
#define G8_BAR __builtin_amdgcn_s_barrier()
#define G8_SCHED __builtin_amdgcn_sched_barrier(0)
    Unit cur, nxt; int ui = 0;
    if (!P.next(0, cur)) return;
    f32x4 acc[2][2][4][2];
#pragma unroll
    for (int a = 0; a < 2; ++a)
#pragma unroll
        for (int b = 0; b < 2; ++b)
#pragma unroll
            for (int m = 0; m < 4; ++m)
#pragma unroll
                for (int n = 0; n < 2; ++n) acc[a][b][m][n] = (f32x4){0.f, 0.f, 0.f, 0.f};
    bf16x8 At[4][2], B0[2][2], B1[2][2];
    unsigned cvA[2][2];
    P.a_off(cur, 0, tid, cvA);
    const char* cA = P.a_base(cur);
    const char* cB = P.b_ptr(cur);
    G8_STAGE(G8_SB(0, 0), cB, voffB); G8_STAGE(G8_SB(0, 1), cB + hstepB, voffB); G8_STAGE(G8_SA(0, 0), cA, cvA[0]); G8_STAGE(G8_SA(0, 1), cA, cvA[1]);
    if (wr == 1) G8_BAR;
    G8_WAIT_V(2); G8_BAR;
    G8_STAGE(G8_SB(1, 0), cB + kstep, voffB); G8_STAGE(G8_SA(1, 0), cA + kstep, cvA[0]); G8_STAGE(G8_SB(1, 1), cB + hstepB + kstep, voffB);
    G8_WAIT_V(6); G8_BAR;
    for (;;) {
        const bool has_next = P.next(ui + 1, nxt);
        const char* nB = has_next ? P.b_ptr(nxt) : cB;
        const char* nA = has_next ? P.a_base(nxt) : cA;
        for (int t = 0; t < nt; t += 2) {
            const bool last = (t == nt - 2);
            const char* a1 = cA + (size_t)(t + 1) * kstep;
            const char* a2 = last ? nA : cA + (size_t)(t + 2) * kstep; const char* b2 = last ? nB : cB + (size_t)(t + 2) * kstep;
            const char* a3 = a2 + kstep; const char* b3 = b2 + kstep;
            G8_LDB(B0, 0, 0); G8_LDB(B1, 0, 1); G8_SCHED; G8_LDA(At, 0, 0); G8_STAGE(G8_SA(1, 1), a1, cvA[1]);
            G8_WAIT_V(8); G8_WAIT_L(0); G8_BAR; G8_MMA(0, 0, At, B0); G8_MMA(0, 1, At, B1); G8_BAR; G8_SCHED;
            if (last && has_next) { int tz = threadIdx.x; asm volatile("" : "+v"(tz)); P.a_off(nxt, ui + 1, tz, cvA); }
            G8_LDA(At, 0, 1); G8_STAGE(G8_SB(0, 0), b2, voffB); G8_STAGE(G8_SB(0, 1), b2 + hstepB, voffB); G8_STAGE(G8_SA(0, 0), a2, cvA[0]);
            G8_WAIT_V(8); G8_WAIT_L(0); G8_BAR; G8_MMA(1, 0, At, B0); G8_MMA(1, 1, At, B1); G8_BAR; G8_SCHED;
            G8_LDB(B0, 1, 0); G8_LDB(B1, 1, 1); G8_SCHED; G8_LDA(At, 1, 0); G8_STAGE(G8_SA(0, 1), a2, cvA[1]);
            G8_WAIT_V(8); G8_WAIT_L(0); G8_BAR; G8_MMA(0, 0, At, B0); G8_MMA(0, 1, At, B1); G8_BAR; G8_SCHED;
            G8_LDA(At, 1, 1); G8_STAGE(G8_SB(1, 0), b3, voffB); G8_STAGE(G8_SB(1, 1), b3 + hstepB, voffB); G8_STAGE(G8_SA(1, 0), a3, cvA[0]);
            G8_WAIT_V(8); G8_WAIT_L(0); G8_BAR; G8_MMA(1, 0, At, B0); G8_MMA(1, 1, At, B1); G8_BAR; G8_SCHED;
        }
        if (wr == 0) G8_BAR;
        P.epi(acc, cur, ui, wr, wc, fr, fq);
        if (!has_next) break;
#pragma unroll
        for (int a = 0; a < 2; ++a)
#pragma unroll
            for (int b = 0; b < 2; ++b)
#pragma unroll
                for (int m = 0; m < 4; ++m)
#pragma unroll
                    for (int n = 0; n < 2; ++n) acc[a][b][m][n] = (f32x4){0.f, 0.f, 0.f, 0.f};
        cur = nxt; cB = nB; cA = nA; ++ui;
        if (wr == 1) G8_BAR;
    }
    G8_WAIT_V(0);
    G8_BAR;
#undef G8_SA
#undef G8_SB
#undef G8_STAGE
#undef G8_LDA
#undef G8_LDB
#undef G8_MMA
#undef G8_WAIT_V
#undef G8_WAIT_L
#undef G8_BAR
#undef G8_SCHED
}


struct ProbIn {
    static constexpr bool PERM = true, FP8 = false;
    const char* A; const char* Bt; bf16* O; bf16* VT; int G, c; int dry;
    __device__ __forceinline__ static bool swapped(const Unit& u) { return u.pn >= 3 && u.pn <= 5; }
    __device__ __forceinline__ bool next(int i, Unit& u) const { return static_unit((long)i * G + c, TT / 256, NP / 256, u); }
    __device__ __forceinline__ void a_off(const Unit& u, int, int tid, unsigned (&v)[2][2]) const {
        int R0, C0, R1, C1; stage_rc(tid * 16, R0, C0); stage_rc(tid * 16 + 8192, R1, C1);
        const int rt = swapped(u) ? u.pn : u.pm;
#pragma unroll
        for (int h = 0; h < 2; ++h) { v[h][0] = (unsigned)((rt * 256 + h * 128 + R0) * KD + C0) * 2u; v[h][1] = (unsigned)((rt * 256 + h * 128 + R1) * KD + C1) * 2u; }
    }
    __device__ __forceinline__ const char* a_base(const Unit& u) const { return swapped(u) ? Bt : A; }
    __device__ __forceinline__ const char* b_ptr(const Unit& u) const { return swapped(u) ? A + (size_t)u.pm * 256 * KD * 2 : Bt + (size_t)u.pn * 256 * KD * 2; }
    __device__ __forceinline__ void epi(const f32x4 (&acc)[2][2][4][2], const Unit& u, int, int wr, int wc, int fr, int fq) const {
        if (PROBE_DRY && dry) { asm volatile("" :: "v"(acc[0][0][0][0][0]), "v"(acc[1][1][3][1][3]), "v"(acc[0][1][2][0][1]), "v"(acc[1][0][1][1][2])); return; }
        const bool sw = swapped(u);
        bf16* base = sw ? VT + (size_t)(u.pn * 256 - VT_C0 + wr * 64 + fr) * VTS + u.pm * 256 + wc * 32 + 8 * fq
                        : O + (size_t)(u.pm * 256 + wr * 64 + fr) * NP + u.pn * 256 + wc * 32 + 8 * fq;
        const size_t ld = sw ? (size_t)VTS : (size_t)NP;
#pragma unroll
        for (int ai = 0; ai < 2; ++ai)
#pragma unroll
            for (int m = 0; m < 4; ++m) { bf16* rowp = base + (size_t)(ai * 128 + m * 16) * ld;
#pragma unroll
                for (int bj = 0; bj < 2; ++bj) { const f32x4 v0 = acc[ai][bj][m][0], v1 = acc[ai][bj][m][1];
                    u32x4 w; w.x = cvt_pk_bf16(v0[0], v0[1]); w.y = cvt_pk_bf16(v0[2], v0[3]); w.z = cvt_pk_bf16(v1[0], v1[1]); w.w = cvt_pk_bf16(v1[2], v1[3]);
                    *(u32x4*)(rowp + bj * 128) = w; } }
    }
};
struct ProbOut {
    static constexpr bool PERM = false, FP8 = false;
    const char* A; const char* Bt; float* X; const float* modl  ; int G, c, nM;
    __device__ __forceinline__ bool next(int i, Unit& u) const { return static_unit((long)i * G + c, nM, DM / 256, u); }
    __device__ __forceinline__ void a_off(const Unit& u, int, int tid, unsigned (&v)[2][2]) const {
        int R0, C0, R1, C1; stage_rc(tid * 16, R0, C0); stage_rc(tid * 16 + 8192, R1, C1);
#pragma unroll
        for (int h = 0; h < 2; ++h) { v[h][0] = (unsigned)((u.pm * 256 + h * 128 + R0) * KD + C0) * 2u; v[h][1] = (unsigned)((u.pm * 256 + h * 128 + R1) * KD + C1) * 2u; }
    }
    __device__ __forceinline__ const char* a_base(const Unit&) const { return A; }
    __device__ __forceinline__ const char* b_ptr(const Unit& u) const { return Bt + (size_t)u.pn * 256 * KD * 2; }
    __device__ __forceinline__ void epi(const f32x4 (&acc)[2][2][4][2], const Unit& u, int, int wr, int wc, int fr, int fq) const {
        const int r0 = u.pm * 256, br = r0 < TX ? (r0 / SEQ) : NB;
        const float* g1 = modl + (size_t)br * 6 * DM + 2 * DM;
        const int row0 = r0 + wr * 64 + fr, col0 = u.pn * 256 + wc * 32 + 4 * fq;
        f32x4 gv[2][2];
#pragma unroll
        for (int bj = 0; bj < 2; ++bj)
#pragma unroll
            for (int n = 0; n < 2; ++n) gv[bj][n] = *(const f32x4*)(g1 + col0 + bj * 128 + n * 16);
#pragma unroll
        for (int ai = 0; ai < 2; ++ai) {
            f32x4 xv[4][2][2];
#pragma unroll
            for (int m = 0; m < 4; ++m)
#pragma unroll
                for (int bj = 0; bj < 2; ++bj)
#pragma unroll
                    for (int n = 0; n < 2; ++n) xv[m][bj][n] = *(const f32x4*)(X + (size_t)(row0 + ai * 128 + m * 16) * DM + col0 + bj * 128 + n * 16);
#pragma unroll
            for (int m = 0; m < 4; ++m)
#pragma unroll
                for (int bj = 0; bj < 2; ++bj)
#pragma unroll
                    for (int n = 0; n < 2; ++n) *(f32x4*)(X + (size_t)(row0 + ai * 128 + m * 16) * DM + col0 + bj * 128 + n * 16) = xv[m][bj][n] + gv[bj][n] * acc[ai][bj][m][n];
        }
    }
};
__device__ __forceinline__ bool moe_unit(long L, int npn, const volatile LAS int* tp, Unit& u) {
    const int q = (int)(L / npn); if (q >= tp[NE]) return false;
    int e = 0;
#pragma unroll 1
    while (tp[e + 1] <= q) ++e;
    u.e = e; u.pm = q - tp[e]; u.pn = (int)(L % npn); return true;
}
struct ProbGU {
    static constexpr bool PERM = true, FP8 = (MOE_FP8 != 0); static constexpr unsigned EB = FP8 ? 1u : 2u;
    const char* A; const char* Bt  ; unsigned char* ACT; const float* bgu  ; const volatile LAS int* tp; const LAS int* tab; int G, c; int dry; const volatile LAS int* eb;
    __device__ __forceinline__ bool next(int i, Unit& u) const { return i < MAXU && moe_unit((long)i * G + c, 8, tp, u); }
    __device__ __forceinline__ void a_off(const Unit&, int ui, int tid, unsigned (&v)[2][2]) const {
        int R0, C0, R1, C1; stage_rc(tid * 16, R0, C0); stage_rc(tid * 16 + 8192, R1, C1);
#pragma unroll
        for (int h = 0; h < 2; ++h) { const int a0 = tab[ui * 256 + h * 128 + R0], a1 = tab[ui * 256 + h * 128 + R1];
            v[h][0] = (unsigned)(a0 < 0 ? TT : (a0 >> 2)) * (unsigned)KD * EB + (unsigned)C0 * 2u; v[h][1] = (unsigned)(a1 < 0 ? TT : (a1 >> 2)) * (unsigned)KD * EB + (unsigned)C1 * 2u; }
    }
    __device__ __forceinline__ const char* a_base(const Unit&) const { return A; }
    __device__ __forceinline__ const char* b_ptr(const Unit& u) const { return Bt + ((size_t)u.e * 2 * DM + (size_t)u.pn * 256) * KD * EB; }
    __device__ __forceinline__ void epi(const f32x4 (&acc)[2][2][4][2], const Unit& u, int ui, int wr, int wc, int fr, int fq) const {
        if (PROBE_DRY && dry) { asm volatile("" :: "v"(acc[0][0][0][0][0]), "v"(acc[1][1][3][1][3]), "v"(acc[0][1][2][0][1]), "v"(acc[1][0][1][1][2])); return; }
        const int cb = u.pn * 128 + wc * 32 + 8 * fq;
        const float* bg = bgu + (size_t)u.e * 2 * DM + cb; const float* bu = bg + DM;
        const f32x4 bg0 = *(const f32x4*)bg, bg1 = *(const f32x4*)(bg + 4), bu0 = *(const f32x4*)bu, bu1 = *(const f32x4*)(bu + 4);
        const int ebu = eb[u.e] + u.pm * 256;
#pragma unroll
        for (int ai = 0; ai < 2; ++ai)
#pragma unroll
            for (int m = 0; m < 4; ++m) {
                const int a = tab[ui * 256 + ai * 128 + wr * 64 + m * 16 + fr];
                unsigned char* rowp = ACT + ((size_t)(a < 0 ? SLOT_DUMMY : ebu + ai * 128 + wr * 64 + m * 16 + fr) * DM + cb) * EB;
                float o[8];
#pragma unroll
                for (int n = 0; n < 2; ++n) { const f32x4 gb = n ? bg1 : bg0, ub = n ? bu1 : bu0;
#pragma unroll
                    for (int j = 0; j < 4; ++j) { float g = acc[ai][0][m][n][j] * (FP8 ? W8_INV : 1.f) + gb[j], uu = acc[ai][1][m][n][j] * (FP8 ? W8_INV : 1.f) + ub[j];
                        g = fminf(g, 7.f); uu = fminf(fmaxf(uu, -7.f), 7.f);
                        o[n * 4 + j] = g * __builtin_amdgcn_rcpf(1.f + __expf(-1.702f * g)) * (uu + 1.f); } }
                if constexpr (FP8) { u32x2 w; w.x = pk4_fp8(o[0], o[1], o[2], o[3]); w.y = pk4_fp8(o[4], o[5], o[6], o[7]); *(u32x2*)rowp = w; }
                else { u32x4 w; w.x = cvt_pk_bf16(o[0], o[1]); w.y = cvt_pk_bf16(o[2], o[3]); w.z = cvt_pk_bf16(o[4], o[5]); w.w = cvt_pk_bf16(o[6], o[7]); *(u32x4*)rowp = w; } }
    }
};
struct ProbDN {
    static constexpr bool PERM = true, FP8 = (MOE_FP8 != 0); static constexpr unsigned EB = FP8 ? 1u : 2u;
    const char* A; const char* Bt  ; bf16* YB; const float* bdn  ; const float* gates  ; const volatile LAS int* tp; int G, c; int dry; const volatile LAS int* eb; const volatile LAS int* cntl;
    __device__ __forceinline__ bool next(int i, Unit& u) const { return i < MAXU && moe_unit((long)i * G + c, 4, tp, u); }
    __device__ __forceinline__ void a_off(const Unit& u, int, int tid, unsigned (&v)[2][2]) const {
        int R0, C0, R1, C1; stage_rc(tid * 16, R0, C0); stage_rc(tid * 16 + 8192, R1, C1);
        const int r0 = eb[u.e] + u.pm * 256;
#pragma unroll
        for (int h = 0; h < 2; ++h) { v[h][0] = (unsigned)(r0 + h * 128 + R0) * (unsigned)KD * EB + (unsigned)C0 * 2u; v[h][1] = (unsigned)(r0 + h * 128 + R1) * (unsigned)KD * EB + (unsigned)C1 * 2u; }
    }
    __device__ __forceinline__ const char* a_base(const Unit&) const { return A; }
    __device__ __forceinline__ const char* b_ptr(const Unit& u) const { return Bt + ((size_t)u.e * DM + (size_t)u.pn * 256) * KD * EB; }
    __device__ __forceinline__ void epi(const f32x4 (&acc)[2][2][4][2], const Unit& u, int ui, int wr, int wc, int fr, int fq) const {
        if (PROBE_DRY && dry) { asm volatile("" :: "v"(acc[0][0][0][0][0]), "v"(acc[1][1][3][1][3]), "v"(acc[0][1][2][0][1]), "v"(acc[1][0][1][1][2])); return; }
        const int col0 = u.pn * 256 + wc * 32 + 8 * fq;
        const float* bd = bdn + (size_t)u.e * DM + col0;
        f32x4 bv[2][2];
#pragma unroll
        for (int bj = 0; bj < 2; ++bj)
#pragma unroll
            for (int n = 0; n < 2; ++n) bv[bj][n] = *(const f32x4*)(bd + bj * 128 + 4 * n);
        int sl[2][4]; float gt[2][4]; const int ebu = eb[u.e] + u.pm * 256, nval = cntl[u.e] - u.pm * 256;
#pragma unroll
        for (int ai = 0; ai < 2; ++ai)
#pragma unroll
            for (int m = 0; m < 4; ++m) { const int rl = ai * 128 + wr * 64 + m * 16 + fr; sl[ai][m] = rl < nval ? ebu + rl : SLOT_DUMMY; gt[ai][m] = gates[sl[ai][m]]; }
#pragma unroll
        for (int ai = 0; ai < 2; ++ai)
#pragma unroll
            for (int m = 0; m < 4; ++m) {
                if constexpr (FP8) {
                    unsigned char* rowp = (unsigned char*)YB + (size_t)sl[ai][m] * DM + col0;
#pragma unroll
                    for (int bj = 0; bj < 2; ++bj) { const f32x4 v0 = (acc[ai][bj][m][0] * W8_INV + bv[bj][0]) * (gt[ai][m] * Y8_SCALE), v1 = (acc[ai][bj][m][1] * W8_INV + bv[bj][1]) * (gt[ai][m] * Y8_SCALE);
                        u32x2 w; w.x = pk4_fp8(v0[0], v0[1], v0[2], v0[3]); w.y = pk4_fp8(v1[0], v1[1], v1[2], v1[3]); *(u32x2*)(rowp + bj * 128) = w; }
                } else {
                    bf16* rowp = YB + (size_t)sl[ai][m] * DM + col0;
#pragma unroll
                    for (int bj = 0; bj < 2; ++bj) { const f32x4 v0 = (acc[ai][bj][m][0] + bv[bj][0]) * gt[ai][m], v1 = (acc[ai][bj][m][1] + bv[bj][1]) * gt[ai][m];
                        u32x4 w; w.x = cvt_pk_bf16(v0[0], v0[1]); w.y = cvt_pk_bf16(v0[2], v0[3]); w.z = cvt_pk_bf16(v1[0], v1[1]); w.w = cvt_pk_bf16(v1[2], v1[3]);
                        *(u32x4*)(rowp + bj * 128) = w; }
                } }
    }
};
}

struct Args { const float* in[23]; float* out; unsigned char* ws; int ph_lo, ph_hi; };
struct Frame {
    LAS unsigned char* lds; volatile LAS unsigned* MISC;
    int tid, lane, wave, G, vcu;
    const float *x, *c, *ctx, *c_ctx, *norm1_g, *norm2_g, *w_ada, *b_ada, *w_in, *gla_wa2, *gla_ba, *gla_norm_g, *na_rpb, *pool_w, *pool_scale, *w_out, *router_w, *router_b, *w_gu, *b_gu, *w_down, *b_down, *final_g;
    float* out; unsigned char* ws; unsigned* ctl;
    float* mod; bf16 *Bin, *Bout, *Bgu, *Bdn; float* X; bf16 *H, *P, *VTX, *VTC, *MIX; float *OF, *OB; bf16 *ACT, *YB; int* LIST; float* GATE; float *DS, *GD, *ROPE; bf16 *VTA, *OPS, *STB; unsigned char* H8; int* INV; float* GATES;
};


#define CAS __attribute__((address_space(4)))
__device__ __forceinline__ void frame_ptrs(Frame& F) {
    const CAS unsigned char* ka = (const CAS unsigned char*)__builtin_amdgcn_kernarg_segment_ptr();
    asm volatile("" : "+s"(ka));
    typedef const GAS float* gfp;
    const CAS gfp* in = (const CAS gfp*)ka;
    F.x = (const float*)in[0]; F.c = (const float*)in[1]; F.ctx = (const float*)in[2]; F.c_ctx = (const float*)in[3]; F.norm1_g = (const float*)in[4]; F.norm2_g = (const float*)in[5];
    F.w_ada = (const float*)in[6]; F.b_ada = (const float*)in[7]; F.w_in = (const float*)in[8]; F.gla_wa2 = (const float*)in[9]; F.gla_ba = (const float*)in[10]; F.gla_norm_g = (const float*)in[11];
    F.na_rpb = (const float*)in[12]; F.pool_w = (const float*)in[13]; F.pool_scale = (const float*)in[14]; F.w_out = (const float*)in[15]; F.router_w = (const float*)in[16]; F.router_b = (const float*)in[17];
    F.w_gu = (const float*)in[18]; F.b_gu = (const float*)in[19]; F.w_down = (const float*)in[20]; F.b_down = (const float*)in[21]; F.final_g = (const float*)in[22];
    F.out = (float*)*(GAS float* const CAS*)(ka + 184);
    GAS unsigned char* ws = *(GAS unsigned char* const CAS*)(ka + 192);
    F.ws = (unsigned char*)ws; F.ctl = (unsigned*)(ws + WS_CTL);
    F.mod = (float*)(ws + WS_MOD); F.Bin = (bf16*)(ws + WS_BIN); F.Bout = (bf16*)(ws + WS_BOUT); F.Bgu = (bf16*)(ws + WS_BGU); F.Bdn = (bf16*)(ws + WS_BDN);
    F.X = (float*)(ws + WS_X); F.H = (bf16*)(ws + WS_H); F.P = (bf16*)(ws + WS_P); F.VTX = (bf16*)(ws + WS_VTX); F.VTC = (bf16*)(ws + WS_VTC); F.MIX = (bf16*)(ws + WS_MIX);
    F.OF = (float*)(ws + WS_OF); F.OB = (float*)(ws + WS_OB); F.ACT = (bf16*)(ws + WS_ACT); F.YB = (bf16*)(ws + WS_YB); F.LIST = (int*)(ws + WS_LIST); F.GATE = (float*)(ws + WS_GATE);
    F.DS = (float*)(ws + WS_DS); F.GD = (float*)(ws + WS_GD); F.ROPE = (float*)(ws + WS_ROPE); F.VTA = (bf16*)(ws + WS_VTA); F.OPS = (bf16*)(ws + WS_OPS); F.STB = (bf16*)(ws + WS_STB); F.H8 = (unsigned char*)(ws + WS_H8); F.INV = (int*)(ws + WS_INV); F.GATES = (float*)(ws + WS_GATES);
}
static_assert(offsetof(Args, out) == 184 && offsetof(Args, ws) == 192, "Args layout");

__device__ __forceinline__ void in_col_map(int n0, int& dst, float& scale) {
    scale = 1.f;
    if (n0 < 192) { dst = C_GQ + n0; scale = 0.14433756729740643f; }
    else if (n0 < 384) dst = C_GK + (n0 - 192);
    else if (n0 < 768) dst = C_GV + (n0 - 384);
    else if (n0 < 800) dst = C_AF + (n0 - 768);
    else if (n0 < 1184) dst = C_GG + (n0 - 800);
    else if (n0 < 1568) { dst = C_NAQ + (n0 - 1184); scale = 0.125f; }
    else if (n0 < 1952) dst = C_NAK + (n0 - 1568);
    else if (n0 < 2336) dst = C_NAV + (n0 - 1952);
    else dst = C_POOL + (n0 - 2336);
}
struct TItem { const float* src; int N; unsigned char* dst; int fp8; float scale; };
__device__ __forceinline__ TItem titem_decode(const Frame& F, int r) {
    constexpr int I_IN = DEPTH * 16 * 81, I_OUT = DEPTH * 16 * 32, I_GU = DEPTH * NE * 16 * 64;
    TItem t; t.fp8 = 0; t.scale = 1.f;
    if (r < I_IN) { const int l = r / (16 * 81), rr = r % (16 * 81), kb = rr / 81, nb = rr % 81; int dst; in_col_map(nb * 32, dst, t.scale);
        t.N = 2592; t.src = F.w_in + (size_t)l * DM * 2592 + (size_t)(kb * 64) * 2592 + nb * 32; t.dst = (unsigned char*)(F.Bin + ((size_t)l * NP + dst) * DM + kb * 64); return t; }
    r -= I_IN;
    if (r < I_OUT) { const int l = r / (16 * 32), rr = r % (16 * 32), kb = rr / 32, nb = rr % 32;
        t.N = DM; t.src = F.w_out + (size_t)l * DM * DM + (size_t)(kb * 64) * DM + nb * 32; t.dst = (unsigned char*)(F.Bout + ((size_t)l * DM + nb * 32) * DM + kb * 64); return t; }
    r -= I_OUT; t.fp8 = MOE_FP8; constexpr size_t EB = MOE_FP8 ? 1 : 2;
    if (r < I_GU) { const int le = r / (16 * 64), rr = r % (16 * 64), kb = rr / 64, nb = rr % 64; const int j0 = nb * 32;
        const int dst = j0 < DM ? (j0 / 128) * 256 + (j0 % 128) : ((j0 - DM) / 128) * 256 + 128 + ((j0 - DM) % 128);
        t.N = 2 * DM; t.src = F.w_gu + (size_t)le * DM * 2 * DM + (size_t)(kb * 64) * 2 * DM + j0; t.dst = (unsigned char*)F.Bgu + (((size_t)le * 2 * DM + dst) * DM + kb * 64) * EB; return t; }
    r -= I_GU;
    { const int le = r / (16 * 32), rr = r % (16 * 32), kb = rr / 32, nb = rr % 32;
        t.N = DM; t.src = F.w_down + (size_t)le * DM * DM + (size_t)(kb * 64) * DM + nb * 32; t.dst = (unsigned char*)F.Bdn + (((size_t)le * DM + nb * 32) * DM + kb * 64) * EB; return t; }
}
__device__ __forceinline__ void titem_load(const TItem& t, int lane, f32x4 (&r)[8]) {
#pragma unroll
    for (int i = 0; i < 8; ++i) r[i] = *(const f32x4*)(t.src + (size_t)((lane >> 3) + 8 * i) * t.N + 4 * (lane & 7));
}
__device__ __forceinline__ void titem_store(const TItem& t, const f32x4 (&r)[8], LAS float* scr, int lane) {
#pragma unroll
    for (int i = 0; i < 8; ++i) { LAS float* p = scr + ((lane >> 3) + 8 * i) * 33 + 4 * (lane & 7); p[0] = r[i].x; p[1] = r[i].y; p[2] = r[i].z; p[3] = r[i].w; }
    LDS_WAIT(); asm volatile("" ::: "memory");
    if (t.fp8) { const int c = lane & 3; const float sc = W8_SCALE;
#pragma unroll
        for (int j = 0; j < 2; ++j) { const int n = (lane >> 2) + 16 * j; const LAS float* s = scr + (16 * c) * 33 + n;
            u32x4 o;
            o.x = pk4_fp8(s[0 * 33] * sc, s[1 * 33] * sc, s[2 * 33] * sc, s[3 * 33] * sc); o.y = pk4_fp8(s[4 * 33] * sc, s[5 * 33] * sc, s[6 * 33] * sc, s[7 * 33] * sc);
            o.z = pk4_fp8(s[8 * 33] * sc, s[9 * 33] * sc, s[10 * 33] * sc, s[11 * 33] * sc); o.w = pk4_fp8(s[12 * 33] * sc, s[13 * 33] * sc, s[14 * 33] * sc, s[15 * 33] * sc);
            *(u32x4*)(t.dst + (size_t)n * DM + 16 * c) = o; }
    } else { const int c = lane & 7; const float sc = t.scale;
#pragma unroll
        for (int j = 0; j < 4; ++j) { const int n = (lane >> 3) + 8 * j; const LAS float* s = scr + (8 * c) * 33 + n;
            u32x4 o; o.x = pk2(s[0 * 33] * sc, s[1 * 33] * sc); o.y = pk2(s[2 * 33] * sc, s[3 * 33] * sc); o.z = pk2(s[4 * 33] * sc, s[5 * 33] * sc); o.w = pk2(s[6 * 33] * sc, s[7 * 33] * sc);
            *(u32x4*)(t.dst + ((size_t)n * DM + 8 * c) * 2) = o; }
    }
    LDS_WAIT(); asm volatile("" ::: "memory");
}
__device__ __forceinline__ int conv_item_id(int t, int lay, int nfix) {
    constexpr int I_IN = DEPTH * 16 * 81, I_OUT = DEPTH * 16 * 32, I_GU = DEPTH * NE * 16 * 64;
    if (t < nfix) return t;
    t -= nfix;
    return t < NE * 16 * 64 ? I_IN + I_OUT + lay * (NE * 16 * 64) + t : I_IN + I_OUT + I_GU + lay * (NE * 16 * 32) + (t - NE * 16 * 64);
}
__device__ __forceinline__ void convert_items(Frame& F, int lay, int ntot, int t0 = 0, int t1 = -1) {
    LAS float* scr = (LAS float*)(F.lds + F.wave * 16384);
    const int gw = F.vcu * NWAVES + F.wave, NGW = F.G * NWAVES, lane = F.lane;
    const int nfix = ntot - 3 * (NE * 16 * 32);
    if (t1 >= 0) ntot = t1;
    int it = t0 + gw; TItem cur = titem_decode(F, conv_item_id(it < ntot ? it : 0, lay, nfix)); f32x4 ra[8];
    if (it < ntot) titem_load(cur, lane, ra);
    while (it < ntot) {
        const int itn = it + NGW; const bool hn = itn < ntot;
        TItem nxt = titem_decode(F, conv_item_id(hn ? itn : 0, lay, nfix)); f32x4 rb[8];
        if (hn) titem_load(nxt, lane, rb);
        titem_store(cur, ra, scr, lane);
        it = itn; cur = nxt;
#pragma unroll
        for (int i = 0; i < 8; ++i) ra[i] = rb[i];
    }
}
__device__ __forceinline__ void ph_prologue(Frame& F) {
    const int gw = F.vcu * NWAVES + F.wave, NGW = F.G * NWAVES, lane = F.lane;
    constexpr int I_IN = DEPTH * 16 * 81, I_OUT = DEPTH * 16 * 32;
    for (int r = F.vcu; r < DEPTH * 24; r += F.G) {
        const int l = r / 24, j4 = (r % 24) * 256 + 4 * lane, k0 = F.wave * 128;
        const float* W = F.w_ada + (size_t)l * DM * 6 * DM + (size_t)k0 * 6 * DM + j4;
        f32x4 acc[9];
#pragma unroll
        for (int q = 0; q < 9; ++q) acc[q] = (f32x4){0.f, 0.f, 0.f, 0.f};
#pragma unroll 1
        for (int kh = 0; kh < 2; ++kh) {
            float cv[9];
#pragma unroll
            for (int q = 0; q < 8; ++q) cv[q] = silu_f(F.c[q * DM + k0 + 64 * kh + lane]);
            cv[8] = silu_f(F.c_ctx[k0 + 64 * kh + lane]);
#pragma unroll 8
            for (int kk = 0; kk < 64; ++kk) { const f32x4 w = *(const f32x4*)(W + (size_t)(64 * kh + kk) * 6 * DM);
#pragma unroll
                for (int q = 0; q < 9; ++q) acc[q] += __builtin_bit_cast(float, __builtin_amdgcn_readlane(__builtin_bit_cast(int, cv[q]), kk)) * w; }
        }
        LAS float* part = (LAS float*)F.lds;
#pragma unroll
        for (int q = 0; q < 9; ++q) *(LAS f32x4*)(part + (F.wave * 9 + q) * 256 + 4 * lane) = acc[q];
        __syncthreads();
        for (int o = F.tid; o < 9 * 256; o += NTHREADS) { const int q = o >> 8, cc = o & 255; float sum = F.b_ada[(size_t)l * 6 * DM + (r % 24) * 256 + cc];
#pragma unroll
            for (int w = 0; w < NWAVES; ++w) sum += part[(w * 9 + q) * 256 + cc];
            F.mod[((size_t)l * 9 + q) * 6 * DM + (r % 24) * 256 + cc] = sum; }
        __syncthreads();
    }
    convert_items(F, 0, I_IN + I_OUT + 3 * (NE * 16 * 32), 0, I_IN + I_OUT);
#if GLA_CHECK
    for (int lay = 0; lay < DEPTH; ++lay) convert_items(F, lay, 3 * (NE * 16 * 32));
#endif
    if (F.vcu == 0) for (int i = F.tid; i < 64 * 12; i += NTHREADS) { const int pos = i / 12, fi = i % 12;
        const float invf = expf(-((float)(2 * fi) / 24.f) * 9.210340371976184f); const float ang = (float)pos * invf; F.ROPE[i] = cosf(ang); F.ROPE[768 + i] = sinf(ang); }
    const size_t gt = (size_t)F.vcu * NTHREADS + F.tid, NGT = (size_t)F.G * NTHREADS;
    for (size_t i = gt; i < (size_t)DEPTH * 224 * DM / 8; i += NGT) { const size_t l = i / (224 * DM / 8), rr = i % (224 * DM / 8);
        *(u32x4*)(F.Bin + (l * NP + 2592) * DM + rr * 8) = (u32x4){0u, 0u, 0u, 0u}; }
    for (size_t i = gt; i < (size_t)256 * DM / 8; i += NGT) *(u32x4*)(F.H + (size_t)TT * DM + i * 8) = (u32x4){0u, 0u, 0u, 0u};
    for (size_t i = gt; i < (size_t)256 * DM / 16; i += NGT) *(u32x4*)(F.H8 + (size_t)TT * DM + i * 16) = (u32x4){0u, 0u, 0u, 0u};
}

__device__ __forceinline__ void norm_mod_store(const f32x4 (&v)[4], const float* gw, const float* sc, const float* sh, bf16* orow, int lane) {
    float s = 0.f;
#pragma unroll
    for (int j = 0; j < 4; ++j) s += (v[j].x * v[j].x + v[j].y * v[j].y) + (v[j].z * v[j].z + v[j].w * v[j].w);
    const float rinv = 1.f / sqrtf(wave_sum(s) * (1.f / DM) + EPS);
#pragma unroll
    for (int j = 0; j < 4; ++j) { const int c = 4 * lane + 256 * j;
        const f32x4 g = *(const f32x4*)(gw + c), a = *(const f32x4*)(sc + c), b = *(const f32x4*)(sh + c);
        const f32x4 y = (v[j] * rinv * g) * (a + 1.f) + b;
        u32x2 w; w.x = pk2(y.x, y.y); w.y = pk2(y.z, y.w);
        *(u32x2*)(orow + c) = w; }
}
__device__ __forceinline__ void ph_first_norm(Frame& F) {
    const int gw = F.vcu * NWAVES + F.wave, NGW = F.G * NWAVES, lane = F.lane;
    for (int m = gw; m < TT; m += NGW) {
        const float* src = m < TX ? F.x + (size_t)m * DM : F.ctx + (size_t)(m - TX) * DM;
        const int br = m < TX ? m / SEQ : NB;
        f32x4 v[4];
#pragma unroll
        for (int j = 0; j < 4; ++j) { v[j] = *(const f32x4*)(src + 4 * lane + 256 * j); *(f32x4*)(F.X + (size_t)m * DM + 4 * lane + 256 * j) = v[j]; }
        const float* md = F.mod + (size_t)br * 6 * DM;
        norm_mod_store(v, F.norm1_g, md + DM, md, F.H + (size_t)m * DM, lane);
    }
}
__device__ __forceinline__ void ph_combine(Frame& F, int l, bool dry = false) {
    const int gw = F.vcu * NWAVES + F.wave, NGW = F.G * NWAVES, lane = F.lane;
    float* Xo = dry ? (float*)F.ACT : F.X; bf16* Ho = dry ? (bf16*)F.P : F.H; float* Oo = dry ? (float*)F.ACT : F.out;
    const int M = (l == DEPTH - 1) ? TX : TT;
    const int cA = 8 * lane, cB = 512 + 8 * lane;
    for (int m0 = gw; m0 < M; m0 += 2 * NGW) {
        u32x4 yw[2][4][2]; f32x4 xv[2][4]; bool have[2]; int br[2];
#pragma unroll
        for (int rr = 0; rr < 2; ++rr) { const int m = m0 + rr * NGW; have[rr] = m < M; const int mm = have[rr] ? m : m0; br[rr] = mm < TX ? mm / SEQ : NB;
            const u32x4 sl4 = *(const u32x4*)(F.INV + (size_t)mm * 4); const unsigned slk[4] = {sl4.x, sl4.y, sl4.z, sl4.w};
#pragma unroll
            for (int k = 0; k < 4; ++k) {
                if (MOE_FP8) { const unsigned char* yr = (const unsigned char*)F.YB + (size_t)slk[k] * DM; const u32x2 a = *(const u32x2*)(yr + cA), b = *(const u32x2*)(yr + cB);
                    yw[rr][k][0] = (u32x4){a.x, a.y, 0u, 0u}; yw[rr][k][1] = (u32x4){b.x, b.y, 0u, 0u}; }
                else { yw[rr][k][0] = *(const u32x4*)(F.YB + (size_t)slk[k] * DM + cA); yw[rr][k][1] = *(const u32x4*)(F.YB + (size_t)slk[k] * DM + cB); } }
            const float* xr = F.X + (size_t)mm * DM;
            xv[rr][0] = *(const f32x4*)(xr + cA); xv[rr][1] = *(const f32x4*)(xr + cA + 4); xv[rr][2] = *(const f32x4*)(xr + cB); xv[rr][3] = *(const f32x4*)(xr + cB + 4); }
#pragma unroll
        for (int rr = 0; rr < 2; ++rr) { if (!have[rr]) continue;
            const int m = m0 + rr * NGW;
            const float* md = F.mod + ((size_t)l * 9 + br[rr]) * 6 * DM;
            f32x4 y[4];
#pragma unroll
            for (int j = 0; j < 4; ++j) y[j] = (f32x4){0.f, 0.f, 0.f, 0.f};
#pragma unroll
            for (int k = 0; k < 4; ++k) { const u32x4 a = yw[rr][k][0], b = yw[rr][k][1];
                if (MOE_FP8) { const f32x2 a0 = __builtin_amdgcn_cvt_pk_f32_fp8((int)a.x, false), a1 = __builtin_amdgcn_cvt_pk_f32_fp8((int)a.x, true), a2 = __builtin_amdgcn_cvt_pk_f32_fp8((int)a.y, false), a3 = __builtin_amdgcn_cvt_pk_f32_fp8((int)a.y, true);
                    const f32x2 b0 = __builtin_amdgcn_cvt_pk_f32_fp8((int)b.x, false), b1 = __builtin_amdgcn_cvt_pk_f32_fp8((int)b.x, true), b2 = __builtin_amdgcn_cvt_pk_f32_fp8((int)b.y, false), b3 = __builtin_amdgcn_cvt_pk_f32_fp8((int)b.y, true);
                    y[0] += (f32x4){a0.x, a0.y, a1.x, a1.y}; y[1] += (f32x4){a2.x, a2.y, a3.x, a3.y}; y[2] += (f32x4){b0.x, b0.y, b1.x, b1.y}; y[3] += (f32x4){b2.x, b2.y, b3.x, b3.y}; }
                else { y[0] += (f32x4){bflo(a.x), bfhi(a.x), bflo(a.y), bfhi(a.y)}; y[1] += (f32x4){bflo(a.z), bfhi(a.z), bflo(a.w), bfhi(a.w)};
                    y[2] += (f32x4){bflo(b.x), bfhi(b.x), bflo(b.y), bfhi(b.y)}; y[3] += (f32x4){bflo(b.z), bfhi(b.z), bflo(b.w), bfhi(b.w)}; } }
            if (MOE_FP8) {
#pragma unroll
                for (int j = 0; j < 4; ++j) y[j] *= Y8_INV; }
            const int cc[4] = {cA, cA + 4, cB, cB + 4};
            f32x4 v[4]; float ss = 0.f;
#pragma unroll
            for (int j = 0; j < 4; ++j) { v[j] = xv[rr][j] + *(const f32x4*)(md + 5 * DM + cc[j]) * y[j]; ss += (v[j].x * v[j].x + v[j].y * v[j].y) + (v[j].z * v[j].z + v[j].w * v[j].w); }
            const float rinv = 1.f / sqrtf(wave_sum(ss) * (1.f / DM) + EPS);
            if (l < DEPTH - 1) {
#pragma unroll
                for (int j = 0; j < 4; ++j) *(f32x4*)(Xo + (size_t)m * DM + cc[j]) = v[j];
                const float* mn = F.mod + ((size_t)(l + 1) * 9 + br[rr]) * 6 * DM; const float* gw1 = F.norm1_g + (size_t)(l + 1) * DM;
                f32x4 h[4];
#pragma unroll
                for (int j = 0; j < 4; ++j) h[j] = (v[j] * rinv * *(const f32x4*)(gw1 + cc[j])) * (*(const f32x4*)(mn + DM + cc[j]) + 1.f) + *(const f32x4*)(mn + cc[j]);
                u32x4 w0, w1; w0.x = pk2(h[0].x, h[0].y); w0.y = pk2(h[0].z, h[0].w); w0.z = pk2(h[1].x, h[1].y); w0.w = pk2(h[1].z, h[1].w);
                w1.x = pk2(h[2].x, h[2].y); w1.y = pk2(h[2].z, h[2].w); w1.z = pk2(h[3].x, h[3].y); w1.w = pk2(h[3].z, h[3].w);
                *(u32x4*)(Ho + (size_t)m * DM + cA) = w0; *(u32x4*)(Ho + (size_t)m * DM + cB) = w1;
            } else {
#pragma unroll
                for (int j = 0; j < 4; ++j) { f32x4 o = v[j] * rinv * *(const f32x4*)(F.final_g + cc[j]);
#if GLA_CHECK
                    if (__hip_atomic_load(F.ctl + 64, __ATOMIC_RELAXED, __HIP_MEMORY_SCOPE_AGENT) != 0u) { const float q = __builtin_nanf(""); o = (f32x4){q, q, q, q}; }
#endif
                    *(f32x4*)(Oo + (size_t)m * DM + cc[j]) = o; }
            }
        }
    }
}

constexpr int PL_U = 0, PL_P = 49152, PL_LD = 264, PREP_PW = 81920, PW_LD = 72, PREP_PS = PREP_PW + 4 * 64 * PW_LD * 2;
static_assert(PREP_PS + 1024 <= STAGE_BYTES && PL_P + 32 * PL_LD * 2 <= PREP_PW, "pool LDS map");
__device__ __forceinline__ void pool_unit(Frame& F, int l, int u) {
    LAS float* U = (LAS float*)(F.lds + PL_U);
    LAS bf16* PL = (LAS bf16*)(F.lds + PL_P);
    const LAS bf16* PW = (const LAS bf16*)(F.lds + PREP_PW); const LAS float* PS = (const LAS float*)(F.lds + PREP_PS);
    const int tid = F.tid;
    int s, tb, seqbase, tlen;
    if (u < NB * 128) { s = u / 128; tb = u % 128; seqbase = s * SEQ; tlen = SEQ; } else { const int v = u - NB * 128; s = v / 8; tb = v % 8; seqbase = TX + s * CTXL; tlen = CTXL; }
    const int t0 = tb * 32;
    for (int i = tid; i < 48 * 32; i += NTHREADS) { const int rr = i / 32, ch = i % 32, t = t0 - 8 + rr;
        f32x4 a = (f32x4){0.f, 0.f, 0.f, 0.f}, b = a;
        if (t >= 0 && t < tlen) { const u32x4 w = *(const u32x4*)(F.P + (size_t)(seqbase + t) * NP + C_POOL + ch * 8);
            a = (f32x4){bflo(w.x), bfhi(w.x), bflo(w.y), bfhi(w.y)}; b = (f32x4){bflo(w.z), bfhi(w.z), bflo(w.w), bfhi(w.w)}; }
        *(LAS f32x4*)(U + rr * 256 + ch * 8) = a; *(LAS f32x4*)(U + rr * 256 + ch * 8 + 4) = b; }
    __syncthreads();
    { const int tt = tid >> 4, cg = tid & 15, g = cg >> 2, w = 2 << g, t = t0 + tt;
      int lo = t - w / 2; if (lo < 0) lo = 0; int hi = t + w - w / 2; if (hi > tlen) hi = tlen;
      const float inv = 1.f / (float)(hi - lo);
      f32x4 sum[4];
#pragma unroll
      for (int q4 = 0; q4 < 4; ++q4) sum[q4] = (f32x4){0.f, 0.f, 0.f, 0.f};
      for (int jj = lo; jj < hi; ++jj) {
#pragma unroll
          for (int q4 = 0; q4 < 4; ++q4) sum[q4] += *(const LAS f32x4*)(U + (jj - t0 + 8) * 256 + cg * 16 + 4 * q4); }
      u32x4 w0, w1;
      { const f32x4 y0 = sum[0] * inv - *(const LAS f32x4*)(U + (tt + 8) * 256 + cg * 16), y1 = sum[1] * inv - *(const LAS f32x4*)(U + (tt + 8) * 256 + cg * 16 + 4);
        const f32x4 y2 = sum[2] * inv - *(const LAS f32x4*)(U + (tt + 8) * 256 + cg * 16 + 8), y3 = sum[3] * inv - *(const LAS f32x4*)(U + (tt + 8) * 256 + cg * 16 + 12);
        w0.x = pk2(y0.x, y0.y); w0.y = pk2(y0.z, y0.w); w0.z = pk2(y1.x, y1.y); w0.w = pk2(y1.z, y1.w);
        w1.x = pk2(y2.x, y2.y); w1.y = pk2(y2.z, y2.w); w1.z = pk2(y3.x, y3.y); w1.w = pk2(y3.z, y3.w); }
      *(LAS u32x4*)(PL + tt * PL_LD + cg * 16) = w0; *(LAS u32x4*)(PL + tt * PL_LD + cg * 16 + 8) = w1; }
    __syncthreads();
    { const int lane = F.lane, q = lane & 15, g4 = lane >> 4;
#pragma unroll
      for (int k = 0; k < 4; ++k) { const int ti = F.wave * 4 + k, mt = ti & 1, ct = ti >> 1, g = ct >> 2, ot = ct & 3;
          f32x4 acc = (f32x4){0.f, 0.f, 0.f, 0.f};
#pragma unroll
          for (int s2 = 0; s2 < 2; ++s2) { const bf16x8 a = *(const LAS bf16x8*)(PW + (g * 64 + 16 * ot + q) * PW_LD + 32 * s2 + 8 * g4), b = *(const LAS bf16x8*)(PL + (16 * mt + q) * PL_LD + g * 64 + 32 * s2 + 8 * g4);
              acc = __builtin_amdgcn_mfma_f32_16x16x32_bf16(a, b, acc, 0, 0, 0); }
          const f32x4 y = acc * *(const LAS f32x4*)(PS + g * 64 + 16 * ot + 4 * g4);
          u32x2 w; w.x = pk2(y.x, y.y); w.y = pk2(y.z, y.w);
          *(u32x2*)(F.MIX + (size_t)(seqbase + t0 + 16 * mt + q) * DM + 768 + g * 64 + 16 * ot + 4 * g4) = w; } }
    __syncthreads();
}
#if GLA_CHECK
__device__ __forceinline__ void gla_chain(Frame& F, int l, int u) {
    const int tid = F.tid;
    const int dir = u & 1, hh = (u >> 1) & 3, b = u >> 3;
    LAS float* qs = (LAS float*)F.lds;
    LAS float* ks = qs + 64 * 48;
    LAS float* as = ks + 64 * 48;
    LAS float* vs = as + 64 * 48;
    LAS float* os = vs + 64 * 96;
    LAS float* rc = os + 64 * 96;
    LAS float* rs = rc + 64 * 12;
    LAS float* wa = rs + 64 * 12;
    LAS float* ba = wa + 16 * 48;
    for (int i = tid; i < 64 * 12; i += NTHREADS) { const int pos = i / 12, fi = i % 12;
        const float invf = expf(-((float)(2 * fi) / 24.f) * 9.210340371976184f);
        const float ang = (float)pos * invf; rc[i] = cosf(ang); rs[i] = sinf(ang); }
    for (int i = tid; i < 16 * 48; i += NTHREADS) { const int r = i / 48, d = i % 48; wa[i] = F.gla_wa2[(((size_t)l * 2 + dir) * 16 + r) * 192 + hh * 48 + d]; }
    if (tid < 48) ba[tid] = F.gla_ba[((size_t)l * 2 + dir) * 192 + hh * 48 + tid];
    __syncthreads();
    float S[12];
#pragma unroll
    for (int i = 0; i < 12; ++i) S[i] = 0.f;
    const int vv = tid >> 2, dg = tid & 3;
    float* Odir = dir ? F.OB : F.OF;
    const bool need_ctx = l < DEPTH - 1;
    for (int cidx = 0; cidx < 4 + 64; ++cidx) {
        const bool isctx = cidx < 4;
        const int nch = isctx ? 4 : 64, ci0 = isctx ? cidx : cidx - 4, ci = dir ? (nch - 1 - ci0) : ci0;
        const int seqbase = isctx ? TX + b * CTXL : b * SEQ, t0 = ci * 64;
        for (int i = tid; i < 64 * 2 * 2 * 12; i += NTHREADS) {
            const int fi = i % 12, hf = (i / 12) & 1, isk = (i / 24) & 1, j = i / 48;
            const bf16* row = F.P + (size_t)(seqbase + t0 + j) * NP + (isk ? C_GK : C_GQ) + hh * 48 + hf * 24;
            const float x1 = bf2f(row[fi]), x2 = bf2f(row[12 + fi]);
            float o1 = x1, o2 = x2;
            if (!isctx) { const int t = t0 + j, pos = hf ? (t % GRIDW) : (t / GRIDW); const float cs = rc[pos * 12 + fi], sn = rs[pos * 12 + fi]; o1 = x1 * cs - x2 * sn; o2 = x1 * sn + x2 * cs; }
            LAS float* dst = (isk ? ks : qs) + j * 48 + hf * 24;
            dst[fi] = o1; dst[12 + fi] = o2; }
        for (int i = tid; i < 64 * 48; i += NTHREADS) { const int j = i / 48, d = i % 48;
            const bf16* row = F.P + (size_t)(seqbase + t0 + j) * NP + (dir ? C_AB : C_AF);
            float z = ba[d];
#pragma unroll
            for (int r = 0; r < 16; ++r) z += bf2f(row[r]) * wa[r * 48 + d];
            const float ls = fminf(z, 0.f) - log1pf(expf(-fabsf(z)));
            as[i] = expf(ls * (1.f / 16.f)); }
        for (int i = tid; i < 64 * 96; i += NTHREADS) { const int j = i / 96, d = i % 96; vs[i] = bf2f(F.VTA[(size_t)(384 + hh * 96 + d) * VTS + seqbase + t0 + j]); }
        __syncthreads();
        if (tid < 384) {
            for (int st = 0; st < 64; ++st) {
                const int j = dir ? 63 - st : st;
                const float vj = vs[j * 96 + vv];
                float part = 0.f;
#pragma unroll
                for (int q4 = 0; q4 < 3; ++q4) {
                    const f32x4 a4 = *(const LAS f32x4*)(as + j * 48 + dg * 12 + q4 * 4), k4 = *(const LAS f32x4*)(ks + j * 48 + dg * 12 + q4 * 4), qq = *(const LAS f32x4*)(qs + j * 48 + dg * 12 + q4 * 4);
#pragma unroll
                    for (int e = 0; e < 4; ++e) { const float sn = a4[e] * S[q4 * 4 + e] + k4[e] * vj; S[q4 * 4 + e] = sn; part += qq[e] * sn; } }
                part += __shfl_xor(part, 1); part += __shfl_xor(part, 2);
                if (dg == 0) os[j * 96 + vv] = part;
            }
        }
        __syncthreads();
        if (!isctx || need_ctx)
            for (int i = tid; i < 64 * 96; i += NTHREADS) { const int j = i / 96, d = i % 96; Odir[(size_t)(seqbase + t0 + j) * 384 + hh * 96 + d] = os[i]; }
        __syncthreads();
    }
}

#endif
typedef float f32x16 __attribute__((ext_vector_type(16)));
constexpr int GL_BF = 0, GL_BB = 12288, GL_WA = 24576, GL_VT = 31232, GL_KEF = 45056, GL_KEB = 51968;
constexpr int GL_QF = 45056, GL_KF = 52224, GL_QB = 59392, GL_KB = 66560, GL_STF = 73728, GL_STB = 84480, GL_O = 95232;
constexpr int VT_LD = 72, QK_LD = 56, ST_LD = 56, O_LD = 100, NCH = 68;
struct GlaU { int b, hh, cpos, seqbase, t0, isctx; };
__device__ __forceinline__ GlaU gla_unit_geom(int u) { GlaU g; g.cpos = u % NCH; g.hh = (u / NCH) & 3; g.b = u / (NCH * 4); g.isctx = g.cpos < 4;
    const int ci = g.isctx ? g.cpos : g.cpos - 4; g.seqbase = g.isctx ? TX + g.b * CTXL : g.b * SEQ; g.t0 = ci * 64; return g; }
__device__ __forceinline__ void gla_rope_pair(const Frame& F, const GlaU& g, const bf16* row, int j, int hf, int fi, float& o1, float& o2) {
    const float x1 = bf2f(row[fi]), x2 = bf2f(row[12 + fi]); o1 = x1; o2 = x2;
    if (!g.isctx) { const int t = g.t0 + j, pos = hf ? (t % GRIDW) : (t / GRIDW); const float cs = F.ROPE[pos * 12 + fi], sn = F.ROPE[768 + pos * 12 + fi]; o1 = x1 * cs - x2 * sn; o2 = x1 * sn + x2 * cs; }
}
constexpr int G1_BF = 0, G1_BB = 12288, G1_KEF = 24576, G1_KEB = 31488, G1_OPS = 38400;
constexpr int PREP_WA = TAB_OFF;
__device__ __forceinline__ void gla_g1_unit(Frame& F, int l, int u) {
    const GlaU g = gla_unit_geom(u);
    LAS bf16* kef = (LAS bf16*)(F.lds + G1_KEF); LAS bf16* keb = (LAS bf16*)(F.lds + G1_KEB); LAS bf16* ops = (LAS bf16*)(F.lds + G1_OPS);
    const LAS float* wa = (const LAS float*)(F.lds + PREP_WA) + g.hh * 1536; const LAS float* ba = (const LAS float*)(F.lds + PREP_WA) + 6144 + g.hh * 96;
    const bf16* vtg = F.VTA + (size_t)(384 + g.hh * 96) * VTS + g.seqbase + g.t0;
    const int tid = F.tid, lane = F.lane, j = lane, w = F.wave;
    const bf16* prow = F.P + (size_t)(g.seqbase + g.t0 + j) * NP;
    u32x4 araw[4];
#pragma unroll
    for (int q4 = 0; q4 < 4; ++q4) araw[q4] = *(const u32x4*)(prow + C_AF + 8 * q4);
    float q1[3], q2[3], k1[3], k2[3], cs[3], sn[3];
#pragma unroll
    for (int e = 0; e < 3; ++e) { const int p = 3 * w + e, hf = p / 12, fi = p % 12, cb = g.hh * 48 + hf * 24 + fi;
        q1[e] = bf2f(prow[C_GQ + cb]); q2[e] = bf2f(prow[C_GQ + cb + 12]); k1[e] = bf2f(prow[C_GK + cb]); k2[e] = bf2f(prow[C_GK + cb + 12]);
        const int t = g.t0 + j, pos = hf ? (t % GRIDW) : (t / GRIDW);
        cs[e] = g.isctx ? 1.f : F.ROPE[pos * 12 + fi]; sn[e] = g.isctx ? 0.f : F.ROPE[768 + pos * 12 + fi]; }
    float a[32];
#pragma unroll
    for (int q4 = 0; q4 < 4; ++q4) { const u32x4 x = araw[q4]; a[q4 * 8 + 0] = bflo(x.x); a[q4 * 8 + 1] = bfhi(x.x); a[q4 * 8 + 2] = bflo(x.y); a[q4 * 8 + 3] = bfhi(x.y);
        a[q4 * 8 + 4] = bflo(x.z); a[q4 * 8 + 5] = bfhi(x.z); a[q4 * 8 + 6] = bflo(x.w); a[q4 * 8 + 7] = bfhi(x.w); }
    float bf[3][2], bb[3][2];
#pragma unroll
    for (int e = 0; e < 3; ++e)
#pragma unroll
        for (int wh = 0; wh < 2; ++wh) { const int p = 3 * w + e, d = (p / 12) * 24 + p % 12 + 12 * wh;
            float zf = ba[d], zb = ba[48 + d];
#pragma unroll
            for (int r = 0; r < 16; ++r) { zf += a[r] * wa[r * 48 + d]; zb += a[16 + r] * wa[(16 + r) * 48 + d]; }
            float xf = (fminf(zf, 0.f) - __logf(1.f + __expf(-fabsf(zf)))) * (1.f / 16.f), xb = (fminf(zb, 0.f) - __logf(1.f + __expf(-fabsf(zb)))) * (1.f / 16.f);
#pragma unroll
            for (int o = 1; o < 64; o <<= 1) { const float yf = __shfl_up(xf, o), yb = __shfl_down(xb, o); if (lane >= o) xf += yf; if (lane + o < 64) xb += yb; }
            bf[e][wh] = xf; bb[e][wh] = xb; }
#pragma unroll
    for (int e = 0; e < 3; ++e) { const int p = 3 * w + e, d1 = (p / 12) * 24 + p % 12, d2 = d1 + 12;
        const float qa = q1[e] * cs[e] - q2[e] * sn[e], qb = q1[e] * sn[e] + q2[e] * cs[e], ka = k1[e] * cs[e] - k2[e] * sn[e], kb = k1[e] * sn[e] + k2[e] * cs[e];
        const float f1 = bf[e][0], f2 = bf[e][1], b1 = bb[e][0], b2 = bb[e][1];
        const float fe1 = __builtin_bit_cast(float, __builtin_amdgcn_readlane(__builtin_bit_cast(int, f1), 63)), fe2 = __builtin_bit_cast(float, __builtin_amdgcn_readlane(__builtin_bit_cast(int, f2), 63));
        const float be1 = __builtin_bit_cast(float, __builtin_amdgcn_readlane(__builtin_bit_cast(int, b1), 0)), be2 = __builtin_bit_cast(float, __builtin_amdgcn_readlane(__builtin_bit_cast(int, b2), 0));
        const float ef1 = __expf(f1), ef2 = __expf(f2), eb1 = __expf(b1), eb2 = __expf(b2), nf1 = __expf(-f1), nf2 = __expf(-f2), nb1 = __expf(-b1), nb2 = __expf(-b2);
        ops[j * 48 + d1] = (bf16)f2bf(qa * ef1); ops[j * 48 + d2] = (bf16)f2bf(qb * ef2); ops[3072 + j * 48 + d1] = (bf16)f2bf(ka * nf1); ops[3072 + j * 48 + d2] = (bf16)f2bf(kb * nf2);
        ops[6144 + j * 48 + d1] = (bf16)f2bf(qa * eb1); ops[6144 + j * 48 + d2] = (bf16)f2bf(qb * eb2); ops[9216 + j * 48 + d1] = (bf16)f2bf(ka * nb1); ops[9216 + j * 48 + d2] = (bf16)f2bf(kb * nb2);
        const float ge1 = __expf(fe1), ge2 = __expf(fe2), he1 = __expf(be1), he2 = __expf(be2);
        kef[d1 * VT_LD + j] = (bf16)f2bf(ka * nf1 * ge1); kef[d2 * VT_LD + j] = (bf16)f2bf(kb * nf2 * ge2);
        keb[d1 * VT_LD + j] = (bf16)f2bf(ka * nb1 * he1); keb[d2 * VT_LD + j] = (bf16)f2bf(kb * nb2 * he2);
        if (lane == 0) { float* gd = F.GD + (((size_t)(g.b * 4 + g.hh) * 2) * NCH + g.cpos) * 48; gd[d1] = ge1; gd[d2] = ge2; gd[(size_t)NCH * 48 + d1] = he1; gd[(size_t)NCH * 48 + d2] = he2; } }
    __syncthreads();
    { const int q = lane & 15, g4 = lane >> 4;
      for (int ti = F.wave; ti < 36; ti += NWAVES) { const int dir = ti / 18, dt = (ti % 18) / 6, vtile = ti % 6;
          const LAS bf16* ke = dir ? keb : kef;
          f32x4 acc = (f32x4){0.f, 0.f, 0.f, 0.f};
#pragma unroll
          for (int s2 = 0; s2 < 2; ++s2) { const bf16x8 av = *(const LAS bf16x8*)(ke + (16 * dt + q) * VT_LD + 32 * s2 + 8 * g4), bv = *(const bf16x8*)(vtg + (size_t)(16 * vtile + q) * VTS + 32 * s2 + 8 * g4);
              acc = __builtin_amdgcn_mfma_f32_16x16x32_bf16(av, bv, acc, 0, 0, 0); }
          *(f32x4*)(F.DS + ((((size_t)(g.b * 4 + g.hh) * 2 + dir) * NCH + g.cpos) * 96 + 16 * vtile + q) * 48 + 16 * dt + 4 * g4) = acc; } }
    { u32x4* dst = (u32x4*)(F.OPS + (size_t)u * 12288);
      for (int i = tid; i < 1536; i += NTHREADS) dst[i] = *(const LAS u32x4*)(ops + i * 8); }
    __syncthreads();
}
__device__ __forceinline__ void gla_g2_unit(Frame& F, int u) {
    const int chain = u >> 2, qt = u & 3, dir = chain & 1, tid = F.tid;
    const float* ds = F.DS + (size_t)chain * NCH * 4608; const float* gd = F.GD + (size_t)chain * NCH * 48; bf16* stb = F.STB + (size_t)chain * NCH * 4608;
    const int e0 = qt * 1152 + 2 * tid, e1 = qt * 1152 + 1024 + 2 * tid; const bool h1 = tid < 64;
    const int d0 = e0 % 48, d1 = h1 ? e1 % 48 : 0;
    f32x2 S0 = (f32x2){0.f, 0.f}, S1 = (f32x2){0.f, 0.f};
    for (int st0 = 0; st0 < NCH; st0 += 4) {
        f32x2 x0[4], x1[4], g0[4], g1[4]; int cp[4];
#pragma unroll
        for (int k = 0; k < 4; ++k) { const int st = st0 + k; cp[k] = st < 4 ? (dir ? 3 - st : st) : (dir ? 4 + (67 - st) : st);
            const float* p = ds + (size_t)cp[k] * 4608; const float* gp = gd + cp[k] * 48;
            x0[k] = *(const f32x2*)(p + e0); g0[k] = *(const f32x2*)(gp + d0);
            if (h1) { x1[k] = *(const f32x2*)(p + e1); g1[k] = *(const f32x2*)(gp + d1); } else { x1[k] = (f32x2){0.f, 0.f}; g1[k] = x1[k]; } }
#pragma unroll
        for (int k = 0; k < 4; ++k) { bf16* p = stb + (size_t)cp[k] * 4608;
            *(unsigned*)(p + e0) = pk2(S0.x, S0.y); if (h1) *(unsigned*)(p + e1) = pk2(S1.x, S1.y);
            S0 = g0[k] * S0 + x0[k]; S1 = g1[k] * S1 + x1[k]; }
    }
}
__device__ __forceinline__ void gla_g3_wave(Frame& F, int l, int wu) {
    const int u = wu >> 1, it = wu & 1;
    const GlaU g = gla_unit_geom(u);
    const int lane = F.lane, r = lane & 31, h = lane >> 5;
    const bf16* ops = F.OPS + (size_t)u * 12288 + 16 * 0 + 8 * h;
    const bf16* vtg = F.VTA + (size_t)(384 + g.hh * 96) * VTS + g.seqbase + g.t0;
    const bf16* stf = F.STB + ((((size_t)(g.b * 4 + g.hh) * 2 + 0) * NCH + g.cpos) * 4608) + 8 * h; const bf16* stbk = stf + (size_t)NCH * 4608;
    LAS float* O = (LAS float*)(F.lds + F.wave * 16384);
    bf16x8 qf[3], qb[3];
#pragma unroll
    for (int s3 = 0; s3 < 3; ++s3) { qf[s3] = *(const bf16x8*)(ops + (32 * it + r) * 48 + 16 * s3); qb[s3] = *(const bf16x8*)(ops + 6144 + (32 * it + r) * 48 + 16 * s3); }
    f32x16 X[2];
#pragma unroll
    for (int jt = 0; jt < 2; ++jt) {
        f32x16 xf, xb;
#pragma unroll
        for (int e = 0; e < 16; ++e) { xf[e] = 0.f; xb[e] = 0.f; }
        if (jt <= it) {
#pragma unroll
            for (int s3 = 0; s3 < 3; ++s3) xf = __builtin_amdgcn_mfma_f32_32x32x16_bf16(*(const bf16x8*)(ops + 3072 + (32 * jt + r) * 48 + 16 * s3), qf[s3], xf, 0, 0, 0); }
        if (jt >= it) {
#pragma unroll
            for (int s3 = 0; s3 < 3; ++s3) xb = __builtin_amdgcn_mfma_f32_32x32x16_bf16(*(const bf16x8*)(ops + 9216 + (32 * jt + r) * 48 + 16 * s3), qb[s3], xb, 0, 0, 0); }
        if (jt == it) {
#pragma unroll
            for (int e = 0; e < 16; ++e) { const int jl = (e & 3) + 8 * (e >> 2) + 4 * h; X[jt][e] = (jl <= r ? xf[e] : 0.f) + (jl >= r ? xb[e] : 0.f); }
        } else X[jt] = jt < it ? xf : xb;
    }
    f32x16 o[3];
#pragma unroll
    for (int vt = 0; vt < 3; ++vt)
#pragma unroll
        for (int e = 0; e < 16; ++e) o[vt][e] = 0.f;
#pragma unroll
    for (int jt = 0; jt < 2; ++jt)
#pragma unroll
        for (int s2 = 0; s2 < 2; ++s2) {
            u32x4 aw; aw.x = pk2(X[jt][8 * s2 + 0], X[jt][8 * s2 + 1]); aw.y = pk2(X[jt][8 * s2 + 2], X[jt][8 * s2 + 3]); aw.z = pk2(X[jt][8 * s2 + 4], X[jt][8 * s2 + 5]); aw.w = pk2(X[jt][8 * s2 + 6], X[jt][8 * s2 + 7]);
#pragma unroll
            for (int vt = 0; vt < 3; ++vt) {
                const bf16* vr = vtg + (size_t)(32 * vt + r) * VTS + 32 * jt + 16 * s2 + 4 * h;
                const u32x2 lo = *(const u32x2*)vr, hi = *(const u32x2*)(vr + 8);
                const u32x4 bw = (u32x4){lo.x, lo.y, hi.x, hi.y};
                o[vt] = __builtin_amdgcn_mfma_f32_32x32x16_bf16(__builtin_bit_cast(bf16x8, aw), __builtin_bit_cast(bf16x8, bw), o[vt], 0, 0, 0); } }
#pragma unroll
    for (int s3 = 0; s3 < 3; ++s3)
#pragma unroll
        for (int vt = 0; vt < 3; ++vt) {
            o[vt] = __builtin_amdgcn_mfma_f32_32x32x16_bf16(qf[s3], *(const bf16x8*)(stf + (32 * vt + r) * 48 + 16 * s3), o[vt], 0, 0, 0);
            o[vt] = __builtin_amdgcn_mfma_f32_32x32x16_bf16(qb[s3], *(const bf16x8*)(stbk + (32 * vt + r) * 48 + 16 * s3), o[vt], 0, 0, 0); }
#pragma unroll
    for (int vt = 0; vt < 3; ++vt)
#pragma unroll
        for (int e = 0; e < 16; ++e) O[((e & 3) + 8 * (e >> 2) + 4 * h) * O_LD + 32 * vt + r] = o[vt][e];
    LDS_WAIT(); asm volatile("" ::: "memory");
    { const int i = lane >> 1, half = lane & 1; const size_t row = (size_t)(g.seqbase + g.t0 + 32 * it + i);
      f32x4 ov[12]; float ss = 0.f;
#pragma unroll
      for (int e = 0; e < 12; ++e) { ov[e] = *(const LAS f32x4*)(O + i * O_LD + half * 48 + 4 * e); ss += (ov[e].x * ov[e].x + ov[e].y * ov[e].y) + (ov[e].z * ov[e].z + ov[e].w * ov[e].w); }
      ss += __shfl_xor(ss, 1);
      const float rinv = 1.f / sqrtf(ss * (1.f / 96.f) + EPS);
      const float* ng = F.gla_norm_g + (size_t)l * 384 + g.hh * 96 + half * 48;
      const u32x4* gp = (const u32x4*)(F.P + row * NP + C_GG + g.hh * 96 + half * 48);
      u32x4* dst = (u32x4*)(F.MIX + row * DM + g.hh * 96 + half * 48);
#if GLA_CHECK
      { float sn = 0.f; const float* pf = F.OF + row * 384 + g.hh * 96 + half * 48; const float* pb = F.OB + row * 384 + g.hh * 96 + half * 48;
#pragma unroll
        for (int e = 0; e < 48; ++e) { const float on = pf[e] + pb[e]; sn += on * on; }
        sn += __shfl_xor(sn, 1);
        const float rms = sqrtf(sn * (1.f / 96.f)) + 1e-6f; int bad = 0;
#pragma unroll
        for (int e = 0; e < 48; ++e) { const float on = pf[e] + pb[e]; if (!(fabsf(ov[e >> 2][e & 3] - on) <= 0.03f * rms + 0.03f * fabsf(on))) ++bad; }
        if (bad) atomicAdd(F.ctl + 64, (unsigned)bad); }
#endif
#pragma unroll
      for (int q6 = 0; q6 < 6; ++q6) { const u32x4 gw = gp[q6]; const f32x4 n0 = *(const f32x4*)(ng + 8 * q6), n1 = *(const f32x4*)(ng + 8 * q6 + 4); const f32x4 a = ov[2 * q6], b = ov[2 * q6 + 1];
          u32x4 w;
          w.x = pk2(a.x * rinv * n0.x * silu_f(bflo(gw.x)), a.y * rinv * n0.y * silu_f(bfhi(gw.x))); w.y = pk2(a.z * rinv * n0.z * silu_f(bflo(gw.y)), a.w * rinv * n0.w * silu_f(bfhi(gw.y)));
          w.z = pk2(b.x * rinv * n1.x * silu_f(bflo(gw.z)), b.y * rinv * n1.y * silu_f(bfhi(gw.z))); w.w = pk2(b.z * rinv * n1.z * silu_f(bflo(gw.w)), b.w * rinv * n1.w * silu_f(bfhi(gw.w)));
          dst[q6] = w; } }
    LDS_WAIT(); asm volatile("" ::: "memory");
}
__device__ __forceinline__ void ph_gla3(Frame& F, int l) {
    const bool need_ctx = l < DEPTH - 1;
    const int gw = F.vcu * NWAVES + F.wave, NGW = F.G * NWAVES;
    for (int wu = gw; wu < NB * GH * NCH * 2; wu += NGW) { if (!need_ctx && ((wu >> 1) % NCH) < 4) continue; gla_g3_wave(F, l, wu); }
}
__device__ __forceinline__ void ph_prep(Frame& F, int l) {
    const bool need_ctx = l < DEPTH - 1;
    const int tid = F.tid;
#if GLA_CHECK
    for (int u = F.vcu; u < NB * GH * 2; u += F.G) gla_chain(F, l, u);
    __syncthreads();
#endif
    { LAS float* wa = (LAS float*)(F.lds + PREP_WA);
      for (int i = tid; i < 4 * 2 * 16 * 48; i += NTHREADS) { const int hh = i / 1536, dir = (i / 768) & 1, r = (i / 48) % 16, d = i % 48; wa[i] = F.gla_wa2[(((size_t)l * 2 + dir) * 16 + r) * 192 + hh * 48 + d]; }
      for (int i = tid; i < 4 * 2 * 48; i += NTHREADS) { const int hh = i / 96, dir = (i / 48) & 1, d = i % 48; wa[6144 + i] = F.gla_ba[((size_t)l * 2 + dir) * 192 + hh * 48 + d]; }
      LAS bf16* pw = (LAS bf16*)(F.lds + PREP_PW); LAS float* ps = (LAS float*)(F.lds + PREP_PS);
      for (int i = tid; i < 4 * 64 * 64; i += NTHREADS) { const int g = i >> 12, ii = (i >> 6) & 63, o = i & 63; pw[(g * 64 + o) * PW_LD + ii] = (bf16)f2bf(F.pool_w[(size_t)l * 16384 + i]); }
      if (tid < 256) ps[tid] = F.pool_scale[(size_t)l * 256 + tid]; }
    __syncthreads();
    for (int u = F.vcu; u < NB * GH * NCH; u += F.G) gla_g1_unit(F, l, u);
    const int NPOOL = NB * 128 + (need_ctx ? NB * 8 : 0);
    for (int u = F.vcu; u < NPOOL; u += F.G) pool_unit(F, l, u);
}

#define NA_LOG2E 1.4426950408889634f
struct NaCtx {
    __amdgpu_buffer_rsrc_t rP, rV; unsigned voffK, voffV; int b, cw, r0, krlo, nnb; const LAS float* rpb; unsigned bidx[2][4];
    bf16x8 qa[4][2]; float mrun[4], lsum[4]; f32x4 o[4][4];
};
__device__ __forceinline__ int na_segtok(const NaCtx& C, int sg) { return sg < C.nnb ? C.b * SEQ + (C.krlo + sg) * GRIDW + C.cw : TX + C.b * CTXL + 32 * (sg - C.nnb); }
__device__ __forceinline__ void na_load(const NaCtx& C, int sg, bf16x8 (&kb)[2][2], bf16x8 (&vb)[4]) {
    const int tok = na_segtok(C, sg);
#pragma unroll
    for (int par = 0; par < 2; ++par)
#pragma unroll
        for (int s2 = 0; s2 < 2; ++s2) kb[par][s2] = __builtin_bit_cast(bf16x8, __builtin_amdgcn_raw_buffer_load_b128(C.rP, C.voffK, (unsigned)((tok + 4 * par) * (NP * 2) + 64 * s2), 0));
#pragma unroll
    for (int dt = 0; dt < 4; ++dt) vb[dt] = __builtin_bit_cast(bf16x8, __builtin_amdgcn_raw_buffer_load_b128(C.rV, C.voffV, (unsigned)((16 * dt * VTS + tok) * 2), 0));
}
template <bool LATENT>
__device__ __forceinline__ void na_segment(NaCtx& C, int sg, int lane, const bf16x8 (&kb)[2][2], const bf16x8 (&vb)[4]) {
    const int g = lane >> 4;
    const bool nb = LATENT && sg < C.nnb;
    const int kr = C.krlo + sg;
#pragma unroll
    for (int i = 0; i < 4; ++i) {
        if (nb) { const int ri = C.r0 + i, rsi = ri - 4 < 0 ? 0 : (ri - 4 > 56 ? 56 : ri - 4); if (kr < rsi || kr > rsi + 7) continue; }
        float bv[2][4];
        if (nb) { const unsigned rowoff = (unsigned)((kr - (C.r0 + i) + 7) * 32 * 4);
#pragma unroll
            for (int par = 0; par < 2; ++par)
#pragma unroll
                for (int rg = 0; rg < 4; ++rg) bv[par][rg] = *(const LAS float*)((const LAS char*)C.rpb + rowoff + C.bidx[par][rg]); }
        f32x4 st[2];
#pragma unroll
        for (int par = 0; par < 2; ++par) {
            f32x4 a = (f32x4){0.f, 0.f, 0.f, 0.f};
#pragma unroll
            for (int s2 = 0; s2 < 2; ++s2) a = __builtin_amdgcn_mfma_f32_16x16x32_bf16(kb[par][s2], C.qa[i][s2], a, 0, 0, 0);
#pragma unroll
            for (int rg = 0; rg < 4; ++rg) a[rg] = nb ? __builtin_fmaf(a[rg], NA_LOG2E, bv[par][rg]) : a[rg] * NA_LOG2E;
            st[par] = a;
        }
        float mx = fmaxf(fmaxf(fmaxf(st[0][0], st[0][1]), fmaxf(st[0][2], st[0][3])), fmaxf(fmaxf(st[1][0], st[1][1]), fmaxf(st[1][2], st[1][3])));
        mx = fmaxf(mx, __shfl_xor(mx, 16)); mx = fmaxf(mx, __shfl_xor(mx, 32));
        const float mnew = fmaxf(C.mrun[i], mx), alpha = __builtin_amdgcn_exp2f(C.mrun[i] - mnew);
        float psum = 0.f;
#pragma unroll
        for (int par = 0; par < 2; ++par)
#pragma unroll
            for (int rg = 0; rg < 4; ++rg) { const float p = __builtin_amdgcn_exp2f(st[par][rg] - mnew); st[par][rg] = p; psum += p; }
        psum += __shfl_xor(psum, 16); psum += __shfl_xor(psum, 32);
        C.lsum[i] = C.lsum[i] * alpha + psum; C.mrun[i] = mnew;
#pragma unroll
        for (int rg = 0; rg < 4; ++rg) { const float ar = __shfl(alpha, 4 * g + rg);
#pragma unroll
            for (int dt = 0; dt < 4; ++dt) C.o[i][dt][rg] *= ar; }
        u32x4 pw; pw.x = cvt_pk_bf16(st[0][0], st[0][1]); pw.y = cvt_pk_bf16(st[0][2], st[0][3]); pw.z = cvt_pk_bf16(st[1][0], st[1][1]); pw.w = cvt_pk_bf16(st[1][2], st[1][3]);
        const bf16x8 pa = __builtin_bit_cast(bf16x8, pw);
#pragma unroll
        for (int dt = 0; dt < 4; ++dt) C.o[i][dt] = __builtin_amdgcn_mfma_f32_16x16x32_bf16(pa, vb[dt], C.o[i][dt], 0, 0, 0);
    }
}
#ifndef NA_DRYMODE
#define NA_DRYMODE 0
#endif
template <bool LATENT>
__device__ __forceinline__ void na_unit(Frame& F, int l, int u, const LAS float* rpb_lds, bool dry = false) {
    const int lane = F.lane, q = lane & 15, g = lane >> 4;
    NaCtx C;
    int hh, c0 = 0, qrow0, qstep;
    if (LATENT) { const int cb = u & 3, rg4 = (u >> 2) & 15; hh = (u >> 6) % NH; C.b = u / (64 * NH); c0 = cb * 16; C.r0 = rg4 * 4; qrow0 = C.b * SEQ + C.r0 * GRIDW + c0; qstep = GRIDW;
        const int rs0 = C.r0 - 4 < 0 ? 0 : (C.r0 - 4 > 56 ? 56 : C.r0 - 4), r3 = C.r0 + 3, rs3 = r3 - 4 < 0 ? 0 : (r3 - 4 > 56 ? 56 : r3 - 4);
        C.krlo = rs0; C.nnb = rs3 + 7 - rs0 + 1; }
    else { const int qi = u & 3; hh = (u >> 2) % NH; C.b = u / (4 * NH); qrow0 = TX + C.b * CTXL + qi * 64; qstep = 16; C.r0 = 0; C.krlo = 0; C.nnb = 0; }
    C.cw = c0 == 0 ? 0 : (c0 == 48 ? 32 : c0 - 8);
    const int c = c0 + q; const int start = c - 8 < 0 ? 0 : (c - 8 > 48 ? 48 : c - 8);
    C.rpb = rpb_lds + hh * 15 * 32;
    C.rP = __builtin_amdgcn_make_buffer_rsrc((void*)F.P, 0, (int)((size_t)TT * NP * 2), 0x00020000);
    C.rV = __builtin_amdgcn_make_buffer_rsrc((void*)F.VTA, 0, (int)((size_t)VT_NC * VTS * 2), 0x00020000);
    const int koff = 8 * (q >> 2) + (q & 3);
    C.voffK = (unsigned)((koff * NP + C_NAK + hh * NDH + 8 * g) * 2);
    C.voffV = (unsigned)(((hh * NDH + q) * VTS + 8 * g) * 2);
#pragma unroll
    for (int par = 0; par < 2; ++par)
#pragma unroll
        for (int rg = 0; rg < 4; ++rg) { const int kc = C.cw + 8 * g + rg + 4 * par; const bool valid = (kc >= start) && (kc < start + 16);
            C.bidx[par][rg] = (unsigned)((valid ? kc - c + 15 : 31) * 4); }
#pragma unroll
    for (int i = 0; i < 4; ++i) {
#pragma unroll
        for (int s2 = 0; s2 < 2; ++s2) C.qa[i][s2] = *(const bf16x8*)(F.P + (size_t)(qrow0 + i * qstep + q) * NP + C_NAQ + hh * NDH + 32 * s2 + 8 * g);
        C.mrun[i] = -1e30f; C.lsum[i] = 0.f;
#pragma unroll
        for (int dt = 0; dt < 4; ++dt) C.o[i][dt] = (f32x4){0.f, 0.f, 0.f, 0.f}; }
    const int nseg = C.nnb + 8;
    bf16x8 k0[2][2], v0[4], k1[2][2], v1[4];
    na_load(C, 0, k0, v0);
#pragma unroll 1
    for (int sg = 0; sg < nseg; sg += 2) {
        if (sg + 1 < nseg) na_load(C, sg + 1, k1, v1);
        na_segment<LATENT>(C, sg, lane, k0, v0);
        if (sg + 2 < nseg) na_load(C, sg + 2, k0, v0);
        if (sg + 1 < nseg) na_segment<LATENT>(C, sg + 1, lane, k1, v1);
    }
    bf16* mixb = dry ? (bf16*)F.VTC : F.MIX;
#pragma unroll
    for (int i = 0; i < 4; ++i)
#pragma unroll
        for (int rg = 0; rg < 4; ++rg) { const float li = 1.f / __shfl(C.lsum[i], 4 * g + rg);
            bf16* orow = mixb + (size_t)(dry ? 0 : (qrow0 + i * qstep + 4 * g + rg)) * DM + 384 + hh * NDH + q;
#pragma unroll
            for (int dt = 0; dt < 4; ++dt) orow[16 * dt] = (bf16)f2bf(C.o[i][dt][rg] * li); }
}
__device__ __forceinline__ void ph_attn(Frame& F, int l) {
    const bool need_ctx = l < DEPTH - 1;
    const int gw = F.vcu * NWAVES + F.wave, NGW = F.G * NWAVES;
    LAS float* rpb = (LAS float*)(F.lds + TAB_OFF);
    for (int i = F.tid; i < NH * 15 * 32; i += NTHREADS) { const int col = i & 31, hr = i >> 5; rpb[i] = col < 31 ? F.na_rpb[((size_t)l * NH * 15 + hr) * 31 + col] * NA_LOG2E : -1e30f; }
    __syncthreads();
    for (int rep = 0; rep < REPS(11); ++rep)
    for (int u = F.vcu; u < NB * GH * 2 * 4; u += F.G) gla_g2_unit(F, u);
    const bool bg = !GLA_CHECK;
    if (bg && (F.wave & 1)) convert_items(F, l, 3 * (NE * 16 * 32));
    for (int rep = 0; rep < REPS(12); ++rep) {
    for (int u = gw; u < NB * NH * 16 * 4; u += NGW) na_unit<true>(F, l, u, rpb, rep + 1 < REPS(12));
    if (need_ctx) for (int u = gw; u < NB * NH * 4; u += NGW) na_unit<false>(F, l, u, rpb, rep + 1 < REPS(12)); }
    if (bg && !(F.wave & 1)) convert_items(F, l, 3 * (NE * 16 * 32));
}
constexpr int RW_LD = 1032;
static_assert(2 * NE * RW_LD * 2 <= STAGE_BYTES, "router LDS");
__device__ __forceinline__ unsigned f2key(float f, int e) { unsigned u = __builtin_bit_cast(unsigned, f); u = (u & 0x80000000u) ? ~u : (u | 0x80000000u); return (u & ~31u) | (unsigned)(31 - e); }
__device__ __forceinline__ float key2f(unsigned k) { unsigned u = k & ~31u; u = (u & 0x80000000u) ? (u & 0x7fffffffu) : ~u; return __builtin_bit_cast(float, u); }
__device__ __forceinline__ void ph_router(Frame& F, int l, bool dry = false) {
    const int tid = F.tid, lane = F.lane, q = lane & 15, g = lane >> 4;
    LAS bf16* WH = (LAS bf16*)F.lds; LAS bf16* WL = WH + NE * RW_LD;
    LAS int* lcount = (LAS int*)(F.lds + MISC_OFF + 64 * 4);
    volatile LAS int* lbase = (volatile LAS int*)(F.MISC + 96);
    LAS int* apos = (LAS int*)(F.lds + TAB_OFF);
    const float* rw = F.router_w + (size_t)l * DM * NE;
    for (int i = tid; i < DM * NE; i += NTHREADS) { const int c = i >> 5, e = i & 31; const float w = rw[i]; const unsigned hi = f2bf(w); const unsigned lo = f2bf(w - bf2f(hi));
        WH[e * RW_LD + c] = (bf16)hi; WL[e * RW_LD + c] = (bf16)lo; }
    if (tid < NE) lcount[tid] = 0;
    __syncthreads();
    const int M = (l == DEPTH - 1) ? TX : TT;
    const int per = (M + F.G - 1) / F.G, tok0 = F.vcu * per, tok1 = (tok0 + per < M) ? tok0 + per : M;
    const int ntile = tok1 > tok0 ? (tok1 - tok0 + 15) >> 4 : 0;
    const float* g2w = F.norm2_g + (size_t)l * DM + 8 * g;
    const float rb0 = F.router_b[(size_t)l * NE + q], rb1 = F.router_b[(size_t)l * NE + 16 + q];
    for (int tile = F.wave; tile < ntile; tile += NWAVES) {
        const int tbase = tok0 + 16 * tile, t = tbase + q, tq = t < tok1 ? t : tok1 - 1; const bool valid = t < tok1;
        const float* xr = F.X + (size_t)tq * DM + 8 * g;
        float ss = 0.f;
#pragma unroll 8
        for (int s = 0; s < 32; ++s) { const f32x4 a = *(const f32x4*)(xr + 32 * s), b = *(const f32x4*)(xr + 32 * s + 4); ss += (a.x * a.x + a.y * a.y) + (a.z * a.z + a.w * a.w) + (b.x * b.x + b.y * b.y) + (b.z * b.z + b.w * b.w); }
        ss += __shfl_xor(ss, 16); ss += __shfl_xor(ss, 32);
        const float rinv = 1.f / sqrtf(ss * (1.f / DM) + EPS);
        const int br = tq < TX ? tq / SEQ : NB;
        const float* md = F.mod + ((size_t)l * 9 + br) * 6 * DM + 8 * g;
        unsigned char* hrow = MOE_FP8 ? F.H8 + (size_t)tq * DM + 8 * g : (unsigned char*)(F.H + (size_t)tq * DM + 8 * g);
        f32x4 acc[2]; acc[0] = (f32x4){0.f, 0.f, 0.f, 0.f}; acc[1] = acc[0];
#pragma unroll 2
        for (int s = 0; s < 32; ++s) { const int c = 32 * s;
            const f32x4 xa = *(const f32x4*)(xr + c), xb = *(const f32x4*)(xr + c + 4), ga = *(const f32x4*)(g2w + c), gb = *(const f32x4*)(g2w + c + 4);
            const f32x4 ca = *(const f32x4*)(md + 4 * DM + c), cb = *(const f32x4*)(md + 4 * DM + c + 4), sa = *(const f32x4*)(md + 3 * DM + c), sb = *(const f32x4*)(md + 3 * DM + c + 4);
            const f32x4 ha = (xa * rinv * ga) * (ca + 1.f) + sa, hb = (xb * rinv * gb) * (cb + 1.f) + sb;
            u32x4 hw; hw.x = cvt_pk_bf16(ha.x, ha.y); hw.y = cvt_pk_bf16(ha.z, ha.w); hw.z = cvt_pk_bf16(hb.x, hb.y); hw.w = cvt_pk_bf16(hb.z, hb.w);
            u32x4 lw; lw.x = cvt_pk_bf16(ha.x - bflo(hw.x), ha.y - bfhi(hw.x)); lw.y = cvt_pk_bf16(ha.z - bflo(hw.y), ha.w - bfhi(hw.y));
            lw.z = cvt_pk_bf16(hb.x - bflo(hw.z), hb.y - bfhi(hw.z)); lw.w = cvt_pk_bf16(hb.z - bflo(hw.w), hb.w - bfhi(hw.w));
            if (valid) { if (MOE_FP8) { u32x2 h8; h8.x = pk4_fp8(ha.x, ha.y, ha.z, ha.w); h8.y = pk4_fp8(hb.x, hb.y, hb.z, hb.w); *(u32x2*)(hrow + c) = h8; } else *(u32x4*)(hrow + 2 * c) = hw; }
            const bf16x8 ah = __builtin_bit_cast(bf16x8, hw), al = __builtin_bit_cast(bf16x8, lw);
#pragma unroll
            for (int tt = 0; tt < 2; ++tt) { const bf16x8 bh = *(const LAS bf16x8*)(WH + (16 * tt + q) * RW_LD + c + 8 * g), bl = *(const LAS bf16x8*)(WL + (16 * tt + q) * RW_LD + c + 8 * g);
                acc[tt] = __builtin_amdgcn_mfma_f32_16x16x32_bf16(ah, bh, acc[tt], 0, 0, 0);
                acc[tt] = __builtin_amdgcn_mfma_f32_16x16x32_bf16(ah, bl, acc[tt], 0, 0, 0);
                acc[tt] = __builtin_amdgcn_mfma_f32_16x16x32_bf16(al, bh, acc[tt], 0, 0, 0); } }
        unsigned k0[4], k1[4], win[4][4];
#pragma unroll
        for (int rg = 0; rg < 4; ++rg) { k0[rg] = f2key(acc[0][rg] + rb0, q); k1[rg] = f2key(acc[1][rg] + rb1, 16 + q); }
#pragma unroll
        for (int k = 0; k < 4; ++k)
#pragma unroll
            for (int rg = 0; rg < 4; ++rg) { unsigned m = k0[rg] > k1[rg] ? k0[rg] : k1[rg];
#pragma unroll
                for (int o = 1; o < 16; o <<= 1) { const unsigned y = (unsigned)__shfl_xor((int)m, o); m = y > m ? y : m; }
                win[rg][k] = m; if (k0[rg] == m) k0[rg] = 0u; if (k1[rg] == m) k1[rg] = 0u; }
        { const int rsel = q >> 2, ksel = q & 3;
          unsigned w4[4];
#pragma unroll
          for (int k = 0; k < 4; ++k) w4[k] = rsel == 0 ? win[0][k] : rsel == 1 ? win[1][k] : rsel == 2 ? win[2][k] : win[3][k];
          const float v0 = key2f(w4[0]), e1 = __expf(key2f(w4[1]) - v0), e2 = __expf(key2f(w4[2]) - v0), e3 = __expf(key2f(w4[3]) - v0);
          const float inv = 1.f / (1.f + e1 + e2 + e3);
          const float gt = (ksel == 0 ? 1.f : ksel == 1 ? e1 : ksel == 2 ? e2 : e3) * inv;
          const unsigned wk = ksel == 0 ? w4[0] : ksel == 1 ? w4[1] : ksel == 2 ? w4[2] : w4[3];
          const int e = 31 - (int)(wk & 31u), tt2 = tbase + 4 * g + rsel;
          if (tt2 < tok1 && !dry) { F.GATE[(size_t)tt2 * 4 + ksel] = gt;
              const int pos = __hip_atomic_fetch_add(lcount + e, 1, __ATOMIC_RELAXED, __HIP_MEMORY_SCOPE_WORKGROUP);
              apos[(tt2 - tok0) * 4 + ksel] = (e << 16) | pos; } }
    }
    __syncthreads();
    if (dry) return;
    if (tid < NE) lbase[tid] = (int)__hip_atomic_fetch_add(F.ctl + CW_CNT + (l * NE + tid) * 64, (unsigned)__hip_atomic_load(lcount + tid, __ATOMIC_RELAXED, __HIP_MEMORY_SCOPE_WORKGROUP), __ATOMIC_RELAXED, __HIP_MEMORY_SCOPE_AGENT);
    __syncthreads();
    const int nas = (tok1 > tok0 ? (tok1 - tok0) : 0) * 4;
    for (int i = tid; i < nas; i += NTHREADS) { const int w = apos[i], e = w >> 16, pos = w & 0xffff; F.LIST[(size_t)e * TT + lbase[e] + pos] = tok0 * 4 + i; }
    __syncthreads();
}
__device__ __forceinline__ void moe_tables(Frame& F, int l, int npn) {
    volatile LAS int* tp = (volatile LAS int*)(F.MISC + 16);
    LAS int* tab = (LAS int*)(F.lds + TAB_OFF);
    const int tid = F.tid;
    volatile LAS int* eb = (volatile LAS int*)(F.MISC + 128);
    volatile LAS int* cntl = (volatile LAS int*)(F.MISC + 168);
    if (tid == 0) { int acc = 0, sb = 0;
        for (int e = 0; e < NE; ++e) { tp[e] = acc; eb[e] = sb; const int cnt = (int)__hip_atomic_load(F.ctl + CW_CNT + (l * NE + e) * 64, __ATOMIC_RELAXED, __HIP_MEMORY_SCOPE_AGENT); cntl[e] = cnt; acc += (cnt + 255) >> 8; sb += cnt; }
        tp[NE] = acc; }
    __syncthreads();
    if (npn != 8) return;
#pragma unroll 1
    for (int i2 = 0; i2 < MAXU; i2 += 2) {
        const int i = i2 + (tid >> 8), rr = tid & 255;
        g8::Unit u;
        if (i < MAXU && g8::moe_unit((long)i * F.G + F.vcu, npn, tp, u)) {
            const int cnt = (int)__hip_atomic_load(F.ctl + CW_CNT + (l * NE + u.e) * 64, __ATOMIC_RELAXED, __HIP_MEMORY_SCOPE_AGENT);
            const int idx = u.pm * 256 + rr;
            const int a = idx < cnt ? F.LIST[(size_t)u.e * TT + idx] : -1;
            tab[i * 256 + rr] = a;
            if (u.pn == 0 && a >= 0) { F.INV[a] = eb[u.e] + idx; F.GATES[eb[u.e] + idx] = F.GATE[a]; }
        }
    }
    __syncthreads();
}

__global__ void __launch_bounds__(NTHREADS, 2) mk_fwd(Args args) {
    extern __shared__ __attribute__((aligned(16))) unsigned char lds_raw[];
    Frame F;
    F.lds = (LAS unsigned char*)lds_raw;
    F.MISC = (volatile LAS unsigned*)(F.lds + MISC_OFF);
    F.tid = threadIdx.x; F.lane = F.tid & 63; F.wave = __builtin_amdgcn_readfirstlane(F.tid >> 6);
    F.G = gridDim.x; { const int bx = blockIdx.x; F.vcu = (F.G % 8 == 0) ? (bx % 8) * (F.G / 8) + bx / 8 : bx; }
    frame_ptrs(F);
    for (int u = F.tid; u < 256; u += NTHREADS) F.MISC[u] = 0u;
    __syncthreads();
    const int lo = args.ph_lo, hi = args.ph_hi;
    const bool one_launch = (hi - lo) > 1;
    XcdBarrier bar; bar.bar = F.ctl + CW_BAR; bar.x = 0; bar.st = nullptr;
    if (one_launch) bar = xcd_barrier_post(F.ctl + CW_BAR, F.MISC);
#ifndef PHMASK
#define PHMASK 0xFFFFFFFF
#endif
#define IN(k) (lo <= (k) && (k) < hi)
#define PHON(b) ((PHMASK >> (b)) & 1)
#define STAGGER() do { if (STAG_TICKS > 0 && (blockIdx.x & 8)) { const unsigned long long t0_ = __builtin_amdgcn_s_memrealtime(); while (__builtin_amdgcn_s_memrealtime() - t0_ < (unsigned long long)STAG_TICKS) __builtin_amdgcn_s_sleep(8); } } while (0)
#define REFRESH() do { int tz_ = threadIdx.x; asm volatile("" : "+v"(tz_)); F.tid = tz_; F.lane = tz_ & 63; frame_ptrs(F); } while (0)
#define SEAM(k) do { if (IN(k) && IN((k) + 1)) xcd_barrier(bar); } while (0)

    if (PHON(0) && IN(0)) { for (int rep = 0; rep < REPS(0); ++rep) { REFRESH(); ph_prologue(F); } } SEAM(0);
    if (PHON(1) && IN(1)) { REFRESH(); ph_first_norm(F); } SEAM(1);
    for (int l = 0; l < DEPTH; ++l) {
        const int pb = 2 + PPL * l;
        const bool lastl = (l == DEPTH - 1);
        if (PHON(2) && IN(pb + 0)) for (int rep = 0; rep < REPS(2); ++rep) {
            REFRESH(); STAGGER();
            g8::ProbIn Pb{(const char*)F.H, (const char*)(F.Bin + (size_t)l * NP * DM), F.P, F.VTA, F.G, (int)blockIdx.x, (rep + 1 < REPS(2)) ? 1 : 0};
            g8::gemm_phase(F.lds, Pb);
        }
        SEAM(pb + 0);
        if (PHON(3) && IN(pb + 1)) { for (int rep = 0; rep < REPS(3); ++rep) { REFRESH(); ph_prep(F, l); } } SEAM(pb + 1);
        if (PHON(4) && IN(pb + 2)) { for (int rep = 0; rep < REPS(4); ++rep) { REFRESH(); ph_attn(F, l); } } SEAM(pb + 2);
        if (PHON(10) && IN(pb + 3)) { for (int rep = 0; rep < REPS(10); ++rep) { REFRESH(); ph_gla3(F, l); } } SEAM(pb + 3);
        if (PHON(5) && IN(pb + 4)) for (int rep = 0; rep < REPS(5); ++rep) {
            REFRESH(); STAGGER();
            g8::ProbOut Pb{(const char*)F.MIX, (const char*)(F.Bout + (size_t)l * DM * DM), (rep + 1 < REPS(5)) ? (float*)F.ACT : F.X, F.mod + (size_t)l * 9 * 6 * DM, F.G, (int)blockIdx.x, (lastl ? TX : TT) / 256};
            g8::gemm_phase(F.lds, Pb);
        }
        SEAM(pb + 4);
        if (PHON(6) && IN(pb + 5)) { for (int rep = 0; rep < REPS(6); ++rep) { REFRESH(); ph_router(F, l, rep + 1 < REPS(6)); __syncthreads(); } } SEAM(pb + 5);
        if (PHON(7) && IN(pb + 6)) for (int rep = 0; rep < REPS(7); ++rep) {
            REFRESH(); moe_tables(F, l, 8); STAGGER();
            g8::ProbGU Pb{MOE_FP8 ? (const char*)F.H8 : (const char*)F.H, (const char*)F.Bgu + (size_t)l * NE * 2 * DM * DM * (MOE_FP8 ? 1 : 2), (unsigned char*)F.ACT, F.b_gu + (size_t)l * NE * 2 * DM, (volatile LAS int*)(F.MISC + 16), (const LAS int*)(F.lds + TAB_OFF), F.G, F.vcu, (rep + 1 < REPS(7)) ? 1 : 0, (volatile LAS int*)(F.MISC + 128)};
            g8::gemm_phase(F.lds, Pb);
        }
        SEAM(pb + 6);
        if (PHON(8) && IN(pb + 7)) for (int rep = 0; rep < REPS(8); ++rep) {
            REFRESH(); moe_tables(F, l, 4); STAGGER();
            g8::ProbDN Pb{(const char*)F.ACT, (const char*)F.Bdn + (size_t)l * NE * DM * DM * (MOE_FP8 ? 1 : 2), F.YB, F.b_down + (size_t)l * NE * DM, F.GATES, (volatile LAS int*)(F.MISC + 16), F.G, F.vcu, (rep + 1 < REPS(8)) ? 1 : 0, (volatile LAS int*)(F.MISC + 128), (volatile LAS int*)(F.MISC + 168)};
            g8::gemm_phase(F.lds, Pb);
        }
        SEAM(pb + 7);
        if (PHON(9) && IN(pb + 8)) { for (int rep = 0; rep < REPS(9); ++rep) { REFRESH(); ph_combine(F, l, rep + 1 < REPS(9)); } }
        if (!lastl) SEAM(pb + 8);
    }
#undef IN
#undef SEAM
}

extern "C" void kernel_launch(void* const* d_in, const int* in_sizes, int n_in, void* d_out, int out_size, void* d_ws, size_t ws_size, hipStream_t stream) {
    static int grid = 0;
    if (grid == 0) {
        if (n_in != 23 || in_sizes[0] != TX * DM || out_size != TX * DM || ws_size < WS_END) {
            fprintf(stderr, "kernel_launch: unexpected problem (n_in %d, in0 %d, out %d, ws %zu; need ws >= %zu); nothing launched\n", n_in, n_in > 0 ? in_sizes[0] : -1, out_size, ws_size, (size_t)WS_END); grid = -1; return; }
        int dev = 0, cus = 0, per_cu = 0;
        if (hipGetDevice(&dev) != hipSuccess || hipDeviceGetAttribute(&cus, hipDeviceAttributeMultiprocessorCount, dev) != hipSuccess) { fprintf(stderr, "kernel_launch: device query failed\n"); grid = -1; return; }
        if (hipFuncSetAttribute((const void*)mk_fwd, hipFuncAttributeMaxDynamicSharedMemorySize, LDS_BYTES) != hipSuccess) { fprintf(stderr, "kernel_launch: hipFuncSetAttribute failed\n"); grid = -1; return; }
        if (hipOccupancyMaxActiveBlocksPerMultiprocessor(&per_cu, (const void*)mk_fwd, NTHREADS, LDS_BYTES) != hipSuccess || per_cu < 1)
            fprintf(stderr, "kernel_launch: note: occupancy query reports %d workgroups per CU\n", per_cu);
        (void)hipGetLastError();
        grid = cus;
        if ((long)grid * MAXU < (long)(NASG / 256 + NE) * 8) { fprintf(stderr, "kernel_launch: grid %d too small for the MoE unit tables\n", grid); grid = -1; return; }
    }
    if (grid < 0) return;
    if (hipMemsetAsync((char*)d_ws + WS_CTL, 0, CTL_ZERO_BYTES, stream) != hipSuccess) { fprintf(stderr, "kernel_launch: memset failed\n"); return; }
    Args a{};
    for (int i = 0; i < 23; ++i) a.in[i] = (const float*)d_in[i];
    a.out = (float*)d_out; a.ws = (unsigned char*)d_ws;
#if MK_N_LAUNCHES == 1
    a.ph_lo = 0; a.ph_hi = NPHASES;
    hipLaunchKernelGGL(mk_fwd, dim3(grid), dim3(NTHREADS), LDS_BYTES, stream, a);
#else
    for (int p = 0; p < NPHASES; ++p) { a.ph_lo = p; a.ph_hi = p + 1; hipLaunchKernelGGL(mk_fwd, dim3(grid), dim3(NTHREADS), LDS_BYTES, stream, a); }
#endif
    const hipError_t le = hipPeekAtLastError();
    if (le != hipSuccess) fprintf(stderr, "kernel_launch: launch failed: %s\n", hipGetErrorName(le));
}
```

```cpp
#include <hip/hip_runtime.h>
#include <cstdio>
#include <cstdint>
#include <cstddef>

#ifndef MK_N_LAUNCHES
#define MK_N_LAUNCHES 1
#endif

#define GAS __attribute__((address_space(1)))
#define LAS __attribute__((address_space(3)))
typedef unsigned short bf16;
typedef short bf16x8 __attribute__((ext_vector_type(8)));
typedef short bf16x4 __attribute__((ext_vector_type(4)));
typedef float f32x4 __attribute__((ext_vector_type(4)));
typedef float f32x2 __attribute__((ext_vector_type(2)));
typedef unsigned u32x4 __attribute__((ext_vector_type(4)));
typedef unsigned u32x2 __attribute__((ext_vector_type(2)));

constexpr int NB = 8, SEQ = 4096, DM = 1024, CTXL = 256, DEPTH = 4, GRIDW = 64;
constexpr int TX = NB * SEQ, TC = NB * CTXL, TT = TX + TC;
constexpr int NP = 2816;
constexpr int C_NAQ = 0, C_NAK = 384, C_NAV = 768, C_GV = 1152, C_GQ = 1536, C_GK = 1728, C_GG = 1920, C_POOL = 2304, C_AF = 2560, C_AB = 2576;
constexpr int VT_C0 = 768, VT_NC = 768, VTS = TT + 128;
constexpr int NE = 32, TOPK = 4, NASG = TT * TOPK;
constexpr int SLOT_DUMMY = NASG + 256;
constexpr int GH = 4, GDK = 48, GDV = 96, NH = 6, NDH = 64;
constexpr float EPS = 1e-6f;
constexpr int NWAVES = 8, NTHREADS = 512;
constexpr int PPL = 9;
constexpr int NPHASES = 2 + PPL * DEPTH;
#ifndef MOE_FP8
#define MOE_FP8 1
#endif
#ifndef REPMASK
#define REPMASK 0
#endif
#define REPS(b) (1 + ((REPMASK >> (b)) & 1))
#ifndef GLA_CHECK
#define GLA_CHECK 0
#endif

constexpr size_t MiB = 1u << 20;
constexpr size_t WS_CTL = 0, CTL_ZERO_BYTES = 128 * 1024;
constexpr size_t WS_MOD = 2 * MiB;
constexpr size_t WS_BIN = 4 * MiB;
constexpr size_t WS_BOUT = 26 * MiB;
constexpr size_t WS_BGU = 34 * MiB;
constexpr size_t WS_BDN = 546 * MiB;
constexpr size_t WS_X = 802 * MiB;
constexpr size_t WS_H = 938 * MiB;
constexpr size_t WS_P = 1008 * MiB;
constexpr size_t WS_VTX = 1196 * MiB;
constexpr size_t WS_VTC = 1220 * MiB;
constexpr size_t WS_MIX = 1222 * MiB;
constexpr size_t WS_OF = 1290 * MiB;
constexpr size_t WS_OB = 1341 * MiB;
constexpr size_t WS_ACT = 1392 * MiB;
constexpr size_t WS_YB = 1665 * MiB;
constexpr size_t WS_LIST = 1938 * MiB;
constexpr size_t WS_GATE = 1943 * MiB;
constexpr size_t WS_DS = 1944 * MiB;
constexpr size_t WS_GD = 2025 * MiB;
constexpr size_t WS_ROPE = 2026 * MiB;
constexpr size_t WS_VTA = 2027 * MiB;
constexpr size_t WS_OPS = 2080 * MiB;
constexpr size_t WS_STB = 2132 * MiB;
constexpr size_t WS_H8 = 2172 * MiB;
constexpr size_t WS_INV = 2208 * MiB;
constexpr size_t WS_GATES = 2209 * MiB;
constexpr size_t WS_END = 2210 * MiB;
constexpr int CW_BAR = 4096;
constexpr int CW_CNT = 16384;

constexpr int STAGE_BYTES = 132096;
constexpr int MISC_OFF = STAGE_BYTES;
constexpr int TAB_OFF = MISC_OFF + 1024;
constexpr int MAXU = 28;
constexpr int LDS_BYTES = TAB_OFF + MAXU * 1024;
static_assert(LDS_BYTES <= 163840, "LDS");

#define LDS_WAIT() asm volatile("s_waitcnt lgkmcnt(0)" ::: "memory")
#define VM_WAIT() asm volatile("s_waitcnt vmcnt(0)" ::: "memory")
__device__ __forceinline__ unsigned f2bf(float f) { unsigned u = __builtin_bit_cast(unsigned, f); return (u + 0x7fffu + ((u >> 16) & 1u)) >> 16; }
__device__ __forceinline__ unsigned pk2(float lo, float hi) { return f2bf(lo) | (f2bf(hi) << 16); }
__device__ __forceinline__ float bf2f(unsigned b) { return __builtin_bit_cast(float, (b & 0xffffu) << 16); }
__device__ __forceinline__ float bflo(unsigned w) { return __builtin_bit_cast(float, w << 16); }
__device__ __forceinline__ float bfhi(unsigned w) { return __builtin_bit_cast(float, w & 0xffff0000u); }
__device__ __forceinline__ unsigned cvt_pk_bf16(float lo, float hi) { unsigned r; asm volatile("v_cvt_pk_bf16_f32 %0, %1, %2" : "=v"(r) : "v"(lo), "v"(hi)); return r; }
__device__ __forceinline__ unsigned pk4_fp8(float a, float b, float c, float d) { int p = __builtin_amdgcn_cvt_pk_fp8_f32(a, b, 0, false); p = __builtin_amdgcn_cvt_pk_fp8_f32(c, d, p, true); return (unsigned)p; }
constexpr float Y8_SCALE = 16.f, Y8_INV = 1.f / 16.f;
constexpr float W8_SCALE = 64.f, W8_INV = 1.f / 64.f;
template <int CTRL, int RM> __device__ __forceinline__ float dpp_add(float v) { const int t = __builtin_amdgcn_update_dpp(0, __float_as_int(v), CTRL, RM, 0xf, true); return v + __int_as_float(t); }
__device__ __forceinline__ float wave_scan_incl(float x) {
    x = dpp_add<0x111, 0xf>(x); x = dpp_add<0x112, 0xf>(x); x = dpp_add<0x114, 0xf>(x); x = dpp_add<0x118, 0xf>(x);
    x = dpp_add<0x142, 0xa>(x); x = dpp_add<0x143, 0xc>(x); return x;
}
template <int CTRL> __device__ __forceinline__ unsigned dpp_umax(unsigned v) { const unsigned t = (unsigned)__builtin_amdgcn_update_dpp(0, (int)v, CTRL, 0xf, 0xf, true); return t > v ? t : v; }
__device__ __forceinline__ unsigned row16_umax(unsigned v) {
    v = dpp_umax<0xB1>(v); v = dpp_umax<0x4E>(v); v = dpp_umax<0x141>(v); v = dpp_umax<0x140>(v); return v;
}
template <int CTRL> __device__ __forceinline__ float dpp_addp(float v) { const int t = __builtin_amdgcn_update_dpp(0, __float_as_int(v), CTRL, 0xf, 0xf, true); return v + __int_as_float(t); }
__device__ __forceinline__ float wave_sum(float v) {
    v = dpp_addp<0xB1>(v); v = dpp_addp<0x4E>(v); v = dpp_addp<0x141>(v); v = dpp_addp<0x140>(v);
    const auto r = __builtin_amdgcn_permlane16_swap(__float_as_uint(v), __float_as_uint(v), false, false);
    v = __uint_as_float(r[0]) + __uint_as_float(r[1]);
    const auto t = __builtin_amdgcn_permlane32_swap(__float_as_uint(v), __float_as_uint(v), false, false);
    return __uint_as_float(t[0]) + __uint_as_float(t[1]);
}
__device__ __forceinline__ float silu_f(float x) { return x / (1.f + __expf(-x)); }

#define XB_TMO      128
#define XB_XCNT(j)  (256  + 64 * (j))
#define XB_XSUB(j)  (1280 + 64 * (j))
#define XB_XGEN(j)  (2304 + 64 * (j))
#define XB_TOP      3328
#define XB_TOPGEN   3392
#define XCD_BAR_WORDS 3456
#define XB_SPIN_CAP (1u << 18)
__device__ __forceinline__ unsigned xb_ld(unsigned* p)              { return __hip_atomic_load(p, __ATOMIC_RELAXED, __HIP_MEMORY_SCOPE_AGENT); }
__device__ __forceinline__ unsigned xb_add(unsigned* p, unsigned v) { return __hip_atomic_fetch_add(p, v, __ATOMIC_RELAXED, __HIP_MEMORY_SCOPE_AGENT); }
__device__ __forceinline__ unsigned xb_xcc_id() { return (unsigned)__builtin_amdgcn_s_getreg((3 << 11) | 20) & 0xFu; }
#define XB_SPIN(cond, bar) do { unsigned _sp = 0; while (cond) { __builtin_amdgcn_s_sleep(1); \
    if ((++_sp & 255u) == 0u) { if (xb_ld(&(bar)[XB_TMO])) break; if (_sp > XB_SPIN_CAP) { atomicAdd(&(bar)[XB_TMO], 1u); break; } } } } while (0)
struct XcdBarrier { unsigned* bar; unsigned x; volatile LAS unsigned* st; };
__device__ __forceinline__ XcdBarrier xcd_barrier_post(unsigned* bar, volatile LAS unsigned* st) {
    XcdBarrier b; b.bar = bar; b.x = xb_xcc_id(); b.st = st;
    if (threadIdx.x == 0) (void)xb_add(&bar[XB_XCNT(b.x)], 1u);
    return b;
}
__device__ __forceinline__ void xcd_barrier_complete(unsigned* bar, unsigned x, unsigned& nloc, unsigned& nx) {
    const unsigned G = gridDim.x * gridDim.y * gridDim.z;
    unsigned sum, cnt, mine, sp = 0u;
    for (;;) {
        sum = 0u; cnt = 0u; mine = 0u;
#pragma unroll
        for (unsigned j = 0; j < 16; ++j) { const unsigned c = xb_ld(&bar[XB_XCNT(j)]); sum += c; cnt += (c > 0u) ? 1u : 0u; mine = (j == x) ? c : mine; }
        if (sum == G) break;
        __builtin_amdgcn_s_sleep(1);
        if ((++sp & 255u) == 0u) { if (xb_ld(&bar[XB_TMO])) break; if (sp > XB_SPIN_CAP) { atomicAdd(&bar[XB_TMO], 1u); break; } }
    }
    nloc = mine > 0u ? mine : 1u; nx = cnt > 0u ? cnt : 1u;
}
__device__ __forceinline__ void xcd_barrier(const XcdBarrier& b) {
    asm volatile("s_waitcnt vmcnt(0)" ::: "memory");
    __syncthreads();
    if (threadIdx.x == 0) {
        unsigned* bar = b.bar;
        __builtin_amdgcn_s_waitcnt(0);
        unsigned nloc = b.st[0], nx = b.st[1];
        if (nloc == 0u) { xcd_barrier_complete(bar, b.x, nloc, nx); b.st[0] = nloc; b.st[1] = nx; }
        const unsigned old = xb_add(&bar[XB_XSUB(b.x)], 1u);
        const unsigned gen = old / nloc;
        if (old + 1u == (gen + 1u) * nloc) {
            __builtin_amdgcn_fence(__ATOMIC_RELEASE, "agent");
            asm volatile("s_waitcnt vmcnt(0)" ::: "memory");
            const unsigned og = xb_add(&bar[XB_TOP], 1u);
            const unsigned tg = og / nx;
            if (og + 1u == (tg + 1u) * nx) xb_add(&bar[XB_TOPGEN], 1u);
            else XB_SPIN(xb_ld(&bar[XB_TOPGEN]) == tg, bar);
            __builtin_amdgcn_fence(__ATOMIC_ACQUIRE, "agent");
            xb_add(&bar[XB_XGEN(b.x)], 1u);
            asm volatile("s_waitcnt vmcnt(0)" ::: "memory");
        } else {
            XB_SPIN(xb_ld(&bar[XB_XGEN(b.x)]) == gen, bar);
            __builtin_amdgcn_fence(__ATOMIC_ACQUIRE, "agent");
            asm volatile("s_waitcnt vmcnt(0)" ::: "memory");
        }
    }
    __syncthreads();
}

namespace g8 {
constexpr int BM = 256, BK = 64, HALF = 128, HTB = HALF * BK * 2, NXCD = 8, WGM = 8, KD = 1024;
__device__ __forceinline__ int lds_byte(int r, int c) { const int st = (r >> 4) * 2 + (c >> 5), rr = r & 15, cc = c & 31, ob = rr * 64 + cc * 2; return st * 1024 + (ob ^ (((ob >> 9) & 1) << 5)); }
__device__ __forceinline__ void stage_rc(int b, int& R, int& C) { const int st = b / 1024, sb = b % 1024, swz = sb ^ (((sb >> 9) & 1) << 5); R = (st >> 1) * 16 + swz / 64; C = (st & 1) * 32 + (swz % 64) / 2; }
__device__ __forceinline__ int perm32(int rho) { const int n = rho >> 4, i = rho & 15; return 8 * (i >> 2) + 4 * n + (i & 3); }
struct Unit { int pm, pn, e; };
typedef int i32x8 __attribute__((ext_vector_type(8)));
typedef int i32x4 __attribute__((ext_vector_type(4)));
__device__ __forceinline__ i32x8 cat8(bf16x8 a, bf16x8 b) { const i32x4 x = __builtin_bit_cast(i32x4, a), y = __builtin_bit_cast(i32x4, b); return (i32x8){x.x, x.y, x.z, x.w, y.x, y.y, y.z, y.w}; }
__device__ __forceinline__ bool static_unit(long L, int nM, int nN, Unit& u) {
    const int nwg = nM * nN; if (L >= nwg) return false;
    int wgid = (int)L; { const int q = nwg / NXCD, r = nwg % NXCD, xcd = wgid % NXCD, off = wgid / NXCD; wgid = (xcd < r ? xcd * (q + 1) : r * (q + 1) + (xcd - r) * q) + off; }
    const int nig = WGM * nN, gid = wgid / nig, fm = gid * WGM, gsz = (nM - fm) < WGM ? (nM - fm) : WGM;
    u.pm = fm + ((wgid % nig) % gsz); u.pn = (wgid % nig) / gsz; u.e = 0; return true;
}

#ifndef PROBE_DRY
#define PROBE_DRY 0
#endif
#ifndef STAG_TICKS
#define STAG_TICKS 0
#endif
template <class Prob>
__device__ __forceinline__ void gemm_phase(LAS unsigned char* lds, const Prob& P) {

    int tid_ = threadIdx.x; asm volatile("" : "+v"(tid_));
    const int tid = tid_, wid = __builtin_amdgcn_readfirstlane(tid >> 6), lane = tid & 63, wr = wid >> 2, wc = wid & 3, fr = lane & 15, fq = lane >> 4;
    constexpr int RPB = Prob::FP8 ? KD : KD * 2, nt = RPB / (BK * 2);
    unsigned voffB[2];
    { int R0, C0, R1, C1; stage_rc(tid * 16, R0, C0); stage_rc(tid * 16 + 8192, R1, C1); const int Rb0 = Prob::PERM ? ((R0 & ~31) + perm32(R0 & 31)) : R0, Rb1 = Prob::PERM ? ((R1 & ~31) + perm32(R1 & 31)) : R1;
      voffB[0] = (unsigned)(Rb0 * RPB + C0 * 2); voffB[1] = (unsigned)(Rb1 * RPB + C1 * 2); }
    const size_t kstep = (size_t)(BK * 2), hstepB = (size_t)HALF * RPB;
    const unsigned ldsw = (unsigned)wid * 1024u;
    const int aoff = lds_byte(wr * 64 + fr, fq * 8), boff = lds_byte(wc * 32 + fr, fq * 8);
#define G8_SA(b, h) (((b) * 2 + (h)) * HTB)
#define G8_SB(b, h) ((4 + (b) * 2 + (h)) * HTB)
#define G8_STAGE(bufoff, gbase, voff) do { _Pragma("unroll") for (int _i = 0; _i < 2; ++_i) \
        __builtin_amdgcn_global_load_lds((const unsigned*)((const char*)(gbase) + (voff)[_i]), (LAS unsigned*)(lds + (bufoff) + ldsw + _i * 8192), 16, 0, 0); } while (0)
#define G8_LDA(dst, b, h) do { _Pragma("unroll") for (int m = 0; m < 4; ++m) _Pragma("unroll") for (int k = 0; k < 2; ++k) dst[m][k] = *(const LAS bf16x8*)(lds + G8_SA(b, h) + aoff + m * 2048 + k * 1024); } while (0)
#define G8_LDB(dst, b, h) do { _Pragma("unroll") for (int n = 0; n < 2; ++n) _Pragma("unroll") for (int k = 0; k < 2; ++k) dst[n][k] = *(const LAS bf16x8*)(lds + G8_SB(b, h) + boff + n * 2048 + k * 1024); } while (0)
#define G8_MMA(ai, bj, At, Bt) do { __builtin_amdgcn_s_setprio(1); if constexpr (Prob::FP8) { \
        _Pragma("unroll") for (int m = 0; m < 4; ++m) _Pragma("unroll") for (int n = 0; n < 2; ++n) \
        acc[ai][bj][m][n] = __builtin_amdgcn_mfma_scale_f32_16x16x128_f8f6f4(cat8(Bt[n][0], Bt[n][1]), cat8(At[m][0], At[m][1]), acc[ai][bj][m][n], 0, 0, 0, 0x7f7f7f7f, 0, 0x7f7f7f7f); } else { \
        _Pragma("unroll") for (int m = 0; m < 4; ++m) _Pragma("unroll") for (int n = 0; n < 2; ++n) _Pragma("unroll") for (int k = 0; k < 2; ++k) \
        acc[ai][bj][m][n] = __builtin_amdgcn_mfma_f32_16x16x32_bf16(Bt[n][k], At[m][k], acc[ai][bj][m][n], 0, 0, 0); } __builtin_amdgcn_s_setprio(0); } while (0)
#define G8_WAIT_V(n) asm volatile("s_waitcnt vmcnt(" #n ")" ::: "memory")
#define G8_WAIT_L(n) asm volatile("s_waitcnt lgkmcnt(" #n ")" ::: "memory")
#define G8_BAR __builtin_amdgcn_s_barrier()
#define G8_SCHED __builtin_amdgcn_sched_barrier(0)
    Unit cur, nxt; int ui = 0;
    if (!P.next(0, cur)) return;
    f32x4 acc[2][2][4][2];
#pragma unroll
    for (int a = 0; a < 2; ++a)
#pragma unroll
        for (int b = 0; b < 2; ++b)
#pragma unroll
            for (int m = 0; m < 4; ++m)
#pragma unroll
                for (int n = 0; n < 2; ++n) acc[a][b][m][n] = (f32x4){0.f, 0.f, 0.f, 0.f};
    bf16x8 At[4][2], B0[2][2], B1[2][2];
    unsigned cvA[2][2];
    P.a_off(cur, 0, tid, cvA);
    const char* cA = P.a_base(cur);
    const char* cB = P.b_ptr(cur);
    G8_STAGE(G8_SB(0, 0), cB, voffB); G8_STAGE(G8_SB(0, 1), cB + hstepB, voffB); G8_STAGE(G8_SA(0, 0), cA, cvA[0]); G8_STAGE(G8_SA(0, 1), cA, cvA[1]);
    if (wr == 1) G8_BAR;
    G8_WAIT_V(2); G8_BAR;
    G8_STAGE(G8_SB(1, 0), cB + kstep, voffB); G8_STAGE(G8_SA(1, 0), cA + kstep, cvA[0]); G8_STAGE(G8_SB(1, 1), cB + hstepB + kstep, voffB);
    G8_WAIT_V(6); G8_BAR;
    for (;;) {
        const bool has_next = P.next(ui + 1, nxt);
        const char* nB = has_next ? P.b_ptr(nxt) : cB;
        const char* nA = has_next ? P.a_base(nxt) : cA;
        for (int t = 0; t < nt; t += 2) {
            const bool last = (t == nt - 2);
            const char* a1 = cA + (size_t)(t + 1) * kstep;
            const char* a2 = last ? nA : cA + (size_t)(t + 2) * kstep; const char* b2 = last ? nB : cB + (size_t)(t + 2) * kstep;
            const char* a3 = a2 + kstep; const char* b3 = b2 + kstep;
            G8_LDB(B0, 0, 0); G8_LDB(B1, 0, 1); G8_SCHED; G8_LDA(At, 0, 0); G8_STAGE(G8_SA(1, 1), a1, cvA[1]);
            G8_WAIT_V(8); G8_WAIT_L(0); G8_BAR; G8_MMA(0, 0, At, B0); G8_MMA(0, 1, At, B1); G8_BAR; G8_SCHED;
            if (last && has_next) { int tz = threadIdx.x; asm volatile("" : "+v"(tz)); P.a_off(nxt, ui + 1, tz, cvA); }
            G8_LDA(At, 0, 1); G8_STAGE(G8_SB(0, 0), b2, voffB); G8_STAGE(G8_SB(0, 1), b2 + hstepB, voffB); G8_STAGE(G8_SA(0, 0), a2, cvA[0]);
            G8_WAIT_V(8); G8_WAIT_L(0); G8_BAR; G8_MMA(1, 0, At, B0); G8_MMA(1, 1, At, B1); G8_BAR; G8_SCHED;
            G8_LDB(B0, 1, 0); G8_LDB(B1, 1, 1); G8_SCHED; G8_LDA(At, 1, 0); G8_STAGE(G8_SA(0, 1), a2, cvA[1]);
            G8_WAIT_V(8); G8_WAIT_L(0); G8_BAR; G8_MMA(0, 0, At, B0); G8_MMA(0, 1, At, B1); G8_BAR; G8_SCHED;
            G8_LDA(At, 1, 1); G8_STAGE(G8_SB(1, 0), b3, voffB); G8_STAGE(G8_SB(1, 1), b3 + hstepB, voffB); G8_STAGE(G8_SA(1, 0), a3, cvA[0]);
            G8_WAIT_V(8); G8_WAIT_L(0); G8_BAR; G8_MMA(1, 0, At, B0); G8_MMA(1, 1, At, B1); G8_BAR; G8_SCHED;
        }
        if (wr == 0) G8_BAR;
        P.epi(acc, cur, ui, wr, wc, fr, fq);
        if (!has_next) break;
#pragma unroll
        for (int a = 0; a < 2; ++a)
#pragma unroll
            for (int b = 0; b < 2; ++b)
#pragma unroll
                for (int m = 0; m < 4; ++m)
#pragma unroll
                    for (int n = 0; n < 2; ++n) acc[a][b][m][n] = (f32x4){0.f, 0.f, 0.f, 0.f};
        cur = nxt; cB = nB; cA = nA; ++ui;
        if (wr == 1) G8_BAR;
    }
    G8_WAIT_V(0);
    G8_BAR;
#undef G8_SA
#undef G8_SB
#undef G8_STAGE
#undef G8_LDA
#undef G8_LDB
#undef G8_MMA
#undef G8_WAIT_V
#undef G8_WAIT_L
#undef G8_BAR
#undef G8_SCHED
}


struct ProbIn {
    static constexpr bool PERM = true, FP8 = false;
    const char* A; const char* Bt; bf16* O; bf16* VT; int G, c; int dry;
    __device__ __forceinline__ static bool swapped(const Unit& u) { return u.pn >= 3 && u.pn <= 5; }
    __device__ __forceinline__ bool next(int i, Unit& u) const { return static_unit((long)i * G + c, TT / 256, NP / 256, u); }
    __device__ __forceinline__ void a_off(const Unit& u, int, int tid, unsigned (&v)[2][2]) const {
        int R0, C0, R1, C1; stage_rc(tid * 16, R0, C0); stage_rc(tid * 16 + 8192, R1, C1);
        const int rt = swapped(u) ? u.pn : u.pm;
#pragma unroll
        for (int h = 0; h < 2; ++h) { v[h][0] = (unsigned)((rt * 256 + h * 128 + R0) * KD + C0) * 2u; v[h][1] = (unsigned)((rt * 256 + h * 128 + R1) * KD + C1) * 2u; }
    }
    __device__ __forceinline__ const char* a_base(const Unit& u) const { return swapped(u) ? Bt : A; }
    __device__ __forceinline__ const char* b_ptr(const Unit& u) const { return swapped(u) ? A + (size_t)u.pm * 256 * KD * 2 : Bt + (size_t)u.pn * 256 * KD * 2; }
    __device__ __forceinline__ void epi(const f32x4 (&acc)[2][2][4][2], const Unit& u, int, int wr, int wc, int fr, int fq) const {
        if (PROBE_DRY && dry) { asm volatile("" :: "v"(acc[0][0][0][0][0]), "v"(acc[1][1][3][1][3]), "v"(acc[0][1][2][0][1]), "v"(acc[1][0][1][1][2])); return; }
        const bool sw = swapped(u);
        bf16* base = sw ? VT + (size_t)(u.pn * 256 - VT_C0 + wr * 64 + fr) * VTS + u.pm * 256 + wc * 32 + 8 * fq
                        : O + (size_t)(u.pm * 256 + wr * 64 + fr) * NP + u.pn * 256 + wc * 32 + 8 * fq;
        const size_t ld = sw ? (size_t)VTS : (size_t)NP;
#pragma unroll
        for (int ai = 0; ai < 2; ++ai)
#pragma unroll
            for (int m = 0; m < 4; ++m) { bf16* rowp = base + (size_t)(ai * 128 + m * 16) * ld;
#pragma unroll
                for (int bj = 0; bj < 2; ++bj) { const f32x4 v0 = acc[ai][bj][m][0], v1 = acc[ai][bj][m][1];
                    u32x4 w; w.x = cvt_pk_bf16(v0[0], v0[1]); w.y = cvt_pk_bf16(v0[2], v0[3]); w.z = cvt_pk_bf16(v1[0], v1[1]); w.w = cvt_pk_bf16(v1[2], v1[3]);
                    *(u32x4*)(rowp + bj * 128) = w; } }
    }
};
struct ProbOut {
    static constexpr bool PERM = false, FP8 = false;
    const char* A; const char* Bt; float* X; const float* modl  ; int G, c, nM;
    __device__ __forceinline__ bool next(int i, Unit& u) const { return static_unit((long)i * G + c, nM, DM / 256, u); }
    __device__ __forceinline__ void a_off(const Unit& u, int, int tid, unsigned (&v)[2][2]) const {
        int R0, C0, R1, C1; stage_rc(tid * 16, R0, C0); stage_rc(tid * 16 + 8192, R1, C1);
#pragma unroll
        for (int h = 0; h < 2; ++h) { v[h][0] = (unsigned)((u.pm * 256 + h * 128 + R0) * KD + C0) * 2u; v[h][1] = (unsigned)((u.pm * 256 + h * 128 + R1) * KD + C1) * 2u; }
    }
    __device__ __forceinline__ const char* a_base(const Unit&) const { return A; }
    __device__ __forceinline__ const char* b_ptr(const Unit& u) const { return Bt + (size_t)u.pn * 256 * KD * 2; }
    __device__ __forceinline__ void epi(const f32x4 (&acc)[2][2][4][2], const Unit& u, int, int wr, int wc, int fr, int fq) const {
        const int r0 = u.pm * 256, br = r0 < TX ? (r0 / SEQ) : NB;
        const float* g1 = modl + (size_t)br * 6 * DM + 2 * DM;
        const int row0 = r0 + wr * 64 + fr, col0 = u.pn * 256 + wc * 32 + 4 * fq;
        f32x4 gv[2][2];
#pragma unroll
        for (int bj = 0; bj < 2; ++bj)
#pragma unroll
            for (int n = 0; n < 2; ++n) gv[bj][n] = *(const f32x4*)(g1 + col0 + bj * 128 + n * 16);
#pragma unroll
        for (int ai = 0; ai < 2; ++ai) {
            f32x4 xv[4][2][2];
#pragma unroll
            for (int m = 0; m < 4; ++m)
#pragma unroll
                for (int bj = 0; bj < 2; ++bj)
#pragma unroll
                    for (int n = 0; n < 2; ++n) xv[m][bj][n] = *(const f32x4*)(X + (size_t)(row0 + ai * 128 + m * 16) * DM + col0 + bj * 128 + n * 16);
#pragma unroll
            for (int m = 0; m < 4; ++m)
#pragma unroll
                for (int bj = 0; bj < 2; ++bj)
#pragma unroll
                    for (int n = 0; n < 2; ++n) *(f32x4*)(X + (size_t)(row0 + ai * 128 + m * 16) * DM + col0 + bj * 128 + n * 16) = xv[m][bj][n] + gv[bj][n] * acc[ai][bj][m][n];
        }
    }
};
__device__ __forceinline__ bool moe_unit(long L, int npn, const volatile LAS int* tp, Unit& u) {
    const int q = (int)(L / npn); if (q >= tp[NE]) return false;
    int e = 0;
#pragma unroll 1
    while (tp[e + 1] <= q) ++e;
    u.e = e; u.pm = q - tp[e]; u.pn = (int)(L % npn); return true;
}
struct ProbGU {
    static constexpr bool PERM = true, FP8 = (MOE_FP8 != 0); static constexpr unsigned EB = FP8 ? 1u : 2u;
    const char* A; const char* Bt  ; unsigned char* ACT; const float* bgu  ; const volatile LAS int* tp; const LAS int* tab; int G, c; int dry; const volatile LAS int* eb;
    __device__ __forceinline__ bool next(int i, Unit& u) const { return i < MAXU && moe_unit((long)i * G + c, 8, tp, u); }
    __device__ __forceinline__ void a_off(const Unit&, int ui, int tid, unsigned (&v)[2][2]) const {
        int R0, C0, R1, C1; stage_rc(tid * 16, R0, C0); stage_rc(tid * 16 + 8192, R1, C1);
#pragma unroll
        for (int h = 0; h < 2; ++h) { const int a0 = tab[ui * 256 + h * 128 + R0], a1 = tab[ui * 256 + h * 128 + R1];
            v[h][0] = (unsigned)(a0 < 0 ? TT : (a0 >> 2)) * (unsigned)KD * EB + (unsigned)C0 * 2u; v[h][1] = (unsigned)(a1 < 0 ? TT : (a1 >> 2)) * (unsigned)KD * EB + (unsigned)C1 * 2u; }
    }
    __device__ __forceinline__ const char* a_base(const Unit&) const { return A; }
    __device__ __forceinline__ const char* b_ptr(const Unit& u) const { return Bt + ((size_t)u.e * 2 * DM + (size_t)u.pn * 256) * KD * EB; }
    __device__ __forceinline__ void epi(const f32x4 (&acc)[2][2][4][2], const Unit& u, int ui, int wr, int wc, int fr, int fq) const {
        if (PROBE_DRY && dry) { asm volatile("" :: "v"(acc[0][0][0][0][0]), "v"(acc[1][1][3][1][3]), "v"(acc[0][1][2][0][1]), "v"(acc[1][0][1][1][2])); return; }
        const int cb = u.pn * 128 + wc * 32 + 8 * fq;
        const float* bg = bgu + (size_t)u.e * 2 * DM + cb; const float* bu = bg + DM;
        const f32x4 bg0 = *(const f32x4*)bg, bg1 = *(const f32x4*)(bg + 4), bu0 = *(const f32x4*)bu, bu1 = *(const f32x4*)(bu + 4);
        const int ebu = eb[u.e] + u.pm * 256;
#pragma unroll
        for (int ai = 0; ai < 2; ++ai)
#pragma unroll
            for (int m = 0; m < 4; ++m) {
                const int a = tab[ui * 256 + ai * 128 + wr * 64 + m * 16 + fr];
                unsigned char* rowp = ACT + ((size_t)(a < 0 ? SLOT_DUMMY : ebu + ai * 128 + wr * 64 + m * 16 + fr) * DM + cb) * EB;
                float o[8];
#pragma unroll
                for (int n = 0; n < 2; ++n) { const f32x4 gb = n ? bg1 : bg0, ub = n ? bu1 : bu0;
#pragma unroll
                    for (int j = 0; j < 4; ++j) { float g = acc[ai][0][m][n][j] * (FP8 ? W8_INV : 1.f) + gb[j], uu = acc[ai][1][m][n][j] * (FP8 ? W8_INV : 1.f) + ub[j];
                        g = fminf(g, 7.f); uu = fminf(fmaxf(uu, -7.f), 7.f);
                        o[n * 4 + j] = g * __builtin_amdgcn_rcpf(1.f + __expf(-1.702f * g)) * (uu + 1.f); } }
                if constexpr (FP8) { u32x2 w; w.x = pk4_fp8(o[0], o[1], o[2], o[3]); w.y = pk4_fp8(o[4], o[5], o[6], o[7]); *(u32x2*)rowp = w; }
                else { u32x4 w; w.x = cvt_pk_bf16(o[0], o[1]); w.y = cvt_pk_bf16(o[2], o[3]); w.z = cvt_pk_bf16(o[4], o[5]); w.w = cvt_pk_bf16(o[6], o[7]); *(u32x4*)rowp = w; } }
    }
};
struct ProbDN {
    static constexpr bool PERM = true, FP8 = (MOE_FP8 != 0); static constexpr unsigned EB = FP8 ? 1u : 2u;
    const char* A; const char* Bt  ; bf16* YB; const float* bdn  ; const float* gates  ; const volatile LAS int* tp; int G, c; int dry; const volatile LAS int* eb; const volatile LAS int* cntl;
    __device__ __forceinline__ bool next(int i, Unit& u) const { return i < MAXU && moe_unit((long)i * G + c, 4, tp, u); }
    __device__ __forceinline__ void a_off(const Unit& u, int, int tid, unsigned (&v)[2][2]) const {
        int R0, C0, R1, C1; stage_rc(tid * 16, R0, C0); stage_rc(tid * 16 + 8192, R1, C1);
        const int r0 = eb[u.e] + u.pm * 256;
#pragma unroll
        for (int h = 0; h < 2; ++h) { v[h][0] = (unsigned)(r0 + h * 128 + R0) * (unsigned)KD * EB + (unsigned)C0 * 2u; v[h][1] = (unsigned)(r0 + h * 128 + R1) * (unsigned)KD * EB + (unsigned)C1 * 2u; }
    }
    __device__ __forceinline__ const char* a_base(const Unit&) const { return A; }
    __device__ __forceinline__ const char* b_ptr(const Unit& u) const { return Bt + ((size_t)u.e * DM + (size_t)u.pn * 256) * KD * EB; }
    __device__ __forceinline__ void epi(const f32x4 (&acc)[2][2][4][2], const Unit& u, int ui, int wr, int wc, int fr, int fq) const {
        if (PROBE_DRY && dry) { asm volatile("" :: "v"(acc[0][0][0][0][0]), "v"(acc[1][1][3][1][3]), "v"(acc[0][1][2][0][1]), "v"(acc[1][0][1][1][2])); return; }
        const int col0 = u.pn * 256 + wc * 32 + 8 * fq;
        const float* bd = bdn + (size_t)u.e * DM + col0;
        f32x4 bv[2][2];
#pragma unroll
        for (int bj = 0; bj < 2; ++bj)
#pragma unroll
            for (int n = 0; n < 2; ++n) bv[bj][n] = *(const f32x4*)(bd + bj * 128 + 4 * n);
        int sl[2][4]; float gt[2][4]; const int ebu = eb[u.e] + u.pm * 256, nval = cntl[u.e] - u.pm * 256;
#pragma unroll
        for (int ai = 0; ai < 2; ++ai)
#pragma unroll
            for (int m = 0; m < 4; ++m) { const int rl = ai * 128 + wr * 64 + m * 16 + fr; sl[ai][m] = rl < nval ? ebu + rl : SLOT_DUMMY; gt[ai][m] = gates[sl[ai][m]]; }
#pragma unroll
        for (int ai = 0; ai < 2; ++ai)
#pragma unroll
            for (int m = 0; m < 4; ++m) {
                if constexpr (FP8) {
                    unsigned char* rowp = (unsigned char*)YB + (size_t)sl[ai][m] * DM + col0;
#pragma unroll
                    for (int bj = 0; bj < 2; ++bj) { const f32x4 v0 = (acc[ai][bj][m][0] * W8_INV + bv[bj][0]) * (gt[ai][m] * Y8_SCALE), v1 = (acc[ai][bj][m][1] * W8_INV + bv[bj][1]) * (gt[ai][m] * Y8_SCALE);
                        u32x2 w; w.x = pk4_fp8(v0[0], v0[1], v0[2], v0[3]); w.y = pk4_fp8(v1[0], v1[1], v1[2], v1[3]); *(u32x2*)(rowp + bj * 128) = w; }
                } else {
                    bf16* rowp = YB + (size_t)sl[ai][m] * DM + col0;
#pragma unroll
                    for (int bj = 0; bj < 2; ++bj) { const f32x4 v0 = (acc[ai][bj][m][0] + bv[bj][0]) * gt[ai][m], v1 = (acc[ai][bj][m][1] + bv[bj][1]) * gt[ai][m];
                        u32x4 w; w.x = cvt_pk_bf16(v0[0], v0[1]); w.y = cvt_pk_bf16(v0[2], v0[3]); w.z = cvt_pk_bf16(v1[0], v1[1]); w.w = cvt_pk_bf16(v1[2], v1[3]);
                        *(u32x4*)(rowp + bj * 128) = w; }
                } }
    }
};
}

struct Args { const float* in[23]; float* out; unsigned char* ws; int ph_lo, ph_hi; };
struct Frame {
    LAS unsigned char* lds; volatile LAS unsigned* MISC;
    int tid, lane, wave, G, vcu;
    const float *x, *c, *ctx, *c_ctx, *norm1_g, *norm2_g, *w_ada, *b_ada, *w_in, *gla_wa2, *gla_ba, *gla_norm_g, *na_rpb, *pool_w, *pool_scale, *w_out, *router_w, *router_b, *w_gu, *b_gu, *w_down, *b_down, *final_g;
    float* out; unsigned char* ws; unsigned* ctl;
    float* mod; bf16 *Bin, *Bout, *Bgu, *Bdn; float* X; bf16 *H, *P, *VTX, *VTC, *MIX; float *OF, *OB; bf16 *ACT, *YB; int* LIST; float* GATE; float *DS, *GD, *ROPE; bf16 *VTA, *OPS, *STB; unsigned char* H8; int* INV; float* GATES;
};


#define CAS __attribute__((address_space(4)))
__device__ __forceinline__ void frame_ptrs(Frame& F) {
    const CAS unsigned char* ka = (const CAS unsigned char*)__builtin_amdgcn_kernarg_segment_ptr();
    asm volatile("" : "+s"(ka));
    typedef const GAS float* gfp;
    const CAS gfp* in = (const CAS gfp*)ka;
    F.x = (const float*)in[0]; F.c = (const float*)in[1]; F.ctx = (const float*)in[2]; F.c_ctx = (const float*)in[3]; F.norm1_g = (const float*)in[4]; F.norm2_g = (const float*)in[5];
    F.w_ada = (const float*)in[6]; F.b_ada = (const float*)in[7]; F.w_in = (const float*)in[8]; F.gla_wa2 = (const float*)in[9]; F.gla_ba = (const float*)in[10]; F.gla_norm_g = (const float*)in[11];
    F.na_rpb = (const float*)in[12]; F.pool_w = (const float*)in[13]; F.pool_scale = (const float*)in[14]; F.w_out = (const float*)in[15]; F.router_w = (const float*)in[16]; F.router_b = (const float*)in[17];
    F.w_gu = (const float*)in[18]; F.b_gu = (const float*)in[19]; F.w_down = (const float*)in[20]; F.b_down = (const float*)in[21]; F.final_g = (const float*)in[22];
    F.out = (float*)*(GAS float* const CAS*)(ka + 184);
    GAS unsigned char* ws = *(GAS unsigned char* const CAS*)(ka + 192);
    F.ws = (unsigned char*)ws; F.ctl = (unsigned*)(ws + WS_CTL);
    F.mod = (float*)(ws + WS_MOD); F.Bin = (bf16*)(ws + WS_BIN); F.Bout = (bf16*)(ws + WS_BOUT); F.Bgu = (bf16*)(ws + WS_BGU); F.Bdn = (bf16*)(ws + WS_BDN);
    F.X = (float*)(ws + WS_X); F.H = (bf16*)(ws + WS_H); F.P = (bf16*)(ws + WS_P); F.VTX = (bf16*)(ws + WS_VTX); F.VTC = (bf16*)(ws + WS_VTC); F.MIX = (bf16*)(ws + WS_MIX);
    F.OF = (float*)(ws + WS_OF); F.OB = (float*)(ws + WS_OB); F.ACT = (bf16*)(ws + WS_ACT); F.YB = (bf16*)(ws + WS_YB); F.LIST = (int*)(ws + WS_LIST); F.GATE = (float*)(ws + WS_GATE);
    F.DS = (float*)(ws + WS_DS); F.GD = (float*)(ws + WS_GD); F.ROPE = (float*)(ws + WS_ROPE); F.VTA = (bf16*)(ws + WS_VTA); F.OPS = (bf16*)(ws + WS_OPS); F.STB = (bf16*)(ws + WS_STB); F.H8 = (unsigned char*)(ws + WS_H8); F.INV = (int*)(ws + WS_INV); F.GATES = (float*)(ws + WS_GATES);
}
static_assert(offsetof(Args, out) == 184 && offsetof(Args, ws) == 192, "Args layout");

__device__ __forceinline__ void in_col_map(int n0, int& dst, float& scale) {
    scale = 1.f;
    if (n0 < 192) { dst = C_GQ + n0; scale = 0.14433756729740643f; }
    else if (n0 < 384) dst = C_GK + (n0 - 192);
    else if (n0 < 768) dst = C_GV + (n0 - 384);
    else if (n0 < 800) dst = C_AF + (n0 - 768);
    else if (n0 < 1184) dst = C_GG + (n0 - 800);
    else if (n0 < 1568) { dst = C_NAQ + (n0 - 1184); scale = 0.125f * 1.4426950408889634f; }
    else if (n0 < 1952) dst = C_NAK + (n0 - 1568);
    else if (n0 < 2336) dst = C_NAV + (n0 - 1952);
    else dst = C_POOL + (n0 - 2336);
}
struct TItem { const float* src; int N; unsigned char* dst; int fp8; float scale; };
__device__ __forceinline__ TItem titem_decode(const Frame& F, int r) {
    constexpr int I_IN = DEPTH * 16 * 81, I_OUT = DEPTH * 16 * 32, I_GU = DEPTH * NE * 16 * 64;
    TItem t; t.fp8 = 0; t.scale = 1.f;
    if (r < I_IN) { const int l = r / (16 * 81), rr = r % (16 * 81), kb = rr / 81, nb = rr % 81; int dst; in_col_map(nb * 32, dst, t.scale);
        t.N = 2592; t.src = F.w_in + (size_t)l * DM * 2592 + (size_t)(kb * 64) * 2592 + nb * 32; t.dst = (unsigned char*)(F.Bin + ((size_t)l * NP + dst) * DM + kb * 64); return t; }
    r -= I_IN;
    if (r < I_OUT) { const int l = r / (16 * 32), rr = r % (16 * 32), kb = rr / 32, nb = rr % 32;
        t.N = DM; t.src = F.w_out + (size_t)l * DM * DM + (size_t)(kb * 64) * DM + nb * 32; t.dst = (unsigned char*)(F.Bout + ((size_t)l * DM + nb * 32) * DM + kb * 64); return t; }
    r -= I_OUT; t.fp8 = MOE_FP8; constexpr size_t EB = MOE_FP8 ? 1 : 2;
    if (r < I_GU) { const int le = r / (16 * 64), rr = r % (16 * 64), kb = rr / 64, nb = rr % 64; const int j0 = nb * 32;
        const int dst = j0 < DM ? (j0 / 128) * 256 + (j0 % 128) : ((j0 - DM) / 128) * 256 + 128 + ((j0 - DM) % 128);
        t.N = 2 * DM; t.src = F.w_gu + (size_t)le * DM * 2 * DM + (size_t)(kb * 64) * 2 * DM + j0; t.dst = (unsigned char*)F.Bgu + (((size_t)le * 2 * DM + dst) * DM + kb * 64) * EB; return t; }
    r -= I_GU;
    { const int le = r / (16 * 32), rr = r % (16 * 32), kb = rr / 32, nb = rr % 32;
        t.N = DM; t.src = F.w_down + (size_t)le * DM * DM + (size_t)(kb * 64) * DM + nb * 32; t.dst = (unsigned char*)F.Bdn + (((size_t)le * DM + nb * 32) * DM + kb * 64) * EB; return t; }
}
__device__ __forceinline__ void titem_load(const TItem& t, int lane, f32x4 (&r)[8]) {
#pragma unroll
    for (int i = 0; i < 8; ++i) r[i] = *(const f32x4*)(t.src + (size_t)((lane >> 3) + 8 * i) * t.N + 4 * (lane & 7));
}
__device__ __forceinline__ void titem_store(const TItem& t, const f32x4 (&r)[8], LAS float* scr, int lane) {
#pragma unroll
    for (int i = 0; i < 8; ++i) { LAS float* p = scr + ((lane >> 3) + 8 * i) * 33 + 4 * (lane & 7); p[0] = r[i].x; p[1] = r[i].y; p[2] = r[i].z; p[3] = r[i].w; }
    LDS_WAIT(); asm volatile("" ::: "memory");
    if (t.fp8) { const int c = lane & 3; const float sc = W8_SCALE;
#pragma unroll
        for (int j = 0; j < 2; ++j) { const int n = (lane >> 2) + 16 * j; const LAS float* s = scr + (16 * c) * 33 + n;
            u32x4 o;
            o.x = pk4_fp8(s[0 * 33] * sc, s[1 * 33] * sc, s[2 * 33] * sc, s[3 * 33] * sc); o.y = pk4_fp8(s[4 * 33] * sc, s[5 * 33] * sc, s[6 * 33] * sc, s[7 * 33] * sc);
            o.z = pk4_fp8(s[8 * 33] * sc, s[9 * 33] * sc, s[10 * 33] * sc, s[11 * 33] * sc); o.w = pk4_fp8(s[12 * 33] * sc, s[13 * 33] * sc, s[14 * 33] * sc, s[15 * 33] * sc);
            *(u32x4*)(t.dst + (size_t)n * DM + 16 * c) = o; }
    } else { const int c = lane & 7; const float sc = t.scale;
#pragma unroll
        for (int j = 0; j < 4; ++j) { const int n = (lane >> 3) + 8 * j; const LAS float* s = scr + (8 * c) * 33 + n;
            u32x4 o; o.x = pk2(s[0 * 33] * sc, s[1 * 33] * sc); o.y = pk2(s[2 * 33] * sc, s[3 * 33] * sc); o.z = pk2(s[4 * 33] * sc, s[5 * 33] * sc); o.w = pk2(s[6 * 33] * sc, s[7 * 33] * sc);
            *(u32x4*)(t.dst + ((size_t)n * DM + 8 * c) * 2) = o; }
    }
    LDS_WAIT(); asm volatile("" ::: "memory");
}
__device__ __forceinline__ int conv_item_id(int t, int lay, int nfix) {
    constexpr int I_IN = DEPTH * 16 * 81, I_OUT = DEPTH * 16 * 32, I_GU = DEPTH * NE * 16 * 64;
    if (t < nfix) return t;
    t -= nfix;
    return t < NE * 16 * 64 ? I_IN + I_OUT + lay * (NE * 16 * 64) + t : I_IN + I_OUT + I_GU + lay * (NE * 16 * 32) + (t - NE * 16 * 64);
}
__device__ __forceinline__ void convert_items(Frame& F, int lay, int ntot, int t0 = 0, int t1 = -1) {
    LAS float* scr = (LAS float*)(F.lds + F.wave * 16384);
    const int gw = F.vcu * NWAVES + F.wave, NGW = F.G * NWAVES, lane = F.lane;
    const int nfix = ntot - 3 * (NE * 16 * 32);
    if (t1 >= 0) ntot = t1;
    int it = t0 + gw; TItem cur = titem_decode(F, conv_item_id(it < ntot ? it : 0, lay, nfix)); f32x4 ra[8];
    if (it < ntot) titem_load(cur, lane, ra);
    while (it < ntot) {
        const int itn = it + NGW; const bool hn = itn < ntot;
        TItem nxt = titem_decode(F, conv_item_id(hn ? itn : 0, lay, nfix)); f32x4 rb[8];
        if (hn) titem_load(nxt, lane, rb);
        titem_store(cur, ra, scr, lane);
        it = itn; cur = nxt;
#pragma unroll
        for (int i = 0; i < 8; ++i) ra[i] = rb[i];
    }
}
__device__ __forceinline__ void ph_prologue(Frame& F) {
    const int gw = F.vcu * NWAVES + F.wave, NGW = F.G * NWAVES, lane = F.lane;
    constexpr int I_IN = DEPTH * 16 * 81, I_OUT = DEPTH * 16 * 32;
    for (int r = F.vcu; r < DEPTH * 24; r += F.G) {
        const int l = r / 24, j4 = (r % 24) * 256 + 4 * lane, k0 = F.wave * 128;
        const float* W = F.w_ada + (size_t)l * DM * 6 * DM + (size_t)k0 * 6 * DM + j4;
        f32x4 acc[9];
#pragma unroll
        for (int q = 0; q < 9; ++q) acc[q] = (f32x4){0.f, 0.f, 0.f, 0.f};
#pragma unroll 1
        for (int kh = 0; kh < 2; ++kh) {
            float cv[9];
#pragma unroll
            for (int q = 0; q < 8; ++q) cv[q] = silu_f(F.c[q * DM + k0 + 64 * kh + lane]);
            cv[8] = silu_f(F.c_ctx[k0 + 64 * kh + lane]);
#pragma unroll 8
            for (int kk = 0; kk < 64; ++kk) { const f32x4 w = *(const f32x4*)(W + (size_t)(64 * kh + kk) * 6 * DM);
#pragma unroll
                for (int q = 0; q < 9; ++q) acc[q] += __builtin_bit_cast(float, __builtin_amdgcn_readlane(__builtin_bit_cast(int, cv[q]), kk)) * w; }
        }
        LAS float* part = (LAS float*)F.lds;
#pragma unroll
        for (int q = 0; q < 9; ++q) *(LAS f32x4*)(part + (F.wave * 9 + q) * 256 + 4 * lane) = acc[q];
        __syncthreads();
        for (int o = F.tid; o < 9 * 256; o += NTHREADS) { const int q = o >> 8, cc = o & 255; float sum = F.b_ada[(size_t)l * 6 * DM + (r % 24) * 256 + cc];
#pragma unroll
            for (int w = 0; w < NWAVES; ++w) sum += part[(w * 9 + q) * 256 + cc];
            F.mod[((size_t)l * 9 + q) * 6 * DM + (r % 24) * 256 + cc] = sum; }
        __syncthreads();
    }
    convert_items(F, 0, I_IN + I_OUT + 3 * (NE * 16 * 32), 0, I_IN + I_OUT);
#if GLA_CHECK
    for (int lay = 0; lay < DEPTH; ++lay) convert_items(F, lay, 3 * (NE * 16 * 32));
#endif
    if (F.vcu == 0) for (int i = F.tid; i < 64 * 12; i += NTHREADS) { const int pos = i / 12, fi = i % 12;
        const float invf = expf(-((float)(2 * fi) / 24.f) * 9.210340371976184f); const float ang = (float)pos * invf; F.ROPE[i] = cosf(ang); F.ROPE[768 + i] = sinf(ang); }
    const size_t gt = (size_t)F.vcu * NTHREADS + F.tid, NGT = (size_t)F.G * NTHREADS;
    for (size_t i = gt; i < (size_t)DEPTH * 224 * DM / 8; i += NGT) { const size_t l = i / (224 * DM / 8), rr = i % (224 * DM / 8);
        *(u32x4*)(F.Bin + (l * NP + 2592) * DM + rr * 8) = (u32x4){0u, 0u, 0u, 0u}; }
    for (size_t i = gt; i < (size_t)256 * DM / 8; i += NGT) *(u32x4*)(F.H + (size_t)TT * DM + i * 8) = (u32x4){0u, 0u, 0u, 0u};
    for (size_t i = gt; i < (size_t)256 * DM / 16; i += NGT) *(u32x4*)(F.H8 + (size_t)TT * DM + i * 16) = (u32x4){0u, 0u, 0u, 0u};
}

__device__ __forceinline__ void norm_mod_store(const f32x4 (&v)[4], const float* gw, const float* sc, const float* sh, bf16* orow, int lane) {
    float s = 0.f;
#pragma unroll
    for (int j = 0; j < 4; ++j) s += (v[j].x * v[j].x + v[j].y * v[j].y) + (v[j].z * v[j].z + v[j].w * v[j].w);
    const float rinv = 1.f / sqrtf(wave_sum(s) * (1.f / DM) + EPS);
#pragma unroll
    for (int j = 0; j < 4; ++j) { const int c = 4 * lane + 256 * j;
        const f32x4 g = *(const f32x4*)(gw + c), a = *(const f32x4*)(sc + c), b = *(const f32x4*)(sh + c);
        const f32x4 y = (v[j] * rinv * g) * (a + 1.f) + b;
        u32x2 w; w.x = pk2(y.x, y.y); w.y = pk2(y.z, y.w);
        *(u32x2*)(orow + c) = w; }
}
__device__ __forceinline__ void ph_first_norm(Frame& F) {
    const int gw = F.vcu * NWAVES + F.wave, NGW = F.G * NWAVES, lane = F.lane;
    for (int m = gw; m < TT; m += NGW) {
        const float* src = m < TX ? F.x + (size_t)m * DM : F.ctx + (size_t)(m - TX) * DM;
        const int br = m < TX ? m / SEQ : NB;
        f32x4 v[4];
#pragma unroll
        for (int j = 0; j < 4; ++j) { v[j] = *(const f32x4*)(src + 4 * lane + 256 * j); *(f32x4*)(F.X + (size_t)m * DM + 4 * lane + 256 * j) = v[j]; }
        const float* md = F.mod + (size_t)br * 6 * DM;
        norm_mod_store(v, F.norm1_g, md + DM, md, F.H + (size_t)m * DM, lane);
    }
}
__device__ __forceinline__ void ph_combine(Frame& F, int l, bool dry = false) {
    const int gw = F.vcu * NWAVES + F.wave, NGW = F.G * NWAVES, lane = F.lane;
    float* Xo = dry ? (float*)F.ACT : F.X; bf16* Ho = dry ? (bf16*)F.P : F.H; float* Oo = dry ? (float*)F.ACT : F.out;
    const int M = (l == DEPTH - 1) ? TX : TT;
    const int cA = 8 * lane, cB = 512 + 8 * lane;
    for (int m0 = gw; m0 < M; m0 += 2 * NGW) {
        u32x4 yw[2][4][2]; f32x4 xv[2][4]; bool have[2]; int br[2];
#pragma unroll
        for (int rr = 0; rr < 2; ++rr) { const int m = m0 + rr * NGW; have[rr] = m < M; const int mm = have[rr] ? m : m0; br[rr] = mm < TX ? mm / SEQ : NB;
            const u32x4 sl4 = *(const u32x4*)(F.INV + (size_t)mm * 4); const unsigned slk[4] = {sl4.x, sl4.y, sl4.z, sl4.w};
#pragma unroll
            for (int k = 0; k < 4; ++k) {
                if (MOE_FP8) { const unsigned char* yr = (const unsigned char*)F.YB + (size_t)slk[k] * DM; const u32x2 a = *(const u32x2*)(yr + cA), b = *(const u32x2*)(yr + cB);
                    yw[rr][k][0] = (u32x4){a.x, a.y, 0u, 0u}; yw[rr][k][1] = (u32x4){b.x, b.y, 0u, 0u}; }
                else { yw[rr][k][0] = *(const u32x4*)(F.YB + (size_t)slk[k] * DM + cA); yw[rr][k][1] = *(const u32x4*)(F.YB + (size_t)slk[k] * DM + cB); } }
            const float* xr = F.X + (size_t)mm * DM;
            xv[rr][0] = *(const f32x4*)(xr + cA); xv[rr][1] = *(const f32x4*)(xr + cA + 4); xv[rr][2] = *(const f32x4*)(xr + cB); xv[rr][3] = *(const f32x4*)(xr + cB + 4); }
#pragma unroll
        for (int rr = 0; rr < 2; ++rr) { if (!have[rr]) continue;
            const int m = m0 + rr * NGW;
            const float* md = F.mod + ((size_t)l * 9 + br[rr]) * 6 * DM;
            f32x4 y[4];
#pragma unroll
            for (int j = 0; j < 4; ++j) y[j] = (f32x4){0.f, 0.f, 0.f, 0.f};
#pragma unroll
            for (int k = 0; k < 4; ++k) { const u32x4 a = yw[rr][k][0], b = yw[rr][k][1];
                if (MOE_FP8) { const f32x2 a0 = __builtin_amdgcn_cvt_pk_f32_fp8((int)a.x, false), a1 = __builtin_amdgcn_cvt_pk_f32_fp8((int)a.x, true), a2 = __builtin_amdgcn_cvt_pk_f32_fp8((int)a.y, false), a3 = __builtin_amdgcn_cvt_pk_f32_fp8((int)a.y, true);
                    const f32x2 b0 = __builtin_amdgcn_cvt_pk_f32_fp8((int)b.x, false), b1 = __builtin_amdgcn_cvt_pk_f32_fp8((int)b.x, true), b2 = __builtin_amdgcn_cvt_pk_f32_fp8((int)b.y, false), b3 = __builtin_amdgcn_cvt_pk_f32_fp8((int)b.y, true);
                    y[0] += (f32x4){a0.x, a0.y, a1.x, a1.y}; y[1] += (f32x4){a2.x, a2.y, a3.x, a3.y}; y[2] += (f32x4){b0.x, b0.y, b1.x, b1.y}; y[3] += (f32x4){b2.x, b2.y, b3.x, b3.y}; }
                else { y[0] += (f32x4){bflo(a.x), bfhi(a.x), bflo(a.y), bfhi(a.y)}; y[1] += (f32x4){bflo(a.z), bfhi(a.z), bflo(a.w), bfhi(a.w)};
                    y[2] += (f32x4){bflo(b.x), bfhi(b.x), bflo(b.y), bfhi(b.y)}; y[3] += (f32x4){bflo(b.z), bfhi(b.z), bflo(b.w), bfhi(b.w)}; } }
            if (MOE_FP8) {
#pragma unroll
                for (int j = 0; j < 4; ++j) y[j] *= Y8_INV; }
            const int cc[4] = {cA, cA + 4, cB, cB + 4};
            f32x4 v[4]; float ss = 0.f;
#pragma unroll
            for (int j = 0; j < 4; ++j) { v[j] = xv[rr][j] + *(const f32x4*)(md + 5 * DM + cc[j]) * y[j]; ss += (v[j].x * v[j].x + v[j].y * v[j].y) + (v[j].z * v[j].z + v[j].w * v[j].w); }
            const float rinv = 1.f / sqrtf(wave_sum(ss) * (1.f / DM) + EPS);
            if (l < DEPTH - 1) {
#pragma unroll
                for (int j = 0; j < 4; ++j) *(f32x4*)(Xo + (size_t)m * DM + cc[j]) = v[j];
                const float* mn = F.mod + ((size_t)(l + 1) * 9 + br[rr]) * 6 * DM; const float* gw1 = F.norm1_g + (size_t)(l + 1) * DM;
                f32x4 h[4];
#pragma unroll
                for (int j = 0; j < 4; ++j) h[j] = (v[j] * rinv * *(const f32x4*)(gw1 + cc[j])) * (*(const f32x4*)(mn + DM + cc[j]) + 1.f) + *(const f32x4*)(mn + cc[j]);
                u32x4 w0, w1; w0.x = pk2(h[0].x, h[0].y); w0.y = pk2(h[0].z, h[0].w); w0.z = pk2(h[1].x, h[1].y); w0.w = pk2(h[1].z, h[1].w);
                w1.x = pk2(h[2].x, h[2].y); w1.y = pk2(h[2].z, h[2].w); w1.z = pk2(h[3].x, h[3].y); w1.w = pk2(h[3].z, h[3].w);
                *(u32x4*)(Ho + (size_t)m * DM + cA) = w0; *(u32x4*)(Ho + (size_t)m * DM + cB) = w1;
            } else {
#pragma unroll
                for (int j = 0; j < 4; ++j) { f32x4 o = v[j] * rinv * *(const f32x4*)(F.final_g + cc[j]);
#if GLA_CHECK
                    if (__hip_atomic_load(F.ctl + 64, __ATOMIC_RELAXED, __HIP_MEMORY_SCOPE_AGENT) != 0u) { const float q = __builtin_nanf(""); o = (f32x4){q, q, q, q}; }
#endif
                    *(f32x4*)(Oo + (size_t)m * DM + cc[j]) = o; }
            }
        }
    }
}

constexpr int PL_U = 0, PL_P = 49152, PL_LD = 264, PREP_PW = 81920, PW_LD = 72, PREP_PS = PREP_PW + 4 * 64 * PW_LD * 2;
static_assert(PREP_PS + 1024 <= STAGE_BYTES && PL_P + 32 * PL_LD * 2 <= PREP_PW, "pool LDS map");
__device__ __forceinline__ void pool_unit(Frame& F, int l, int u) {
    LAS float* U = (LAS float*)(F.lds + PL_U);
    LAS bf16* PL = (LAS bf16*)(F.lds + PL_P);
    const LAS bf16* PW = (const LAS bf16*)(F.lds + PREP_PW); const LAS float* PS = (const LAS float*)(F.lds + PREP_PS);
    const int tid = F.tid;
    int s, tb, seqbase, tlen;
    if (u < NB * 128) { s = u / 128; tb = u % 128; seqbase = s * SEQ; tlen = SEQ; } else { const int v = u - NB * 128; s = v / 8; tb = v % 8; seqbase = TX + s * CTXL; tlen = CTXL; }
    const int t0 = tb * 32;
    for (int i = tid; i < 48 * 32; i += NTHREADS) { const int rr = i / 32, ch = i % 32, t = t0 - 8 + rr;
        f32x4 a = (f32x4){0.f, 0.f, 0.f, 0.f}, b = a;
        if (t >= 0 && t < tlen) { const u32x4 w = *(const u32x4*)(F.P + (size_t)(seqbase + t) * NP + C_POOL + ch * 8);
            a = (f32x4){bflo(w.x), bfhi(w.x), bflo(w.y), bfhi(w.y)}; b = (f32x4){bflo(w.z), bfhi(w.z), bflo(w.w), bfhi(w.w)}; }
        *(LAS f32x4*)(U + rr * 256 + ch * 8) = a; *(LAS f32x4*)(U + rr * 256 + ch * 8 + 4) = b; }
    __syncthreads();
    { const int tt = tid >> 4, cg = tid & 15, g = cg >> 2, w = 2 << g, t = t0 + tt;
      int lo = t - w / 2; if (lo < 0) lo = 0; int hi = t + w - w / 2; if (hi > tlen) hi = tlen;
      const float inv = 1.f / (float)(hi - lo);
      f32x4 sum[4];
#pragma unroll
      for (int q4 = 0; q4 < 4; ++q4) sum[q4] = (f32x4){0.f, 0.f, 0.f, 0.f};
      for (int jj = lo; jj < hi; ++jj) {
#pragma unroll
          for (int q4 = 0; q4 < 4; ++q4) sum[q4] += *(const LAS f32x4*)(U + (jj - t0 + 8) * 256 + cg * 16 + 4 * q4); }
      u32x4 w0, w1;
      { const f32x4 y0 = sum[0] * inv - *(const LAS f32x4*)(U + (tt + 8) * 256 + cg * 16), y1 = sum[1] * inv - *(const LAS f32x4*)(U + (tt + 8) * 256 + cg * 16 + 4);
        const f32x4 y2 = sum[2] * inv - *(const LAS f32x4*)(U + (tt + 8) * 256 + cg * 16 + 8), y3 = sum[3] * inv - *(const LAS f32x4*)(U + (tt + 8) * 256 + cg * 16 + 12);
        w0.x = pk2(y0.x, y0.y); w0.y = pk2(y0.z, y0.w); w0.z = pk2(y1.x, y1.y); w0.w = pk2(y1.z, y1.w);
        w1.x = pk2(y2.x, y2.y); w1.y = pk2(y2.z, y2.w); w1.z = pk2(y3.x, y3.y); w1.w = pk2(y3.z, y3.w); }
      *(LAS u32x4*)(PL + tt * PL_LD + cg * 16) = w0; *(LAS u32x4*)(PL + tt * PL_LD + cg * 16 + 8) = w1; }
    __syncthreads();
    { const int lane = F.lane, q = lane & 15, g4 = lane >> 4;
#pragma unroll
      for (int k = 0; k < 4; ++k) { const int ti = F.wave * 4 + k, mt = ti & 1, ct = ti >> 1, g = ct >> 2, ot = ct & 3;
          f32x4 acc = (f32x4){0.f, 0.f, 0.f, 0.f};
#pragma unroll
          for (int s2 = 0; s2 < 2; ++s2) { const bf16x8 a = *(const LAS bf16x8*)(PW + (g * 64 + 16 * ot + q) * PW_LD + 32 * s2 + 8 * g4), b = *(const LAS bf16x8*)(PL + (16 * mt + q) * PL_LD + g * 64 + 32 * s2 + 8 * g4);
              acc = __builtin_amdgcn_mfma_f32_16x16x32_bf16(a, b, acc, 0, 0, 0); }
          const f32x4 y = acc * *(const LAS f32x4*)(PS + g * 64 + 16 * ot + 4 * g4);
          u32x2 w; w.x = pk2(y.x, y.y); w.y = pk2(y.z, y.w);
          *(u32x2*)(F.MIX + (size_t)(seqbase + t0 + 16 * mt + q) * DM + 768 + g * 64 + 16 * ot + 4 * g4) = w; } }
    __syncthreads();
}
#if GLA_CHECK
__device__ __forceinline__ void gla_chain(Frame& F, int l, int u) {
    const int tid = F.tid;
    const int dir = u & 1, hh = (u >> 1) & 3, b = u >> 3;
    LAS float* qs = (LAS float*)F.lds;
    LAS float* ks = qs + 64 * 48;
    LAS float* as = ks + 64 * 48;
    LAS float* vs = as + 64 * 48;
    LAS float* os = vs + 64 * 96;
    LAS float* rc = os + 64 * 96;
    LAS float* rs = rc + 64 * 12;
    LAS float* wa = rs + 64 * 12;
    LAS float* ba = wa + 16 * 48;
    for (int i = tid; i < 64 * 12; i += NTHREADS) { const int pos = i / 12, fi = i % 12;
        const float invf = expf(-((float)(2 * fi) / 24.f) * 9.210340371976184f);
        const float ang = (float)pos * invf; rc[i] = cosf(ang); rs[i] = sinf(ang); }
    for (int i = tid; i < 16 * 48; i += NTHREADS) { const int r = i / 48, d = i % 48; wa[i] = F.gla_wa2[(((size_t)l * 2 + dir) * 16 + r) * 192 + hh * 48 + d]; }
    if (tid < 48) ba[tid] = F.gla_ba[((size_t)l * 2 + dir) * 192 + hh * 48 + tid];
    __syncthreads();
    float S[12];
#pragma unroll
    for (int i = 0; i < 12; ++i) S[i] = 0.f;
    const int vv = tid >> 2, dg = tid & 3;
    float* Odir = dir ? F.OB : F.OF;
    const bool need_ctx = l < DEPTH - 1;
    for (int cidx = 0; cidx < 4 + 64; ++cidx) {
        const bool isctx = cidx < 4;
        const int nch = isctx ? 4 : 64, ci0 = isctx ? cidx : cidx - 4, ci = dir ? (nch - 1 - ci0) : ci0;
        const int seqbase = isctx ? TX + b * CTXL : b * SEQ, t0 = ci * 64;
        for (int i = tid; i < 64 * 2 * 2 * 12; i += NTHREADS) {
            const int fi = i % 12, hf = (i / 12) & 1, isk = (i / 24) & 1, j = i / 48;
            const bf16* row = F.P + (size_t)(seqbase + t0 + j) * NP + (isk ? C_GK : C_GQ) + hh * 48 + hf * 24;
            const float x1 = bf2f(row[fi]), x2 = bf2f(row[12 + fi]);
            float o1 = x1, o2 = x2;
            if (!isctx) { const int t = t0 + j, pos = hf ? (t % GRIDW) : (t / GRIDW); const float cs = rc[pos * 12 + fi], sn = rs[pos * 12 + fi]; o1 = x1 * cs - x2 * sn; o2 = x1 * sn + x2 * cs; }
            LAS float* dst = (isk ? ks : qs) + j * 48 + hf * 24;
            dst[fi] = o1; dst[12 + fi] = o2; }
        for (int i = tid; i < 64 * 48; i += NTHREADS) { const int j = i / 48, d = i % 48;
            const bf16* row = F.P + (size_t)(seqbase + t0 + j) * NP + (dir ? C_AB : C_AF);
            float z = ba[d];
#pragma unroll
            for (int r = 0; r < 16; ++r) z += bf2f(row[r]) * wa[r * 48 + d];
            const float ls = fminf(z, 0.f) - log1pf(expf(-fabsf(z)));
            as[i] = expf(ls * (1.f / 16.f)); }
        for (int i = tid; i < 64 * 96; i += NTHREADS) { const int j = i / 96, d = i % 96; vs[i] = bf2f(F.VTA[(size_t)(384 + hh * 96 + d) * VTS + seqbase + t0 + j]); }
        __syncthreads();
        if (tid < 384) {
            for (int st = 0; st < 64; ++st) {
                const int j = dir ? 63 - st : st;
                const float vj = vs[j * 96 + vv];
                float part = 0.f;
#pragma unroll
                for (int q4 = 0; q4 < 3; ++q4) {
                    const f32x4 a4 = *(const LAS f32x4*)(as + j * 48 + dg * 12 + q4 * 4), k4 = *(const LAS f32x4*)(ks + j * 48 + dg * 12 + q4 * 4), qq = *(const LAS f32x4*)(qs + j * 48 + dg * 12 + q4 * 4);
#pragma unroll
                    for (int e = 0; e < 4; ++e) { const float sn = a4[e] * S[q4 * 4 + e] + k4[e] * vj; S[q4 * 4 + e] = sn; part += qq[e] * sn; } }
                part += __shfl_xor(part, 1); part += __shfl_xor(part, 2);
                if (dg == 0) os[j * 96 + vv] = part;
            }
        }
        __syncthreads();
        if (!isctx || need_ctx)
            for (int i = tid; i < 64 * 96; i += NTHREADS) { const int j = i / 96, d = i % 96; Odir[(size_t)(seqbase + t0 + j) * 384 + hh * 96 + d] = os[i]; }
        __syncthreads();
    }
}

#endif
typedef float f32x16 __attribute__((ext_vector_type(16)));
constexpr int GL_BF = 0, GL_BB = 12288, GL_WA = 24576, GL_VT = 31232, GL_KEF = 45056, GL_KEB = 51968;
constexpr int GL_QF = 45056, GL_KF = 52224, GL_QB = 59392, GL_KB = 66560, GL_STF = 73728, GL_STB = 84480, GL_O = 95232;
constexpr int VT_LD = 72, QK_LD = 56, ST_LD = 56, O_LD = 100, NCH = 68;
struct GlaU { int b, hh, cpos, seqbase, t0, isctx; };
__device__ __forceinline__ GlaU gla_unit_geom(int u) { GlaU g; g.cpos = u % NCH; g.hh = (u / NCH) & 3; g.b = u / (NCH * 4); g.isctx = g.cpos < 4;
    const int ci = g.isctx ? g.cpos : g.cpos - 4; g.seqbase = g.isctx ? TX + g.b * CTXL : g.b * SEQ; g.t0 = ci * 64; return g; }
__device__ __forceinline__ void gla_rope_pair(const Frame& F, const GlaU& g, const bf16* row, int j, int hf, int fi, float& o1, float& o2) {
    const float x1 = bf2f(row[fi]), x2 = bf2f(row[12 + fi]); o1 = x1; o2 = x2;
    if (!g.isctx) { const int t = g.t0 + j, pos = hf ? (t % GRIDW) : (t / GRIDW); const float cs = F.ROPE[pos * 12 + fi], sn = F.ROPE[768 + pos * 12 + fi]; o1 = x1 * cs - x2 * sn; o2 = x1 * sn + x2 * cs; }
}
constexpr int G1_BF = 0, G1_BB = 12288, G1_KEF = 24576, G1_KEB = 31488, G1_OPS = 38400;
constexpr int PREP_WA = TAB_OFF;
__device__ __forceinline__ void gla_g1_unit(Frame& F, int l, int u) {
    const GlaU g = gla_unit_geom(u);
    LAS bf16* kef = (LAS bf16*)(F.lds + G1_KEF); LAS bf16* keb = (LAS bf16*)(F.lds + G1_KEB); LAS bf16* ops = (LAS bf16*)(F.lds + G1_OPS);
    const LAS float* wa = (const LAS float*)(F.lds + PREP_WA) + g.hh * 1536; const LAS float* ba = (const LAS float*)(F.lds + PREP_WA) + 6144 + g.hh * 96;
    const bf16* vtg = F.VTA + (size_t)(384 + g.hh * 96) * VTS + g.seqbase + g.t0;
    const int tid = F.tid, lane = F.lane, j = lane, w = F.wave;
    const bf16* prow = F.P + (size_t)(g.seqbase + g.t0 + j) * NP;
    u32x4 araw[4];
#pragma unroll
    for (int q4 = 0; q4 < 4; ++q4) araw[q4] = *(const u32x4*)(prow + C_AF + 8 * q4);
    float q1[3], q2[3], k1[3], k2[3], cs[3], sn[3];
#pragma unroll
    for (int e = 0; e < 3; ++e) { const int p = 3 * w + e, hf = p / 12, fi = p % 12, cb = g.hh * 48 + hf * 24 + fi;
        q1[e] = bf2f(prow[C_GQ + cb]); q2[e] = bf2f(prow[C_GQ + cb + 12]); k1[e] = bf2f(prow[C_GK + cb]); k2[e] = bf2f(prow[C_GK + cb + 12]);
        const int t = g.t0 + j, pos = hf ? (t % GRIDW) : (t / GRIDW);
        cs[e] = g.isctx ? 1.f : F.ROPE[pos * 12 + fi]; sn[e] = g.isctx ? 0.f : F.ROPE[768 + pos * 12 + fi]; }
    float a[32];
#pragma unroll
    for (int q4 = 0; q4 < 4; ++q4) { const u32x4 x = araw[q4]; a[q4 * 8 + 0] = bflo(x.x); a[q4 * 8 + 1] = bfhi(x.x); a[q4 * 8 + 2] = bflo(x.y); a[q4 * 8 + 3] = bfhi(x.y);
        a[q4 * 8 + 4] = bflo(x.z); a[q4 * 8 + 5] = bfhi(x.z); a[q4 * 8 + 6] = bflo(x.w); a[q4 * 8 + 7] = bfhi(x.w); }
    float bf[3][2], bb[3][2];
#pragma unroll
    for (int e = 0; e < 3; ++e)
#pragma unroll
        for (int wh = 0; wh < 2; ++wh) { const int p = 3 * w + e, d = (p / 12) * 24 + p % 12 + 12 * wh;
            float zf = ba[d], zb = ba[48 + d];
#pragma unroll
            for (int r = 0; r < 16; ++r) { zf += a[r] * wa[r * 48 + d]; zb += a[16 + r] * wa[(16 + r) * 48 + d]; }
            const float xf = (fminf(zf, 0.f) - __logf(1.f + __expf(-fabsf(zf)))) * (1.f / 16.f), xb = (fminf(zb, 0.f) - __logf(1.f + __expf(-fabsf(zb)))) * (1.f / 16.f);
            bf[e][wh] = wave_scan_incl(xf);
            const float ab = wave_scan_incl(xb);
            bb[e][wh] = __int_as_float(__builtin_amdgcn_readlane(__float_as_int(ab), 63)) - ab + xb; }
#pragma unroll
    for (int e = 0; e < 3; ++e) { const int p = 3 * w + e, d1 = (p / 12) * 24 + p % 12, d2 = d1 + 12;
        const float qa = q1[e] * cs[e] - q2[e] * sn[e], qb = q1[e] * sn[e] + q2[e] * cs[e], ka = k1[e] * cs[e] - k2[e] * sn[e], kb = k1[e] * sn[e] + k2[e] * cs[e];
        const float f1 = bf[e][0], f2 = bf[e][1], b1 = bb[e][0], b2 = bb[e][1];
        const float fe1 = __builtin_bit_cast(float, __builtin_amdgcn_readlane(__builtin_bit_cast(int, f1), 63)), fe2 = __builtin_bit_cast(float, __builtin_amdgcn_readlane(__builtin_bit_cast(int, f2), 63));
        const float be1 = __builtin_bit_cast(float, __builtin_amdgcn_readlane(__builtin_bit_cast(int, b1), 0)), be2 = __builtin_bit_cast(float, __builtin_amdgcn_readlane(__builtin_bit_cast(int, b2), 0));
        const float ef1 = __expf(f1), ef2 = __expf(f2), eb1 = __expf(b1), eb2 = __expf(b2), nf1 = __expf(-f1), nf2 = __expf(-f2), nb1 = __expf(-b1), nb2 = __expf(-b2);
        ops[j * 48 + d1] = (bf16)f2bf(qa * ef1); ops[j * 48 + d2] = (bf16)f2bf(qb * ef2); ops[3072 + j * 48 + d1] = (bf16)f2bf(ka * nf1); ops[3072 + j * 48 + d2] = (bf16)f2bf(kb * nf2);
        ops[6144 + j * 48 + d1] = (bf16)f2bf(qa * eb1); ops[6144 + j * 48 + d2] = (bf16)f2bf(qb * eb2); ops[9216 + j * 48 + d1] = (bf16)f2bf(ka * nb1); ops[9216 + j * 48 + d2] = (bf16)f2bf(kb * nb2);
        const float ge1 = __expf(fe1), ge2 = __expf(fe2), he1 = __expf(be1), he2 = __expf(be2);
        kef[d1 * VT_LD + j] = (bf16)f2bf(ka * nf1 * ge1); kef[d2 * VT_LD + j] = (bf16)f2bf(kb * nf2 * ge2);
        keb[d1 * VT_LD + j] = (bf16)f2bf(ka * nb1 * he1); keb[d2 * VT_LD + j] = (bf16)f2bf(kb * nb2 * he2);
        if (lane == 0) { float* gd = F.GD + (((size_t)(g.b * 4 + g.hh) * 2) * NCH + g.cpos) * 48; gd[d1] = ge1; gd[d2] = ge2; gd[(size_t)NCH * 48 + d1] = he1; gd[(size_t)NCH * 48 + d2] = he2; } }
    __syncthreads();
    { const int q = lane & 15, g4 = lane >> 4;
      for (int ti = F.wave; ti < 36; ti += NWAVES) { const int dir = ti / 18, dt = (ti % 18) / 6, vtile = ti % 6;
          const LAS bf16* ke = dir ? keb : kef;
          f32x4 acc = (f32x4){0.f, 0.f, 0.f, 0.f};
#pragma unroll
          for (int s2 = 0; s2 < 2; ++s2) { const bf16x8 av = *(const LAS bf16x8*)(ke + (16 * dt + q) * VT_LD + 32 * s2 + 8 * g4), bv = *(const bf16x8*)(vtg + (size_t)(16 * vtile + q) * VTS + 32 * s2 + 8 * g4);
              acc = __builtin_amdgcn_mfma_f32_16x16x32_bf16(av, bv, acc, 0, 0, 0); }
          *(f32x4*)(F.DS + ((((size_t)(g.b * 4 + g.hh) * 2 + dir) * NCH + g.cpos) * 96 + 16 * vtile + q) * 48 + 16 * dt + 4 * g4) = acc; } }
    { u32x4* dst = (u32x4*)(F.OPS + (size_t)u * 12288);
      for (int i = tid; i < 1536; i += NTHREADS) dst[i] = *(const LAS u32x4*)(ops + i * 8); }
    __syncthreads();
}
__device__ __forceinline__ void gla_g2_unit(Frame& F, int u) {
    const int chain = u >> 2, qt = u & 3, dir = chain & 1, tid = F.tid;
    const float* ds = F.DS + (size_t)chain * NCH * 4608; const float* gd = F.GD + (size_t)chain * NCH * 48; bf16* stb = F.STB + (size_t)chain * NCH * 4608;
    const int e0 = qt * 1152 + 2 * tid, e1 = qt * 1152 + 1024 + 2 * tid; const bool h1 = tid < 64;
    const int d0 = e0 % 48, d1 = h1 ? e1 % 48 : 0;
    f32x2 S0 = (f32x2){0.f, 0.f}, S1 = (f32x2){0.f, 0.f};
    for (int st0 = 0; st0 < NCH; st0 += 4) {
        f32x2 x0[4], x1[4], g0[4], g1[4]; int cp[4];
#pragma unroll
        for (int k = 0; k < 4; ++k) { const int st = st0 + k; cp[k] = st < 4 ? (dir ? 3 - st : st) : (dir ? 4 + (67 - st) : st);
            const float* p = ds + (size_t)cp[k] * 4608; const float* gp = gd + cp[k] * 48;
            x0[k] = *(const f32x2*)(p + e0); g0[k] = *(const f32x2*)(gp + d0);
            if (h1) { x1[k] = *(const f32x2*)(p + e1); g1[k] = *(const f32x2*)(gp + d1); } else { x1[k] = (f32x2){0.f, 0.f}; g1[k] = x1[k]; } }
#pragma unroll
        for (int k = 0; k < 4; ++k) { bf16* p = stb + (size_t)cp[k] * 4608;
            *(unsigned*)(p + e0) = pk2(S0.x, S0.y); if (h1) *(unsigned*)(p + e1) = pk2(S1.x, S1.y);
            S0 = g0[k] * S0 + x0[k]; S1 = g1[k] * S1 + x1[k]; }
    }
}
__device__ __forceinline__ void gla_g3_wave(Frame& F, int l, int wu) {
    const int u = wu >> 1, it = wu & 1;
    const GlaU g = gla_unit_geom(u);
    const int lane = F.lane, r = lane & 31, h = lane >> 5;
    const bf16* ops = F.OPS + (size_t)u * 12288 + 16 * 0 + 8 * h;
    const bf16* vtg = F.VTA + (size_t)(384 + g.hh * 96) * VTS + g.seqbase + g.t0;
    const bf16* stf = F.STB + ((((size_t)(g.b * 4 + g.hh) * 2 + 0) * NCH + g.cpos) * 4608) + 8 * h; const bf16* stbk = stf + (size_t)NCH * 4608;
    LAS float* O = (LAS float*)(F.lds + F.wave * 16384);
    bf16x8 qf[3], qb[3];
#pragma unroll
    for (int s3 = 0; s3 < 3; ++s3) { qf[s3] = *(const bf16x8*)(ops + (32 * it + r) * 48 + 16 * s3); qb[s3] = *(const bf16x8*)(ops + 6144 + (32 * it + r) * 48 + 16 * s3); }
    f32x16 X[2];
#pragma unroll
    for (int jt = 0; jt < 2; ++jt) {
        f32x16 xf, xb;
#pragma unroll
        for (int e = 0; e < 16; ++e) { xf[e] = 0.f; xb[e] = 0.f; }
        if (jt <= it) {
#pragma unroll
            for (int s3 = 0; s3 < 3; ++s3) xf = __builtin_amdgcn_mfma_f32_32x32x16_bf16(*(const bf16x8*)(ops + 3072 + (32 * jt + r) * 48 + 16 * s3), qf[s3], xf, 0, 0, 0); }
        if (jt >= it) {
#pragma unroll
            for (int s3 = 0; s3 < 3; ++s3) xb = __builtin_amdgcn_mfma_f32_32x32x16_bf16(*(const bf16x8*)(ops + 9216 + (32 * jt + r) * 48 + 16 * s3), qb[s3], xb, 0, 0, 0); }
        if (jt == it) {
#pragma unroll
            for (int e = 0; e < 16; ++e) { const int jl = (e & 3) + 8 * (e >> 2) + 4 * h; X[jt][e] = (jl <= r ? xf[e] : 0.f) + (jl >= r ? xb[e] : 0.f); }
        } else X[jt] = jt < it ? xf : xb;
    }
    f32x16 o[3];
#pragma unroll
    for (int vt = 0; vt < 3; ++vt)
#pragma unroll
        for (int e = 0; e < 16; ++e) o[vt][e] = 0.f;
#pragma unroll
    for (int jt = 0; jt < 2; ++jt)
#pragma unroll
        for (int s2 = 0; s2 < 2; ++s2) {
            u32x4 aw; aw.x = pk2(X[jt][8 * s2 + 0], X[jt][8 * s2 + 1]); aw.y = pk2(X[jt][8 * s2 + 2], X[jt][8 * s2 + 3]); aw.z = pk2(X[jt][8 * s2 + 4], X[jt][8 * s2 + 5]); aw.w = pk2(X[jt][8 * s2 + 6], X[jt][8 * s2 + 7]);
#pragma unroll
            for (int vt = 0; vt < 3; ++vt) {
                const bf16* vr = vtg + (size_t)(32 * vt + r) * VTS + 32 * jt + 16 * s2 + 4 * h;
                const u32x2 lo = *(const u32x2*)vr, hi = *(const u32x2*)(vr + 8);
                const u32x4 bw = (u32x4){lo.x, lo.y, hi.x, hi.y};
                o[vt] = __builtin_amdgcn_mfma_f32_32x32x16_bf16(__builtin_bit_cast(bf16x8, aw), __builtin_bit_cast(bf16x8, bw), o[vt], 0, 0, 0); } }
#pragma unroll
    for (int s3 = 0; s3 < 3; ++s3)
#pragma unroll
        for (int vt = 0; vt < 3; ++vt) {
            o[vt] = __builtin_amdgcn_mfma_f32_32x32x16_bf16(qf[s3], *(const bf16x8*)(stf + (32 * vt + r) * 48 + 16 * s3), o[vt], 0, 0, 0);
            o[vt] = __builtin_amdgcn_mfma_f32_32x32x16_bf16(qb[s3], *(const bf16x8*)(stbk + (32 * vt + r) * 48 + 16 * s3), o[vt], 0, 0, 0); }
#pragma unroll
    for (int vt = 0; vt < 3; ++vt)
#pragma unroll
        for (int e = 0; e < 16; ++e) O[((e & 3) + 8 * (e >> 2) + 4 * h) * O_LD + 32 * vt + r] = o[vt][e];
    LDS_WAIT(); asm volatile("" ::: "memory");
    { const int i = lane >> 1, half = lane & 1; const size_t row = (size_t)(g.seqbase + g.t0 + 32 * it + i);
      f32x4 ov[12]; float ss = 0.f;
#pragma unroll
      for (int e = 0; e < 12; ++e) { ov[e] = *(const LAS f32x4*)(O + i * O_LD + half * 48 + 4 * e); ss += (ov[e].x * ov[e].x + ov[e].y * ov[e].y) + (ov[e].z * ov[e].z + ov[e].w * ov[e].w); }
      ss = dpp_addp<0xB1>(ss);
      const float rinv = 1.f / sqrtf(ss * (1.f / 96.f) + EPS);
      const float* ng = F.gla_norm_g + (size_t)l * 384 + g.hh * 96 + half * 48;
      const u32x4* gp = (const u32x4*)(F.P + row * NP + C_GG + g.hh * 96 + half * 48);
      u32x4* dst = (u32x4*)(F.MIX + row * DM + g.hh * 96 + half * 48);
#if GLA_CHECK
      { float sn = 0.f; const float* pf = F.OF + row * 384 + g.hh * 96 + half * 48; const float* pb = F.OB + row * 384 + g.hh * 96 + half * 48;
#pragma unroll
        for (int e = 0; e < 48; ++e) { const float on = pf[e] + pb[e]; sn += on * on; }
        sn += __shfl_xor(sn, 1);
        const float rms = sqrtf(sn * (1.f / 96.f)) + 1e-6f; int bad = 0;
#pragma unroll
        for (int e = 0; e < 48; ++e) { const float on = pf[e] + pb[e]; if (!(fabsf(ov[e >> 2][e & 3] - on) <= 0.03f * rms + 0.03f * fabsf(on))) ++bad; }
        if (bad) atomicAdd(F.ctl + 64, (unsigned)bad); }
#endif
#pragma unroll
      for (int q6 = 0; q6 < 6; ++q6) { const u32x4 gw = gp[q6]; const f32x4 n0 = *(const f32x4*)(ng + 8 * q6), n1 = *(const f32x4*)(ng + 8 * q6 + 4); const f32x4 a = ov[2 * q6], b = ov[2 * q6 + 1];
          u32x4 w;
          w.x = pk2(a.x * rinv * n0.x * silu_f(bflo(gw.x)), a.y * rinv * n0.y * silu_f(bfhi(gw.x))); w.y = pk2(a.z * rinv * n0.z * silu_f(bflo(gw.y)), a.w * rinv * n0.w * silu_f(bfhi(gw.y)));
          w.z = pk2(b.x * rinv * n1.x * silu_f(bflo(gw.z)), b.y * rinv * n1.y * silu_f(bfhi(gw.z))); w.w = pk2(b.z * rinv * n1.z * silu_f(bflo(gw.w)), b.w * rinv * n1.w * silu_f(bfhi(gw.w)));
          dst[q6] = w; } }
    LDS_WAIT(); asm volatile("" ::: "memory");
}
__device__ __forceinline__ void ph_gla3(Frame& F, int l) {
    const bool need_ctx = l < DEPTH - 1;
    const int gw = F.vcu * NWAVES + F.wave, NGW = F.G * NWAVES;
    for (int wu = gw; wu < NB * GH * NCH * 2; wu += NGW) { if (!need_ctx && ((wu >> 1) % NCH) < 4) continue; gla_g3_wave(F, l, wu); }
}
__device__ __forceinline__ void ph_prep(Frame& F, int l) {
    const bool need_ctx = l < DEPTH - 1;
    const int tid = F.tid;
#if GLA_CHECK
    for (int u = F.vcu; u < NB * GH * 2; u += F.G) gla_chain(F, l, u);
    __syncthreads();
#endif
    { LAS float* wa = (LAS float*)(F.lds + PREP_WA);
      for (int i = tid; i < 4 * 2 * 16 * 48; i += NTHREADS) { const int hh = i / 1536, dir = (i / 768) & 1, r = (i / 48) % 16, d = i % 48; wa[i] = F.gla_wa2[(((size_t)l * 2 + dir) * 16 + r) * 192 + hh * 48 + d]; }
      for (int i = tid; i < 4 * 2 * 48; i += NTHREADS) { const int hh = i / 96, dir = (i / 48) & 1, d = i % 48; wa[6144 + i] = F.gla_ba[((size_t)l * 2 + dir) * 192 + hh * 48 + d]; }
      LAS bf16* pw = (LAS bf16*)(F.lds + PREP_PW); LAS float* ps = (LAS float*)(F.lds + PREP_PS);
      for (int i = tid; i < 4 * 64 * 64; i += NTHREADS) { const int g = i >> 12, ii = (i >> 6) & 63, o = i & 63; pw[(g * 64 + o) * PW_LD + ii] = (bf16)f2bf(F.pool_w[(size_t)l * 16384 + i]); }
      if (tid < 256) ps[tid] = F.pool_scale[(size_t)l * 256 + tid]; }
    __syncthreads();
    for (int u = F.vcu; u < NB * GH * NCH; u += F.G) gla_g1_unit(F, l, u);
    const int NPOOL = NB * 128 + (need_ctx ? NB * 8 : 0);
    for (int u = F.vcu; u < NPOOL; u += F.G) pool_unit(F, l, u);
}

#define NA_LOG2E 1.4426950408889634f
__device__ __forceinline__ float na_max4(float x) {
    const auto r = __builtin_amdgcn_permlane16_swap(__float_as_uint(x), __float_as_uint(x), false, false);
    x = fmaxf(__uint_as_float(r[0]), __uint_as_float(r[1]));
    const auto t = __builtin_amdgcn_permlane32_swap(__float_as_uint(x), __float_as_uint(x), false, false);
    return fmaxf(__uint_as_float(t[0]), __uint_as_float(t[1]));
}
__device__ __forceinline__ float na_sum4(float x) {
    const auto r = __builtin_amdgcn_permlane16_swap(__float_as_uint(x), __float_as_uint(x), false, false);
    x = __uint_as_float(r[0]) + __uint_as_float(r[1]);
    const auto t = __builtin_amdgcn_permlane32_swap(__float_as_uint(x), __float_as_uint(x), false, false);
    return __uint_as_float(t[0]) + __uint_as_float(t[1]);
}
struct NaCtx {
    __amdgpu_buffer_rsrc_t rP, rV; unsigned voffK, voffV; int b, cw, r0, krlo, nnb; const LAS float* rpb; unsigned bidx[2][4];
    bf16x8 qa[4][2]; float mrun[4], lsum[4]; f32x4 o[4][4];
};
__device__ __forceinline__ int na_segtok(const NaCtx& C, int sg) { return sg < C.nnb ? C.b * SEQ + (C.krlo + sg) * GRIDW + C.cw : TX + C.b * CTXL + 32 * (sg - C.nnb); }
__device__ __forceinline__ void na_load(const NaCtx& C, int sg, bf16x8 (&kb)[2][2], bf16x8 (&vb)[4]) {
    const int tok = na_segtok(C, sg);
#pragma unroll
    for (int par = 0; par < 2; ++par)
#pragma unroll
        for (int s2 = 0; s2 < 2; ++s2) kb[par][s2] = __builtin_bit_cast(bf16x8, __builtin_amdgcn_raw_buffer_load_b128(C.rP, C.voffK, (unsigned)((tok + 4 * par) * (NP * 2) + 64 * s2), 0));
#pragma unroll
    for (int dt = 0; dt < 4; ++dt) vb[dt] = __builtin_bit_cast(bf16x8, __builtin_amdgcn_raw_buffer_load_b128(C.rV, C.voffV, (unsigned)((16 * dt * VTS + tok) * 2), 0));
}
template <bool LATENT>
__device__ __forceinline__ void na_segment(NaCtx& C, int sg, int lane, const bf16x8 (&kb)[2][2], const bf16x8 (&vb)[4]) {
    const int g = lane >> 4;
    const bool nb = LATENT && sg < C.nnb;
    const int kr = C.krlo + sg;
#pragma unroll
    for (int i = 0; i < 4; ++i) {
        if (nb) { const int ri = C.r0 + i, rsi = ri - 4 < 0 ? 0 : (ri - 4 > 56 ? 56 : ri - 4); if (kr < rsi || kr > rsi + 7) continue; }
        float bv[2][4];
        if (nb) { const unsigned rowoff = (unsigned)((kr - (C.r0 + i) + 7) * 32 * 4);
#pragma unroll
            for (int par = 0; par < 2; ++par)
#pragma unroll
                for (int rg = 0; rg < 4; ++rg) bv[par][rg] = *(const LAS float*)((const LAS char*)C.rpb + rowoff + C.bidx[par][rg]); }
        f32x4 st[2];
#pragma unroll
        for (int par = 0; par < 2; ++par) {
            f32x4 a = nb ? (f32x4){bv[par][0], bv[par][1], bv[par][2], bv[par][3]} : (f32x4){0.f, 0.f, 0.f, 0.f};
#pragma unroll
            for (int s2 = 0; s2 < 2; ++s2) a = __builtin_amdgcn_mfma_f32_16x16x32_bf16(kb[par][s2], C.qa[i][s2], a, 0, 0, 0);
            st[par] = a;
        }
        float mx = fmaxf(fmaxf(fmaxf(st[0][0], st[0][1]), fmaxf(st[0][2], st[0][3])), fmaxf(fmaxf(st[1][0], st[1][1]), fmaxf(st[1][2], st[1][3])));
        mx = na_max4(mx);
        if (__any(mx > C.mrun[i] + 8.f)) {
            const float mnew = fmaxf(C.mrun[i], mx), alpha = __builtin_amdgcn_exp2f(C.mrun[i] - mnew);
            C.lsum[i] *= alpha; C.mrun[i] = mnew;
#pragma unroll
            for (int rg = 0; rg < 4; ++rg) { const float ar = __shfl(alpha, 4 * g + rg);
#pragma unroll
                for (int dt = 0; dt < 4; ++dt) C.o[i][dt][rg] *= ar; }
        }
        float psum = 0.f;
#pragma unroll
        for (int par = 0; par < 2; ++par)
#pragma unroll
            for (int rg = 0; rg < 4; ++rg) { const float p = __builtin_amdgcn_exp2f(st[par][rg] - C.mrun[i]); st[par][rg] = p; psum += p; }
        C.lsum[i] += na_sum4(psum);
        u32x4 pw; pw.x = cvt_pk_bf16(st[0][0], st[0][1]); pw.y = cvt_pk_bf16(st[0][2], st[0][3]); pw.z = cvt_pk_bf16(st[1][0], st[1][1]); pw.w = cvt_pk_bf16(st[1][2], st[1][3]);
        const bf16x8 pa = __builtin_bit_cast(bf16x8, pw);
#pragma unroll
        for (int dt = 0; dt < 4; ++dt) C.o[i][dt] = __builtin_amdgcn_mfma_f32_16x16x32_bf16(pa, vb[dt], C.o[i][dt], 0, 0, 0);
    }
}
#ifndef NA_DRYMODE
#define NA_DRYMODE 0
#endif
template <bool LATENT>
__device__ __forceinline__ void na_unit(Frame& F, int l, int u, const LAS float* rpb_lds, bool dry = false) {
    const int lane = F.lane, q = lane & 15, g = lane >> 4;
    NaCtx C;
    int hh, c0 = 0, qrow0, qstep;
    if (LATENT) { const int cb = u & 3, rg4 = (u >> 2) & 15; hh = (u >> 6) % NH; C.b = u / (64 * NH); c0 = cb * 16; C.r0 = rg4 * 4; qrow0 = C.b * SEQ + C.r0 * GRIDW + c0; qstep = GRIDW;
        const int rs0 = C.r0 - 4 < 0 ? 0 : (C.r0 - 4 > 56 ? 56 : C.r0 - 4), r3 = C.r0 + 3, rs3 = r3 - 4 < 0 ? 0 : (r3 - 4 > 56 ? 56 : r3 - 4);
        C.krlo = rs0; C.nnb = rs3 + 7 - rs0 + 1; }
    else { const int qi = u & 3; hh = (u >> 2) % NH; C.b = u / (4 * NH); qrow0 = TX + C.b * CTXL + qi * 64; qstep = 16; C.r0 = 0; C.krlo = 0; C.nnb = 0; }
    C.cw = c0 == 0 ? 0 : (c0 == 48 ? 32 : c0 - 8);
    const int c = c0 + q; const int start = c - 8 < 0 ? 0 : (c - 8 > 48 ? 48 : c - 8);
    C.rpb = rpb_lds + hh * 15 * 32;
    C.rP = __builtin_amdgcn_make_buffer_rsrc((void*)F.P, 0, (int)((size_t)TT * NP * 2), 0x00020000);
    C.rV = __builtin_amdgcn_make_buffer_rsrc((void*)F.VTA, 0, (int)((size_t)VT_NC * VTS * 2), 0x00020000);
    const int koff = 8 * (q >> 2) + (q & 3);
    C.voffK = (unsigned)((koff * NP + C_NAK + hh * NDH + 8 * g) * 2);
    C.voffV = (unsigned)(((hh * NDH + q) * VTS + 8 * g) * 2);
#pragma unroll
    for (int par = 0; par < 2; ++par)
#pragma unroll
        for (int rg = 0; rg < 4; ++rg) { const int kc = C.cw + 8 * g + rg + 4 * par; const bool valid = (kc >= start) && (kc < start + 16);
            C.bidx[par][rg] = (unsigned)((valid ? kc - c + 15 : 31) * 4); }
#pragma unroll
    for (int i = 0; i < 4; ++i) {
#pragma unroll
        for (int s2 = 0; s2 < 2; ++s2) C.qa[i][s2] = *(const bf16x8*)(F.P + (size_t)(qrow0 + i * qstep + q) * NP + C_NAQ + hh * NDH + 32 * s2 + 8 * g);
        C.mrun[i] = -1e30f; C.lsum[i] = 0.f;
#pragma unroll
        for (int dt = 0; dt < 4; ++dt) C.o[i][dt] = (f32x4){0.f, 0.f, 0.f, 0.f}; }
    const int nseg = C.nnb + 8;
    bf16x8 k0[2][2], v0[4], k1[2][2], v1[4];
    na_load(C, 0, k0, v0);
#pragma unroll 1
    for (int sg = 0; sg < nseg; sg += 2) {
        if (sg + 1 < nseg) na_load(C, sg + 1, k1, v1);
        na_segment<LATENT>(C, sg, lane, k0, v0);
        if (sg + 2 < nseg) na_load(C, sg + 2, k0, v0);
        if (sg + 1 < nseg) na_segment<LATENT>(C, sg + 1, lane, k1, v1);
    }
    bf16* mixb = dry ? (bf16*)F.VTC : F.MIX;
#pragma unroll
    for (int i = 0; i < 4; ++i)
#pragma unroll
        for (int rg = 0; rg < 4; ++rg) { const float li = 1.f / __shfl(C.lsum[i], 4 * g + rg);
            bf16* orow = mixb + (size_t)(dry ? 0 : (qrow0 + i * qstep + 4 * g + rg)) * DM + 384 + hh * NDH + q;
#pragma unroll
            for (int dt = 0; dt < 4; ++dt) orow[16 * dt] = (bf16)f2bf(C.o[i][dt][rg] * li); }
}
__device__ __forceinline__ void ph_attn(Frame& F, int l) {
    const bool need_ctx = l < DEPTH - 1;
    const int gw = F.vcu * NWAVES + F.wave, NGW = F.G * NWAVES;
    LAS float* rpb = (LAS float*)(F.lds + TAB_OFF);
    for (int i = F.tid; i < NH * 15 * 32; i += NTHREADS) { const int col = i & 31, hr = i >> 5; rpb[i] = col < 31 ? F.na_rpb[((size_t)l * NH * 15 + hr) * 31 + col] * NA_LOG2E : -1e30f; }
    __syncthreads();
    for (int rep = 0; rep < REPS(11); ++rep)
    for (int u = F.vcu; u < NB * GH * 2 * 4; u += F.G) gla_g2_unit(F, u);
    const bool bg = !GLA_CHECK;
    if (bg && (F.wave & 1)) convert_items(F, l, 3 * (NE * 16 * 32));
    for (int rep = 0; rep < REPS(12); ++rep) {
    for (int u = gw; u < NB * NH * 16 * 4; u += NGW) na_unit<true>(F, l, u, rpb, rep + 1 < REPS(12));
    if (need_ctx) for (int u = gw; u < NB * NH * 4; u += NGW) na_unit<false>(F, l, u, rpb, rep + 1 < REPS(12)); }
    if (bg && !(F.wave & 1)) convert_items(F, l, 3 * (NE * 16 * 32));
}
constexpr int RW_LD = 1032;
static_assert(2 * NE * RW_LD * 2 <= STAGE_BYTES, "router LDS");
__device__ __forceinline__ unsigned f2key(float f, int e) { unsigned u = __builtin_bit_cast(unsigned, f); u = (u & 0x80000000u) ? ~u : (u | 0x80000000u); return (u & ~31u) | (unsigned)(31 - e); }
__device__ __forceinline__ float key2f(unsigned k) { unsigned u = k & ~31u; u = (u & 0x80000000u) ? (u & 0x7fffffffu) : ~u; return __builtin_bit_cast(float, u); }
__device__ __forceinline__ void ph_router(Frame& F, int l, bool dry = false) {
    const int tid = F.tid, lane = F.lane, q = lane & 15, g = lane >> 4;
    LAS bf16* WH = (LAS bf16*)F.lds; LAS bf16* WL = WH + NE * RW_LD;
    LAS int* lcount = (LAS int*)(F.lds + MISC_OFF + 64 * 4);
    volatile LAS int* lbase = (volatile LAS int*)(F.MISC + 96);
    LAS int* apos = (LAS int*)(F.lds + TAB_OFF);
    const float* rw = F.router_w + (size_t)l * DM * NE;
    for (int i = tid; i < DM * NE; i += NTHREADS) { const int c = i >> 5, e = i & 31; const float w = rw[i]; const unsigned hi = f2bf(w); const unsigned lo = f2bf(w - bf2f(hi));
        WH[e * RW_LD + c] = (bf16)hi; WL[e * RW_LD + c] = (bf16)lo; }
    if (tid < NE) lcount[tid] = 0;
    __syncthreads();
    const int M = (l == DEPTH - 1) ? TX : TT;
    const int per = (M + F.G - 1) / F.G, tok0 = F.vcu * per, tok1 = (tok0 + per < M) ? tok0 + per : M;
    const int ntile = tok1 > tok0 ? (tok1 - tok0 + 15) >> 4 : 0;
    const float* g2w = F.norm2_g + (size_t)l * DM + 8 * g;
    const float rb0 = F.router_b[(size_t)l * NE + q], rb1 = F.router_b[(size_t)l * NE + 16 + q];
    for (int tile = F.wave; tile < ntile; tile += NWAVES) {
        const int tbase = tok0 + 16 * tile, t = tbase + q, tq = t < tok1 ? t : tok1 - 1; const bool valid = t < tok1;
        const float* xr = F.X + (size_t)tq * DM + 8 * g;
        float ss = 0.f;
#pragma unroll 8
        for (int s = 0; s < 32; ++s) { const f32x4 a = *(const f32x4*)(xr + 32 * s), b = *(const f32x4*)(xr + 32 * s + 4); ss += (a.x * a.x + a.y * a.y) + (a.z * a.z + a.w * a.w) + (b.x * b.x + b.y * b.y) + (b.z * b.z + b.w * b.w); }
        { const auto r = __builtin_amdgcn_permlane16_swap(__float_as_uint(ss), __float_as_uint(ss), false, false); ss = __uint_as_float(r[0]) + __uint_as_float(r[1]);
          const auto t = __builtin_amdgcn_permlane32_swap(__float_as_uint(ss), __float_as_uint(ss), false, false); ss = __uint_as_float(t[0]) + __uint_as_float(t[1]); }
        const float rinv = 1.f / sqrtf(ss * (1.f / DM) + EPS);
        const int br = tq < TX ? tq / SEQ : NB;
        const float* md = F.mod + ((size_t)l * 9 + br) * 6 * DM + 8 * g;
        unsigned char* hrow = MOE_FP8 ? F.H8 + (size_t)tq * DM + 8 * g : (unsigned char*)(F.H + (size_t)tq * DM + 8 * g);
        f32x4 acc[2]; acc[0] = (f32x4){0.f, 0.f, 0.f, 0.f}; acc[1] = acc[0];
#pragma unroll 2
        for (int s = 0; s < 32; ++s) { const int c = 32 * s;
            const f32x4 xa = *(const f32x4*)(xr + c), xb = *(const f32x4*)(xr + c + 4), ga = *(const f32x4*)(g2w + c), gb = *(const f32x4*)(g2w + c + 4);
            const f32x4 ca = *(const f32x4*)(md + 4 * DM + c), cb = *(const f32x4*)(md + 4 * DM + c + 4), sa = *(const f32x4*)(md + 3 * DM + c), sb = *(const f32x4*)(md + 3 * DM + c + 4);
            const f32x4 ha = (xa * rinv * ga) * (ca + 1.f) + sa, hb = (xb * rinv * gb) * (cb + 1.f) + sb;
            u32x4 hw; hw.x = cvt_pk_bf16(ha.x, ha.y); hw.y = cvt_pk_bf16(ha.z, ha.w); hw.z = cvt_pk_bf16(hb.x, hb.y); hw.w = cvt_pk_bf16(hb.z, hb.w);
            u32x4 lw; lw.x = cvt_pk_bf16(ha.x - bflo(hw.x), ha.y - bfhi(hw.x)); lw.y = cvt_pk_bf16(ha.z - bflo(hw.y), ha.w - bfhi(hw.y));
            lw.z = cvt_pk_bf16(hb.x - bflo(hw.z), hb.y - bfhi(hw.z)); lw.w = cvt_pk_bf16(hb.z - bflo(hw.w), hb.w - bfhi(hw.w));
            if (valid) { if (MOE_FP8) { u32x2 h8; h8.x = pk4_fp8(ha.x, ha.y, ha.z, ha.w); h8.y = pk4_fp8(hb.x, hb.y, hb.z, hb.w); *(u32x2*)(hrow + c) = h8; } else *(u32x4*)(hrow + 2 * c) = hw; }
            const bf16x8 ah = __builtin_bit_cast(bf16x8, hw), al = __builtin_bit_cast(bf16x8, lw);
#pragma unroll
            for (int tt = 0; tt < 2; ++tt) { const bf16x8 bh = *(const LAS bf16x8*)(WH + (16 * tt + q) * RW_LD + c + 8 * g), bl = *(const LAS bf16x8*)(WL + (16 * tt + q) * RW_LD + c + 8 * g);
                acc[tt] = __builtin_amdgcn_mfma_f32_16x16x32_bf16(ah, bh, acc[tt], 0, 0, 0);
                acc[tt] = __builtin_amdgcn_mfma_f32_16x16x32_bf16(ah, bl, acc[tt], 0, 0, 0);
                acc[tt] = __builtin_amdgcn_mfma_f32_16x16x32_bf16(al, bh, acc[tt], 0, 0, 0); } }
        unsigned k0[4], k1[4], win[4][4];
#pragma unroll
        for (int rg = 0; rg < 4; ++rg) { k0[rg] = f2key(acc[0][rg] + rb0, q); k1[rg] = f2key(acc[1][rg] + rb1, 16 + q); }
#pragma unroll
        for (int k = 0; k < 4; ++k)
#pragma unroll
            for (int rg = 0; rg < 4; ++rg) { const unsigned m = row16_umax(k0[rg] > k1[rg] ? k0[rg] : k1[rg]);
                win[rg][k] = m; if (k0[rg] == m) k0[rg] = 0u; if (k1[rg] == m) k1[rg] = 0u; }
        { const int rsel = q >> 2, ksel = q & 3;
          unsigned w4[4];
#pragma unroll
          for (int k = 0; k < 4; ++k) w4[k] = rsel == 0 ? win[0][k] : rsel == 1 ? win[1][k] : rsel == 2 ? win[2][k] : win[3][k];
          const float v0 = key2f(w4[0]), e1 = __expf(key2f(w4[1]) - v0), e2 = __expf(key2f(w4[2]) - v0), e3 = __expf(key2f(w4[3]) - v0);
          const float inv = 1.f / (1.f + e1 + e2 + e3);
          const float gt = (ksel == 0 ? 1.f : ksel == 1 ? e1 : ksel == 2 ? e2 : e3) * inv;
          const unsigned wk = ksel == 0 ? w4[0] : ksel == 1 ? w4[1] : ksel == 2 ? w4[2] : w4[3];
          const int e = 31 - (int)(wk & 31u), tt2 = tbase + 4 * g + rsel;
          if (tt2 < tok1 && !dry) { F.GATE[(size_t)tt2 * 4 + ksel] = gt;
              const int pos = __hip_atomic_fetch_add(lcount + e, 1, __ATOMIC_RELAXED, __HIP_MEMORY_SCOPE_WORKGROUP);
              apos[(tt2 - tok0) * 4 + ksel] = (e << 16) | pos; } }
    }
    __syncthreads();
    if (dry) return;
    if (tid < NE) lbase[tid] = (int)__hip_atomic_fetch_add(F.ctl + CW_CNT + (l * NE + tid) * 64, (unsigned)__hip_atomic_load(lcount + tid, __ATOMIC_RELAXED, __HIP_MEMORY_SCOPE_WORKGROUP), __ATOMIC_RELAXED, __HIP_MEMORY_SCOPE_AGENT);
    __syncthreads();
    const int nas = (tok1 > tok0 ? (tok1 - tok0) : 0) * 4;
    for (int i = tid; i < nas; i += NTHREADS) { const int w = apos[i], e = w >> 16, pos = w & 0xffff; F.LIST[(size_t)e * TT + lbase[e] + pos] = tok0 * 4 + i; }
    __syncthreads();
}
__device__ __forceinline__ void moe_tables(Frame& F, int l, int npn) {
    volatile LAS int* tp = (volatile LAS int*)(F.MISC + 16);
    LAS int* tab = (LAS int*)(F.lds + TAB_OFF);
    const int tid = F.tid;
    volatile LAS int* eb = (volatile LAS int*)(F.MISC + 128);
    volatile LAS int* cntl = (volatile LAS int*)(F.MISC + 168);
    if (tid == 0) { int acc = 0, sb = 0;
        for (int e = 0; e < NE; ++e) { tp[e] = acc; eb[e] = sb; const int cnt = (int)__hip_atomic_load(F.ctl + CW_CNT + (l * NE + e) * 64, __ATOMIC_RELAXED, __HIP_MEMORY_SCOPE_AGENT); cntl[e] = cnt; acc += (cnt + 255) >> 8; sb += cnt; }
        tp[NE] = acc; }
    __syncthreads();
    if (npn != 8) return;
#pragma unroll 1
    for (int i2 = 0; i2 < MAXU; i2 += 2) {
        const int i = i2 + (tid >> 8), rr = tid & 255;
        g8::Unit u;
        if (i < MAXU && g8::moe_unit((long)i * F.G + F.vcu, npn, tp, u)) {
            const int cnt = (int)__hip_atomic_load(F.ctl + CW_CNT + (l * NE + u.e) * 64, __ATOMIC_RELAXED, __HIP_MEMORY_SCOPE_AGENT);
            const int idx = u.pm * 256 + rr;
            const int a = idx < cnt ? F.LIST[(size_t)u.e * TT + idx] : -1;
            tab[i * 256 + rr] = a;
            if (u.pn == 0 && a >= 0) { F.INV[a] = eb[u.e] + idx; F.GATES[eb[u.e] + idx] = F.GATE[a]; }
        }
    }
    __syncthreads();
}

__global__ void __launch_bounds__(NTHREADS, 2) mk_fwd(Args args) {
    extern __shared__ __attribute__((aligned(16))) unsigned char lds_raw[];
    Frame F;
    F.lds = (LAS unsigned char*)lds_raw;
    F.MISC = (volatile LAS unsigned*)(F.lds + MISC_OFF);
    F.tid = threadIdx.x; F.lane = F.tid & 63; F.wave = __builtin_amdgcn_readfirstlane(F.tid >> 6);
    F.G = gridDim.x; { const int bx = blockIdx.x; F.vcu = (F.G % 8 == 0) ? (bx % 8) * (F.G / 8) + bx / 8 : bx; }
    frame_ptrs(F);
    for (int u = F.tid; u < 256; u += NTHREADS) F.MISC[u] = 0u;
    __syncthreads();
    const int lo = args.ph_lo, hi = args.ph_hi;
    const bool one_launch = (hi - lo) > 1;
    XcdBarrier bar; bar.bar = F.ctl + CW_BAR; bar.x = 0; bar.st = nullptr;
    if (one_launch) bar = xcd_barrier_post(F.ctl + CW_BAR, F.MISC);
#ifndef PHMASK
#define PHMASK 0xFFFFFFFF
#endif
#define IN(k) (lo <= (k) && (k) < hi)
#define PHON(b) ((PHMASK >> (b)) & 1)
#define STAGGER() do { if (STAG_TICKS > 0 && (blockIdx.x & 8)) { const unsigned long long t0_ = __builtin_amdgcn_s_memrealtime(); while (__builtin_amdgcn_s_memrealtime() - t0_ < (unsigned long long)STAG_TICKS) __builtin_amdgcn_s_sleep(8); } } while (0)
#define REFRESH() do { int tz_ = threadIdx.x; asm volatile("" : "+v"(tz_)); F.tid = tz_; F.lane = tz_ & 63; frame_ptrs(F); } while (0)
#define SEAM(k) do { if (IN(k) && IN((k) + 1)) xcd_barrier(bar); } while (0)

    if (PHON(0) && IN(0)) { for (int rep = 0; rep < REPS(0); ++rep) { REFRESH(); ph_prologue(F); } } SEAM(0);
    if (PHON(1) && IN(1)) { REFRESH(); ph_first_norm(F); } SEAM(1);
    for (int l = 0; l < DEPTH; ++l) {
        const int pb = 2 + PPL * l;
        const bool lastl = (l == DEPTH - 1);
        if (PHON(2) && IN(pb + 0)) for (int rep = 0; rep < REPS(2); ++rep) {
            REFRESH(); STAGGER();
            g8::ProbIn Pb{(const char*)F.H, (const char*)(F.Bin + (size_t)l * NP * DM), F.P, F.VTA, F.G, (int)blockIdx.x, (rep + 1 < REPS(2)) ? 1 : 0};
            g8::gemm_phase(F.lds, Pb);
        }
        SEAM(pb + 0);
        if (PHON(3) && IN(pb + 1)) { for (int rep = 0; rep < REPS(3); ++rep) { REFRESH(); ph_prep(F, l); } } SEAM(pb + 1);
        if (PHON(4) && IN(pb + 2)) { for (int rep = 0; rep < REPS(4); ++rep) { REFRESH(); ph_attn(F, l); } } SEAM(pb + 2);
        if (PHON(10) && IN(pb + 3)) { for (int rep = 0; rep < REPS(10); ++rep) { REFRESH(); ph_gla3(F, l); } } SEAM(pb + 3);
        if (PHON(5) && IN(pb + 4)) for (int rep = 0; rep < REPS(5); ++rep) {
            REFRESH(); STAGGER();
            g8::ProbOut Pb{(const char*)F.MIX, (const char*)(F.Bout + (size_t)l * DM * DM), (rep + 1 < REPS(5)) ? (float*)F.ACT : F.X, F.mod + (size_t)l * 9 * 6 * DM, F.G, (int)blockIdx.x, (lastl ? TX : TT) / 256};
            g8::gemm_phase(F.lds, Pb);
        }
        SEAM(pb + 4);
        if (PHON(6) && IN(pb + 5)) { for (int rep = 0; rep < REPS(6); ++rep) { REFRESH(); ph_router(F, l, rep + 1 < REPS(6)); __syncthreads(); } } SEAM(pb + 5);
        if (PHON(7) && IN(pb + 6)) for (int rep = 0; rep < REPS(7); ++rep) {
            REFRESH(); moe_tables(F, l, 8); STAGGER();
            g8::ProbGU Pb{MOE_FP8 ? (const char*)F.H8 : (const char*)F.H, (const char*)F.Bgu + (size_t)l * NE * 2 * DM * DM * (MOE_FP8 ? 1 : 2), (unsigned char*)F.ACT, F.b_gu + (size_t)l * NE * 2 * DM, (volatile LAS int*)(F.MISC + 16), (const LAS int*)(F.lds + TAB_OFF), F.G, F.vcu, (rep + 1 < REPS(7)) ? 1 : 0, (volatile LAS int*)(F.MISC + 128)};
            g8::gemm_phase(F.lds, Pb);
        }
        SEAM(pb + 6);
        if (PHON(8) && IN(pb + 7)) for (int rep = 0; rep < REPS(8); ++rep) {
            REFRESH(); moe_tables(F, l, 4); STAGGER();
            g8::ProbDN Pb{(const char*)F.ACT, (const char*)F.Bdn + (size_t)l * NE * DM * DM * (MOE_FP8 ? 1 : 2), F.YB, F.b_down + (size_t)l * NE * DM, F.GATES, (volatile LAS int*)(F.MISC + 16), F.G, F.vcu, (rep + 1 < REPS(8)) ? 1 : 0, (volatile LAS int*)(F.MISC + 128), (volatile LAS int*)(F.MISC + 168)};
            g8::gemm_phase(F.lds, Pb);
        }
        SEAM(pb + 7);
        if (PHON(9) && IN(pb + 8)) { for (int rep = 0; rep < REPS(9); ++rep) { REFRESH(); ph_combine(F, l, rep + 1 < REPS(9)); } }
        if (!lastl) SEAM(pb + 8);
    }
#undef IN
#undef SEAM
}

extern "C" void kernel_launch(void* const* d_in, const int* in_sizes, int n_in, void* d_out, int out_size, void* d_ws, size_t ws_size, hipStream_t stream) {
    static int grid = 0;
    if (grid == 0) {
        if (n_in != 23 || in_sizes[0] != TX * DM || out_size != TX * DM || ws_size < WS_END) {
            fprintf(stderr, "kernel_launch: unexpected problem (n_in %d, in0 %d, out %d, ws %zu; need ws >= %zu); nothing launched\n", n_in, n_in > 0 ? in_sizes[0] : -1, out_size, ws_size, (size_t)WS_END); grid = -1; return; }
        int dev = 0, cus = 0, per_cu = 0;
        if (hipGetDevice(&dev) != hipSuccess || hipDeviceGetAttribute(&cus, hipDeviceAttributeMultiprocessorCount, dev) != hipSuccess) { fprintf(stderr, "kernel_launch: device query failed\n"); grid = -1; return; }
        if (hipFuncSetAttribute((const void*)mk_fwd, hipFuncAttributeMaxDynamicSharedMemorySize, LDS_BYTES) != hipSuccess) { fprintf(stderr, "kernel_launch: hipFuncSetAttribute failed\n"); grid = -1; return; }
        if (hipOccupancyMaxActiveBlocksPerMultiprocessor(&per_cu, (const void*)mk_fwd, NTHREADS, LDS_BYTES) != hipSuccess || per_cu < 1)
            fprintf(stderr, "kernel_launch: note: occupancy query reports %d workgroups per CU\n", per_cu);
        (void)hipGetLastError();
        grid = cus;
        if ((long)grid * MAXU < (long)(NASG / 256 + NE) * 8) { fprintf(stderr, "kernel_launch: grid %d too small for the MoE unit tables\n", grid); grid = -1; return; }
    }
    if (grid < 0) return;
    if (hipMemsetAsync((char*)d_ws + WS_CTL, 0, CTL_ZERO_BYTES, stream) != hipSuccess) { fprintf(stderr, "kernel_launch: memset failed\n"); return; }
    Args a{};
    for (int i = 0; i < 23; ++i) a.in[i] = (const float*)d_in[i];
    a.out = (float*)d_out; a.ws = (unsigned char*)d_ws;
#if MK_N_LAUNCHES == 1
    a.ph_lo = 0; a.ph_hi = NPHASES;
    hipLaunchKernelGGL(mk_fwd, dim3(grid), dim3(NTHREADS), LDS_BYTES, stream, a);
#else
    for (int p = 0; p < NPHASES; ++p) { a.ph_lo = p; a.ph_hi = p + 1; hipLaunchKernelGGL(mk_fwd, dim3(grid), dim3(NTHREADS), LDS_BYTES, stream, a); }
#endif
    const hipError_t le = hipPeekAtLastError();
    if (le != hipSuccess) fprintf(stderr, "kernel_launch: launch failed: %s\n", hipGetErrorName(le));
}
```

```cpp
#include <hip/hip_runtime.h>
#include <cstdio>
#include <cstdint>
#include <cstddef>

#ifndef MK_N_LAUNCHES
#define MK_N_LAUNCHES 1
#endif

#define GAS __attribute__((address_space(1)))
#define LAS __attribute__((address_space(3)))
typedef unsigned short bf16;
typedef short bf16x8 __attribute__((ext_vector_type(8)));
typedef short bf16x4 __attribute__((ext_vector_type(4)));
typedef float f32x4 __attribute__((ext_vector_type(4)));
typedef float f32x2 __attribute__((ext_vector_type(2)));
typedef unsigned u32x4 __attribute__((ext_vector_type(4)));
typedef unsigned u32x2 __attribute__((ext_vector_type(2)));

constexpr int NB = 8, SEQ = 4096, DM = 1024, CTXL = 256, DEPTH = 4, GRIDW = 64;
constexpr int TX = NB * SEQ, TC = NB * CTXL, TT = TX + TC;
constexpr int NP = 2816;
constexpr int C_NAQ = 0, C_NAK = 384, C_NAV = 768, C_GV = 1152, C_GQ = 1536, C_GK = 1728, C_GG = 1920, C_POOL = 2304, C_AF = 2560, C_AB = 2576;
constexpr int VT_C0 = 768, VT_NC = 768, VTS = TT + 128;
constexpr int NE = 32, TOPK = 4, NASG = TT * TOPK;
constexpr int SLOT_DUMMY = NASG + 256;
constexpr int GH = 4, GDK = 48, GDV = 96, NH = 6, NDH = 64;
constexpr float EPS = 1e-6f;
constexpr int NWAVES = 8, NTHREADS = 512;
constexpr int PPL = 9;
constexpr int NPHASES = 2 + PPL * DEPTH;
#ifndef MOE_FP8
#define MOE_FP8 1
#endif
#ifndef REPMASK
#define REPMASK 0
#endif
#define REPS(b) (1 + ((REPMASK >> (b)) & 1))
#ifndef GLA_CHECK
#define GLA_CHECK 0
#endif

constexpr size_t MiB = 1u << 20;
constexpr size_t WS_CTL = 0, CTL_ZERO_BYTES = 128 * 1024;
constexpr size_t WS_MOD = 2 * MiB;
constexpr size_t WS_BIN = 4 * MiB;
constexpr size_t WS_BOUT = 26 * MiB;
constexpr size_t WS_BGU = 34 * MiB;
constexpr size_t WS_BDN = 546 * MiB;
constexpr size_t WS_X = 802 * MiB;
constexpr size_t WS_H = 938 * MiB;
constexpr size_t WS_P = 1008 * MiB;
constexpr size_t WS_VTX = 1196 * MiB;
constexpr size_t WS_VTC = 1220 * MiB;
constexpr size_t WS_MIX = 1222 * MiB;
constexpr size_t WS_OF = 1290 * MiB;
constexpr size_t WS_OB = 1341 * MiB;
constexpr size_t WS_ACT = 1392 * MiB;
constexpr size_t WS_YB = 1665 * MiB;
constexpr size_t WS_LIST = 1938 * MiB;
constexpr size_t WS_GATE = 1943 * MiB;
constexpr size_t WS_DS = 1944 * MiB;
constexpr size_t WS_GD = 2025 * MiB;
constexpr size_t WS_ROPE = 2026 * MiB;
constexpr size_t WS_VTA = 2027 * MiB;
constexpr size_t WS_OPS = 2080 * MiB;
constexpr size_t WS_STB = 2132 * MiB;
constexpr size_t WS_H8 = 2172 * MiB;
constexpr size_t WS_INV = 2208 * MiB;
constexpr size_t WS_GATES = 2209 * MiB;
constexpr size_t WS_END = 2210 * MiB;
constexpr int CW_BAR = 4096;
constexpr int CW_CNT = 16384;

constexpr int STAGE_BYTES = 132096;
constexpr int MISC_OFF = STAGE_BYTES;
constexpr int TAB_OFF = MISC_OFF + 1024;
constexpr int MAXU = 28;
constexpr int LDS_BYTES = TAB_OFF + MAXU * 1024;
static_assert(LDS_BYTES <= 163840, "LDS");

#define LDS_WAIT() asm volatile("s_waitcnt lgkmcnt(0)" ::: "memory")
#define VM_WAIT() asm volatile("s_waitcnt vmcnt(0)" ::: "memory")
__device__ __forceinline__ unsigned f2bf(float f) { unsigned u = __builtin_bit_cast(unsigned, f); return (u + 0x7fffu + ((u >> 16) & 1u)) >> 16; }
__device__ __forceinline__ unsigned pk2(float lo, float hi) { return f2bf(lo) | (f2bf(hi) << 16); }
__device__ __forceinline__ float bf2f(unsigned b) { return __builtin_bit_cast(float, (b & 0xffffu) << 16); }
__device__ __forceinline__ float bflo(unsigned w) { return __builtin_bit_cast(float, w << 16); }
__device__ __forceinline__ float bfhi(unsigned w) { return __builtin_bit_cast(float, w & 0xffff0000u); }
__device__ __forceinline__ unsigned cvt_pk_bf16(float lo, float hi) { unsigned r; asm volatile("v_cvt_pk_bf16_f32 %0, %1, %2" : "=v"(r) : "v"(lo), "v"(hi)); return r; }
__device__ __forceinline__ unsigned pk4_fp8(float a, float b, float c, float d) { int p = __builtin_amdgcn_cvt_pk_fp8_f32(a, b, 0, false); p = __builtin_amdgcn_cvt_pk_fp8_f32(c, d, p, true); return (unsigned)p; }
constexpr float Y8_SCALE = 16.f, Y8_INV = 1.f / 16.f;
constexpr float W8_SCALE = 64.f, W8_INV = 1.f / 64.f;
template <int CTRL, int RM> __device__ __forceinline__ float dpp_add(float v) { const int t = __builtin_amdgcn_update_dpp(0, __float_as_int(v), CTRL, RM, 0xf, true); return v + __int_as_float(t); }
__device__ __forceinline__ float wave_scan_incl(float x) {
    x = dpp_add<0x111, 0xf>(x); x = dpp_add<0x112, 0xf>(x); x = dpp_add<0x114, 0xf>(x); x = dpp_add<0x118, 0xf>(x);
    x = dpp_add<0x142, 0xa>(x); x = dpp_add<0x143, 0xc>(x); return x;
}
template <int CTRL> __device__ __forceinline__ unsigned dpp_umax(unsigned v) { const unsigned t = (unsigned)__builtin_amdgcn_update_dpp(0, (int)v, CTRL, 0xf, 0xf, true); return t > v ? t : v; }
__device__ __forceinline__ unsigned row16_umax(unsigned v) {
    v = dpp_umax<0xB1>(v); v = dpp_umax<0x4E>(v); v = dpp_umax<0x141>(v); v = dpp_umax<0x140>(v); return v;
}
template <int CTRL> __device__ __forceinline__ float dpp_addp(float v) { const int t = __builtin_amdgcn_update_dpp(0, __float_as_int(v), CTRL, 0xf, 0xf, true); return v + __int_as_float(t); }
__device__ __forceinline__ float wave_sum(float v) {
    v = dpp_addp<0xB1>(v); v = dpp_addp<0x4E>(v); v = dpp_addp<0x141>(v); v = dpp_addp<0x140>(v);
    const auto r = __builtin_amdgcn_permlane16_swap(__float_as_uint(v), __float_as_uint(v), false, false);
    v = __uint_as_float(r[0]) + __uint_as_float(r[1]);
    const auto t = __builtin_amdgcn_permlane32_swap(__float_as_uint(v), __float_as_uint(v), false, false);
    return __uint_as_float(t[0]) + __uint_as_float(t[1]);
}
__device__ __forceinline__ float silu_f(float x) { return x / (1.f + __expf(-x)); }

#define XB_TMO      128
#define XB_XCNT(j)  (256  + 64 * (j))
#define XB_XSUB(j)  (1280 + 64 * (j))
#define XB_XGEN(j)  (2304 + 64 * (j))
#define XB_TOP      3328
#define XB_TOPGEN   3392
#define XCD_BAR_WORDS 3456
#define XB_SPIN_CAP (1u << 18)
__device__ __forceinline__ unsigned xb_ld(unsigned* p)              { return __hip_atomic_load(p, __ATOMIC_RELAXED, __HIP_MEMORY_SCOPE_AGENT); }
__device__ __forceinline__ unsigned xb_add(unsigned* p, unsigned v) { return __hip_atomic_fetch_add(p, v, __ATOMIC_RELAXED, __HIP_MEMORY_SCOPE_AGENT); }
__device__ __forceinline__ unsigned xb_xcc_id() { return (unsigned)__builtin_amdgcn_s_getreg((3 << 11) | 20) & 0xFu; }
#define XB_SPIN(cond, bar) do { unsigned _sp = 0; while (cond) { __builtin_amdgcn_s_sleep(1); \
    if ((++_sp & 255u) == 0u) { if (xb_ld(&(bar)[XB_TMO])) break; if (_sp > XB_SPIN_CAP) { atomicAdd(&(bar)[XB_TMO], 1u); break; } } } } while (0)
struct XcdBarrier { unsigned* bar; unsigned x; volatile LAS unsigned* st; };
__device__ __forceinline__ XcdBarrier xcd_barrier_post(unsigned* bar, volatile LAS unsigned* st) {
    XcdBarrier b; b.bar = bar; b.x = xb_xcc_id(); b.st = st;
    if (threadIdx.x == 0) (void)xb_add(&bar[XB_XCNT(b.x)], 1u);
    return b;
}
__device__ __forceinline__ void xcd_barrier_complete(unsigned* bar, unsigned x, unsigned& nloc, unsigned& nx) {
    const unsigned G = gridDim.x * gridDim.y * gridDim.z;
    unsigned sum, cnt, mine, sp = 0u;
    for (;;) {
        sum = 0u; cnt = 0u; mine = 0u;
#pragma unroll
        for (unsigned j = 0; j < 16; ++j) { const unsigned c = xb_ld(&bar[XB_XCNT(j)]); sum += c; cnt += (c > 0u) ? 1u : 0u; mine = (j == x) ? c : mine; }
        if (sum == G) break;
        __builtin_amdgcn_s_sleep(1);
        if ((++sp & 255u) == 0u) { if (xb_ld(&bar[XB_TMO])) break; if (sp > XB_SPIN_CAP) { atomicAdd(&bar[XB_TMO], 1u); break; } }
    }
    nloc = mine > 0u ? mine : 1u; nx = cnt > 0u ? cnt : 1u;
}
__device__ __forceinline__ void xcd_barrier(const XcdBarrier& b) {
    asm volatile("s_waitcnt vmcnt(0)" ::: "memory");
    __syncthreads();
    if (threadIdx.x == 0) {
        unsigned* bar = b.bar;
        __builtin_amdgcn_s_waitcnt(0);
        unsigned nloc = b.st[0], nx = b.st[1];
        if (nloc == 0u) { xcd_barrier_complete(bar, b.x, nloc, nx); b.st[0] = nloc; b.st[1] = nx; }
        const unsigned old = xb_add(&bar[XB_XSUB(b.x)], 1u);
        const unsigned gen = old / nloc;
        if (old + 1u == (gen + 1u) * nloc) {
            __builtin_amdgcn_fence(__ATOMIC_RELEASE, "agent");
            asm volatile("s_waitcnt vmcnt(0)" ::: "memory");
            const unsigned og = xb_add(&bar[XB_TOP], 1u);
            const unsigned tg = og / nx;
            if (og + 1u == (tg + 1u) * nx) xb_add(&bar[XB_TOPGEN], 1u);
            else XB_SPIN(xb_ld(&bar[XB_TOPGEN]) == tg, bar);
            __builtin_amdgcn_fence(__ATOMIC_ACQUIRE, "agent");
            xb_add(&bar[XB_XGEN(b.x)], 1u);
            asm volatile("s_waitcnt vmcnt(0)" ::: "memory");
        } else {
            XB_SPIN(xb_ld(&bar[XB_XGEN(b.x)]) == gen, bar);
            __builtin_amdgcn_fence(__ATOMIC_ACQUIRE, "agent");
            asm volatile("s_waitcnt vmcnt(0)" ::: "memory");
        }
    }
    __syncthreads();
}

namespace g8 {
constexpr int BM = 256, BK = 64, HALF = 128, HTB = HALF * BK * 2, NXCD = 8, WGM = 8, KD = 1024;
__device__ __forceinline__ int lds_byte(int r, int c) { const int st = (r >> 4) * 2 + (c >> 5), rr = r & 15, cc = c & 31, ob = rr * 64 + cc * 2; return st * 1024 + (ob ^ (((ob >> 9) & 1) << 5)); }
__device__ __forceinline__ void stage_rc(int b, int& R, int& C) { const int st = b / 1024, sb = b % 1024, swz = sb ^ (((sb >> 9) & 1) << 5); R = (st >> 1) * 16 + swz / 64; C = (st & 1) * 32 + (swz % 64) / 2; }
__device__ __forceinline__ int perm32(int rho) { const int n = rho >> 4, i = rho & 15; return 8 * (i >> 2) + 4 * n + (i & 3); }
struct Unit { int pm, pn, e; };
typedef int i32x8 __attribute__((ext_vector_type(8)));
typedef int i32x4 __attribute__((ext_vector_type(4)));
__device__ __forceinline__ i32x8 cat8(bf16x8 a, bf16x8 b) { const i32x4 x = __builtin_bit_cast(i32x4, a), y = __builtin_bit_cast(i32x4, b); return (i32x8){x.x, x.y, x.z, x.w, y.x, y.y, y.z, y.w}; }
__device__ __forceinline__ bool static_unit(long L, int nM, int nN, Unit& u) {
    const int nwg = nM * nN; if (L >= nwg) return false;
    int wgid = (int)L; { const int q = nwg / NXCD, r = nwg % NXCD, xcd = wgid % NXCD, off = wgid / NXCD; wgid = (xcd < r ? xcd * (q + 1) : r * (q + 1) + (xcd - r) * q) + off; }
    const int nig = WGM * nN, gid = wgid / nig, fm = gid * WGM, gsz = (nM - fm) < WGM ? (nM - fm) : WGM;
    u.pm = fm + ((wgid % nig) % gsz); u.pn = (wgid % nig) / gsz; u.e = 0; return true;
}

#ifndef PROBE_DRY
#define PROBE_DRY 0
#endif
#ifndef STAG_TICKS
#define STAG_TICKS 0
#endif
template <class Prob>
__device__ __forceinline__ void gemm_phase(LAS unsigned char* lds, const Prob& P) {

    int tid_ = threadIdx.x; asm volatile("" : "+v"(tid_));
    const int tid = tid_, wid = __builtin_amdgcn_readfirstlane(tid >> 6), lane = tid & 63, wr = wid >> 2, wc = wid & 3, fr = lane & 15, fq = lane >> 4;
    constexpr int RPB = Prob::FP8 ? KD : KD * 2, nt = RPB / (BK * 2);
    unsigned voffB[2];
    { int R0, C0, R1, C1; stage_rc(tid * 16, R0, C0); stage_rc(tid * 16 + 8192, R1, C1); const int Rb0 = Prob::PERM ? ((R0 & ~31) + perm32(R0 & 31)) : R0, Rb1 = Prob::PERM ? ((R1 & ~31) + perm32(R1 & 31)) : R1;
      voffB[0] = (unsigned)(Rb0 * RPB + C0 * 2); voffB[1] = (unsigned)(Rb1 * RPB + C1 * 2); }
    const size_t kstep = (size_t)(BK * 2), hstepB = (size_t)HALF * RPB;
    const unsigned ldsw = (unsigned)wid * 1024u;
    const int aoff = lds_byte(wr * 64 + fr, fq * 8), boff = lds_byte(wc * 32 + fr, fq * 8);
#define G8_SA(b, h) (((b) * 2 + (h)) * HTB)
#define G8_SB(b, h) ((4 + (b) * 2 + (h)) * HTB)
#define G8_STAGE(bufoff, gbase, voff) do { _Pragma("unroll") for (int _i = 0; _i < 2; ++_i) \
        __builtin_amdgcn_global_load_lds((const unsigned*)((const char*)(gbase) + (voff)[_i]), (LAS unsigned*)(lds + (bufoff) + ldsw + _i * 8192), 16, 0, 0); } while (0)
#define G8_LDA(dst, b, h) do { _Pragma("unroll") for (int m = 0; m < 4; ++m) _Pragma("unroll") for (int k = 0; k < 2; ++k) dst[m][k] = *(const LAS bf16x8*)(lds + G8_SA(b, h) + aoff + m * 2048 + k * 1024); } while (0)
#define G8_LDB(dst, b, h) do { _Pragma("unroll") for (int n = 0; n < 2; ++n) _Pragma("unroll") for (int k = 0; k < 2; ++k) dst[n][k] = *(const LAS bf16x8*)(lds + G8_SB(b, h) + boff + n * 2048 + k * 1024); } while (0)
#define G8_MMA(ai, bj, At, Bt) do { __builtin_amdgcn_s_setprio(1); if constexpr (Prob::FP8) { \
        _Pragma("unroll") for (int m = 0; m < 4; ++m) _Pragma("unroll") for (int n = 0; n < 2; ++n) \
        acc[ai][bj][m][n] = __builtin_amdgcn_mfma_scale_f32_16x16x128_f8f6f4(cat8(Bt[n][0], Bt[n][1]), cat8(At[m][0], At[m][1]), acc[ai][bj][m][n], 0, 0, 0, 0x7f7f7f7f, 0, 0x7f7f7f7f); } else { \
        _Pragma("unroll") for (int m = 0; m < 4; ++m) _Pragma("unroll") for (int n = 0; n < 2; ++n) _Pragma("unroll") for (int k = 0; k < 2; ++k) \
        acc[ai][bj][m][n] = __builtin_amdgcn_mfma_f32_16x16x32_bf16(Bt[n][k], At[m][k], acc[ai][bj][m][n], 0, 0, 0); } __builtin_amdgcn_s_setprio(0); } while (0)
#define G8_WAIT_V(n) asm volatile("s_waitcnt vmcnt(" #n ")" ::: "memory")
#define G8_WAIT_L(n) asm volatile("s_waitcnt lgkmcnt(" #n ")" ::: "memory")
#define G8_BAR __builtin_amdgcn_s_barrier()
#define G8_SCHED __builtin_amdgcn_sched_barrier(0)
    Unit cur, nxt; int ui = 0;
    if (!P.next(0, cur)) return;
    f32x4 acc[2][2][4][2];
#pragma unroll
    for (int a = 0; a < 2; ++a)
#pragma unroll
        for (int b = 0; b < 2; ++b)
#pragma unroll
            for (int m = 0; m < 4; ++m)
#pragma unroll
                for (int n = 0; n < 2; ++n) acc[a][b][m][n] = (f32x4){0.f, 0.f, 0.f, 0.f};
    bf16x8 At[4][2], B0[2][2], B1[2][2];
    unsigned cvA[2][2];
    P.a_off(cur, 0, tid, cvA);
    const char* cA = P.a_base(cur);
    const char* cB = P.b_ptr(cur);
    G8_STAGE(G8_SB(0, 0), cB, voffB); G8_STAGE(G8_SB(0, 1), cB + hstepB, voffB); G8_STAGE(G8_SA(0, 0), cA, cvA[0]); G8_STAGE(G8_SA(0, 1), cA, cvA[1]);
    if (wr == 1) G8_BAR;
    G8_WAIT_V(2); G8_BAR;
    G8_STAGE(G8_SB(1, 0), cB + kstep, voffB); G8_STAGE(G8_SA(1, 0), cA + kstep, cvA[0]); G8_STAGE(G8_SB(1, 1), cB + hstepB + kstep, voffB);
    G8_WAIT_V(6); G8_BAR;
    for (;;) {
        const bool has_next = P.next(ui + 1, nxt);
        const char* nB = has_next ? P.b_ptr(nxt) : cB;
        const char* nA = has_next ? P.a_base(nxt) : cA;
        for (int t = 0; t < nt; t += 2) {
            const bool last = (t == nt - 2);
            const char* a1 = cA + (size_t)(t + 1) * kstep;
            const char* a2 = last ? nA : cA + (size_t)(t + 2) * kstep; const char* b2 = last ? nB : cB + (size_t)(t + 2) * kstep;
            const char* a3 = a2 + kstep; const char* b3 = b2 + kstep;
            G8_LDB(B0, 0, 0); G8_LDB(B1, 0, 1); G8_SCHED; G8_LDA(At, 0, 0); G8_STAGE(G8_SA(1, 1), a1, cvA[1]);
            G8_WAIT_V(8); G8_WAIT_L(0); G8_BAR; G8_MMA(0, 0, At, B0); G8_MMA(0, 1, At, B1); G8_BAR; G8_SCHED;
            if (last && has_next) { int tz = threadIdx.x; asm volatile("" : "+v"(tz)); P.a_off(nxt, ui + 1, tz, cvA); }
            G8_LDA(At, 0, 1); G8_STAGE(G8_SB(0, 0), b2, voffB); G8_STAGE(G8_SB(0, 1), b2 + hstepB, voffB); G8_STAGE(G8_SA(0, 0), a2, cvA[0]);
            G8_WAIT_V(8); G8_WAIT_L(0); G8_BAR; G8_MMA(1, 0, At, B0); G8_MMA(1, 1, At, B1); G8_BAR; G8_SCHED;
            G8_LDB(B0, 1, 0); G8_LDB(B1, 1, 1); G8_SCHED; G8_LDA(At, 1, 0); G8_STAGE(G8_SA(0, 1), a2, cvA[1]);
            G8_WAIT_V(8); G8_WAIT_L(0); G8_BAR; G8_MMA(0, 0, At, B0); G8_MMA(0, 1, At, B1); G8_BAR; G8_SCHED;
            G8_LDA(At, 1, 1); G8_STAGE(G8_SB(1, 0), b3, voffB); G8_STAGE(G8_SB(1, 1), b3 + hstepB, voffB); G8_STAGE(G8_SA(1, 0), a3, cvA[0]);
            G8_WAIT_V(8); G8_WAIT_L(0); G8_BAR; G8_MMA(1, 0, At, B0); G8_MMA(1, 1, At, B1); G8_BAR; G8_SCHED;
        }
        if (wr == 0) G8_BAR;
        P.epi(acc, cur, ui, wr, wc, fr, fq);
        if (!has_next) break;
#pragma unroll
        for (int a = 0; a < 2; ++a)
#pragma unroll
            for (int b = 0; b < 2; ++b)
#pragma unroll
                for (int m = 0; m < 4; ++m)
#pragma unroll
                    for (int n = 0; n < 2; ++n) acc[a][b][m][n] = (f32x4){0.f, 0.f, 0.f, 0.f};
        cur = nxt; cB = nB; cA = nA; ++ui;
        if (wr == 1) G8_BAR;
    }
    G8_WAIT_V(0);
    G8_BAR;
#undef G8_SA
#undef G8_SB
#undef G8_STAGE
#undef G8_LDA
#undef G8_LDB
#undef G8_MMA
#undef G8_WAIT_V
#undef G8_WAIT_L
#undef G8_BAR
#undef G8_SCHED
}


struct ProbIn {
    static constexpr bool PERM = true, FP8 = false;
    const char* A; const char* Bt; bf16* O; bf16* VT; int G, c; int dry;
    __device__ __forceinline__ static bool swapped(const Unit& u) { return u.pn >= 3 && u.pn <= 5; }
    __device__ __forceinline__ bool next(int i, Unit& u) const { return static_unit((long)i * G + c, TT / 256, NP / 256, u); }
    __device__ __forceinline__ void a_off(const Unit& u, int, int tid, unsigned (&v)[2][2]) const {
        int R0, C0, R1, C1; stage_rc(tid * 16, R0, C0); stage_rc(tid * 16 + 8192, R1, C1);
        const int rt = swapped(u) ? u.pn : u.pm;
#pragma unroll
        for (int h = 0; h < 2; ++h) { v[h][0] = (unsigned)((rt * 256 + h * 128 + R0) * KD + C0) * 2u; v[h][1] = (unsigned)((rt * 256 + h * 128 + R1) * KD + C1) * 2u; }
    }
    __device__ __forceinline__ const char* a_base(const Unit& u) const { return swapped(u) ? Bt : A; }
    __device__ __forceinline__ const char* b_ptr(const Unit& u) const { return swapped(u) ? A + (size_t)u.pm * 256 * KD * 2 : Bt + (size_t)u.pn * 256 * KD * 2; }
    __device__ __forceinline__ void epi(const f32x4 (&acc)[2][2][4][2], const Unit& u, int, int wr, int wc, int fr, int fq) const {
        if (PROBE_DRY && dry) { asm volatile("" :: "v"(acc[0][0][0][0][0]), "v"(acc[1][1][3][1][3]), "v"(acc[0][1][2][0][1]), "v"(acc[1][0][1][1][2])); return; }
        const bool sw = swapped(u);
        bf16* base = sw ? VT + (size_t)(u.pn * 256 - VT_C0 + wr * 64 + fr) * VTS + u.pm * 256 + wc * 32 + 8 * fq
                        : O + (size_t)(u.pm * 256 + wr * 64 + fr) * NP + u.pn * 256 + wc * 32 + 8 * fq;
        const size_t ld = sw ? (size_t)VTS : (size_t)NP;
#pragma unroll
        for (int ai = 0; ai < 2; ++ai)
#pragma unroll
            for (int m = 0; m < 4; ++m) { bf16* rowp = base + (size_t)(ai * 128 + m * 16) * ld;
#pragma unroll
                for (int bj = 0; bj < 2; ++bj) { const f32x4 v0 = acc[ai][bj][m][0], v1 = acc[ai][bj][m][1];
                    u32x4 w; w.x = cvt_pk_bf16(v0[0], v0[1]); w.y = cvt_pk_bf16(v0[2], v0[3]); w.z = cvt_pk_bf16(v1[0], v1[1]); w.w = cvt_pk_bf16(v1[2], v1[3]);
                    *(u32x4*)(rowp + bj * 128) = w; } }
    }
};
struct ProbOut {
    static constexpr bool PERM = false, FP8 = false;
    const char* A; const char* Bt; float* X; const float* modl  ; int G, c, nM;
    __device__ __forceinline__ bool next(int i, Unit& u) const { return static_unit((long)i * G + c, nM, DM / 256, u); }
    __device__ __forceinline__ void a_off(const Unit& u, int, int tid, unsigned (&v)[2][2]) const {
        int R0, C0, R1, C1; stage_rc(tid * 16, R0, C0); stage_rc(tid * 16 + 8192, R1, C1);
#pragma unroll
        for (int h = 0; h < 2; ++h) { v[h][0] = (unsigned)((u.pm * 256 + h * 128 + R0) * KD + C0) * 2u; v[h][1] = (unsigned)((u.pm * 256 + h * 128 + R1) * KD + C1) * 2u; }
    }
    __device__ __forceinline__ const char* a_base(const Unit&) const { return A; }
    __device__ __forceinline__ const char* b_ptr(const Unit& u) const { return Bt + (size_t)u.pn * 256 * KD * 2; }
    __device__ __forceinline__ void epi(const f32x4 (&acc)[2][2][4][2], const Unit& u, int, int wr, int wc, int fr, int fq) const {
        const int r0 = u.pm * 256, br = r0 < TX ? (r0 / SEQ) : NB;
        const float* g1 = modl + (size_t)br * 6 * DM + 2 * DM;
        const int row0 = r0 + wr * 64 + fr, col0 = u.pn * 256 + wc * 32 + 4 * fq;
        f32x4 gv[2][2];
#pragma unroll
        for (int bj = 0; bj < 2; ++bj)
#pragma unroll
            for (int n = 0; n < 2; ++n) gv[bj][n] = *(const f32x4*)(g1 + col0 + bj * 128 + n * 16);
#pragma unroll
        for (int ai = 0; ai < 2; ++ai) {
            f32x4 xv[4][2][2];
#pragma unroll
            for (int m = 0; m < 4; ++m)
#pragma unroll
                for (int bj = 0; bj < 2; ++bj)
#pragma unroll
                    for (int n = 0; n < 2; ++n) xv[m][bj][n] = *(const f32x4*)(X + (size_t)(row0 + ai * 128 + m * 16) * DM + col0 + bj * 128 + n * 16);
#pragma unroll
            for (int m = 0; m < 4; ++m)
#pragma unroll
                for (int bj = 0; bj < 2; ++bj)
#pragma unroll
                    for (int n = 0; n < 2; ++n) *(f32x4*)(X + (size_t)(row0 + ai * 128 + m * 16) * DM + col0 + bj * 128 + n * 16) = xv[m][bj][n] + gv[bj][n] * acc[ai][bj][m][n];
        }
    }
};
__device__ __forceinline__ bool moe_unit(long L, int npn, const volatile LAS int* tp, Unit& u) {
    const int q = (int)(L / npn); if (q >= tp[NE]) return false;
    int e = 0;
#pragma unroll 1
    while (tp[e + 1] <= q) ++e;
    u.e = e; u.pm = q - tp[e]; u.pn = (int)(L % npn); return true;
}
struct ProbGU {
    static constexpr bool PERM = true, FP8 = (MOE_FP8 != 0); static constexpr unsigned EB = FP8 ? 1u : 2u;
    const char* A; const char* Bt  ; unsigned char* ACT; const float* bgu  ; const volatile LAS int* tp; const LAS int* tab; int G, c; int dry; const volatile LAS int* eb;
    __device__ __forceinline__ bool next(int i, Unit& u) const { return i < MAXU && moe_unit((long)i * G + c, 8, tp, u); }
    __device__ __forceinline__ void a_off(const Unit&, int ui, int tid, unsigned (&v)[2][2]) const {
        int R0, C0, R1, C1; stage_rc(tid * 16, R0, C0); stage_rc(tid * 16 + 8192, R1, C1);
#pragma unroll
        for (int h = 0; h < 2; ++h) { const int a0 = tab[ui * 256 + h * 128 + R0], a1 = tab[ui * 256 + h * 128 + R1];
            v[h][0] = (unsigned)(a0 < 0 ? TT : (a0 >> 2)) * (unsigned)KD * EB + (unsigned)C0 * 2u; v[h][1] = (unsigned)(a1 < 0 ? TT : (a1 >> 2)) * (unsigned)KD * EB + (unsigned)C1 * 2u; }
    }
    __device__ __forceinline__ const char* a_base(const Unit&) const { return A; }
    __device__ __forceinline__ const char* b_ptr(const Unit& u) const { return Bt + ((size_t)u.e * 2 * DM + (size_t)u.pn * 256) * KD * EB; }
    __device__ __forceinline__ void epi(const f32x4 (&acc)[2][2][4][2], const Unit& u, int ui, int wr, int wc, int fr, int fq) const {
        if (PROBE_DRY && dry) { asm volatile("" :: "v"(acc[0][0][0][0][0]), "v"(acc[1][1][3][1][3]), "v"(acc[0][1][2][0][1]), "v"(acc[1][0][1][1][2])); return; }
        const int cb = u.pn * 128 + wc * 32 + 8 * fq;
        const float* bg = bgu + (size_t)u.e * 2 * DM + cb; const float* bu = bg + DM;
        const f32x4 bg0 = *(const f32x4*)bg, bg1 = *(const f32x4*)(bg + 4), bu0 = *(const f32x4*)bu, bu1 = *(const f32x4*)(bu + 4);
        const int ebu = eb[u.e] + u.pm * 256;
#pragma unroll
        for (int ai = 0; ai < 2; ++ai)
#pragma unroll
            for (int m = 0; m < 4; ++m) {
                const int a = tab[ui * 256 + ai * 128 + wr * 64 + m * 16 + fr];
                unsigned char* rowp = ACT + ((size_t)(a < 0 ? SLOT_DUMMY : ebu + ai * 128 + wr * 64 + m * 16 + fr) * DM + cb) * EB;
                float o[8];
#pragma unroll
                for (int n = 0; n < 2; ++n) { const f32x4 gb = n ? bg1 : bg0, ub = n ? bu1 : bu0;
#pragma unroll
                    for (int j = 0; j < 4; ++j) { float g = acc[ai][0][m][n][j] * (FP8 ? W8_INV : 1.f) + gb[j], uu = acc[ai][1][m][n][j] * (FP8 ? W8_INV : 1.f) + ub[j];
                        g = fminf(g, 7.f); uu = fminf(fmaxf(uu, -7.f), 7.f);
                        o[n * 4 + j] = g * __builtin_amdgcn_rcpf(1.f + __expf(-1.702f * g)) * (uu + 1.f); } }
                if constexpr (FP8) { u32x2 w; w.x = pk4_fp8(o[0], o[1], o[2], o[3]); w.y = pk4_fp8(o[4], o[5], o[6], o[7]); *(u32x2*)rowp = w; }
                else { u32x4 w; w.x = cvt_pk_bf16(o[0], o[1]); w.y = cvt_pk_bf16(o[2], o[3]); w.z = cvt_pk_bf16(o[4], o[5]); w.w = cvt_pk_bf16(o[6], o[7]); *(u32x4*)rowp = w; } }
    }
};
struct ProbDN {
    static constexpr bool PERM = true, FP8 = (MOE_FP8 != 0); static constexpr unsigned EB = FP8 ? 1u : 2u;
    const char* A; const char* Bt  ; bf16* YB; const float* bdn  ; const float* gates  ; const volatile LAS int* tp; int G, c; int dry; const volatile LAS int* eb; const volatile LAS int* cntl;
    __device__ __forceinline__ bool next(int i, Unit& u) const { return i < MAXU && moe_unit((long)i * G + c, 4, tp, u); }
    __device__ __forceinline__ void a_off(const Unit& u, int, int tid, unsigned (&v)[2][2]) const {
        int R0, C0, R1, C1; stage_rc(tid * 16, R0, C0); stage_rc(tid * 16 + 8192, R1, C1);
        const int r0 = eb[u.e] + u.pm * 256;
#pragma unroll
        for (int h = 0; h < 2; ++h) { v[h][0] = (unsigned)(r0 + h * 128 + R0) * (unsigned)KD * EB + (unsigned)C0 * 2u; v[h][1] = (unsigned)(r0 + h * 128 + R1) * (unsigned)KD * EB + (unsigned)C1 * 2u; }
    }
    __device__ __forceinline__ const char* a_base(const Unit&) const { return A; }
    __device__ __forceinline__ const char* b_ptr(const Unit& u) const { return Bt + ((size_t)u.e * DM + (size_t)u.pn * 256) * KD * EB; }
    __device__ __forceinline__ void epi(const f32x4 (&acc)[2][2][4][2], const Unit& u, int ui, int wr, int wc, int fr, int fq) const {
        if (PROBE_DRY && dry) { asm volatile("" :: "v"(acc[0][0][0][0][0]), "v"(acc[1][1][3][1][3]), "v"(acc[0][1][2][0][1]), "v"(acc[1][0][1][1][2])); return; }
        const int col0 = u.pn * 256 + wc * 32 + 8 * fq;
        const float* bd = bdn + (size_t)u.e * DM + col0;
        f32x4 bv[2][2];
#pragma unroll
        for (int bj = 0; bj < 2; ++bj)
#pragma unroll
            for (int n = 0; n < 2; ++n) bv[bj][n] = *(const f32x4*)(bd + bj * 128 + 4 * n);
        int sl[2][4]; float gt[2][4]; const int ebu = eb[u.e] + u.pm * 256, nval = cntl[u.e] - u.pm * 256;
#pragma unroll
        for (int ai = 0; ai < 2; ++ai)
#pragma unroll
            for (int m = 0; m < 4; ++m) { const int rl = ai * 128 + wr * 64 + m * 16 + fr; sl[ai][m] = rl < nval ? ebu + rl : SLOT_DUMMY; gt[ai][m] = gates[sl[ai][m]]; }
#pragma unroll
        for (int ai = 0; ai < 2; ++ai)
#pragma unroll
            for (int m = 0; m < 4; ++m) {
                if constexpr (FP8) {
                    unsigned char* rowp = (unsigned char*)YB + (size_t)sl[ai][m] * DM + col0;
#pragma unroll
                    for (int bj = 0; bj < 2; ++bj) { const f32x4 v0 = (acc[ai][bj][m][0] * W8_INV + bv[bj][0]) * (gt[ai][m] * Y8_SCALE), v1 = (acc[ai][bj][m][1] * W8_INV + bv[bj][1]) * (gt[ai][m] * Y8_SCALE);
                        u32x2 w; w.x = pk4_fp8(v0[0], v0[1], v0[2], v0[3]); w.y = pk4_fp8(v1[0], v1[1], v1[2], v1[3]); *(u32x2*)(rowp + bj * 128) = w; }
                } else {
                    bf16* rowp = YB + (size_t)sl[ai][m] * DM + col0;
#pragma unroll
                    for (int bj = 0; bj < 2; ++bj) { const f32x4 v0 = (acc[ai][bj][m][0] + bv[bj][0]) * gt[ai][m], v1 = (acc[ai][bj][m][1] + bv[bj][1]) * gt[ai][m];
                        u32x4 w; w.x = cvt_pk_bf16(v0[0], v0[1]); w.y = cvt_pk_bf16(v0[2], v0[3]); w.z = cvt_pk_bf16(v1[0], v1[1]); w.w = cvt_pk_bf16(v1[2], v1[3]);
                        *(u32x4*)(rowp + bj * 128) = w; }
                } }
    }
};
}

struct Args { const float* in[23]; float* out; unsigned char* ws; int ph_lo, ph_hi; };
struct Frame {
    LAS unsigned char* lds; volatile LAS unsigned* MISC;
    int tid, lane, wave, G, vcu;
    const float *x, *c, *ctx, *c_ctx, *norm1_g, *norm2_g, *w_ada, *b_ada, *w_in, *gla_wa2, *gla_ba, *gla_norm_g, *na_rpb, *pool_w, *pool_scale, *w_out, *router_w, *router_b, *w_gu, *b_gu, *w_down, *b_down, *final_g;
    float* out; unsigned char* ws; unsigned* ctl;
    float* mod; bf16 *Bin, *Bout, *Bgu, *Bdn; float* X; bf16 *H, *P, *VTX, *VTC, *MIX; float *OF, *OB; bf16 *ACT, *YB; int* LIST; float* GATE; float *DS, *GD, *ROPE; bf16 *VTA, *OPS, *STB; unsigned char* H8; int* INV; float* GATES;
};


#define CAS __attribute__((address_space(4)))
__device__ __forceinline__ void frame_ptrs(Frame& F) {
    const CAS unsigned char* ka = (const CAS unsigned char*)__builtin_amdgcn_kernarg_segment_ptr();
    asm volatile("" : "+s"(ka));
    typedef const GAS float* gfp;
    const CAS gfp* in = (const CAS gfp*)ka;
    F.x = (const float*)in[0]; F.c = (const float*)in[1]; F.ctx = (const float*)in[2]; F.c_ctx = (const float*)in[3]; F.norm1_g = (const float*)in[4]; F.norm2_g = (const float*)in[5];
    F.w_ada = (const float*)in[6]; F.b_ada = (const float*)in[7]; F.w_in = (const float*)in[8]; F.gla_wa2 = (const float*)in[9]; F.gla_ba = (const float*)in[10]; F.gla_norm_g = (const float*)in[11];
    F.na_rpb = (const float*)in[12]; F.pool_w = (const float*)in[13]; F.pool_scale = (const float*)in[14]; F.w_out = (const float*)in[15]; F.router_w = (const float*)in[16]; F.router_b = (const float*)in[17];
    F.w_gu = (const float*)in[18]; F.b_gu = (const float*)in[19]; F.w_down = (const float*)in[20]; F.b_down = (const float*)in[21]; F.final_g = (const float*)in[22];
    F.out = (float*)*(GAS float* const CAS*)(ka + 184);
    GAS unsigned char* ws = *(GAS unsigned char* const CAS*)(ka + 192);
    F.ws = (unsigned char*)ws; F.ctl = (unsigned*)(ws + WS_CTL);
    F.mod = (float*)(ws + WS_MOD); F.Bin = (bf16*)(ws + WS_BIN); F.Bout = (bf16*)(ws + WS_BOUT); F.Bgu = (bf16*)(ws + WS_BGU); F.Bdn = (bf16*)(ws + WS_BDN);
    F.X = (float*)(ws + WS_X); F.H = (bf16*)(ws + WS_H); F.P = (bf16*)(ws + WS_P); F.VTX = (bf16*)(ws + WS_VTX); F.VTC = (bf16*)(ws + WS_VTC); F.MIX = (bf16*)(ws + WS_MIX);
    F.OF = (float*)(ws + WS_OF); F.OB = (float*)(ws + WS_OB); F.ACT = (bf16*)(ws + WS_ACT); F.YB = (bf16*)(ws + WS_YB); F.LIST = (int*)(ws + WS_LIST); F.GATE = (float*)(ws + WS_GATE);
    F.DS = (float*)(ws + WS_DS); F.GD = (float*)(ws + WS_GD); F.ROPE = (float*)(ws + WS_ROPE); F.VTA = (bf16*)(ws + WS_VTA); F.OPS = (bf16*)(ws + WS_OPS); F.STB = (bf16*)(ws + WS_STB); F.H8 = (unsigned char*)(ws + WS_H8); F.INV = (int*)(ws + WS_INV); F.GATES = (float*)(ws + WS_GATES);
}
static_assert(offsetof(Args, out) == 184 && offsetof(Args, ws) == 192, "Args layout");

__device__ __forceinline__ void in_col_map(int n0, int& dst, float& scale) {
    scale = 1.f;
    if (n0 < 192) { dst = C_GQ + n0; scale = 0.14433756729740643f; }
    else if (n0 < 384) dst = C_GK + (n0 - 192);
    else if (n0 < 768) dst = C_GV + (n0 - 384);
    else if (n0 < 800) dst = C_AF + (n0 - 768);
    else if (n0 < 1184) dst = C_GG + (n0 - 800);
    else if (n0 < 1568) { dst = C_NAQ + (n0 - 1184); scale = 0.125f * 1.4426950408889634f; }
    else if (n0 < 1952) dst = C_NAK + (n0 - 1568);
    else if (n0 < 2336) dst = C_NAV + (n0 - 1952);
    else dst = C_POOL + (n0 - 2336);
}
struct TItem { const float* src; int N; unsigned char* dst; int fp8; float scale; };
__device__ __forceinline__ TItem titem_decode(const Frame& F, int r) {
    constexpr int I_IN = DEPTH * 16 * 81, I_OUT = DEPTH * 16 * 32, I_GU = DEPTH * NE * 16 * 64;
    TItem t; t.fp8 = 0; t.scale = 1.f;
    if (r < I_IN) { const int l = r / (16 * 81), rr = r % (16 * 81), kb = rr / 81, nb = rr % 81; int dst; in_col_map(nb * 32, dst, t.scale);
        t.N = 2592; t.src = F.w_in + (size_t)l * DM * 2592 + (size_t)(kb * 64) * 2592 + nb * 32; t.dst = (unsigned char*)(F.Bin + ((size_t)l * NP + dst) * DM + kb * 64); return t; }
    r -= I_IN;
    if (r < I_OUT) { const int l = r / (16 * 32), rr = r % (16 * 32), kb = rr / 32, nb = rr % 32;
        t.N = DM; t.src = F.w_out + (size_t)l * DM * DM + (size_t)(kb * 64) * DM + nb * 32; t.dst = (unsigned char*)(F.Bout + ((size_t)l * DM + nb * 32) * DM + kb * 64); return t; }
    r -= I_OUT; t.fp8 = MOE_FP8; constexpr size_t EB = MOE_FP8 ? 1 : 2;
    if (r < I_GU) { const int le = r / (16 * 64), rr = r % (16 * 64), kb = rr / 64, nb = rr % 64; const int j0 = nb * 32;
        const int dst = j0 < DM ? (j0 / 128) * 256 + (j0 % 128) : ((j0 - DM) / 128) * 256 + 128 + ((j0 - DM) % 128);
        t.N = 2 * DM; t.src = F.w_gu + (size_t)le * DM * 2 * DM + (size_t)(kb * 64) * 2 * DM + j0; t.dst = (unsigned char*)F.Bgu + (((size_t)le * 2 * DM + dst) * DM + kb * 64) * EB; return t; }
    r -= I_GU;
    { const int le = r / (16 * 32), rr = r % (16 * 32), kb = rr / 32, nb = rr % 32;
        t.N = DM; t.src = F.w_down + (size_t)le * DM * DM + (size_t)(kb * 64) * DM + nb * 32; t.dst = (unsigned char*)F.Bdn + (((size_t)le * DM + nb * 32) * DM + kb * 64) * EB; return t; }
}
__device__ __forceinline__ void titem_load(const TItem& t, int lane, f32x4 (&r)[8]) {
#pragma unroll
    for (int i = 0; i < 8; ++i) r[i] = *(const f32x4*)(t.src + (size_t)((lane >> 3) + 8 * i) * t.N + 4 * (lane & 7));
}
__device__ __forceinline__ void titem_store(const TItem& t, const f32x4 (&r)[8], LAS float* scr, int lane) {
#pragma unroll
    for (int i = 0; i < 8; ++i) { LAS float* p = scr + ((lane >> 3) + 8 * i) * 33 + 4 * (lane & 7); p[0] = r[i].x; p[1] = r[i].y; p[2] = r[i].z; p[3] = r[i].w; }
    LDS_WAIT(); asm volatile("" ::: "memory");
    if (t.fp8) { const int c = lane & 3; const float sc = W8_SCALE;
#pragma unroll
        for (int j = 0; j < 2; ++j) { const int n = (lane >> 2) + 16 * j; const LAS float* s = scr + (16 * c) * 33 + n;
            u32x4 o;
            o.x = pk4_fp8(s[0 * 33] * sc, s[1 * 33] * sc, s[2 * 33] * sc, s[3 * 33] * sc); o.y = pk4_fp8(s[4 * 33] * sc, s[5 * 33] * sc, s[6 * 33] * sc, s[7 * 33] * sc);
            o.z = pk4_fp8(s[8 * 33] * sc, s[9 * 33] * sc, s[10 * 33] * sc, s[11 * 33] * sc); o.w = pk4_fp8(s[12 * 33] * sc, s[13 * 33] * sc, s[14 * 33] * sc, s[15 * 33] * sc);
            *(u32x4*)(t.dst + (size_t)n * DM + 16 * c) = o; }
    } else { const int c = lane & 7; const float sc = t.scale;
#pragma unroll
        for (int j = 0; j < 4; ++j) { const int n = (lane >> 3) + 8 * j; const LAS float* s = scr + (8 * c) * 33 + n;
            u32x4 o; o.x = pk2(s[0 * 33] * sc, s[1 * 33] * sc); o.y = pk2(s[2 * 33] * sc, s[3 * 33] * sc); o.z = pk2(s[4 * 33] * sc, s[5 * 33] * sc); o.w = pk2(s[6 * 33] * sc, s[7 * 33] * sc);
            *(u32x4*)(t.dst + ((size_t)n * DM + 8 * c) * 2) = o; }
    }
    LDS_WAIT(); asm volatile("" ::: "memory");
}
__device__ __forceinline__ int conv_item_id(int t, int lay, int nfix) {
    constexpr int I_IN = DEPTH * 16 * 81, I_OUT = DEPTH * 16 * 32, I_GU = DEPTH * NE * 16 * 64;
    if (t < nfix) return t;
    t -= nfix;
    return t < NE * 16 * 64 ? I_IN + I_OUT + lay * (NE * 16 * 64) + t : I_IN + I_OUT + I_GU + lay * (NE * 16 * 32) + (t - NE * 16 * 64);
}
__device__ __forceinline__ void convert_items(Frame& F, int lay, int ntot, int t0 = 0, int t1 = -1) {
    LAS float* scr = (LAS float*)(F.lds + F.wave * 16384);
    const int gw = F.vcu * NWAVES + F.wave, NGW = F.G * NWAVES, lane = F.lane;
    const int nfix = ntot - 3 * (NE * 16 * 32);
    if (t1 >= 0) ntot = t1;
    int it = t0 + gw; TItem cur = titem_decode(F, conv_item_id(it < ntot ? it : 0, lay, nfix)); f32x4 ra[8];
    if (it < ntot) titem_load(cur, lane, ra);
    while (it < ntot) {
        const int itn = it + NGW; const bool hn = itn < ntot;
        TItem nxt = titem_decode(F, conv_item_id(hn ? itn : 0, lay, nfix)); f32x4 rb[8];
        if (hn) titem_load(nxt, lane, rb);
        titem_store(cur, ra, scr, lane);
        it = itn; cur = nxt;
#pragma unroll
        for (int i = 0; i < 8; ++i) ra[i] = rb[i];
    }
}
__device__ __forceinline__ void ph_prologue(Frame& F) {
    const int gw = F.vcu * NWAVES + F.wave, NGW = F.G * NWAVES, lane = F.lane;
    constexpr int I_IN = DEPTH * 16 * 81, I_OUT = DEPTH * 16 * 32;
    for (int r = F.vcu; r < DEPTH * 24; r += F.G) {
        const int l = r / 24, j4 = (r % 24) * 256 + 4 * lane, k0 = F.wave * 128;
        const float* W = F.w_ada + (size_t)l * DM * 6 * DM + (size_t)k0 * 6 * DM + j4;
        f32x4 acc[9];
#pragma unroll
        for (int q = 0; q < 9; ++q) acc[q] = (f32x4){0.f, 0.f, 0.f, 0.f};
#pragma unroll 1
        for (int kh = 0; kh < 2; ++kh) {
            float cv[9];
#pragma unroll
            for (int q = 0; q < 8; ++q) cv[q] = silu_f(F.c[q * DM + k0 + 64 * kh + lane]);
            cv[8] = silu_f(F.c_ctx[k0 + 64 * kh + lane]);
#pragma unroll 8
            for (int kk = 0; kk < 64; ++kk) { const f32x4 w = *(const f32x4*)(W + (size_t)(64 * kh + kk) * 6 * DM);
#pragma unroll
                for (int q = 0; q < 9; ++q) acc[q] += __builtin_bit_cast(float, __builtin_amdgcn_readlane(__builtin_bit_cast(int, cv[q]), kk)) * w; }
        }
        LAS float* part = (LAS float*)F.lds;
#pragma unroll
        for (int q = 0; q < 9; ++q) *(LAS f32x4*)(part + (F.wave * 9 + q) * 256 + 4 * lane) = acc[q];
        __syncthreads();
        for (int o = F.tid; o < 9 * 256; o += NTHREADS) { const int q = o >> 8, cc = o & 255; float sum = F.b_ada[(size_t)l * 6 * DM + (r % 24) * 256 + cc];
#pragma unroll
            for (int w = 0; w < NWAVES; ++w) sum += part[(w * 9 + q) * 256 + cc];
            F.mod[((size_t)l * 9 + q) * 6 * DM + (r % 24) * 256 + cc] = sum; }
        __syncthreads();
    }
    convert_items(F, 0, I_IN + I_OUT + 3 * (NE * 16 * 32), 0, I_IN + I_OUT);
#if GLA_CHECK
    for (int lay = 0; lay < DEPTH; ++lay) convert_items(F, lay, 3 * (NE * 16 * 32));
#endif
    if (F.vcu == 0) for (int i = F.tid; i < 64 * 12; i += NTHREADS) { const int pos = i / 12, fi = i % 12;
        const float invf = expf(-((float)(2 * fi) / 24.f) * 9.210340371976184f); const float ang = (float)pos * invf; F.ROPE[i] = cosf(ang); F.ROPE[768 + i] = sinf(ang); }
    const size_t gt = (size_t)F.vcu * NTHREADS + F.tid, NGT = (size_t)F.G * NTHREADS;
    for (size_t i = gt; i < (size_t)DEPTH * 224 * DM / 8; i += NGT) { const size_t l = i / (224 * DM / 8), rr = i % (224 * DM / 8);
        *(u32x4*)(F.Bin + (l * NP + 2592) * DM + rr * 8) = (u32x4){0u, 0u, 0u, 0u}; }
    for (size_t i = gt; i < (size_t)256 * DM / 8; i += NGT) *(u32x4*)(F.H + (size_t)TT * DM + i * 8) = (u32x4){0u, 0u, 0u, 0u};
    for (size_t i = gt; i < (size_t)256 * DM / 16; i += NGT) *(u32x4*)(F.H8 + (size_t)TT * DM + i * 16) = (u32x4){0u, 0u, 0u, 0u};
}

__device__ __forceinline__ void norm_mod_store(const f32x4 (&v)[4], const float* gw, const float* sc, const float* sh, bf16* orow, int lane) {
    float s = 0.f;
#pragma unroll
    for (int j = 0; j < 4; ++j) s += (v[j].x * v[j].x + v[j].y * v[j].y) + (v[j].z * v[j].z + v[j].w * v[j].w);
    const float rinv = 1.f / sqrtf(wave_sum(s) * (1.f / DM) + EPS);
#pragma unroll
    for (int j = 0; j < 4; ++j) { const int c = 4 * lane + 256 * j;
        const f32x4 g = *(const f32x4*)(gw + c), a = *(const f32x4*)(sc + c), b = *(const f32x4*)(sh + c);
        const f32x4 y = (v[j] * rinv * g) * (a + 1.f) + b;
        u32x2 w; w.x = pk2(y.x, y.y); w.y = pk2(y.z, y.w);
        *(u32x2*)(orow + c) = w; }
}
__device__ __forceinline__ void ph_first_norm(Frame& F) {
    const int gw = F.vcu * NWAVES + F.wave, NGW = F.G * NWAVES, lane = F.lane;
    for (int m = gw; m < TT; m += NGW) {
        const float* src = m < TX ? F.x + (size_t)m * DM : F.ctx + (size_t)(m - TX) * DM;
        const int br = m < TX ? m / SEQ : NB;
        f32x4 v[4];
#pragma unroll
        for (int j = 0; j < 4; ++j) { v[j] = *(const f32x4*)(src + 4 * lane + 256 * j); *(f32x4*)(F.X + (size_t)m * DM + 4 * lane + 256 * j) = v[j]; }
        const float* md = F.mod + (size_t)br * 6 * DM;
        norm_mod_store(v, F.norm1_g, md + DM, md, F.H + (size_t)m * DM, lane);
    }
}
__device__ __forceinline__ void ph_combine(Frame& F, int l, bool dry = false) {
    const int gw = F.vcu * NWAVES + F.wave, NGW = F.G * NWAVES, lane = F.lane;
    float* Xo = dry ? (float*)F.ACT : F.X; bf16* Ho = dry ? (bf16*)F.P : F.H; float* Oo = dry ? (float*)F.ACT : F.out;
    const int M = (l == DEPTH - 1) ? TX : TT;
    const int cA = 8 * lane, cB = 512 + 8 * lane;
    for (int m0 = gw; m0 < M; m0 += 2 * NGW) {
        u32x4 yw[2][4][2]; f32x4 xv[2][4]; bool have[2]; int br[2];
#pragma unroll
        for (int rr = 0; rr < 2; ++rr) { const int m = m0 + rr * NGW; have[rr] = m < M; const int mm = have[rr] ? m : m0; br[rr] = mm < TX ? mm / SEQ : NB;
            const u32x4 sl4 = *(const u32x4*)(F.INV + (size_t)mm * 4); const unsigned slk[4] = {sl4.x, sl4.y, sl4.z, sl4.w};
#pragma unroll
            for (int k = 0; k < 4; ++k) {
                if (MOE_FP8) { const unsigned char* yr = (const unsigned char*)F.YB + (size_t)slk[k] * DM; const u32x2 a = *(const u32x2*)(yr + cA), b = *(const u32x2*)(yr + cB);
                    yw[rr][k][0] = (u32x4){a.x, a.y, 0u, 0u}; yw[rr][k][1] = (u32x4){b.x, b.y, 0u, 0u}; }
                else { yw[rr][k][0] = *(const u32x4*)(F.YB + (size_t)slk[k] * DM + cA); yw[rr][k][1] = *(const u32x4*)(F.YB + (size_t)slk[k] * DM + cB); } }
            const float* xr = F.X + (size_t)mm * DM;
            xv[rr][0] = *(const f32x4*)(xr + cA); xv[rr][1] = *(const f32x4*)(xr + cA + 4); xv[rr][2] = *(const f32x4*)(xr + cB); xv[rr][3] = *(const f32x4*)(xr + cB + 4); }
#pragma unroll
        for (int rr = 0; rr < 2; ++rr) { if (!have[rr]) continue;
            const int m = m0 + rr * NGW;
            const float* md = F.mod + ((size_t)l * 9 + br[rr]) * 6 * DM;
            f32x4 y[4];
#pragma unroll
            for (int j = 0; j < 4; ++j) y[j] = (f32x4){0.f, 0.f, 0.f, 0.f};
#pragma unroll
            for (int k = 0; k < 4; ++k) { const u32x4 a = yw[rr][k][0], b = yw[rr][k][1];
                if (MOE_FP8) { const f32x2 a0 = __builtin_amdgcn_cvt_pk_f32_fp8((int)a.x, false), a1 = __builtin_amdgcn_cvt_pk_f32_fp8((int)a.x, true), a2 = __builtin_amdgcn_cvt_pk_f32_fp8((int)a.y, false), a3 = __builtin_amdgcn_cvt_pk_f32_fp8((int)a.y, true);
                    const f32x2 b0 = __builtin_amdgcn_cvt_pk_f32_fp8((int)b.x, false), b1 = __builtin_amdgcn_cvt_pk_f32_fp8((int)b.x, true), b2 = __builtin_amdgcn_cvt_pk_f32_fp8((int)b.y, false), b3 = __builtin_amdgcn_cvt_pk_f32_fp8((int)b.y, true);
                    y[0] += (f32x4){a0.x, a0.y, a1.x, a1.y}; y[1] += (f32x4){a2.x, a2.y, a3.x, a3.y}; y[2] += (f32x4){b0.x, b0.y, b1.x, b1.y}; y[3] += (f32x4){b2.x, b2.y, b3.x, b3.y}; }
                else { y[0] += (f32x4){bflo(a.x), bfhi(a.x), bflo(a.y), bfhi(a.y)}; y[1] += (f32x4){bflo(a.z), bfhi(a.z), bflo(a.w), bfhi(a.w)};
                    y[2] += (f32x4){bflo(b.x), bfhi(b.x), bflo(b.y), bfhi(b.y)}; y[3] += (f32x4){bflo(b.z), bfhi(b.z), bflo(b.w), bfhi(b.w)}; } }
            if (MOE_FP8) {
#pragma unroll
                for (int j = 0; j < 4; ++j) y[j] *= Y8_INV; }
            const int cc[4] = {cA, cA + 4, cB, cB + 4};
            f32x4 v[4]; float ss = 0.f;
#pragma unroll
            for (int j = 0; j < 4; ++j) { v[j] = xv[rr][j] + *(const f32x4*)(md + 5 * DM + cc[j]) * y[j]; ss += (v[j].x * v[j].x + v[j].y * v[j].y) + (v[j].z * v[j].z + v[j].w * v[j].w); }
            const float rinv = 1.f / sqrtf(wave_sum(ss) * (1.f / DM) + EPS);
            if (l < DEPTH - 1) {
#pragma unroll
                for (int j = 0; j < 4; ++j) *(f32x4*)(Xo + (size_t)m * DM + cc[j]) = v[j];
                const float* mn = F.mod + ((size_t)(l + 1) * 9 + br[rr]) * 6 * DM; const float* gw1 = F.norm1_g + (size_t)(l + 1) * DM;
                f32x4 h[4];
#pragma unroll
                for (int j = 0; j < 4; ++j) h[j] = (v[j] * rinv * *(const f32x4*)(gw1 + cc[j])) * (*(const f32x4*)(mn + DM + cc[j]) + 1.f) + *(const f32x4*)(mn + cc[j]);
                u32x4 w0, w1; w0.x = pk2(h[0].x, h[0].y); w0.y = pk2(h[0].z, h[0].w); w0.z = pk2(h[1].x, h[1].y); w0.w = pk2(h[1].z, h[1].w);
                w1.x = pk2(h[2].x, h[2].y); w1.y = pk2(h[2].z, h[2].w); w1.z = pk2(h[3].x, h[3].y); w1.w = pk2(h[3].z, h[3].w);
                *(u32x4*)(Ho + (size_t)m * DM + cA) = w0; *(u32x4*)(Ho + (size_t)m * DM + cB) = w1;
            } else {
#pragma unroll
                for (int j = 0; j < 4; ++j) { f32x4 o = v[j] * rinv * *(const f32x4*)(F.final_g + cc[j]);
#if GLA_CHECK
                    if (__hip_atomic_load(F.ctl + 64, __ATOMIC_RELAXED, __HIP_MEMORY_SCOPE_AGENT) != 0u) { const float q = __builtin_nanf(""); o = (f32x4){q, q, q, q}; }
#endif
                    *(f32x4*)(Oo + (size_t)m * DM + cc[j]) = o; }
            }
        }
    }
}

constexpr int PL_U = 0, PL_P = 49152, PL_LD = 264, PREP_PW = 81920, PW_LD = 72, PREP_PS = PREP_PW + 4 * 64 * PW_LD * 2;
static_assert(PREP_PS + 1024 <= STAGE_BYTES && PL_P + 32 * PL_LD * 2 <= PREP_PW, "pool LDS map");
__device__ __forceinline__ void pool_unit(Frame& F, int l, int u) {
    LAS float* U = (LAS float*)(F.lds + PL_U);
    LAS bf16* PL = (LAS bf16*)(F.lds + PL_P);
    const LAS bf16* PW = (const LAS bf16*)(F.lds + PREP_PW); const LAS float* PS = (const LAS float*)(F.lds + PREP_PS);
    const int tid = F.tid;
    int s, tb, seqbase, tlen;
    if (u < NB * 128) { s = u / 128; tb = u % 128; seqbase = s * SEQ; tlen = SEQ; } else { const int v = u - NB * 128; s = v / 8; tb = v % 8; seqbase = TX + s * CTXL; tlen = CTXL; }
    const int t0 = tb * 32;
    for (int i = tid; i < 48 * 32; i += NTHREADS) { const int rr = i / 32, ch = i % 32, t = t0 - 8 + rr;
        f32x4 a = (f32x4){0.f, 0.f, 0.f, 0.f}, b = a;
        if (t >= 0 && t < tlen) { const u32x4 w = *(const u32x4*)(F.P + (size_t)(seqbase + t) * NP + C_POOL + ch * 8);
            a = (f32x4){bflo(w.x), bfhi(w.x), bflo(w.y), bfhi(w.y)}; b = (f32x4){bflo(w.z), bfhi(w.z), bflo(w.w), bfhi(w.w)}; }
        *(LAS f32x4*)(U + rr * 256 + ch * 8) = a; *(LAS f32x4*)(U + rr * 256 + ch * 8 + 4) = b; }
    __syncthreads();
    { const int tt = tid >> 4, cg = tid & 15, g = cg >> 2, w = 2 << g, t = t0 + tt;
      int lo = t - w / 2; if (lo < 0) lo = 0; int hi = t + w - w / 2; if (hi > tlen) hi = tlen;
      const float inv = 1.f / (float)(hi - lo);
      f32x4 sum[4];
#pragma unroll
      for (int q4 = 0; q4 < 4; ++q4) sum[q4] = (f32x4){0.f, 0.f, 0.f, 0.f};
      for (int jj = lo; jj < hi; ++jj) {
#pragma unroll
          for (int q4 = 0; q4 < 4; ++q4) sum[q4] += *(const LAS f32x4*)(U + (jj - t0 + 8) * 256 + cg * 16 + 4 * q4); }
      u32x4 w0, w1;
      { const f32x4 y0 = sum[0] * inv - *(const LAS f32x4*)(U + (tt + 8) * 256 + cg * 16), y1 = sum[1] * inv - *(const LAS f32x4*)(U + (tt + 8) * 256 + cg * 16 + 4);
        const f32x4 y2 = sum[2] * inv - *(const LAS f32x4*)(U + (tt + 8) * 256 + cg * 16 + 8), y3 = sum[3] * inv - *(const LAS f32x4*)(U + (tt + 8) * 256 + cg * 16 + 12);
        w0.x = pk2(y0.x, y0.y); w0.y = pk2(y0.z, y0.w); w0.z = pk2(y1.x, y1.y); w0.w = pk2(y1.z, y1.w);
        w1.x = pk2(y2.x, y2.y); w1.y = pk2(y2.z, y2.w); w1.z = pk2(y3.x, y3.y); w1.w = pk2(y3.z, y3.w); }
      *(LAS u32x4*)(PL + tt * PL_LD + cg * 16) = w0; *(LAS u32x4*)(PL + tt * PL_LD + cg * 16 + 8) = w1; }
    __syncthreads();
    { const int lane = F.lane, q = lane & 15, g4 = lane >> 4;
#pragma unroll
      for (int k = 0; k < 4; ++k) { const int ti = F.wave * 4 + k, mt = ti & 1, ct = ti >> 1, g = ct >> 2, ot = ct & 3;
          f32x4 acc = (f32x4){0.f, 0.f, 0.f, 0.f};
#pragma unroll
          for (int s2 = 0; s2 < 2; ++s2) { const bf16x8 a = *(const LAS bf16x8*)(PW + (g * 64 + 16 * ot + q) * PW_LD + 32 * s2 + 8 * g4), b = *(const LAS bf16x8*)(PL + (16 * mt + q) * PL_LD + g * 64 + 32 * s2 + 8 * g4);
              acc = __builtin_amdgcn_mfma_f32_16x16x32_bf16(a, b, acc, 0, 0, 0); }
          const f32x4 y = acc * *(const LAS f32x4*)(PS + g * 64 + 16 * ot + 4 * g4);
          u32x2 w; w.x = pk2(y.x, y.y); w.y = pk2(y.z, y.w);
          *(u32x2*)(F.MIX + (size_t)(seqbase + t0 + 16 * mt + q) * DM + 768 + g * 64 + 16 * ot + 4 * g4) = w; } }
    __syncthreads();
}
#if GLA_CHECK
__device__ __forceinline__ void gla_chain(Frame& F, int l, int u) {
    const int tid = F.tid;
    const int dir = u & 1, hh = (u >> 1) & 3, b = u >> 3;
    LAS float* qs = (LAS float*)F.lds;
    LAS float* ks = qs + 64 * 48;
    LAS float* as = ks + 64 * 48;
    LAS float* vs = as + 64 * 48;
    LAS float* os = vs + 64 * 96;
    LAS float* rc = os + 64 * 96;
    LAS float* rs = rc + 64 * 12;
    LAS float* wa = rs + 64 * 12;
    LAS float* ba = wa + 16 * 48;
    for (int i = tid; i < 64 * 12; i += NTHREADS) { const int pos = i / 12, fi = i % 12;
        const float invf = expf(-((float)(2 * fi) / 24.f) * 9.210340371976184f);
        const float ang = (float)pos * invf; rc[i] = cosf(ang); rs[i] = sinf(ang); }
    for (int i = tid; i < 16 * 48; i += NTHREADS) { const int r = i / 48, d = i % 48; wa[i] = F.gla_wa2[(((size_t)l * 2 + dir) * 16 + r) * 192 + hh * 48 + d]; }
    if (tid < 48) ba[tid] = F.gla_ba[((size_t)l * 2 + dir) * 192 + hh * 48 + tid];
    __syncthreads();
    float S[12];
#pragma unroll
    for (int i = 0; i < 12; ++i) S[i] = 0.f;
    const int vv = tid >> 2, dg = tid & 3;
    float* Odir = dir ? F.OB : F.OF;
    const bool need_ctx = l < DEPTH - 1;
    for (int cidx = 0; cidx < 4 + 64; ++cidx) {
        const bool isctx = cidx < 4;
        const int nch = isctx ? 4 : 64, ci0 = isctx ? cidx : cidx - 4, ci = dir ? (nch - 1 - ci0) : ci0;
        const int seqbase = isctx ? TX + b * CTXL : b * SEQ, t0 = ci * 64;
        for (int i = tid; i < 64 * 2 * 2 * 12; i += NTHREADS) {
            const int fi = i % 12, hf = (i / 12) & 1, isk = (i / 24) & 1, j = i / 48;
            const bf16* row = F.P + (size_t)(seqbase + t0 + j) * NP + (isk ? C_GK : C_GQ) + hh * 48 + hf * 24;
            const float x1 = bf2f(row[fi]), x2 = bf2f(row[12 + fi]);
            float o1 = x1, o2 = x2;
            if (!isctx) { const int t = t0 + j, pos = hf ? (t % GRIDW) : (t / GRIDW); const float cs = rc[pos * 12 + fi], sn = rs[pos * 12 + fi]; o1 = x1 * cs - x2 * sn; o2 = x1 * sn + x2 * cs; }
            LAS float* dst = (isk ? ks : qs) + j * 48 + hf * 24;
            dst[fi] = o1; dst[12 + fi] = o2; }
        for (int i = tid; i < 64 * 48; i += NTHREADS) { const int j = i / 48, d = i % 48;
            const bf16* row = F.P + (size_t)(seqbase + t0 + j) * NP + (dir ? C_AB : C_AF);
            float z = ba[d];
#pragma unroll
            for (int r = 0; r < 16; ++r) z += bf2f(row[r]) * wa[r * 48 + d];
            const float ls = fminf(z, 0.f) - log1pf(expf(-fabsf(z)));
            as[i] = expf(ls * (1.f / 16.f)); }
        for (int i = tid; i < 64 * 96; i += NTHREADS) { const int j = i / 96, d = i % 96; vs[i] = bf2f(F.VTA[(size_t)(384 + hh * 96 + d) * VTS + seqbase + t0 + j]); }
        __syncthreads();
        if (tid < 384) {
            for (int st = 0; st < 64; ++st) {
                const int j = dir ? 63 - st : st;
                const float vj = vs[j * 96 + vv];
                float part = 0.f;
#pragma unroll
                for (int q4 = 0; q4 < 3; ++q4) {
                    const f32x4 a4 = *(const LAS f32x4*)(as + j * 48 + dg * 12 + q4 * 4), k4 = *(const LAS f32x4*)(ks + j * 48 + dg * 12 + q4 * 4), qq = *(const LAS f32x4*)(qs + j * 48 + dg * 12 + q4 * 4);
#pragma unroll
                    for (int e = 0; e < 4; ++e) { const float sn = a4[e] * S[q4 * 4 + e] + k4[e] * vj; S[q4 * 4 + e] = sn; part += qq[e] * sn; } }
                part += __shfl_xor(part, 1); part += __shfl_xor(part, 2);
                if (dg == 0) os[j * 96 + vv] = part;
            }
        }
        __syncthreads();
        if (!isctx || need_ctx)
            for (int i = tid; i < 64 * 96; i += NTHREADS) { const int j = i / 96, d = i % 96; Odir[(size_t)(seqbase + t0 + j) * 384 + hh * 96 + d] = os[i]; }
        __syncthreads();
    }
}

#endif
typedef float f32x16 __attribute__((ext_vector_type(16)));
constexpr int GL_BF = 0, GL_BB = 12288, GL_WA = 24576, GL_VT = 31232, GL_KEF = 45056, GL_KEB = 51968;
constexpr int GL_QF = 45056, GL_KF = 52224, GL_QB = 59392, GL_KB = 66560, GL_STF = 73728, GL_STB = 84480, GL_O = 95232;
constexpr int VT_LD = 72, QK_LD = 56, ST_LD = 56, O_LD = 100, NCH = 68;
struct GlaU { int b, hh, cpos, seqbase, t0, isctx; };
__device__ __forceinline__ GlaU gla_unit_geom(int u) { GlaU g; g.cpos = u % NCH; g.hh = (u / NCH) & 3; g.b = u / (NCH * 4); g.isctx = g.cpos < 4;
    const int ci = g.isctx ? g.cpos : g.cpos - 4; g.seqbase = g.isctx ? TX + g.b * CTXL : g.b * SEQ; g.t0 = ci * 64; return g; }
__device__ __forceinline__ void gla_rope_pair(const Frame& F, const GlaU& g, const bf16* row, int j, int hf, int fi, float& o1, float& o2) {
    const float x1 = bf2f(row[fi]), x2 = bf2f(row[12 + fi]); o1 = x1; o2 = x2;
    if (!g.isctx) { const int t = g.t0 + j, pos = hf ? (t % GRIDW) : (t / GRIDW); const float cs = F.ROPE[pos * 12 + fi], sn = F.ROPE[768 + pos * 12 + fi]; o1 = x1 * cs - x2 * sn; o2 = x1 * sn + x2 * cs; }
}
constexpr int G1_BF = 0, G1_BB = 12288, G1_KEF = 24576, G1_KEB = 31488, G1_OPS = 38400;
constexpr int PREP_WA = TAB_OFF;
__device__ __forceinline__ void gla_g1_unit(Frame& F, int l, int u) {
    const GlaU g = gla_unit_geom(u);
    LAS bf16* kef = (LAS bf16*)(F.lds + G1_KEF); LAS bf16* keb = (LAS bf16*)(F.lds + G1_KEB); LAS bf16* ops = (LAS bf16*)(F.lds + G1_OPS);
    const LAS float* wa = (const LAS float*)(F.lds + PREP_WA) + g.hh * 1536; const LAS float* ba = (const LAS float*)(F.lds + PREP_WA) + 6144 + g.hh * 96;
    const bf16* vtg = F.VTA + (size_t)(384 + g.hh * 96) * VTS + g.seqbase + g.t0;
    const int tid = F.tid, lane = F.lane, j = lane, w = F.wave;
    const bf16* prow = F.P + (size_t)(g.seqbase + g.t0 + j) * NP;
    u32x4 araw[4];
#pragma unroll
    for (int q4 = 0; q4 < 4; ++q4) araw[q4] = *(const u32x4*)(prow + C_AF + 8 * q4);
    float q1[3], q2[3], k1[3], k2[3], cs[3], sn[3];
#pragma unroll
    for (int e = 0; e < 3; ++e) { const int p = 3 * w + e, hf = p / 12, fi = p % 12, cb = g.hh * 48 + hf * 24 + fi;
        q1[e] = bf2f(prow[C_GQ + cb]); q2[e] = bf2f(prow[C_GQ + cb + 12]); k1[e] = bf2f(prow[C_GK + cb]); k2[e] = bf2f(prow[C_GK + cb + 12]);
        const int t = g.t0 + j, pos = hf ? (t % GRIDW) : (t / GRIDW);
        cs[e] = g.isctx ? 1.f : F.ROPE[pos * 12 + fi]; sn[e] = g.isctx ? 0.f : F.ROPE[768 + pos * 12 + fi]; }
    float a[32];
#pragma unroll
    for (int q4 = 0; q4 < 4; ++q4) { const u32x4 x = araw[q4]; a[q4 * 8 + 0] = bflo(x.x); a[q4 * 8 + 1] = bfhi(x.x); a[q4 * 8 + 2] = bflo(x.y); a[q4 * 8 + 3] = bfhi(x.y);
        a[q4 * 8 + 4] = bflo(x.z); a[q4 * 8 + 5] = bfhi(x.z); a[q4 * 8 + 6] = bflo(x.w); a[q4 * 8 + 7] = bfhi(x.w); }
    float bf[3][2], bb[3][2];
#pragma unroll
    for (int e = 0; e < 3; ++e)
#pragma unroll
        for (int wh = 0; wh < 2; ++wh) { const int p = 3 * w + e, d = (p / 12) * 24 + p % 12 + 12 * wh;
            float zf = ba[d], zb = ba[48 + d];
#pragma unroll
            for (int r = 0; r < 16; ++r) { zf += a[r] * wa[r * 48 + d]; zb += a[16 + r] * wa[(16 + r) * 48 + d]; }
            const float xf = (fminf(zf, 0.f) - __logf(1.f + __expf(-fabsf(zf)))) * (1.f / 16.f), xb = (fminf(zb, 0.f) - __logf(1.f + __expf(-fabsf(zb)))) * (1.f / 16.f);
            bf[e][wh] = wave_scan_incl(xf);
            const float ab = wave_scan_incl(xb);
            bb[e][wh] = __int_as_float(__builtin_amdgcn_readlane(__float_as_int(ab), 63)) - ab + xb; }
#pragma unroll
    for (int e = 0; e < 3; ++e) { const int p = 3 * w + e, d1 = (p / 12) * 24 + p % 12, d2 = d1 + 12;
        const float qa = q1[e] * cs[e] - q2[e] * sn[e], qb = q1[e] * sn[e] + q2[e] * cs[e], ka = k1[e] * cs[e] - k2[e] * sn[e], kb = k1[e] * sn[e] + k2[e] * cs[e];
        const float f1 = bf[e][0], f2 = bf[e][1], b1 = bb[e][0], b2 = bb[e][1];
        const float fe1 = __builtin_bit_cast(float, __builtin_amdgcn_readlane(__builtin_bit_cast(int, f1), 63)), fe2 = __builtin_bit_cast(float, __builtin_amdgcn_readlane(__builtin_bit_cast(int, f2), 63));
        const float be1 = __builtin_bit_cast(float, __builtin_amdgcn_readlane(__builtin_bit_cast(int, b1), 0)), be2 = __builtin_bit_cast(float, __builtin_amdgcn_readlane(__builtin_bit_cast(int, b2), 0));
        const float ef1 = __expf(f1), ef2 = __expf(f2), eb1 = __expf(b1), eb2 = __expf(b2), nf1 = __expf(-f1), nf2 = __expf(-f2), nb1 = __expf(-b1), nb2 = __expf(-b2);
        ops[j * 48 + d1] = (bf16)f2bf(qa * ef1); ops[j * 48 + d2] = (bf16)f2bf(qb * ef2); ops[3072 + j * 48 + d1] = (bf16)f2bf(ka * nf1); ops[3072 + j * 48 + d2] = (bf16)f2bf(kb * nf2);
        ops[6144 + j * 48 + d1] = (bf16)f2bf(qa * eb1); ops[6144 + j * 48 + d2] = (bf16)f2bf(qb * eb2); ops[9216 + j * 48 + d1] = (bf16)f2bf(ka * nb1); ops[9216 + j * 48 + d2] = (bf16)f2bf(kb * nb2);
        const float ge1 = __expf(fe1), ge2 = __expf(fe2), he1 = __expf(be1), he2 = __expf(be2);
        kef[d1 * VT_LD + j] = (bf16)f2bf(ka * nf1 * ge1); kef[d2 * VT_LD + j] = (bf16)f2bf(kb * nf2 * ge2);
        keb[d1 * VT_LD + j] = (bf16)f2bf(ka * nb1 * he1); keb[d2 * VT_LD + j] = (bf16)f2bf(kb * nb2 * he2);
        if (lane == 0) { float* gd = F.GD + (((size_t)(g.b * 4 + g.hh) * 2) * NCH + g.cpos) * 48; gd[d1] = ge1; gd[d2] = ge2; gd[(size_t)NCH * 48 + d1] = he1; gd[(size_t)NCH * 48 + d2] = he2; } }
    __syncthreads();
    { const int q = lane & 15, g4 = lane >> 4;
      for (int ti = F.wave; ti < 36; ti += NWAVES) { const int dir = ti / 18, dt = (ti % 18) / 6, vtile = ti % 6;
          const LAS bf16* ke = dir ? keb : kef;
          f32x4 acc = (f32x4){0.f, 0.f, 0.f, 0.f};
#pragma unroll
          for (int s2 = 0; s2 < 2; ++s2) { const bf16x8 av = *(const LAS bf16x8*)(ke + (16 * dt + q) * VT_LD + 32 * s2 + 8 * g4), bv = *(const bf16x8*)(vtg + (size_t)(16 * vtile + q) * VTS + 32 * s2 + 8 * g4);
              acc = __builtin_amdgcn_mfma_f32_16x16x32_bf16(av, bv, acc, 0, 0, 0); }
          *(f32x4*)(F.DS + ((((size_t)(g.b * 4 + g.hh) * 2 + dir) * NCH + g.cpos) * 96 + 16 * vtile + q) * 48 + 16 * dt + 4 * g4) = acc; } }
    { u32x4* dst = (u32x4*)(F.OPS + (size_t)u * 12288);
      for (int i = tid; i < 1536; i += NTHREADS) dst[i] = *(const LAS u32x4*)(ops + i * 8); }
    __syncthreads();
}
__device__ __forceinline__ void gla_g2_unit(Frame& F, int u) {
    const int chain = u >> 2, qt = u & 3, dir = chain & 1, tid = F.tid;
    const float* ds = F.DS + (size_t)chain * NCH * 4608; const float* gd = F.GD + (size_t)chain * NCH * 48; bf16* stb = F.STB + (size_t)chain * NCH * 4608;
    const int e0 = qt * 1152 + 2 * tid, e1 = qt * 1152 + 1024 + 2 * tid; const bool h1 = tid < 64;
    const int d0 = e0 % 48, d1 = h1 ? e1 % 48 : 0;
    f32x2 S0 = (f32x2){0.f, 0.f}, S1 = (f32x2){0.f, 0.f};
    for (int st0 = 0; st0 < NCH; st0 += 4) {
        f32x2 x0[4], x1[4], g0[4], g1[4]; int cp[4];
#pragma unroll
        for (int k = 0; k < 4; ++k) { const int st = st0 + k; cp[k] = st < 4 ? (dir ? 3 - st : st) : (dir ? 4 + (67 - st) : st);
            const float* p = ds + (size_t)cp[k] * 4608; const float* gp = gd + cp[k] * 48;
            x0[k] = *(const f32x2*)(p + e0); g0[k] = *(const f32x2*)(gp + d0);
            if (h1) { x1[k] = *(const f32x2*)(p + e1); g1[k] = *(const f32x2*)(gp + d1); } else { x1[k] = (f32x2){0.f, 0.f}; g1[k] = x1[k]; } }
#pragma unroll
        for (int k = 0; k < 4; ++k) { bf16* p = stb + (size_t)cp[k] * 4608;
            *(unsigned*)(p + e0) = pk2(S0.x, S0.y); if (h1) *(unsigned*)(p + e1) = pk2(S1.x, S1.y);
            S0 = g0[k] * S0 + x0[k]; S1 = g1[k] * S1 + x1[k]; }
    }
}
__device__ __forceinline__ void gla_g3_wave(Frame& F, int l, int wu) {
    const int u = wu >> 1, it = wu & 1;
    const GlaU g = gla_unit_geom(u);
    const int lane = F.lane, r = lane & 31, h = lane >> 5;
    const bf16* ops = F.OPS + (size_t)u * 12288 + 16 * 0 + 8 * h;
    const bf16* vtg = F.VTA + (size_t)(384 + g.hh * 96) * VTS + g.seqbase + g.t0;
    const bf16* stf = F.STB + ((((size_t)(g.b * 4 + g.hh) * 2 + 0) * NCH + g.cpos) * 4608) + 8 * h; const bf16* stbk = stf + (size_t)NCH * 4608;
    LAS float* O = (LAS float*)(F.lds + F.wave * 16384);
    bf16x8 qf[3], qb[3];
#pragma unroll
    for (int s3 = 0; s3 < 3; ++s3) { qf[s3] = *(const bf16x8*)(ops + (32 * it + r) * 48 + 16 * s3); qb[s3] = *(const bf16x8*)(ops + 6144 + (32 * it + r) * 48 + 16 * s3); }
    f32x16 X[2];
#pragma unroll
    for (int jt = 0; jt < 2; ++jt) {
        f32x16 xf, xb;
#pragma unroll
        for (int e = 0; e < 16; ++e) { xf[e] = 0.f; xb[e] = 0.f; }
        if (jt <= it) {
#pragma unroll
            for (int s3 = 0; s3 < 3; ++s3) xf = __builtin_amdgcn_mfma_f32_32x32x16_bf16(*(const bf16x8*)(ops + 3072 + (32 * jt + r) * 48 + 16 * s3), qf[s3], xf, 0, 0, 0); }
        if (jt >= it) {
#pragma unroll
            for (int s3 = 0; s3 < 3; ++s3) xb = __builtin_amdgcn_mfma_f32_32x32x16_bf16(*(const bf16x8*)(ops + 9216 + (32 * jt + r) * 48 + 16 * s3), qb[s3], xb, 0, 0, 0); }
        if (jt == it) {
#pragma unroll
            for (int e = 0; e < 16; ++e) { const int jl = (e & 3) + 8 * (e >> 2) + 4 * h; X[jt][e] = (jl <= r ? xf[e] : 0.f) + (jl >= r ? xb[e] : 0.f); }
        } else X[jt] = jt < it ? xf : xb;
    }
    f32x16 o[3];
#pragma unroll
    for (int vt = 0; vt < 3; ++vt)
#pragma unroll
        for (int e = 0; e < 16; ++e) o[vt][e] = 0.f;
#pragma unroll
    for (int jt = 0; jt < 2; ++jt)
#pragma unroll
        for (int s2 = 0; s2 < 2; ++s2) {
            u32x4 aw; aw.x = pk2(X[jt][8 * s2 + 0], X[jt][8 * s2 + 1]); aw.y = pk2(X[jt][8 * s2 + 2], X[jt][8 * s2 + 3]); aw.z = pk2(X[jt][8 * s2 + 4], X[jt][8 * s2 + 5]); aw.w = pk2(X[jt][8 * s2 + 6], X[jt][8 * s2 + 7]);
#pragma unroll
            for (int vt = 0; vt < 3; ++vt) {
                const bf16* vr = vtg + (size_t)(32 * vt + r) * VTS + 32 * jt + 16 * s2 + 4 * h;
                const u32x2 lo = *(const u32x2*)vr, hi = *(const u32x2*)(vr + 8);
                const u32x4 bw = (u32x4){lo.x, lo.y, hi.x, hi.y};
                o[vt] = __builtin_amdgcn_mfma_f32_32x32x16_bf16(__builtin_bit_cast(bf16x8, aw), __builtin_bit_cast(bf16x8, bw), o[vt], 0, 0, 0); } }
#pragma unroll
    for (int s3 = 0; s3 < 3; ++s3)
#pragma unroll
        for (int vt = 0; vt < 3; ++vt) {
            o[vt] = __builtin_amdgcn_mfma_f32_32x32x16_bf16(qf[s3], *(const bf16x8*)(stf + (32 * vt + r) * 48 + 16 * s3), o[vt], 0, 0, 0);
            o[vt] = __builtin_amdgcn_mfma_f32_32x32x16_bf16(qb[s3], *(const bf16x8*)(stbk + (32 * vt + r) * 48 + 16 * s3), o[vt], 0, 0, 0); }
#pragma unroll
    for (int vt = 0; vt < 3; ++vt)
#pragma unroll
        for (int e = 0; e < 16; ++e) O[((e & 3) + 8 * (e >> 2) + 4 * h) * O_LD + 32 * vt + r] = o[vt][e];
    LDS_WAIT(); asm volatile("" ::: "memory");
    { const int i = lane >> 1, half = lane & 1; const size_t row = (size_t)(g.seqbase + g.t0 + 32 * it + i);
      f32x4 ov[12]; float ss = 0.f;
#pragma unroll
      for (int e = 0; e < 12; ++e) { ov[e] = *(const LAS f32x4*)(O + i * O_LD + half * 48 + 4 * e); ss += (ov[e].x * ov[e].x + ov[e].y * ov[e].y) + (ov[e].z * ov[e].z + ov[e].w * ov[e].w); }
      ss = dpp_addp<0xB1>(ss);
      const float rinv = 1.f / sqrtf(ss * (1.f / 96.f) + EPS);
      const float* ng = F.gla_norm_g + (size_t)l * 384 + g.hh * 96 + half * 48;
      const u32x4* gp = (const u32x4*)(F.P + row * NP + C_GG + g.hh * 96 + half * 48);
      u32x4* dst = (u32x4*)(F.MIX + row * DM + g.hh * 96 + half * 48);
#if GLA_CHECK
      { float sn = 0.f; const float* pf = F.OF + row * 384 + g.hh * 96 + half * 48; const float* pb = F.OB + row * 384 + g.hh * 96 + half * 48;
#pragma unroll
        for (int e = 0; e < 48; ++e) { const float on = pf[e] + pb[e]; sn += on * on; }
        sn += __shfl_xor(sn, 1);
        const float rms = sqrtf(sn * (1.f / 96.f)) + 1e-6f; int bad = 0;
#pragma unroll
        for (int e = 0; e < 48; ++e) { const float on = pf[e] + pb[e]; if (!(fabsf(ov[e >> 2][e & 3] - on) <= 0.03f * rms + 0.03f * fabsf(on))) ++bad; }
        if (bad) atomicAdd(F.ctl + 64, (unsigned)bad); }
#endif
#pragma unroll
      for (int q6 = 0; q6 < 6; ++q6) { const u32x4 gw = gp[q6]; const f32x4 n0 = *(const f32x4*)(ng + 8 * q6), n1 = *(const f32x4*)(ng + 8 * q6 + 4); const f32x4 a = ov[2 * q6], b = ov[2 * q6 + 1];
          u32x4 w;
          w.x = pk2(a.x * rinv * n0.x * silu_f(bflo(gw.x)), a.y * rinv * n0.y * silu_f(bfhi(gw.x))); w.y = pk2(a.z * rinv * n0.z * silu_f(bflo(gw.y)), a.w * rinv * n0.w * silu_f(bfhi(gw.y)));
          w.z = pk2(b.x * rinv * n1.x * silu_f(bflo(gw.z)), b.y * rinv * n1.y * silu_f(bfhi(gw.z))); w.w = pk2(b.z * rinv * n1.z * silu_f(bflo(gw.w)), b.w * rinv * n1.w * silu_f(bfhi(gw.w)));
          dst[q6] = w; } }
    LDS_WAIT(); asm volatile("" ::: "memory");
}
__device__ __forceinline__ void ph_gla3(Frame& F, int l) {
    const bool need_ctx = l < DEPTH - 1;
    const int gw = F.vcu * NWAVES + F.wave, NGW = F.G * NWAVES;
    for (int wu = gw; wu < NB * GH * NCH * 2; wu += NGW) { if (!need_ctx && ((wu >> 1) % NCH) < 4) continue; gla_g3_wave(F, l, wu); }
}
__device__ __forceinline__ void ph_prep(Frame& F, int l) {
    const bool need_ctx = l < DEPTH - 1;
    const int tid = F.tid;
#if GLA_CHECK
    for (int u = F.vcu; u < NB * GH * 2; u += F.G) gla_chain(F, l, u);
    __syncthreads();
#endif
    { LAS float* wa = (LAS float*)(F.lds + PREP_WA);
      for (int i = tid; i < 4 * 2 * 16 * 48; i += NTHREADS) { const int hh = i / 1536, dir = (i / 768) & 1, r = (i / 48) % 16, d = i % 48; wa[i] = F.gla_wa2[(((size_t)l * 2 + dir) * 16 + r) * 192 + hh * 48 + d]; }
      for (int i = tid; i < 4 * 2 * 48; i += NTHREADS) { const int hh = i / 96, dir = (i / 48) & 1, d = i % 48; wa[6144 + i] = F.gla_ba[((size_t)l * 2 + dir) * 192 + hh * 48 + d]; }
      LAS bf16* pw = (LAS bf16*)(F.lds + PREP_PW); LAS float* ps = (LAS float*)(F.lds + PREP_PS);
      for (int i = tid; i < 4 * 64 * 64; i += NTHREADS) { const int g = i >> 12, ii = (i >> 6) & 63, o = i & 63; pw[(g * 64 + o) * PW_LD + ii] = (bf16)f2bf(F.pool_w[(size_t)l * 16384 + i]); }
      if (tid < 256) ps[tid] = F.pool_scale[(size_t)l * 256 + tid]; }
    __syncthreads();
    const int NPOOL = NB * 128 + (need_ctx ? NB * 8 : 0), NG1 = NB * GH * NCH, NMIX = 3 * NPOOL;
    for (int k = F.vcu; k < NG1 + NPOOL; k += F.G) {
        if (k < NMIX) { if (k % 3 == 2) pool_unit(F, l, k / 3); else gla_g1_unit(F, l, (k / 3) * 2 + k % 3); }
        else gla_g1_unit(F, l, 2 * NPOOL + (k - NMIX));
    }
}

#define NA_LOG2E 1.4426950408889634f
__device__ __forceinline__ float na_max4(float x) {
    const auto r = __builtin_amdgcn_permlane16_swap(__float_as_uint(x), __float_as_uint(x), false, false);
    x = fmaxf(__uint_as_float(r[0]), __uint_as_float(r[1]));
    const auto t = __builtin_amdgcn_permlane32_swap(__float_as_uint(x), __float_as_uint(x), false, false);
    return fmaxf(__uint_as_float(t[0]), __uint_as_float(t[1]));
}
__device__ __forceinline__ float na_sum4(float x) {
    const auto r = __builtin_amdgcn_permlane16_swap(__float_as_uint(x), __float_as_uint(x), false, false);
    x = __uint_as_float(r[0]) + __uint_as_float(r[1]);
    const auto t = __builtin_amdgcn_permlane32_swap(__float_as_uint(x), __float_as_uint(x), false, false);
    return __uint_as_float(t[0]) + __uint_as_float(t[1]);
}
struct NaCtx {
    __amdgpu_buffer_rsrc_t rP, rV; unsigned voffK, voffV; int b, cw, r0, krlo, nnb; const LAS float* rpb; unsigned bidx[2][4];
    bf16x8 qa[4][2]; float mrun[4], lsum[4]; f32x4 o[4][4];
};
__device__ __forceinline__ int na_segtok(const NaCtx& C, int sg) { return sg < C.nnb ? C.b * SEQ + (C.krlo + sg) * GRIDW + C.cw : TX + C.b * CTXL + 32 * (sg - C.nnb); }
__device__ __forceinline__ void na_load(const NaCtx& C, int sg, bf16x8 (&kb)[2][2], bf16x8 (&vb)[4]) {
    const int tok = na_segtok(C, sg);
#pragma unroll
    for (int par = 0; par < 2; ++par)
#pragma unroll
        for (int s2 = 0; s2 < 2; ++s2) kb[par][s2] = __builtin_bit_cast(bf16x8, __builtin_amdgcn_raw_buffer_load_b128(C.rP, C.voffK, (unsigned)((tok + 4 * par) * (NP * 2) + 64 * s2), 0));
#pragma unroll
    for (int dt = 0; dt < 4; ++dt) vb[dt] = __builtin_bit_cast(bf16x8, __builtin_amdgcn_raw_buffer_load_b128(C.rV, C.voffV, (unsigned)((16 * dt * VTS + tok) * 2), 0));
}
template <bool LATENT>
__device__ __forceinline__ void na_segment(NaCtx& C, int sg, int lane, const bf16x8 (&kb)[2][2], const bf16x8 (&vb)[4]) {
    const int g = lane >> 4;
    const bool nb = LATENT && sg < C.nnb;
    const int kr = C.krlo + sg;
#pragma unroll
    for (int i = 0; i < 4; ++i) {
        if (nb) { const int ri = C.r0 + i, rsi = ri - 4 < 0 ? 0 : (ri - 4 > 56 ? 56 : ri - 4); if (kr < rsi || kr > rsi + 7) continue; }
        float bv[2][4];
        if (nb) { const unsigned rowoff = (unsigned)((kr - (C.r0 + i) + 7) * 32 * 4);
#pragma unroll
            for (int par = 0; par < 2; ++par)
#pragma unroll
                for (int rg = 0; rg < 4; ++rg) bv[par][rg] = *(const LAS float*)((const LAS char*)C.rpb + rowoff + C.bidx[par][rg]); }
        f32x4 st[2];
#pragma unroll
        for (int par = 0; par < 2; ++par) {
            f32x4 a = nb ? (f32x4){bv[par][0], bv[par][1], bv[par][2], bv[par][3]} : (f32x4){0.f, 0.f, 0.f, 0.f};
#pragma unroll
            for (int s2 = 0; s2 < 2; ++s2) a = __builtin_amdgcn_mfma_f32_16x16x32_bf16(kb[par][s2], C.qa[i][s2], a, 0, 0, 0);
            st[par] = a;
        }
        float mx = fmaxf(fmaxf(fmaxf(st[0][0], st[0][1]), fmaxf(st[0][2], st[0][3])), fmaxf(fmaxf(st[1][0], st[1][1]), fmaxf(st[1][2], st[1][3])));
        mx = na_max4(mx);
        if (__any(mx > C.mrun[i] + 8.f)) {
            const float mnew = fmaxf(C.mrun[i], mx), alpha = __builtin_amdgcn_exp2f(C.mrun[i] - mnew);
            C.lsum[i] *= alpha; C.mrun[i] = mnew;
#pragma unroll
            for (int rg = 0; rg < 4; ++rg) { const float ar = __shfl(alpha, 4 * g + rg);
#pragma unroll
                for (int dt = 0; dt < 4; ++dt) C.o[i][dt][rg] *= ar; }
        }
        float psum = 0.f;
#pragma unroll
        for (int par = 0; par < 2; ++par)
#pragma unroll
            for (int rg = 0; rg < 4; ++rg) { const float p = __builtin_amdgcn_exp2f(st[par][rg] - C.mrun[i]); st[par][rg] = p; psum += p; }
        C.lsum[i] += na_sum4(psum);
        u32x4 pw; pw.x = cvt_pk_bf16(st[0][0], st[0][1]); pw.y = cvt_pk_bf16(st[0][2], st[0][3]); pw.z = cvt_pk_bf16(st[1][0], st[1][1]); pw.w = cvt_pk_bf16(st[1][2], st[1][3]);
        const bf16x8 pa = __builtin_bit_cast(bf16x8, pw);
#pragma unroll
        for (int dt = 0; dt < 4; ++dt) C.o[i][dt] = __builtin_amdgcn_mfma_f32_16x16x32_bf16(pa, vb[dt], C.o[i][dt], 0, 0, 0);
    }
}
#ifndef NA_DRYMODE
#define NA_DRYMODE 0
#endif
template <bool LATENT>
__device__ __forceinline__ void na_unit(Frame& F, int l, int u, const LAS float* rpb_lds, bool dry = false) {
    const int lane = F.lane, q = lane & 15, g = lane >> 4;
    NaCtx C;
    int hh, c0 = 0, qrow0, qstep;
    if (LATENT) { const int cb = u & 3, rg4 = (u >> 2) & 15; hh = (u >> 6) % NH; C.b = u / (64 * NH); c0 = cb * 16; C.r0 = rg4 * 4; qrow0 = C.b * SEQ + C.r0 * GRIDW + c0; qstep = GRIDW;
        const int rs0 = C.r0 - 4 < 0 ? 0 : (C.r0 - 4 > 56 ? 56 : C.r0 - 4), r3 = C.r0 + 3, rs3 = r3 - 4 < 0 ? 0 : (r3 - 4 > 56 ? 56 : r3 - 4);
        C.krlo = rs0; C.nnb = rs3 + 7 - rs0 + 1; }
    else { const int qi = u & 3; hh = (u >> 2) % NH; C.b = u / (4 * NH); qrow0 = TX + C.b * CTXL + qi * 64; qstep = 16; C.r0 = 0; C.krlo = 0; C.nnb = 0; }
    C.cw = c0 == 0 ? 0 : (c0 == 48 ? 32 : c0 - 8);
    const int c = c0 + q; const int start = c - 8 < 0 ? 0 : (c - 8 > 48 ? 48 : c - 8);
    C.rpb = rpb_lds + hh * 15 * 32;
    C.rP = __builtin_amdgcn_make_buffer_rsrc((void*)F.P, 0, (int)((size_t)TT * NP * 2), 0x00020000);
    C.rV = __builtin_amdgcn_make_buffer_rsrc((void*)F.VTA, 0, (int)((size_t)VT_NC * VTS * 2), 0x00020000);
    const int koff = 8 * (q >> 2) + (q & 3);
    C.voffK = (unsigned)((koff * NP + C_NAK + hh * NDH + 8 * g) * 2);
    C.voffV = (unsigned)(((hh * NDH + q) * VTS + 8 * g) * 2);
#pragma unroll
    for (int par = 0; par < 2; ++par)
#pragma unroll
        for (int rg = 0; rg < 4; ++rg) { const int kc = C.cw + 8 * g + rg + 4 * par; const bool valid = (kc >= start) && (kc < start + 16);
            C.bidx[par][rg] = (unsigned)((valid ? kc - c + 15 : 31) * 4); }
#pragma unroll
    for (int i = 0; i < 4; ++i) {
#pragma unroll
        for (int s2 = 0; s2 < 2; ++s2) C.qa[i][s2] = *(const bf16x8*)(F.P + (size_t)(qrow0 + i * qstep + q) * NP + C_NAQ + hh * NDH + 32 * s2 + 8 * g);
        C.mrun[i] = -1e30f; C.lsum[i] = 0.f;
#pragma unroll
        for (int dt = 0; dt < 4; ++dt) C.o[i][dt] = (f32x4){0.f, 0.f, 0.f, 0.f}; }
    const int nseg = C.nnb + 8;
    bf16x8 k0[2][2], v0[4], k1[2][2], v1[4];
    na_load(C, 0, k0, v0);
#pragma unroll 1
    for (int sg = 0; sg < nseg; sg += 2) {
        if (sg + 1 < nseg) na_load(C, sg + 1, k1, v1);
        na_segment<LATENT>(C, sg, lane, k0, v0);
        if (sg + 2 < nseg) na_load(C, sg + 2, k0, v0);
        if (sg + 1 < nseg) na_segment<LATENT>(C, sg + 1, lane, k1, v1);
    }
    bf16* mixb = dry ? (bf16*)F.VTC : F.MIX;
#pragma unroll
    for (int i = 0; i < 4; ++i)
#pragma unroll
        for (int rg = 0; rg < 4; ++rg) { const float li = 1.f / __shfl(C.lsum[i], 4 * g + rg);
            bf16* orow = mixb + (size_t)(dry ? 0 : (qrow0 + i * qstep + 4 * g + rg)) * DM + 384 + hh * NDH + q;
#pragma unroll
            for (int dt = 0; dt < 4; ++dt) orow[16 * dt] = (bf16)f2bf(C.o[i][dt][rg] * li); }
}
__device__ __forceinline__ void ph_attn(Frame& F, int l) {
    const bool need_ctx = l < DEPTH - 1;
    const int gw = F.vcu * NWAVES + F.wave, NGW = F.G * NWAVES;
    LAS float* rpb = (LAS float*)(F.lds + TAB_OFF);
    for (int i = F.tid; i < NH * 15 * 32; i += NTHREADS) { const int col = i & 31, hr = i >> 5; rpb[i] = col < 31 ? F.na_rpb[((size_t)l * NH * 15 + hr) * 31 + col] * NA_LOG2E : -1e30f; }
    __syncthreads();
    for (int rep = 0; rep < REPS(11); ++rep)
    for (int u = F.vcu; u < NB * GH * 2 * 4; u += F.G) gla_g2_unit(F, u);
    const bool bg = !GLA_CHECK;
    if (bg && (F.wave & 1)) convert_items(F, l, 3 * (NE * 16 * 32));
    for (int rep = 0; rep < REPS(12); ++rep) {
    for (int u = gw; u < NB * NH * 16 * 4; u += NGW) na_unit<true>(F, l, u, rpb, rep + 1 < REPS(12));
    if (need_ctx) for (int u = gw; u < NB * NH * 4; u += NGW) na_unit<false>(F, l, u, rpb, rep + 1 < REPS(12)); }
    if (bg && !(F.wave & 1)) convert_items(F, l, 3 * (NE * 16 * 32));
}
constexpr int RW_LD = 1032;
static_assert(2 * NE * RW_LD * 2 <= STAGE_BYTES, "router LDS");
__device__ __forceinline__ unsigned f2key(float f, int e) { unsigned u = __builtin_bit_cast(unsigned, f); u = (u & 0x80000000u) ? ~u : (u | 0x80000000u); return (u & ~31u) | (unsigned)(31 - e); }
__device__ __forceinline__ float key2f(unsigned k) { unsigned u = k & ~31u; u = (u & 0x80000000u) ? (u & 0x7fffffffu) : ~u; return __builtin_bit_cast(float, u); }
__device__ __forceinline__ void ph_router(Frame& F, int l, bool dry = false) {
    const int tid = F.tid, lane = F.lane, q = lane & 15, g = lane >> 4;
    LAS bf16* WH = (LAS bf16*)F.lds; LAS bf16* WL = WH + NE * RW_LD;
    LAS int* lcount = (LAS int*)(F.lds + MISC_OFF + 64 * 4);
    volatile LAS int* lbase = (volatile LAS int*)(F.MISC + 96);
    LAS int* apos = (LAS int*)(F.lds + TAB_OFF);
    const float* rw = F.router_w + (size_t)l * DM * NE;
    for (int i = tid; i < DM * NE; i += NTHREADS) { const int c = i >> 5, e = i & 31; const float w = rw[i]; const unsigned hi = f2bf(w); const unsigned lo = f2bf(w - bf2f(hi));
        WH[e * RW_LD + c] = (bf16)hi; WL[e * RW_LD + c] = (bf16)lo; }
    if (tid < NE) lcount[tid] = 0;
    __syncthreads();
    const int M = (l == DEPTH - 1) ? TX : TT;
    const int per = (M + F.G - 1) / F.G, tok0 = F.vcu * per, tok1 = (tok0 + per < M) ? tok0 + per : M;
    const int ntile = tok1 > tok0 ? (tok1 - tok0 + 15) >> 4 : 0;
    const float* g2w = F.norm2_g + (size_t)l * DM + 8 * g;
    const float rb0 = F.router_b[(size_t)l * NE + q], rb1 = F.router_b[(size_t)l * NE + 16 + q];
    for (int tile = F.wave; tile < ntile; tile += NWAVES) {
        const int tbase = tok0 + 16 * tile, t = tbase + q, tq = t < tok1 ? t : tok1 - 1; const bool valid = t < tok1;
        const float* xr = F.X + (size_t)tq * DM + 8 * g;
        float ss = 0.f;
#pragma unroll 8
        for (int s = 0; s < 32; ++s) { const f32x4 a = *(const f32x4*)(xr + 32 * s), b = *(const f32x4*)(xr + 32 * s + 4); ss += (a.x * a.x + a.y * a.y) + (a.z * a.z + a.w * a.w) + (b.x * b.x + b.y * b.y) + (b.z * b.z + b.w * b.w); }
        { const auto r = __builtin_amdgcn_permlane16_swap(__float_as_uint(ss), __float_as_uint(ss), false, false); ss = __uint_as_float(r[0]) + __uint_as_float(r[1]);
          const auto t = __builtin_amdgcn_permlane32_swap(__float_as_uint(ss), __float_as_uint(ss), false, false); ss = __uint_as_float(t[0]) + __uint_as_float(t[1]); }
        const float rinv = 1.f / sqrtf(ss * (1.f / DM) + EPS);
        const int br = tq < TX ? tq / SEQ : NB;
        const float* md = F.mod + ((size_t)l * 9 + br) * 6 * DM + 8 * g;
        unsigned char* hrow = MOE_FP8 ? F.H8 + (size_t)tq * DM + 8 * g : (unsigned char*)(F.H + (size_t)tq * DM + 8 * g);
        f32x4 acc[2]; acc[0] = (f32x4){0.f, 0.f, 0.f, 0.f}; acc[1] = acc[0];
#pragma unroll 2
        for (int s = 0; s < 32; ++s) { const int c = 32 * s;
            const f32x4 xa = *(const f32x4*)(xr + c), xb = *(const f32x4*)(xr + c + 4), ga = *(const f32x4*)(g2w + c), gb = *(const f32x4*)(g2w + c + 4);
            const f32x4 ca = *(const f32x4*)(md + 4 * DM + c), cb = *(const f32x4*)(md + 4 * DM + c + 4), sa = *(const f32x4*)(md + 3 * DM + c), sb = *(const f32x4*)(md + 3 * DM + c + 4);
            const f32x4 ha = (xa * rinv * ga) * (ca + 1.f) + sa, hb = (xb * rinv * gb) * (cb + 1.f) + sb;
            u32x4 hw; hw.x = cvt_pk_bf16(ha.x, ha.y); hw.y = cvt_pk_bf16(ha.z, ha.w); hw.z = cvt_pk_bf16(hb.x, hb.y); hw.w = cvt_pk_bf16(hb.z, hb.w);
            u32x4 lw; lw.x = cvt_pk_bf16(ha.x - bflo(hw.x), ha.y - bfhi(hw.x)); lw.y = cvt_pk_bf16(ha.z - bflo(hw.y), ha.w - bfhi(hw.y));
            lw.z = cvt_pk_bf16(hb.x - bflo(hw.z), hb.y - bfhi(hw.z)); lw.w = cvt_pk_bf16(hb.z - bflo(hw.w), hb.w - bfhi(hw.w));
            if (valid) { if (MOE_FP8) { u32x2 h8; h8.x = pk4_fp8(ha.x, ha.y, ha.z, ha.w); h8.y = pk4_fp8(hb.x, hb.y, hb.z, hb.w); *(u32x2*)(hrow + c) = h8; } else *(u32x4*)(hrow + 2 * c) = hw; }
            const bf16x8 ah = __builtin_bit_cast(bf16x8, hw), al = __builtin_bit_cast(bf16x8, lw);
#pragma unroll
            for (int tt = 0; tt < 2; ++tt) { const bf16x8 bh = *(const LAS bf16x8*)(WH + (16 * tt + q) * RW_LD + c + 8 * g), bl = *(const LAS bf16x8*)(WL + (16 * tt + q) * RW_LD + c + 8 * g);
                acc[tt] = __builtin_amdgcn_mfma_f32_16x16x32_bf16(ah, bh, acc[tt], 0, 0, 0);
                acc[tt] = __builtin_amdgcn_mfma_f32_16x16x32_bf16(ah, bl, acc[tt], 0, 0, 0);
                acc[tt] = __builtin_amdgcn_mfma_f32_16x16x32_bf16(al, bh, acc[tt], 0, 0, 0); } }
        unsigned k0[4], k1[4], win[4][4];
#pragma unroll
        for (int rg = 0; rg < 4; ++rg) { k0[rg] = f2key(acc[0][rg] + rb0, q); k1[rg] = f2key(acc[1][rg] + rb1, 16 + q); }
#pragma unroll
        for (int k = 0; k < 4; ++k)
#pragma unroll
            for (int rg = 0; rg < 4; ++rg) { const unsigned m = row16_umax(k0[rg] > k1[rg] ? k0[rg] : k1[rg]);
                win[rg][k] = m; if (k0[rg] == m) k0[rg] = 0u; if (k1[rg] == m) k1[rg] = 0u; }
        { const int rsel = q >> 2, ksel = q & 3;
          unsigned w4[4];
#pragma unroll
          for (int k = 0; k < 4; ++k) w4[k] = rsel == 0 ? win[0][k] : rsel == 1 ? win[1][k] : rsel == 2 ? win[2][k] : win[3][k];
          const float v0 = key2f(w4[0]), e1 = __expf(key2f(w4[1]) - v0), e2 = __expf(key2f(w4[2]) - v0), e3 = __expf(key2f(w4[3]) - v0);
          const float inv = 1.f / (1.f + e1 + e2 + e3);
          const float gt = (ksel == 0 ? 1.f : ksel == 1 ? e1 : ksel == 2 ? e2 : e3) * inv;
          const unsigned wk = ksel == 0 ? w4[0] : ksel == 1 ? w4[1] : ksel == 2 ? w4[2] : w4[3];
          const int e = 31 - (int)(wk & 31u), tt2 = tbase + 4 * g + rsel;
          if (tt2 < tok1 && !dry) { F.GATE[(size_t)tt2 * 4 + ksel] = gt;
              const int pos = __hip_atomic_fetch_add(lcount + e, 1, __ATOMIC_RELAXED, __HIP_MEMORY_SCOPE_WORKGROUP);
              apos[(tt2 - tok0) * 4 + ksel] = (e << 16) | pos; } }
    }
    __syncthreads();
    if (dry) return;
    if (tid < NE) lbase[tid] = (int)__hip_atomic_fetch_add(F.ctl + CW_CNT + (l * NE + tid) * 64, (unsigned)__hip_atomic_load(lcount + tid, __ATOMIC_RELAXED, __HIP_MEMORY_SCOPE_WORKGROUP), __ATOMIC_RELAXED, __HIP_MEMORY_SCOPE_AGENT);
    __syncthreads();
    const int nas = (tok1 > tok0 ? (tok1 - tok0) : 0) * 4;
    for (int i = tid; i < nas; i += NTHREADS) { const int w = apos[i], e = w >> 16, pos = w & 0xffff; F.LIST[(size_t)e * TT + lbase[e] + pos] = tok0 * 4 + i; }
    __syncthreads();
}
__device__ __forceinline__ void moe_tables(Frame& F, int l, int npn) {
    volatile LAS int* tp = (volatile LAS int*)(F.MISC + 16);
    LAS int* tab = (LAS int*)(F.lds + TAB_OFF);
    const int tid = F.tid;
    volatile LAS int* eb = (volatile LAS int*)(F.MISC + 128);
    volatile LAS int* cntl = (volatile LAS int*)(F.MISC + 168);
    if (tid == 0) { int acc = 0, sb = 0;
        for (int e = 0; e < NE; ++e) { tp[e] = acc; eb[e] = sb; const int cnt = (int)__hip_atomic_load(F.ctl + CW_CNT + (l * NE + e) * 64, __ATOMIC_RELAXED, __HIP_MEMORY_SCOPE_AGENT); cntl[e] = cnt; acc += (cnt + 255) >> 8; sb += cnt; }
        tp[NE] = acc; }
    __syncthreads();
    if (npn != 8) return;
#pragma unroll 1
    for (int i2 = 0; i2 < MAXU; i2 += 2) {
        const int i = i2 + (tid >> 8), rr = tid & 255;
        g8::Unit u;
        if (i < MAXU && g8::moe_unit((long)i * F.G + F.vcu, npn, tp, u)) {
            const int cnt = (int)__hip_atomic_load(F.ctl + CW_CNT + (l * NE + u.e) * 64, __ATOMIC_RELAXED, __HIP_MEMORY_SCOPE_AGENT);
            const int idx = u.pm * 256 + rr;
            const int a = idx < cnt ? F.LIST[(size_t)u.e * TT + idx] : -1;
            tab[i * 256 + rr] = a;
            if (u.pn == 0 && a >= 0) { F.INV[a] = eb[u.e] + idx; F.GATES[eb[u.e] + idx] = F.GATE[a]; }
        }
    }
    __syncthreads();
}

__global__ void __launch_bounds__(NTHREADS, 2) mk_fwd(Args args) {
    extern __shared__ __attribute__((aligned(16))) unsigned char lds_raw[];
    Frame F;
    F.lds = (LAS unsigned char*)lds_raw;
    F.MISC = (volatile LAS unsigned*)(F.lds + MISC_OFF);
    F.tid = threadIdx.x; F.lane = F.tid & 63; F.wave = __builtin_amdgcn_readfirstlane(F.tid >> 6);
    F.G = gridDim.x; { const int bx = blockIdx.x; F.vcu = (F.G % 8 == 0) ? (bx % 8) * (F.G / 8) + bx / 8 : bx; }
    frame_ptrs(F);
    for (int u = F.tid; u < 256; u += NTHREADS) F.MISC[u] = 0u;
    __syncthreads();
    const int lo = args.ph_lo, hi = args.ph_hi;
    const bool one_launch = (hi - lo) > 1;
    XcdBarrier bar; bar.bar = F.ctl + CW_BAR; bar.x = 0; bar.st = nullptr;
    if (one_launch) bar = xcd_barrier_post(F.ctl + CW_BAR, F.MISC);
#ifndef PHMASK
#define PHMASK 0xFFFFFFFF
#endif
#define IN(k) (lo <= (k) && (k) < hi)
#define PHON(b) ((PHMASK >> (b)) & 1)
#define STAGGER() do { if (STAG_TICKS > 0 && (blockIdx.x & 8)) { const unsigned long long t0_ = __builtin_amdgcn_s_memrealtime(); while (__builtin_amdgcn_s_memrealtime() - t0_ < (unsigned long long)STAG_TICKS) __builtin_amdgcn_s_sleep(8); } } while (0)
#define REFRESH() do { int tz_ = threadIdx.x; asm volatile("" : "+v"(tz_)); F.tid = tz_; F.lane = tz_ & 63; frame_ptrs(F); } while (0)
#define SEAM(k) do { if (IN(k) && IN((k) + 1)) xcd_barrier(bar); } while (0)

    if (PHON(0) && IN(0)) { for (int rep = 0; rep < REPS(0); ++rep) { REFRESH(); ph_prologue(F); } } SEAM(0);
    if (PHON(1) && IN(1)) { REFRESH(); ph_first_norm(F); } SEAM(1);
    for (int l = 0; l < DEPTH; ++l) {
        const int pb = 2 + PPL * l;
        const bool lastl = (l == DEPTH - 1);
        if (PHON(2) && IN(pb + 0)) for (int rep = 0; rep < REPS(2); ++rep) {
            REFRESH(); STAGGER();
            g8::ProbIn Pb{(const char*)F.H, (const char*)(F.Bin + (size_t)l * NP * DM), F.P, F.VTA, F.G, (int)blockIdx.x, (rep + 1 < REPS(2)) ? 1 : 0};
            g8::gemm_phase(F.lds, Pb);
        }
        SEAM(pb + 0);
        if (PHON(3) && IN(pb + 1)) { for (int rep = 0; rep < REPS(3); ++rep) { REFRESH(); ph_prep(F, l); } } SEAM(pb + 1);
        if (PHON(4) && IN(pb + 2)) { for (int rep = 0; rep < REPS(4); ++rep) { REFRESH(); ph_attn(F, l); } } SEAM(pb + 2);
        if (PHON(10) && IN(pb + 3)) { for (int rep = 0; rep < REPS(10); ++rep) { REFRESH(); ph_gla3(F, l); } } SEAM(pb + 3);
        if (PHON(5) && IN(pb + 4)) for (int rep = 0; rep < REPS(5); ++rep) {
            REFRESH(); STAGGER();
            g8::ProbOut Pb{(const char*)F.MIX, (const char*)(F.Bout + (size_t)l * DM * DM), (rep + 1 < REPS(5)) ? (float*)F.ACT : F.X, F.mod + (size_t)l * 9 * 6 * DM, F.G, (int)blockIdx.x, (lastl ? TX : TT) / 256};
            g8::gemm_phase(F.lds, Pb);
        }
        SEAM(pb + 4);
        if (PHON(6) && IN(pb + 5)) { for (int rep = 0; rep < REPS(6); ++rep) { REFRESH(); ph_router(F, l, rep + 1 < REPS(6)); __syncthreads(); } } SEAM(pb + 5);
        if (PHON(7) && IN(pb + 6)) for (int rep = 0; rep < REPS(7); ++rep) {
            REFRESH(); moe_tables(F, l, 8); STAGGER();
            g8::ProbGU Pb{MOE_FP8 ? (const char*)F.H8 : (const char*)F.H, (const char*)F.Bgu + (size_t)l * NE * 2 * DM * DM * (MOE_FP8 ? 1 : 2), (unsigned char*)F.ACT, F.b_gu + (size_t)l * NE * 2 * DM, (volatile LAS int*)(F.MISC + 16), (const LAS int*)(F.lds + TAB_OFF), F.G, F.vcu, (rep + 1 < REPS(7)) ? 1 : 0, (volatile LAS int*)(F.MISC + 128)};
            g8::gemm_phase(F.lds, Pb);
        }
        SEAM(pb + 6);
        if (PHON(8) && IN(pb + 7)) for (int rep = 0; rep < REPS(8); ++rep) {
            REFRESH(); moe_tables(F, l, 4); STAGGER();
            g8::ProbDN Pb{(const char*)F.ACT, (const char*)F.Bdn + (size_t)l * NE * DM * DM * (MOE_FP8 ? 1 : 2), F.YB, F.b_down + (size_t)l * NE * DM, F.GATES, (volatile LAS int*)(F.MISC + 16), F.G, F.vcu, (rep + 1 < REPS(8)) ? 1 : 0, (volatile LAS int*)(F.MISC + 128), (volatile LAS int*)(F.MISC + 168)};
            g8::gemm_phase(F.lds, Pb);
        }
        SEAM(pb + 7);
        if (PHON(9) && IN(pb + 8)) { for (int rep = 0; rep < REPS(9); ++rep) { REFRESH(); ph_combine(F, l, rep + 1 < REPS(9)); } }
        if (!lastl) SEAM(pb + 8);
    }
#undef IN
#undef SEAM
}

extern "C" void kernel_launch(void* const* d_in, const int* in_sizes, int n_in, void* d_out, int out_size, void* d_ws, size_t ws_size, hipStream_t stream) {
    static int grid = 0;
    if (grid == 0) {
        if (n_in != 23 || in_sizes[0] != TX * DM || out_size != TX * DM || ws_size < WS_END) {
            fprintf(stderr, "kernel_launch: unexpected problem (n_in %d, in0 %d, out %d, ws %zu; need ws >= %zu); nothing launched\n", n_in, n_in > 0 ? in_sizes[0] : -1, out_size, ws_size, (size_t)WS_END); grid = -1; return; }
        int dev = 0, cus = 0, per_cu = 0;
        if (hipGetDevice(&dev) != hipSuccess || hipDeviceGetAttribute(&cus, hipDeviceAttributeMultiprocessorCount, dev) != hipSuccess) { fprintf(stderr, "kernel_launch: device query failed\n"); grid = -1; return; }
        if (hipFuncSetAttribute((const void*)mk_fwd, hipFuncAttributeMaxDynamicSharedMemorySize, LDS_BYTES) != hipSuccess) { fprintf(stderr, "kernel_launch: hipFuncSetAttribute failed\n"); grid = -1; return; }
        if (hipOccupancyMaxActiveBlocksPerMultiprocessor(&per_cu, (const void*)mk_fwd, NTHREADS, LDS_BYTES) != hipSuccess || per_cu < 1)
            fprintf(stderr, "kernel_launch: note: occupancy query reports %d workgroups per CU\n", per_cu);
        (void)hipGetLastError();
        grid = cus;
        if ((long)grid * MAXU < (long)(NASG / 256 + NE) * 8) { fprintf(stderr, "kernel_launch: grid %d too small for the MoE unit tables\n", grid); grid = -1; return; }
    }
    if (grid < 0) return;
    if (hipMemsetAsync((char*)d_ws + WS_CTL, 0, CTL_ZERO_BYTES, stream) != hipSuccess) { fprintf(stderr, "kernel_launch: memset failed\n"); return; }
    Args a{};
    for (int i = 0; i < 23; ++i) a.in[i] = (const float*)d_in[i];
    a.out = (float*)d_out; a.ws = (unsigned char*)d_ws;
#if MK_N_LAUNCHES == 1
    a.ph_lo = 0; a.ph_hi = NPHASES;
    hipLaunchKernelGGL(mk_fwd, dim3(grid), dim3(NTHREADS), LDS_BYTES, stream, a);
#else
    for (int p = 0; p < NPHASES; ++p) { a.ph_lo = p; a.ph_hi = p + 1; hipLaunchKernelGGL(mk_fwd, dim3(grid), dim3(NTHREADS), LDS_BYTES, stream, a); }
#endif
    const hipError_t le = hipPeekAtLastError();
    if (le != hipSuccess) fprintf(stderr, "kernel_launch: launch failed: %s\n", hipGetErrorName(le));
}
```

```cpp
#include <hip/hip_runtime.h>
#include <cstdio>
#include <cstdint>
#include <cstddef>

#ifndef MK_N_LAUNCHES
#define MK_N_LAUNCHES 1
#endif

#define GAS __attribute__((address_space(1)))
#define LAS __attribute__((address_space(3)))
typedef unsigned short bf16;
typedef short bf16x8 __attribute__((ext_vector_type(8)));
typedef short bf16x4 __attribute__((ext_vector_type(4)));
typedef float f32x4 __attribute__((ext_vector_type(4)));
typedef float f32x2 __attribute__((ext_vector_type(2)));
typedef unsigned u32x4 __attribute__((ext_vector_type(4)));
typedef unsigned u32x2 __attribute__((ext_vector_type(2)));

constexpr int NB = 8, SEQ = 4096, DM = 1024, CTXL = 256, DEPTH = 4, GRIDW = 64;
constexpr int TX = NB * SEQ, TC = NB * CTXL, TT = TX + TC;
constexpr int NP = 2816;
constexpr int C_NAQ = 0, C_NAK = 384, C_NAV = 768, C_GV = 1152, C_GQ = 1536, C_GK = 1728, C_GG = 1920, C_POOL = 2304, C_AF = 2560, C_AB = 2576;
constexpr int VT_C0 = 768, VT_NC = 768, VTS = TT + 128;
constexpr int NE = 32, TOPK = 4, NASG = TT * TOPK;
constexpr int SLOT_DUMMY = NASG + 256;
constexpr int GH = 4, GDK = 48, GDV = 96, NH = 6, NDH = 64;
constexpr float EPS = 1e-6f;
constexpr int NWAVES = 8, NTHREADS = 512;
constexpr int PPL = 9;
constexpr int NPHASES = 2 + PPL * DEPTH;
#ifndef MOE_FP8
#define MOE_FP8 1
#endif
#ifndef REPMASK
#define REPMASK 0
#endif
#define REPS(b) (1 + ((REPMASK >> (b)) & 1))
#ifndef GLA_CHECK
#define GLA_CHECK 0
#endif

constexpr size_t MiB = 1u << 20;
constexpr size_t WS_CTL = 0, CTL_ZERO_BYTES = 128 * 1024;
constexpr size_t WS_MOD = 2 * MiB;
constexpr size_t WS_BIN = 4 * MiB;
constexpr size_t WS_BOUT = 26 * MiB;
constexpr size_t WS_BGU = 34 * MiB;
constexpr size_t WS_BDN = 546 * MiB;
constexpr size_t WS_X = 802 * MiB;
constexpr size_t WS_H = 938 * MiB;
constexpr size_t WS_P = 1008 * MiB;
constexpr size_t WS_VTX = 1196 * MiB;
constexpr size_t WS_VTC = 1220 * MiB;
constexpr size_t WS_MIX = 1222 * MiB;
constexpr size_t WS_OF = 1290 * MiB;
constexpr size_t WS_OB = 1341 * MiB;
constexpr size_t WS_ACT = 1392 * MiB;
constexpr size_t WS_YB = 1665 * MiB;
constexpr size_t WS_LIST = 1938 * MiB;
constexpr size_t WS_GATE = 1943 * MiB;
constexpr size_t WS_DS = 1944 * MiB;
constexpr size_t WS_GD = 2025 * MiB;
constexpr size_t WS_ROPE = 2026 * MiB;
constexpr size_t WS_VTA = 2027 * MiB;
constexpr size_t WS_OPS = 2080 * MiB;
constexpr size_t WS_STB = 2132 * MiB;
constexpr size_t WS_H8 = 2172 * MiB;
constexpr size_t WS_INV = 2208 * MiB;
constexpr size_t WS_GATES = 2209 * MiB;
constexpr size_t WS_END = 2210 * MiB;
constexpr int CW_BAR = 4096;
constexpr int CW_CNT = 16384;

constexpr int STAGE_BYTES = 132096;
constexpr int MISC_OFF = STAGE_BYTES;
constexpr int TAB_OFF = MISC_OFF + 1024;
constexpr int MAXU = 28;
constexpr int LDS_BYTES = TAB_OFF + MAXU * 1024;
static_assert(LDS_BYTES <= 163840, "LDS");

#define LDS_WAIT() asm volatile("s_waitcnt lgkmcnt(0)" ::: "memory")
#define VM_WAIT() asm volatile("s_waitcnt vmcnt(0)" ::: "memory")
__device__ __forceinline__ unsigned f2bf(float f) { unsigned u = __builtin_bit_cast(unsigned, f); return (u + 0x7fffu + ((u >> 16) & 1u)) >> 16; }
__device__ __forceinline__ unsigned pk2(float lo, float hi) { return f2bf(lo) | (f2bf(hi) << 16); }
__device__ __forceinline__ float bf2f(unsigned b) { return __builtin_bit_cast(float, (b & 0xffffu) << 16); }
__device__ __forceinline__ float bflo(unsigned w) { return __builtin_bit_cast(float, w << 16); }
__device__ __forceinline__ float bfhi(unsigned w) { return __builtin_bit_cast(float, w & 0xffff0000u); }
__device__ __forceinline__ unsigned cvt_pk_bf16(float lo, float hi) { unsigned r; asm volatile("v_cvt_pk_bf16_f32 %0, %1, %2" : "=v"(r) : "v"(lo), "v"(hi)); return r; }
__device__ __forceinline__ unsigned pk4_fp8(float a, float b, float c, float d) { int p = __builtin_amdgcn_cvt_pk_fp8_f32(a, b, 0, false); p = __builtin_amdgcn_cvt_pk_fp8_f32(c, d, p, true); return (unsigned)p; }
constexpr float Y8_SCALE = 16.f, Y8_INV = 1.f / 16.f;
constexpr float W8_SCALE = 64.f, W8_INV = 1.f / 64.f;
template <int CTRL, int RM> __device__ __forceinline__ float dpp_add(float v) { const int t = __builtin_amdgcn_update_dpp(0, __float_as_int(v), CTRL, RM, 0xf, true); return v + __int_as_float(t); }
__device__ __forceinline__ float wave_scan_incl(float x) {
    x = dpp_add<0x111, 0xf>(x); x = dpp_add<0x112, 0xf>(x); x = dpp_add<0x114, 0xf>(x); x = dpp_add<0x118, 0xf>(x);
    x = dpp_add<0x142, 0xa>(x); x = dpp_add<0x143, 0xc>(x); return x;
}
template <int CTRL> __device__ __forceinline__ unsigned dpp_umax(unsigned v) { const unsigned t = (unsigned)__builtin_amdgcn_update_dpp(0, (int)v, CTRL, 0xf, 0xf, true); return t > v ? t : v; }
__device__ __forceinline__ unsigned row16_umax(unsigned v) {
    v = dpp_umax<0xB1>(v); v = dpp_umax<0x4E>(v); v = dpp_umax<0x141>(v); v = dpp_umax<0x140>(v); return v;
}
template <int CTRL> __device__ __forceinline__ float dpp_addp(float v) { const int t = __builtin_amdgcn_update_dpp(0, __float_as_int(v), CTRL, 0xf, 0xf, true); return v + __int_as_float(t); }
__device__ __forceinline__ float wave_sum(float v) {
    v = dpp_addp<0xB1>(v); v = dpp_addp<0x4E>(v); v = dpp_addp<0x141>(v); v = dpp_addp<0x140>(v);
    const auto r = __builtin_amdgcn_permlane16_swap(__float_as_uint(v), __float_as_uint(v), false, false);
    v = __uint_as_float(r[0]) + __uint_as_float(r[1]);
    const auto t = __builtin_amdgcn_permlane32_swap(__float_as_uint(v), __float_as_uint(v), false, false);
    return __uint_as_float(t[0]) + __uint_as_float(t[1]);
}
__device__ __forceinline__ float silu_f(float x) { return x / (1.f + __expf(-x)); }

#define XB_TMO      128
#define XB_XCNT(j)  (256  + 64 * (j))
#define XB_XSUB(j)  (1280 + 64 * (j))
#define XB_XGEN(j)  (2304 + 64 * (j))
#define XB_TOP      3328
#define XB_TOPGEN   3392
#define XCD_BAR_WORDS 3456
#define XB_SPIN_CAP (1u << 18)
__device__ __forceinline__ unsigned xb_ld(unsigned* p)              { return __hip_atomic_load(p, __ATOMIC_RELAXED, __HIP_MEMORY_SCOPE_AGENT); }
__device__ __forceinline__ unsigned xb_add(unsigned* p, unsigned v) { return __hip_atomic_fetch_add(p, v, __ATOMIC_RELAXED, __HIP_MEMORY_SCOPE_AGENT); }
__device__ __forceinline__ unsigned xb_xcc_id() { return (unsigned)__builtin_amdgcn_s_getreg((3 << 11) | 20) & 0xFu; }
#define XB_SPIN(cond, bar) do { unsigned _sp = 0; while (cond) { __builtin_amdgcn_s_sleep(1); \
    if ((++_sp & 255u) == 0u) { if (xb_ld(&(bar)[XB_TMO])) break; if (_sp > XB_SPIN_CAP) { atomicAdd(&(bar)[XB_TMO], 1u); break; } } } } while (0)
struct XcdBarrier { unsigned* bar; unsigned x; volatile LAS unsigned* st; };
__device__ __forceinline__ XcdBarrier xcd_barrier_post(unsigned* bar, volatile LAS unsigned* st) {
    XcdBarrier b; b.bar = bar; b.x = xb_xcc_id(); b.st = st;
    if (threadIdx.x == 0) (void)xb_add(&bar[XB_XCNT(b.x)], 1u);
    return b;
}
__device__ __forceinline__ void xcd_barrier_complete(unsigned* bar, unsigned x, unsigned& nloc, unsigned& nx) {
    const unsigned G = gridDim.x * gridDim.y * gridDim.z;
    unsigned sum, cnt, mine, sp = 0u;
    for (;;) {
        sum = 0u; cnt = 0u; mine = 0u;
#pragma unroll
        for (unsigned j = 0; j < 16; ++j) { const unsigned c = xb_ld(&bar[XB_XCNT(j)]); sum += c; cnt += (c > 0u) ? 1u : 0u; mine = (j == x) ? c : mine; }
        if (sum == G) break;
        __builtin_amdgcn_s_sleep(1);
        if ((++sp & 255u) == 0u) { if (xb_ld(&bar[XB_TMO])) break; if (sp > XB_SPIN_CAP) { atomicAdd(&bar[XB_TMO], 1u); break; } }
    }
    nloc = mine > 0u ? mine : 1u; nx = cnt > 0u ? cnt : 1u;
}
__device__ __forceinline__ void xcd_barrier(const XcdBarrier& b) {
    asm volatile("s_waitcnt vmcnt(0)" ::: "memory");
    __syncthreads();
    if (threadIdx.x == 0) {
        unsigned* bar = b.bar;
        __builtin_amdgcn_s_waitcnt(0);
        unsigned nloc = b.st[0], nx = b.st[1];
        if (nloc == 0u) { xcd_barrier_complete(bar, b.x, nloc, nx); b.st[0] = nloc; b.st[1] = nx; }
        const unsigned old = xb_add(&bar[XB_XSUB(b.x)], 1u);
        const unsigned gen = old / nloc;
        if (old + 1u == (gen + 1u) * nloc) {
            __builtin_amdgcn_fence(__ATOMIC_RELEASE, "agent");
            asm volatile("s_waitcnt vmcnt(0)" ::: "memory");
            const unsigned og = xb_add(&bar[XB_TOP], 1u);
            const unsigned tg = og / nx;
            if (og + 1u == (tg + 1u) * nx) xb_add(&bar[XB_TOPGEN], 1u);
            else XB_SPIN(xb_ld(&bar[XB_TOPGEN]) == tg, bar);
            __builtin_amdgcn_fence(__ATOMIC_ACQUIRE, "agent");
            xb_add(&bar[XB_XGEN(b.x)], 1u);
            asm volatile("s_waitcnt vmcnt(0)" ::: "memory");
        } else {
            XB_SPIN(xb_ld(&bar[XB_XGEN(b.x)]) == gen, bar);
            __builtin_amdgcn_fence(__ATOMIC_ACQUIRE, "agent");
            asm volatile("s_waitcnt vmcnt(0)" ::: "memory");
        }
    }
    __syncthreads();
}

namespace g8 {
constexpr int BM = 256, BK = 64, HALF = 128, HTB = HALF * BK * 2, NXCD = 8, WGM = 8, KD = 1024;
__device__ __forceinline__ int lds_byte(int r, int c) { const int st = (r >> 4) * 2 + (c >> 5), rr = r & 15, cc = c & 31, ob = rr * 64 + cc * 2; return st * 1024 + (ob ^ (((ob >> 9) & 1) << 5)); }
__device__ __forceinline__ void stage_rc(int b, int& R, int& C) { const int st = b / 1024, sb = b % 1024, swz = sb ^ (((sb >> 9) & 1) << 5); R = (st >> 1) * 16 + swz / 64; C = (st & 1) * 32 + (swz % 64) / 2; }
__device__ __forceinline__ int perm32(int rho) { const int n = rho >> 4, i = rho & 15; return 8 * (i >> 2) + 4 * n + (i & 3); }
struct Unit { int pm, pn, e; };
typedef int i32x8 __attribute__((ext_vector_type(8)));
typedef int i32x4 __attribute__((ext_vector_type(4)));
__device__ __forceinline__ i32x8 cat8(bf16x8 a, bf16x8 b) { const i32x4 x = __builtin_bit_cast(i32x4, a), y = __builtin_bit_cast(i32x4, b); return (i32x8){x.x, x.y, x.z, x.w, y.x, y.y, y.z, y.w}; }
__device__ __forceinline__ bool static_unit(long L, int nM, int nN, Unit& u) {
    const int nwg = nM * nN; if (L >= nwg) return false;
    int wgid = (int)L; { const int q = nwg / NXCD, r = nwg % NXCD, xcd = wgid % NXCD, off = wgid / NXCD; wgid = (xcd < r ? xcd * (q + 1) : r * (q + 1) + (xcd - r) * q) + off; }
    const int nig = WGM * nN, gid = wgid / nig, fm = gid * WGM, gsz = (nM - fm) < WGM ? (nM - fm) : WGM;
    u.pm = fm + ((wgid % nig) % gsz); u.pn = (wgid % nig) / gsz; u.e = 0; return true;
}

#ifndef PROBE_DRY
#define PROBE_DRY 0
#endif
#ifndef STAG_TICKS
#define STAG_TICKS 0
#endif
template <class Prob>
__device__ __forceinline__ void gemm_phase(LAS unsigned char* lds, const Prob& P) {

    int tid_ = threadIdx.x; asm volatile("" : "+v"(tid_));
    const int tid = tid_, wid = __builtin_amdgcn_readfirstlane(tid >> 6), lane = tid & 63, wr = wid >> 2, wc = wid & 3, fr = lane & 15, fq = lane >> 4;
    constexpr int RPB = Prob::FP8 ? KD : KD * 2, nt = RPB / (BK * 2);
    unsigned voffB[2];
    { int R0, C0, R1, C1; stage_rc(tid * 16, R0, C0); stage_rc(tid * 16 + 8192, R1, C1); const int Rb0 = Prob::PERM ? ((R0 & ~31) + perm32(R0 & 31)) : R0, Rb1 = Prob::PERM ? ((R1 & ~31) + perm32(R1 & 31)) : R1;
      voffB[0] = (unsigned)(Rb0 * RPB + C0 * 2); voffB[1] = (unsigned)(Rb1 * RPB + C1 * 2); }
    const size_t kstep = (size_t)(BK * 2), hstepB = (size_t)HALF * RPB;
    const unsigned ldsw = (unsigned)wid * 1024u;
    const int aoff = lds_byte(wr * 64 + fr, fq * 8), boff = lds_byte(wc * 32 + fr, fq * 8);
#define G8_SA(b, h) (((b) * 2 + (h)) * HTB)
#define G8_SB(b, h) ((4 + (b) * 2 + (h)) * HTB)
#define G8_STAGE(bufoff, gbase, voff) do { _Pragma("unroll") for (int _i = 0; _i < 2; ++_i) \
        __builtin_amdgcn_global_load_lds((const unsigned*)((const char*)(gbase) + (voff)[_i]), (LAS unsigned*)(lds + (bufoff) + ldsw + _i * 8192), 16, 0, 0); } while (0)
#define G8_LDA(dst, b, h) do { _Pragma("unroll") for (int m = 0; m < 4; ++m) _Pragma("unroll") for (int k = 0; k < 2; ++k) dst[m][k] = *(const LAS bf16x8*)(lds + G8_SA(b, h) + aoff + m * 2048 + k * 1024); } while (0)
#define G8_LDB(dst, b, h) do { _Pragma("unroll") for (int n = 0; n < 2; ++n) _Pragma("unroll") for (int k = 0; k < 2; ++k) dst[n][k] = *(const LAS bf16x8*)(lds + G8_SB(b, h) + boff + n * 2048 + k * 1024); } while (0)
#define G8_MMA(ai, bj, At, Bt) do { __builtin_amdgcn_s_setprio(1); if constexpr (Prob::FP8) { \
        _Pragma("unroll") for (int m = 0; m < 4; ++m) _Pragma("unroll") for (int n = 0; n < 2; ++n) \
        acc[ai][bj][m][n] = __builtin_amdgcn_mfma_scale_f32_16x16x128_f8f6f4(cat8(Bt[n][0], Bt[n][1]), cat8(At[m][0], At[m][1]), acc[ai][bj][m][n], 0, 0, 0, 0x7f7f7f7f, 0, 0x7f7f7f7f); } else { \
        _Pragma("unroll") for (int m = 0; m < 4; ++m) _Pragma("unroll") for (int n = 0; n < 2; ++n) _Pragma("unroll") for (int k = 0; k < 2; ++k) \
        acc[ai][bj][m][n] = __builtin_amdgcn_mfma_f32_16x16x32_bf16(Bt[n][k], At[m][k], acc[ai][bj][m][n], 0, 0, 0); } __builtin_amdgcn_s_setprio(0); } while (0)
#define G8_WAIT_V(n) asm volatile("s_waitcnt vmcnt(" #n ")" ::: "memory")
#define G8_WAIT_L(n) asm volatile("s_waitcnt lgkmcnt(" #n ")" ::: "memory")
#define G8_BAR __builtin_amdgcn_s_barrier()
#define G8_SCHED __builtin_amdgcn_sched_barrier(0)
    Unit cur, nxt; int ui = 0;
    if (!P.next(0, cur)) return;
    f32x4 acc[2][2][4][2];
#pragma unroll
    for (int a = 0; a < 2; ++a)
#pragma unroll
        for (int b = 0; b < 2; ++b)
#pragma unroll
            for (int m = 0; m < 4; ++m)
#pragma unroll
                for (int n = 0; n < 2; ++n) acc[a][b][m][n] = (f32x4){0.f, 0.f, 0.f, 0.f};
    bf16x8 At[4][2], B0[2][2], B1[2][2];
    unsigned cvA[2][2];
    P.a_off(cur, 0, tid, cvA);
    const char* cA = P.a_base(cur);
    const char* cB = P.b_ptr(cur);
    G8_STAGE(G8_SB(0, 0), cB, voffB); G8_STAGE(G8_SB(0, 1), cB + hstepB, voffB); G8_STAGE(G8_SA(0, 0), cA, cvA[0]); G8_STAGE(G8_SA(0, 1), cA, cvA[1]);
    if (wr == 1) G8_BAR;
    G8_WAIT_V(2); G8_BAR;
    G8_STAGE(G8_SB(1, 0), cB + kstep, voffB); G8_STAGE(G8_SA(1, 0), cA + kstep, cvA[0]); G8_STAGE(G8_SB(1, 1), cB + hstepB + kstep, voffB);
    G8_WAIT_V(6); G8_BAR;
    for (;;) {
        const bool has_next = P.next(ui + 1, nxt);
        const char* nB = has_next ? P.b_ptr(nxt) : cB;
        const char* nA = has_next ? P.a_base(nxt) : cA;
        for (int t = 0; t < nt; t += 2) {
            const bool last = (t == nt - 2);
            const char* a1 = cA + (size_t)(t + 1) * kstep;
            const char* a2 = last ? nA : cA + (size_t)(t + 2) * kstep; const char* b2 = last ? nB : cB + (size_t)(t + 2) * kstep;
            const char* a3 = a2 + kstep; const char* b3 = b2 + kstep;
            G8_LDB(B0, 0, 0); G8_LDB(B1, 0, 1); G8_SCHED; G8_LDA(At, 0, 0); G8_STAGE(G8_SA(1, 1), a1, cvA[1]);
            G8_WAIT_V(8); G8_WAIT_L(0); G8_BAR; G8_MMA(0, 0, At, B0); G8_MMA(0, 1, At, B1); G8_BAR; G8_SCHED;
            if (last && has_next) { int tz = threadIdx.x; asm volatile("" : "+v"(tz)); P.a_off(nxt, ui + 1, tz, cvA); }
            G8_LDA(At, 0, 1); G8_STAGE(G8_SB(0, 0), b2, voffB); G8_STAGE(G8_SB(0, 1), b2 + hstepB, voffB); G8_STAGE(G8_SA(0, 0), a2, cvA[0]);
            G8_WAIT_V(8); G8_WAIT_L(0); G8_BAR; G8_MMA(1, 0, At, B0); G8_MMA(1, 1, At, B1); G8_BAR; G8_SCHED;
            G8_LDB(B0, 1, 0); G8_LDB(B1, 1, 1); G8_SCHED; G8_LDA(At, 1, 0); G8_STAGE(G8_SA(0, 1), a2, cvA[1]);
            G8_WAIT_V(8); G8_WAIT_L(0); G8_BAR; G8_MMA(0, 0, At, B0); G8_MMA(0, 1, At, B1); G8_BAR; G8_SCHED;
            G8_LDA(At, 1, 1); G8_STAGE(G8_SB(1, 0), b3, voffB); G8_STAGE(G8_SB(1, 1), b3 + hstepB, voffB); G8_STAGE(G8_SA(1, 0), a3, cvA[0]);
            G8_WAIT_V(8); G8_WAIT_L(0); G8_BAR; G8_MMA(1, 0, At, B0); G8_MMA(1, 1, At, B1); G8_BAR; G8_SCHED;
        }
        if (wr == 0) G8_BAR;
        P.epi(acc, cur, ui, wr, wc, fr, fq);
        if (!has_next) break;
#pragma unroll
        for (int a = 0; a < 2; ++a)
#pragma unroll
            for (int b = 0; b < 2; ++b)
#pragma unroll
                for (int m = 0; m < 4; ++m)
#pragma unroll
                    for (int n = 0; n < 2; ++n) acc[a][b][m][n] = (f32x4){0.f, 0.f, 0.f, 0.f};
        cur = nxt; cB = nB; cA = nA; ++ui;
        if (wr == 1) G8_BAR;
    }
    G8_WAIT_V(0);
    G8_BAR;
#undef G8_SA
#undef G8_SB
#undef G8_STAGE
#undef G8_LDA
#undef G8_LDB
#undef G8_MMA
#undef G8_WAIT_V
#undef G8_WAIT_L
#undef G8_BAR
#undef G8_SCHED
}


struct ProbIn {
    static constexpr bool PERM = true, FP8 = false;
    const char* A; const char* Bt; bf16* O; bf16* VT; int G, c; int dry;
    __device__ __forceinline__ static bool swapped(const Unit& u) { return u.pn >= 3 && u.pn <= 5; }
    __device__ __forceinline__ bool next(int i, Unit& u) const { return static_unit((long)i * G + c, TT / 256, NP / 256, u); }
    __device__ __forceinline__ void a_off(const Unit& u, int, int tid, unsigned (&v)[2][2]) const {
        int R0, C0, R1, C1; stage_rc(tid * 16, R0, C0); stage_rc(tid * 16 + 8192, R1, C1);
        const int rt = swapped(u) ? u.pn : u.pm;
#pragma unroll
        for (int h = 0; h < 2; ++h) { v[h][0] = (unsigned)((rt * 256 + h * 128 + R0) * KD + C0) * 2u; v[h][1] = (unsigned)((rt * 256 + h * 128 + R1) * KD + C1) * 2u; }
    }
    __device__ __forceinline__ const char* a_base(const Unit& u) const { return swapped(u) ? Bt : A; }
    __device__ __forceinline__ const char* b_ptr(const Unit& u) const { return swapped(u) ? A + (size_t)u.pm * 256 * KD * 2 : Bt + (size_t)u.pn * 256 * KD * 2; }
    __device__ __forceinline__ void epi(const f32x4 (&acc)[2][2][4][2], const Unit& u, int, int wr, int wc, int fr, int fq) const {
        if (PROBE_DRY && dry) { asm volatile("" :: "v"(acc[0][0][0][0][0]), "v"(acc[1][1][3][1][3]), "v"(acc[0][1][2][0][1]), "v"(acc[1][0][1][1][2])); return; }
        const bool sw = swapped(u);
        bf16* base = sw ? VT + (size_t)(u.pn * 256 - VT_C0 + wr * 64 + fr) * VTS + u.pm * 256 + wc * 32 + 8 * fq
                        : O + (size_t)(u.pm * 256 + wr * 64 + fr) * NP + u.pn * 256 + wc * 32 + 8 * fq;
        const size_t ld = sw ? (size_t)VTS : (size_t)NP;
#pragma unroll
        for (int ai = 0; ai < 2; ++ai)
#pragma unroll
            for (int m = 0; m < 4; ++m) { bf16* rowp = base + (size_t)(ai * 128 + m * 16) * ld;
#pragma unroll
                for (int bj = 0; bj < 2; ++bj) { const f32x4 v0 = acc[ai][bj][m][0], v1 = acc[ai][bj][m][1];
                    u32x4 w; w.x = cvt_pk_bf16(v0[0], v0[1]); w.y = cvt_pk_bf16(v0[2], v0[3]); w.z = cvt_pk_bf16(v1[0], v1[1]); w.w = cvt_pk_bf16(v1[2], v1[3]);
                    *(u32x4*)(rowp + bj * 128) = w; } }
    }
};
struct ProbOut {
    static constexpr bool PERM = false, FP8 = false;
    const char* A; const char* Bt; bf16* X; const float* modl  ; int G, c, nM;
    __device__ __forceinline__ bool next(int i, Unit& u) const { return static_unit((long)i * G + c, nM, DM / 256, u); }
    __device__ __forceinline__ void a_off(const Unit& u, int, int tid, unsigned (&v)[2][2]) const {
        int R0, C0, R1, C1; stage_rc(tid * 16, R0, C0); stage_rc(tid * 16 + 8192, R1, C1);
#pragma unroll
        for (int h = 0; h < 2; ++h) { v[h][0] = (unsigned)((u.pm * 256 + h * 128 + R0) * KD + C0) * 2u; v[h][1] = (unsigned)((u.pm * 256 + h * 128 + R1) * KD + C1) * 2u; }
    }
    __device__ __forceinline__ const char* a_base(const Unit&) const { return A; }
    __device__ __forceinline__ const char* b_ptr(const Unit& u) const { return Bt + (size_t)u.pn * 256 * KD * 2; }
    __device__ __forceinline__ void epi(const f32x4 (&acc)[2][2][4][2], const Unit& u, int, int wr, int wc, int fr, int fq) const {
        const int r0 = u.pm * 256, br = r0 < TX ? (r0 / SEQ) : NB;
        const float* g1 = modl + (size_t)br * 6 * DM + 2 * DM;
        const int row0 = r0 + wr * 64 + fr, col0 = u.pn * 256 + wc * 32 + 4 * fq;
        f32x4 gv[2][2];
#pragma unroll
        for (int bj = 0; bj < 2; ++bj)
#pragma unroll
            for (int n = 0; n < 2; ++n) gv[bj][n] = *(const f32x4*)(g1 + col0 + bj * 128 + n * 16);
#pragma unroll
        for (int ai = 0; ai < 2; ++ai) {
            u32x2 xv[4][2][2];
#pragma unroll
            for (int m = 0; m < 4; ++m)
#pragma unroll
                for (int bj = 0; bj < 2; ++bj)
#pragma unroll
                    for (int n = 0; n < 2; ++n) xv[m][bj][n] = *(const u32x2*)(X + (size_t)(row0 + ai * 128 + m * 16) * DM + col0 + bj * 128 + n * 16);
#pragma unroll
            for (int m = 0; m < 4; ++m)
#pragma unroll
                for (int bj = 0; bj < 2; ++bj)
#pragma unroll
                    for (int n = 0; n < 2; ++n) { const u32x2 xw = xv[m][bj][n]; const f32x4 y = (f32x4){bflo(xw.x), bfhi(xw.x), bflo(xw.y), bfhi(xw.y)} + gv[bj][n] * acc[ai][bj][m][n];
                        u32x2 w; w.x = cvt_pk_bf16(y[0], y[1]); w.y = cvt_pk_bf16(y[2], y[3]);
                        *(u32x2*)(X + (size_t)(row0 + ai * 128 + m * 16) * DM + col0 + bj * 128 + n * 16) = w; }
        }
    }
};
__device__ __forceinline__ bool moe_unit(long L, int npn, const volatile LAS int* tp, Unit& u) {
    const int q = (int)(L / npn); if (q >= tp[NE]) return false;
    int e = 0;
#pragma unroll 1
    while (tp[e + 1] <= q) ++e;
    u.e = e; u.pm = q - tp[e]; u.pn = (int)(L % npn); return true;
}
struct ProbGU {
    static constexpr bool PERM = true, FP8 = (MOE_FP8 != 0); static constexpr unsigned EB = FP8 ? 1u : 2u;
    const char* A; const char* Bt  ; unsigned char* ACT; const float* bgu  ; const volatile LAS int* tp; const LAS int* tab; int G, c; int dry; const volatile LAS int* eb;
    __device__ __forceinline__ bool next(int i, Unit& u) const { return i < MAXU && moe_unit((long)i * G + c, 8, tp, u); }
    __device__ __forceinline__ void a_off(const Unit&, int ui, int tid, unsigned (&v)[2][2]) const {
        int R0, C0, R1, C1; stage_rc(tid * 16, R0, C0); stage_rc(tid * 16 + 8192, R1, C1);
#pragma unroll
        for (int h = 0; h < 2; ++h) { const int a0 = tab[ui * 256 + h * 128 + R0], a1 = tab[ui * 256 + h * 128 + R1];
            v[h][0] = (unsigned)(a0 < 0 ? TT : (a0 >> 2)) * (unsigned)KD * EB + (unsigned)C0 * 2u; v[h][1] = (unsigned)(a1 < 0 ? TT : (a1 >> 2)) * (unsigned)KD * EB + (unsigned)C1 * 2u; }
    }
    __device__ __forceinline__ const char* a_base(const Unit&) const { return A; }
    __device__ __forceinline__ const char* b_ptr(const Unit& u) const { return Bt + ((size_t)u.e * 2 * DM + (size_t)u.pn * 256) * KD * EB; }
    __device__ __forceinline__ void epi(const f32x4 (&acc)[2][2][4][2], const Unit& u, int ui, int wr, int wc, int fr, int fq) const {
        if (PROBE_DRY && dry) { asm volatile("" :: "v"(acc[0][0][0][0][0]), "v"(acc[1][1][3][1][3]), "v"(acc[0][1][2][0][1]), "v"(acc[1][0][1][1][2])); return; }
        const int cb = u.pn * 128 + wc * 32 + 8 * fq;
        const float* bg = bgu + (size_t)u.e * 2 * DM + cb; const float* bu = bg + DM;
        const f32x4 bg0 = *(const f32x4*)bg, bg1 = *(const f32x4*)(bg + 4), bu0 = *(const f32x4*)bu, bu1 = *(const f32x4*)(bu + 4);
        const int ebu = eb[u.e] + u.pm * 256;
#pragma unroll
        for (int ai = 0; ai < 2; ++ai)
#pragma unroll
            for (int m = 0; m < 4; ++m) {
                const int a = tab[ui * 256 + ai * 128 + wr * 64 + m * 16 + fr];
                unsigned char* rowp = ACT + ((size_t)(a < 0 ? SLOT_DUMMY : ebu + ai * 128 + wr * 64 + m * 16 + fr) * DM + cb) * EB;
                float o[8];
#pragma unroll
                for (int n = 0; n < 2; ++n) { const f32x4 gb = n ? bg1 : bg0, ub = n ? bu1 : bu0;
#pragma unroll
                    for (int j = 0; j < 4; ++j) { float g = acc[ai][0][m][n][j] * (FP8 ? W8_INV : 1.f) + gb[j], uu = acc[ai][1][m][n][j] * (FP8 ? W8_INV : 1.f) + ub[j];
                        g = fminf(g, 7.f); uu = fminf(fmaxf(uu, -7.f), 7.f);
                        o[n * 4 + j] = g * __builtin_amdgcn_rcpf(1.f + __expf(-1.702f * g)) * (uu + 1.f); } }
                if constexpr (FP8) { u32x2 w; w.x = pk4_fp8(o[0], o[1], o[2], o[3]); w.y = pk4_fp8(o[4], o[5], o[6], o[7]); *(u32x2*)rowp = w; }
                else { u32x4 w; w.x = cvt_pk_bf16(o[0], o[1]); w.y = cvt_pk_bf16(o[2], o[3]); w.z = cvt_pk_bf16(o[4], o[5]); w.w = cvt_pk_bf16(o[6], o[7]); *(u32x4*)rowp = w; } }
    }
};
struct ProbDN {
    static constexpr bool PERM = true, FP8 = (MOE_FP8 != 0); static constexpr unsigned EB = FP8 ? 1u : 2u;
    const char* A; const char* Bt  ; bf16* YB; const float* bdn  ; const float* gates  ; const volatile LAS int* tp; int G, c; int dry; const volatile LAS int* eb; const volatile LAS int* cntl;
    __device__ __forceinline__ bool next(int i, Unit& u) const { return i < MAXU && moe_unit((long)i * G + c, 4, tp, u); }
    __device__ __forceinline__ void a_off(const Unit& u, int, int tid, unsigned (&v)[2][2]) const {
        int R0, C0, R1, C1; stage_rc(tid * 16, R0, C0); stage_rc(tid * 16 + 8192, R1, C1);
        const int r0 = eb[u.e] + u.pm * 256;
#pragma unroll
        for (int h = 0; h < 2; ++h) { v[h][0] = (unsigned)(r0 + h * 128 + R0) * (unsigned)KD * EB + (unsigned)C0 * 2u; v[h][1] = (unsigned)(r0 + h * 128 + R1) * (unsigned)KD * EB + (unsigned)C1 * 2u; }
    }
    __device__ __forceinline__ const char* a_base(const Unit&) const { return A; }
    __device__ __forceinline__ const char* b_ptr(const Unit& u) const { return Bt + ((size_t)u.e * DM + (size_t)u.pn * 256) * KD * EB; }
    __device__ __forceinline__ void epi(const f32x4 (&acc)[2][2][4][2], const Unit& u, int ui, int wr, int wc, int fr, int fq) const {
        if (PROBE_DRY && dry) { asm volatile("" :: "v"(acc[0][0][0][0][0]), "v"(acc[1][1][3][1][3]), "v"(acc[0][1][2][0][1]), "v"(acc[1][0][1][1][2])); return; }
        const int col0 = u.pn * 256 + wc * 32 + 8 * fq;
        const float* bd = bdn + (size_t)u.e * DM + col0;
        f32x4 bv[2][2];
#pragma unroll
        for (int bj = 0; bj < 2; ++bj)
#pragma unroll
            for (int n = 0; n < 2; ++n) bv[bj][n] = *(const f32x4*)(bd + bj * 128 + 4 * n);
        int sl[2][4]; float gt[2][4]; const int ebu = eb[u.e] + u.pm * 256, nval = cntl[u.e] - u.pm * 256;
#pragma unroll
        for (int ai = 0; ai < 2; ++ai)
#pragma unroll
            for (int m = 0; m < 4; ++m) { const int rl = ai * 128 + wr * 64 + m * 16 + fr; sl[ai][m] = rl < nval ? ebu + rl : SLOT_DUMMY; gt[ai][m] = gates[sl[ai][m]]; }
#pragma unroll
        for (int ai = 0; ai < 2; ++ai)
#pragma unroll
            for (int m = 0; m < 4; ++m) {
                if constexpr (FP8) {
                    unsigned char* rowp = (unsigned char*)YB + (size_t)sl[ai][m] * DM + col0;
#pragma unroll
                    for (int bj = 0; bj < 2; ++bj) { const f32x4 v0 = (acc[ai][bj][m][0] * W8_INV + bv[bj][0]) * (gt[ai][m] * Y8_SCALE), v1 = (acc[ai][bj][m][1] * W8_INV + bv[bj][1]) * (gt[ai][m] * Y8_SCALE);
                        u32x2 w; w.x = pk4_fp8(v0[0], v0[1], v0[2], v0[3]); w.y = pk4_fp8(v1[0], v1[1], v1[2], v1[3]); *(u32x2*)(rowp + bj * 128) = w; }
                } else {
                    bf16* rowp = YB + (size_t)sl[ai][m] * DM + col0;
#pragma unroll
                    for (int bj = 0; bj < 2; ++bj) { const f32x4 v0 = (acc[ai][bj][m][0] + bv[bj][0]) * gt[ai][m], v1 = (acc[ai][bj][m][1] + bv[bj][1]) * gt[ai][m];
                        u32x4 w; w.x = cvt_pk_bf16(v0[0], v0[1]); w.y = cvt_pk_bf16(v0[2], v0[3]); w.z = cvt_pk_bf16(v1[0], v1[1]); w.w = cvt_pk_bf16(v1[2], v1[3]);
                        *(u32x4*)(rowp + bj * 128) = w; }
                } }
    }
};
}

struct Args { const float* in[23]; float* out; unsigned char* ws; int ph_lo, ph_hi; };
struct Frame {
    LAS unsigned char* lds; volatile LAS unsigned* MISC;
    int tid, lane, wave, G, vcu;
    const float *x, *c, *ctx, *c_ctx, *norm1_g, *norm2_g, *w_ada, *b_ada, *w_in, *gla_wa2, *gla_ba, *gla_norm_g, *na_rpb, *pool_w, *pool_scale, *w_out, *router_w, *router_b, *w_gu, *b_gu, *w_down, *b_down, *final_g;
    float* out; unsigned char* ws; unsigned* ctl;
    float* mod; bf16 *Bin, *Bout, *Bgu, *Bdn; bf16* X; bf16 *H, *P, *VTX, *VTC, *MIX; float *OF, *OB; bf16 *ACT, *YB; int* LIST; float* GATE; float *DS, *GD, *ROPE; bf16 *VTA, *OPS, *STB; unsigned char* H8; int* INV; float* GATES;
};


#define CAS __attribute__((address_space(4)))
__device__ __forceinline__ void frame_ptrs(Frame& F) {
    const CAS unsigned char* ka = (const CAS unsigned char*)__builtin_amdgcn_kernarg_segment_ptr();
    asm volatile("" : "+s"(ka));
    typedef const GAS float* gfp;
    const CAS gfp* in = (const CAS gfp*)ka;
    F.x = (const float*)in[0]; F.c = (const float*)in[1]; F.ctx = (const float*)in[2]; F.c_ctx = (const float*)in[3]; F.norm1_g = (const float*)in[4]; F.norm2_g = (const float*)in[5];
    F.w_ada = (const float*)in[6]; F.b_ada = (const float*)in[7]; F.w_in = (const float*)in[8]; F.gla_wa2 = (const float*)in[9]; F.gla_ba = (const float*)in[10]; F.gla_norm_g = (const float*)in[11];
    F.na_rpb = (const float*)in[12]; F.pool_w = (const float*)in[13]; F.pool_scale = (const float*)in[14]; F.w_out = (const float*)in[15]; F.router_w = (const float*)in[16]; F.router_b = (const float*)in[17];
    F.w_gu = (const float*)in[18]; F.b_gu = (const float*)in[19]; F.w_down = (const float*)in[20]; F.b_down = (const float*)in[21]; F.final_g = (const float*)in[22];
    F.out = (float*)*(GAS float* const CAS*)(ka + 184);
    GAS unsigned char* ws = *(GAS unsigned char* const CAS*)(ka + 192);
    F.ws = (unsigned char*)ws; F.ctl = (unsigned*)(ws + WS_CTL);
    F.mod = (float*)(ws + WS_MOD); F.Bin = (bf16*)(ws + WS_BIN); F.Bout = (bf16*)(ws + WS_BOUT); F.Bgu = (bf16*)(ws + WS_BGU); F.Bdn = (bf16*)(ws + WS_BDN);
    F.X = (bf16*)(ws + WS_X); F.H = (bf16*)(ws + WS_H); F.P = (bf16*)(ws + WS_P); F.VTX = (bf16*)(ws + WS_VTX); F.VTC = (bf16*)(ws + WS_VTC); F.MIX = (bf16*)(ws + WS_MIX);
    F.OF = (float*)(ws + WS_OF); F.OB = (float*)(ws + WS_OB); F.ACT = (bf16*)(ws + WS_ACT); F.YB = (bf16*)(ws + WS_YB); F.LIST = (int*)(ws + WS_LIST); F.GATE = (float*)(ws + WS_GATE);
    F.DS = (float*)(ws + WS_DS); F.GD = (float*)(ws + WS_GD); F.ROPE = (float*)(ws + WS_ROPE); F.VTA = (bf16*)(ws + WS_VTA); F.OPS = (bf16*)(ws + WS_OPS); F.STB = (bf16*)(ws + WS_STB); F.H8 = (unsigned char*)(ws + WS_H8); F.INV = (int*)(ws + WS_INV); F.GATES = (float*)(ws + WS_GATES);
}
static_assert(offsetof(Args, out) == 184 && offsetof(Args, ws) == 192, "Args layout");

__device__ __forceinline__ void in_col_map(int n0, int& dst, float& scale) {
    scale = 1.f;
    if (n0 < 192) { dst = C_GQ + n0; scale = 0.14433756729740643f; }
    else if (n0 < 384) dst = C_GK + (n0 - 192);
    else if (n0 < 768) dst = C_GV + (n0 - 384);
    else if (n0 < 800) dst = C_AF + (n0 - 768);
    else if (n0 < 1184) dst = C_GG + (n0 - 800);
    else if (n0 < 1568) { dst = C_NAQ + (n0 - 1184); scale = 0.125f * 1.4426950408889634f; }
    else if (n0 < 1952) dst = C_NAK + (n0 - 1568);
    else if (n0 < 2336) dst = C_NAV + (n0 - 1952);
    else dst = C_POOL + (n0 - 2336);
}
struct TItem { const float* src; int N; unsigned char* dst; int fp8; float scale; };
__device__ __forceinline__ TItem titem_decode(const Frame& F, int r) {
    constexpr int I_IN = DEPTH * 16 * 81, I_OUT = DEPTH * 16 * 32, I_GU = DEPTH * NE * 16 * 64;
    TItem t; t.fp8 = 0; t.scale = 1.f;
    if (r < I_IN) { const int l = r / (16 * 81), rr = r % (16 * 81), kb = rr / 81, nb = rr % 81; int dst; in_col_map(nb * 32, dst, t.scale);
        t.N = 2592; t.src = F.w_in + (size_t)l * DM * 2592 + (size_t)(kb * 64) * 2592 + nb * 32; t.dst = (unsigned char*)(F.Bin + ((size_t)l * NP + dst) * DM + kb * 64); return t; }
    r -= I_IN;
    if (r < I_OUT) { const int l = r / (16 * 32), rr = r % (16 * 32), kb = rr / 32, nb = rr % 32;
        t.N = DM; t.src = F.w_out + (size_t)l * DM * DM + (size_t)(kb * 64) * DM + nb * 32; t.dst = (unsigned char*)(F.Bout + ((size_t)l * DM + nb * 32) * DM + kb * 64); return t; }
    r -= I_OUT; t.fp8 = MOE_FP8; constexpr size_t EB = MOE_FP8 ? 1 : 2;
    if (r < I_GU) { const int le = r / (16 * 64), rr = r % (16 * 64), kb = rr / 64, nb = rr % 64; const int j0 = nb * 32;
        const int dst = j0 < DM ? (j0 / 128) * 256 + (j0 % 128) : ((j0 - DM) / 128) * 256 + 128 + ((j0 - DM) % 128);
        t.N = 2 * DM; t.src = F.w_gu + (size_t)le * DM * 2 * DM + (size_t)(kb * 64) * 2 * DM + j0; t.dst = (unsigned char*)F.Bgu + (((size_t)le * 2 * DM + dst) * DM + kb * 64) * EB; return t; }
    r -= I_GU;
    { const int le = r / (16 * 32), rr = r % (16 * 32), kb = rr / 32, nb = rr % 32;
        t.N = DM; t.src = F.w_down + (size_t)le * DM * DM + (size_t)(kb * 64) * DM + nb * 32; t.dst = (unsigned char*)F.Bdn + (((size_t)le * DM + nb * 32) * DM + kb * 64) * EB; return t; }
}
__device__ __forceinline__ void titem_load(const TItem& t, int lane, f32x4 (&r)[8]) {
#pragma unroll
    for (int i = 0; i < 8; ++i) r[i] = *(const f32x4*)(t.src + (size_t)((lane >> 3) + 8 * i) * t.N + 4 * (lane & 7));
}
__device__ __forceinline__ void titem_store(const TItem& t, const f32x4 (&r)[8], LAS float* scr, int lane) {
#pragma unroll
    for (int i = 0; i < 8; ++i) { LAS float* p = scr + ((lane >> 3) + 8 * i) * 33 + 4 * (lane & 7); p[0] = r[i].x; p[1] = r[i].y; p[2] = r[i].z; p[3] = r[i].w; }
    LDS_WAIT(); asm volatile("" ::: "memory");
    if (t.fp8) { const int c = lane & 3; const float sc = W8_SCALE;
#pragma unroll
        for (int j = 0; j < 2; ++j) { const int n = (lane >> 2) + 16 * j; const LAS float* s = scr + (16 * c) * 33 + n;
            u32x4 o;
            o.x = pk4_fp8(s[0 * 33] * sc, s[1 * 33] * sc, s[2 * 33] * sc, s[3 * 33] * sc); o.y = pk4_fp8(s[4 * 33] * sc, s[5 * 33] * sc, s[6 * 33] * sc, s[7 * 33] * sc);
            o.z = pk4_fp8(s[8 * 33] * sc, s[9 * 33] * sc, s[10 * 33] * sc, s[11 * 33] * sc); o.w = pk4_fp8(s[12 * 33] * sc, s[13 * 33] * sc, s[14 * 33] * sc, s[15 * 33] * sc);
            *(u32x4*)(t.dst + (size_t)n * DM + 16 * c) = o; }
    } else { const int c = lane & 7; const float sc = t.scale;
#pragma unroll
        for (int j = 0; j < 4; ++j) { const int n = (lane >> 3) + 8 * j; const LAS float* s = scr + (8 * c) * 33 + n;
            u32x4 o; o.x = pk2(s[0 * 33] * sc, s[1 * 33] * sc); o.y = pk2(s[2 * 33] * sc, s[3 * 33] * sc); o.z = pk2(s[4 * 33] * sc, s[5 * 33] * sc); o.w = pk2(s[6 * 33] * sc, s[7 * 33] * sc);
            *(u32x4*)(t.dst + ((size_t)n * DM + 8 * c) * 2) = o; }
    }
    LDS_WAIT(); asm volatile("" ::: "memory");
}
__device__ __forceinline__ int conv_item_id(int t, int lay, int nfix) {
    constexpr int I_IN = DEPTH * 16 * 81, I_OUT = DEPTH * 16 * 32, I_GU = DEPTH * NE * 16 * 64;
    if (t < nfix) return t;
    t -= nfix;
    return t < NE * 16 * 64 ? I_IN + I_OUT + lay * (NE * 16 * 64) + t : I_IN + I_OUT + I_GU + lay * (NE * 16 * 32) + (t - NE * 16 * 64);
}
__device__ __forceinline__ void convert_items(Frame& F, int lay, int ntot, int t0 = 0, int t1 = -1) {
    LAS float* scr = (LAS float*)(F.lds + F.wave * 16384);
    const int gw = F.vcu * NWAVES + F.wave, NGW = F.G * NWAVES, lane = F.lane;
    const int nfix = ntot - 3 * (NE * 16 * 32);
    if (t1 >= 0) ntot = t1;
    int it = t0 + gw; TItem cur = titem_decode(F, conv_item_id(it < ntot ? it : 0, lay, nfix)); f32x4 ra[8];
    if (it < ntot) titem_load(cur, lane, ra);
    while (it < ntot) {
        const int itn = it + NGW; const bool hn = itn < ntot;
        TItem nxt = titem_decode(F, conv_item_id(hn ? itn : 0, lay, nfix)); f32x4 rb[8];
        if (hn) titem_load(nxt, lane, rb);
        titem_store(cur, ra, scr, lane);
        it = itn; cur = nxt;
#pragma unroll
        for (int i = 0; i < 8; ++i) ra[i] = rb[i];
    }
}
__device__ __forceinline__ void ph_prologue(Frame& F) {
    const int gw = F.vcu * NWAVES + F.wave, NGW = F.G * NWAVES, lane = F.lane;
    constexpr int I_IN = DEPTH * 16 * 81, I_OUT = DEPTH * 16 * 32;
    for (int r = F.vcu; r < DEPTH * 24; r += F.G) {
        const int l = r / 24, j4 = (r % 24) * 256 + 4 * lane, k0 = F.wave * 128;
        const float* W = F.w_ada + (size_t)l * DM * 6 * DM + (size_t)k0 * 6 * DM + j4;
        f32x4 acc[9];
#pragma unroll
        for (int q = 0; q < 9; ++q) acc[q] = (f32x4){0.f, 0.f, 0.f, 0.f};
#pragma unroll 1
        for (int kh = 0; kh < 2; ++kh) {
            float cv[9];
#pragma unroll
            for (int q = 0; q < 8; ++q) cv[q] = silu_f(F.c[q * DM + k0 + 64 * kh + lane]);
            cv[8] = silu_f(F.c_ctx[k0 + 64 * kh + lane]);
#pragma unroll 8
            for (int kk = 0; kk < 64; ++kk) { const f32x4 w = *(const f32x4*)(W + (size_t)(64 * kh + kk) * 6 * DM);
#pragma unroll
                for (int q = 0; q < 9; ++q) acc[q] += __builtin_bit_cast(float, __builtin_amdgcn_readlane(__builtin_bit_cast(int, cv[q]), kk)) * w; }
        }
        LAS float* part = (LAS float*)F.lds;
#pragma unroll
        for (int q = 0; q < 9; ++q) *(LAS f32x4*)(part + (F.wave * 9 + q) * 256 + 4 * lane) = acc[q];
        __syncthreads();
        for (int o = F.tid; o < 9 * 256; o += NTHREADS) { const int q = o >> 8, cc = o & 255; float sum = F.b_ada[(size_t)l * 6 * DM + (r % 24) * 256 + cc];
#pragma unroll
            for (int w = 0; w < NWAVES; ++w) sum += part[(w * 9 + q) * 256 + cc];
            F.mod[((size_t)l * 9 + q) * 6 * DM + (r % 24) * 256 + cc] = sum; }
        __syncthreads();
    }
    convert_items(F, 0, I_IN + I_OUT + 3 * (NE * 16 * 32), 0, I_IN + I_OUT);
#if GLA_CHECK
    for (int lay = 0; lay < DEPTH; ++lay) convert_items(F, lay, 3 * (NE * 16 * 32));
#endif
    if (F.vcu == 0) for (int i = F.tid; i < 64 * 12; i += NTHREADS) { const int pos = i / 12, fi = i % 12;
        const float invf = expf(-((float)(2 * fi) / 24.f) * 9.210340371976184f); const float ang = (float)pos * invf; F.ROPE[i] = cosf(ang); F.ROPE[768 + i] = sinf(ang); }
    const size_t gt = (size_t)F.vcu * NTHREADS + F.tid, NGT = (size_t)F.G * NTHREADS;
    for (size_t i = gt; i < (size_t)DEPTH * 224 * DM / 8; i += NGT) { const size_t l = i / (224 * DM / 8), rr = i % (224 * DM / 8);
        *(u32x4*)(F.Bin + (l * NP + 2592) * DM + rr * 8) = (u32x4){0u, 0u, 0u, 0u}; }
    for (size_t i = gt; i < (size_t)256 * DM / 8; i += NGT) *(u32x4*)(F.H + (size_t)TT * DM + i * 8) = (u32x4){0u, 0u, 0u, 0u};
    for (size_t i = gt; i < (size_t)256 * DM / 16; i += NGT) *(u32x4*)(F.H8 + (size_t)TT * DM + i * 16) = (u32x4){0u, 0u, 0u, 0u};
}

__device__ __forceinline__ void norm_mod_store(const f32x4 (&v)[4], const float* gw, const float* sc, const float* sh, bf16* orow, int lane) {
    float s = 0.f;
#pragma unroll
    for (int j = 0; j < 4; ++j) s += (v[j].x * v[j].x + v[j].y * v[j].y) + (v[j].z * v[j].z + v[j].w * v[j].w);
    const float rinv = 1.f / sqrtf(wave_sum(s) * (1.f / DM) + EPS);
#pragma unroll
    for (int j = 0; j < 4; ++j) { const int c = 4 * lane + 256 * j;
        const f32x4 g = *(const f32x4*)(gw + c), a = *(const f32x4*)(sc + c), b = *(const f32x4*)(sh + c);
        const f32x4 y = (v[j] * rinv * g) * (a + 1.f) + b;
        u32x2 w; w.x = pk2(y.x, y.y); w.y = pk2(y.z, y.w);
        *(u32x2*)(orow + c) = w; }
}
__device__ __forceinline__ void ph_first_norm(Frame& F) {
    const int gw = F.vcu * NWAVES + F.wave, NGW = F.G * NWAVES, lane = F.lane;
    for (int m = gw; m < TT; m += NGW) {
        const float* src = m < TX ? F.x + (size_t)m * DM : F.ctx + (size_t)(m - TX) * DM;
        const int br = m < TX ? m / SEQ : NB;
        f32x4 v[4];
#pragma unroll
        for (int j = 0; j < 4; ++j) { v[j] = *(const f32x4*)(src + 4 * lane + 256 * j); u32x2 w; w.x = pk2(v[j].x, v[j].y); w.y = pk2(v[j].z, v[j].w); *(u32x2*)(F.X + (size_t)m * DM + 4 * lane + 256 * j) = w; }
        const float* md = F.mod + (size_t)br * 6 * DM;
        norm_mod_store(v, F.norm1_g, md + DM, md, F.H + (size_t)m * DM, lane);
    }
}
__device__ __forceinline__ void ph_combine(Frame& F, int l, bool dry = false) {
    const int gw = F.vcu * NWAVES + F.wave, NGW = F.G * NWAVES, lane = F.lane;
    bf16* Xo = dry ? (bf16*)F.ACT : F.X; bf16* Ho = dry ? (bf16*)F.P : F.H; float* Oo = dry ? (float*)F.ACT : F.out;
    const int M = (l == DEPTH - 1) ? TX : TT;
    const int cA = 8 * lane, cB = 512 + 8 * lane;
    for (int m0 = gw; m0 < M; m0 += 2 * NGW) {
        u32x4 yw[2][4][2]; u32x4 xw[2][2]; bool have[2]; int br[2];
#pragma unroll
        for (int rr = 0; rr < 2; ++rr) { const int m = m0 + rr * NGW; have[rr] = m < M; const int mm = have[rr] ? m : m0; br[rr] = mm < TX ? mm / SEQ : NB;
            const u32x4 sl4 = *(const u32x4*)(F.INV + (size_t)mm * 4); const unsigned slk[4] = {sl4.x, sl4.y, sl4.z, sl4.w};
#pragma unroll
            for (int k = 0; k < 4; ++k) {
                if (MOE_FP8) { const unsigned char* yr = (const unsigned char*)F.YB + (size_t)slk[k] * DM; const u32x2 a = *(const u32x2*)(yr + cA), b = *(const u32x2*)(yr + cB);
                    yw[rr][k][0] = (u32x4){a.x, a.y, 0u, 0u}; yw[rr][k][1] = (u32x4){b.x, b.y, 0u, 0u}; }
                else { yw[rr][k][0] = *(const u32x4*)(F.YB + (size_t)slk[k] * DM + cA); yw[rr][k][1] = *(const u32x4*)(F.YB + (size_t)slk[k] * DM + cB); } }
            const bf16* xr = F.X + (size_t)mm * DM;
            xw[rr][0] = *(const u32x4*)(xr + cA); xw[rr][1] = *(const u32x4*)(xr + cB); }
#pragma unroll
        for (int rr = 0; rr < 2; ++rr) { if (!have[rr]) continue;
            const int m = m0 + rr * NGW;
            const float* md = F.mod + ((size_t)l * 9 + br[rr]) * 6 * DM;
            f32x4 y[4];
#pragma unroll
            for (int j = 0; j < 4; ++j) y[j] = (f32x4){0.f, 0.f, 0.f, 0.f};
#pragma unroll
            for (int k = 0; k < 4; ++k) { const u32x4 a = yw[rr][k][0], b = yw[rr][k][1];
                if (MOE_FP8) { const f32x2 a0 = __builtin_amdgcn_cvt_pk_f32_fp8((int)a.x, false), a1 = __builtin_amdgcn_cvt_pk_f32_fp8((int)a.x, true), a2 = __builtin_amdgcn_cvt_pk_f32_fp8((int)a.y, false), a3 = __builtin_amdgcn_cvt_pk_f32_fp8((int)a.y, true);
                    const f32x2 b0 = __builtin_amdgcn_cvt_pk_f32_fp8((int)b.x, false), b1 = __builtin_amdgcn_cvt_pk_f32_fp8((int)b.x, true), b2 = __builtin_amdgcn_cvt_pk_f32_fp8((int)b.y, false), b3 = __builtin_amdgcn_cvt_pk_f32_fp8((int)b.y, true);
                    y[0] += (f32x4){a0.x, a0.y, a1.x, a1.y}; y[1] += (f32x4){a2.x, a2.y, a3.x, a3.y}; y[2] += (f32x4){b0.x, b0.y, b1.x, b1.y}; y[3] += (f32x4){b2.x, b2.y, b3.x, b3.y}; }
                else { y[0] += (f32x4){bflo(a.x), bfhi(a.x), bflo(a.y), bfhi(a.y)}; y[1] += (f32x4){bflo(a.z), bfhi(a.z), bflo(a.w), bfhi(a.w)};
                    y[2] += (f32x4){bflo(b.x), bfhi(b.x), bflo(b.y), bfhi(b.y)}; y[3] += (f32x4){bflo(b.z), bfhi(b.z), bflo(b.w), bfhi(b.w)}; } }
            if (MOE_FP8) {
#pragma unroll
                for (int j = 0; j < 4; ++j) y[j] *= Y8_INV; }
            const int cc[4] = {cA, cA + 4, cB, cB + 4};
            f32x4 v[4]; float ss = 0.f;
            const f32x4 xv4[4] = {(f32x4){bflo(xw[rr][0].x), bfhi(xw[rr][0].x), bflo(xw[rr][0].y), bfhi(xw[rr][0].y)}, (f32x4){bflo(xw[rr][0].z), bfhi(xw[rr][0].z), bflo(xw[rr][0].w), bfhi(xw[rr][0].w)},
                                  (f32x4){bflo(xw[rr][1].x), bfhi(xw[rr][1].x), bflo(xw[rr][1].y), bfhi(xw[rr][1].y)}, (f32x4){bflo(xw[rr][1].z), bfhi(xw[rr][1].z), bflo(xw[rr][1].w), bfhi(xw[rr][1].w)}};
#pragma unroll
            for (int j = 0; j < 4; ++j) { v[j] = xv4[j] + *(const f32x4*)(md + 5 * DM + cc[j]) * y[j]; ss += (v[j].x * v[j].x + v[j].y * v[j].y) + (v[j].z * v[j].z + v[j].w * v[j].w); }
            const float rinv = 1.f / sqrtf(wave_sum(ss) * (1.f / DM) + EPS);
            if (l < DEPTH - 1) {
                { u32x4 x0, x1; x0.x = pk2(v[0].x, v[0].y); x0.y = pk2(v[0].z, v[0].w); x0.z = pk2(v[1].x, v[1].y); x0.w = pk2(v[1].z, v[1].w);
                  x1.x = pk2(v[2].x, v[2].y); x1.y = pk2(v[2].z, v[2].w); x1.z = pk2(v[3].x, v[3].y); x1.w = pk2(v[3].z, v[3].w);
                  *(u32x4*)(Xo + (size_t)m * DM + cA) = x0; *(u32x4*)(Xo + (size_t)m * DM + cB) = x1; }
                const float* mn = F.mod + ((size_t)(l + 1) * 9 + br[rr]) * 6 * DM; const float* gw1 = F.norm1_g + (size_t)(l + 1) * DM;
                f32x4 h[4];
#pragma unroll
                for (int j = 0; j < 4; ++j) h[j] = (v[j] * rinv * *(const f32x4*)(gw1 + cc[j])) * (*(const f32x4*)(mn + DM + cc[j]) + 1.f) + *(const f32x4*)(mn + cc[j]);
                u32x4 w0, w1; w0.x = pk2(h[0].x, h[0].y); w0.y = pk2(h[0].z, h[0].w); w0.z = pk2(h[1].x, h[1].y); w0.w = pk2(h[1].z, h[1].w);
                w1.x = pk2(h[2].x, h[2].y); w1.y = pk2(h[2].z, h[2].w); w1.z = pk2(h[3].x, h[3].y); w1.w = pk2(h[3].z, h[3].w);
                *(u32x4*)(Ho + (size_t)m * DM + cA) = w0; *(u32x4*)(Ho + (size_t)m * DM + cB) = w1;
            } else {
#pragma unroll
                for (int j = 0; j < 4; ++j) { f32x4 o = v[j] * rinv * *(const f32x4*)(F.final_g + cc[j]);
#if GLA_CHECK
                    if (__hip_atomic_load(F.ctl + 64, __ATOMIC_RELAXED, __HIP_MEMORY_SCOPE_AGENT) != 0u) { const float q = __builtin_nanf(""); o = (f32x4){q, q, q, q}; }
#endif
                    *(f32x4*)(Oo + (size_t)m * DM + cc[j]) = o; }
            }
        }
    }
}

constexpr int PL_U = 0, PL_P = 49152, PL_LD = 264, PREP_PW = 81920, PW_LD = 72, PREP_PS = PREP_PW + 4 * 64 * PW_LD * 2;
static_assert(PREP_PS + 1024 <= STAGE_BYTES && PL_P + 32 * PL_LD * 2 <= PREP_PW, "pool LDS map");
__device__ __forceinline__ void pool_unit(Frame& F, int l, int u) {
    LAS float* U = (LAS float*)(F.lds + PL_U);
    LAS bf16* PL = (LAS bf16*)(F.lds + PL_P);
    const LAS bf16* PW = (const LAS bf16*)(F.lds + PREP_PW); const LAS float* PS = (const LAS float*)(F.lds + PREP_PS);
    const int tid = F.tid;
    int s, tb, seqbase, tlen;
    if (u < NB * 128) { s = u / 128; tb = u % 128; seqbase = s * SEQ; tlen = SEQ; } else { const int v = u - NB * 128; s = v / 8; tb = v % 8; seqbase = TX + s * CTXL; tlen = CTXL; }
    const int t0 = tb * 32;
    for (int i = tid; i < 48 * 32; i += NTHREADS) { const int rr = i / 32, ch = i % 32, t = t0 - 8 + rr;
        f32x4 a = (f32x4){0.f, 0.f, 0.f, 0.f}, b = a;
        if (t >= 0 && t < tlen) { const u32x4 w = *(const u32x4*)(F.P + (size_t)(seqbase + t) * NP + C_POOL + ch * 8);
            a = (f32x4){bflo(w.x), bfhi(w.x), bflo(w.y), bfhi(w.y)}; b = (f32x4){bflo(w.z), bfhi(w.z), bflo(w.w), bfhi(w.w)}; }
        *(LAS f32x4*)(U + rr * 256 + ch * 8) = a; *(LAS f32x4*)(U + rr * 256 + ch * 8 + 4) = b; }
    __syncthreads();
    { const int tt = tid >> 4, cg = tid & 15, g = cg >> 2, w = 2 << g, t = t0 + tt;
      int lo = t - w / 2; if (lo < 0) lo = 0; int hi = t + w - w / 2; if (hi > tlen) hi = tlen;
      const float inv = 1.f / (float)(hi - lo);
      f32x4 sum[4];
#pragma unroll
      for (int q4 = 0; q4 < 4; ++q4) sum[q4] = (f32x4){0.f, 0.f, 0.f, 0.f};
      for (int jj = lo; jj < hi; ++jj) {
#pragma unroll
          for (int q4 = 0; q4 < 4; ++q4) sum[q4] += *(const LAS f32x4*)(U + (jj - t0 + 8) * 256 + cg * 16 + 4 * q4); }
      u32x4 w0, w1;
      { const f32x4 y0 = sum[0] * inv - *(const LAS f32x4*)(U + (tt + 8) * 256 + cg * 16), y1 = sum[1] * inv - *(const LAS f32x4*)(U + (tt + 8) * 256 + cg * 16 + 4);
        const f32x4 y2 = sum[2] * inv - *(const LAS f32x4*)(U + (tt + 8) * 256 + cg * 16 + 8), y3 = sum[3] * inv - *(const LAS f32x4*)(U + (tt + 8) * 256 + cg * 16 + 12);
        w0.x = pk2(y0.x, y0.y); w0.y = pk2(y0.z, y0.w); w0.z = pk2(y1.x, y1.y); w0.w = pk2(y1.z, y1.w);
        w1.x = pk2(y2.x, y2.y); w1.y = pk2(y2.z, y2.w); w1.z = pk2(y3.x, y3.y); w1.w = pk2(y3.z, y3.w); }
      *(LAS u32x4*)(PL + tt * PL_LD + cg * 16) = w0; *(LAS u32x4*)(PL + tt * PL_LD + cg * 16 + 8) = w1; }
    __syncthreads();
    { const int lane = F.lane, q = lane & 15, g4 = lane >> 4;
#pragma unroll
      for (int k = 0; k < 4; ++k) { const int ti = F.wave * 4 + k, mt = ti & 1, ct = ti >> 1, g = ct >> 2, ot = ct & 3;
          f32x4 acc = (f32x4){0.f, 0.f, 0.f, 0.f};
#pragma unroll
          for (int s2 = 0; s2 < 2; ++s2) { const bf16x8 a = *(const LAS bf16x8*)(PW + (g * 64 + 16 * ot + q) * PW_LD + 32 * s2 + 8 * g4), b = *(const LAS bf16x8*)(PL + (16 * mt + q) * PL_LD + g * 64 + 32 * s2 + 8 * g4);
              acc = __builtin_amdgcn_mfma_f32_16x16x32_bf16(a, b, acc, 0, 0, 0); }
          const f32x4 y = acc * *(const LAS f32x4*)(PS + g * 64 + 16 * ot + 4 * g4);
          u32x2 w; w.x = pk2(y.x, y.y); w.y = pk2(y.z, y.w);
          *(u32x2*)(F.MIX + (size_t)(seqbase + t0 + 16 * mt + q) * DM + 768 + g * 64 + 16 * ot + 4 * g4) = w; } }
    __syncthreads();
}
#if GLA_CHECK
__device__ __forceinline__ void gla_chain(Frame& F, int l, int u) {
    const int tid = F.tid;
    const int dir = u & 1, hh = (u >> 1) & 3, b = u >> 3;
    LAS float* qs = (LAS float*)F.lds;
    LAS float* ks = qs + 64 * 48;
    LAS float* as = ks + 64 * 48;
    LAS float* vs = as + 64 * 48;
    LAS float* os = vs + 64 * 96;
    LAS float* rc = os + 64 * 96;
    LAS float* rs = rc + 64 * 12;
    LAS float* wa = rs + 64 * 12;
    LAS float* ba = wa + 16 * 48;
    for (int i = tid; i < 64 * 12; i += NTHREADS) { const int pos = i / 12, fi = i % 12;
        const float invf = expf(-((float)(2 * fi) / 24.f) * 9.210340371976184f);
        const float ang = (float)pos * invf; rc[i] = cosf(ang); rs[i] = sinf(ang); }
    for (int i = tid; i < 16 * 48; i += NTHREADS) { const int r = i / 48, d = i % 48; wa[i] = F.gla_wa2[(((size_t)l * 2 + dir) * 16 + r) * 192 + hh * 48 + d]; }
    if (tid < 48) ba[tid] = F.gla_ba[((size_t)l * 2 + dir) * 192 + hh * 48 + tid];
    __syncthreads();
    float S[12];
#pragma unroll
    for (int i = 0; i < 12; ++i) S[i] = 0.f;
    const int vv = tid >> 2, dg = tid & 3;
    float* Odir = dir ? F.OB : F.OF;
    const bool need_ctx = l < DEPTH - 1;
    for (int cidx = 0; cidx < 4 + 64; ++cidx) {
        const bool isctx = cidx < 4;
        const int nch = isctx ? 4 : 64, ci0 = isctx ? cidx : cidx - 4, ci = dir ? (nch - 1 - ci0) : ci0;
        const int seqbase = isctx ? TX + b * CTXL : b * SEQ, t0 = ci * 64;
        for (int i = tid; i < 64 * 2 * 2 * 12; i += NTHREADS) {
            const int fi = i % 12, hf = (i / 12) & 1, isk = (i / 24) & 1, j = i / 48;
            const bf16* row = F.P + (size_t)(seqbase + t0 + j) * NP + (isk ? C_GK : C_GQ) + hh * 48 + hf * 24;
            const float x1 = bf2f(row[fi]), x2 = bf2f(row[12 + fi]);
            float o1 = x1, o2 = x2;
            if (!isctx) { const int t = t0 + j, pos = hf ? (t % GRIDW) : (t / GRIDW); const float cs = rc[pos * 12 + fi], sn = rs[pos * 12 + fi]; o1 = x1 * cs - x2 * sn; o2 = x1 * sn + x2 * cs; }
            LAS float* dst = (isk ? ks : qs) + j * 48 + hf * 24;
            dst[fi] = o1; dst[12 + fi] = o2; }
        for (int i = tid; i < 64 * 48; i += NTHREADS) { const int j = i / 48, d = i % 48;
            const bf16* row = F.P + (size_t)(seqbase + t0 + j) * NP + (dir ? C_AB : C_AF);
            float z = ba[d];
#pragma unroll
            for (int r = 0; r < 16; ++r) z += bf2f(row[r]) * wa[r * 48 + d];
            const float ls = fminf(z, 0.f) - log1pf(expf(-fabsf(z)));
            as[i] = expf(ls * (1.f / 16.f)); }
        for (int i = tid; i < 64 * 96; i += NTHREADS) { const int j = i / 96, d = i % 96; vs[i] = bf2f(F.VTA[(size_t)(384 + hh * 96 + d) * VTS + seqbase + t0 + j]); }
        __syncthreads();
        if (tid < 384) {
            for (int st = 0; st < 64; ++st) {
                const int j = dir ? 63 - st : st;
                const float vj = vs[j * 96 + vv];
                float part = 0.f;
#pragma unroll
                for (int q4 = 0; q4 < 3; ++q4) {
                    const f32x4 a4 = *(const LAS f32x4*)(as + j * 48 + dg * 12 + q4 * 4), k4 = *(const LAS f32x4*)(ks + j * 48 + dg * 12 + q4 * 4), qq = *(const LAS f32x4*)(qs + j * 48 + dg * 12 + q4 * 4);
#pragma unroll
                    for (int e = 0; e < 4; ++e) { const float sn = a4[e] * S[q4 * 4 + e] + k4[e] * vj; S[q4 * 4 + e] = sn; part += qq[e] * sn; } }
                part += __shfl_xor(part, 1); part += __shfl_xor(part, 2);
                if (dg == 0) os[j * 96 + vv] = part;
            }
        }
        __syncthreads();
        if (!isctx || need_ctx)
            for (int i = tid; i < 64 * 96; i += NTHREADS) { const int j = i / 96, d = i % 96; Odir[(size_t)(seqbase + t0 + j) * 384 + hh * 96 + d] = os[i]; }
        __syncthreads();
    }
}

#endif
typedef float f32x16 __attribute__((ext_vector_type(16)));
constexpr int GL_BF = 0, GL_BB = 12288, GL_WA = 24576, GL_VT = 31232, GL_KEF = 45056, GL_KEB = 51968;
constexpr int GL_QF = 45056, GL_KF = 52224, GL_QB = 59392, GL_KB = 66560, GL_STF = 73728, GL_STB = 84480, GL_O = 95232;
constexpr int VT_LD = 72, QK_LD = 56, ST_LD = 56, O_LD = 100, NCH = 68;
struct GlaU { int b, hh, cpos, seqbase, t0, isctx; };
__device__ __forceinline__ GlaU gla_unit_geom(int u) { GlaU g; g.cpos = u % NCH; g.hh = (u / NCH) & 3; g.b = u / (NCH * 4); g.isctx = g.cpos < 4;
    const int ci = g.isctx ? g.cpos : g.cpos - 4; g.seqbase = g.isctx ? TX + g.b * CTXL : g.b * SEQ; g.t0 = ci * 64; return g; }
__device__ __forceinline__ void gla_rope_pair(const Frame& F, const GlaU& g, const bf16* row, int j, int hf, int fi, float& o1, float& o2) {
    const float x1 = bf2f(row[fi]), x2 = bf2f(row[12 + fi]); o1 = x1; o2 = x2;
    if (!g.isctx) { const int t = g.t0 + j, pos = hf ? (t % GRIDW) : (t / GRIDW); const float cs = F.ROPE[pos * 12 + fi], sn = F.ROPE[768 + pos * 12 + fi]; o1 = x1 * cs - x2 * sn; o2 = x1 * sn + x2 * cs; }
}
constexpr int G1_BF = 0, G1_BB = 12288, G1_KEF = 24576, G1_KEB = 31488, G1_OPS = 38400;
constexpr int PREP_WA = TAB_OFF;
__device__ __forceinline__ void gla_g1_unit(Frame& F, int l, int u) {
    const GlaU g = gla_unit_geom(u);
    LAS bf16* kef = (LAS bf16*)(F.lds + G1_KEF); LAS bf16* keb = (LAS bf16*)(F.lds + G1_KEB); LAS bf16* ops = (LAS bf16*)(F.lds + G1_OPS);
    const LAS float* wa = (const LAS float*)(F.lds + PREP_WA) + g.hh * 1536; const LAS float* ba = (const LAS float*)(F.lds + PREP_WA) + 6144 + g.hh * 96;
    const bf16* vtg = F.VTA + (size_t)(384 + g.hh * 96) * VTS + g.seqbase + g.t0;
    const int tid = F.tid, lane = F.lane, j = lane, w = F.wave;
    const bf16* prow = F.P + (size_t)(g.seqbase + g.t0 + j) * NP;
    u32x4 araw[4];
#pragma unroll
    for (int q4 = 0; q4 < 4; ++q4) araw[q4] = *(const u32x4*)(prow + C_AF + 8 * q4);
    float q1[3], q2[3], k1[3], k2[3], cs[3], sn[3];
#pragma unroll
    for (int e = 0; e < 3; ++e) { const int p = 3 * w + e, hf = p / 12, fi = p % 12, cb = g.hh * 48 + hf * 24 + fi;
        q1[e] = bf2f(prow[C_GQ + cb]); q2[e] = bf2f(prow[C_GQ + cb + 12]); k1[e] = bf2f(prow[C_GK + cb]); k2[e] = bf2f(prow[C_GK + cb + 12]);
        const int t = g.t0 + j, pos = hf ? (t % GRIDW) : (t / GRIDW);
        cs[e] = g.isctx ? 1.f : F.ROPE[pos * 12 + fi]; sn[e] = g.isctx ? 0.f : F.ROPE[768 + pos * 12 + fi]; }
    float a[32];
#pragma unroll
    for (int q4 = 0; q4 < 4; ++q4) { const u32x4 x = araw[q4]; a[q4 * 8 + 0] = bflo(x.x); a[q4 * 8 + 1] = bfhi(x.x); a[q4 * 8 + 2] = bflo(x.y); a[q4 * 8 + 3] = bfhi(x.y);
        a[q4 * 8 + 4] = bflo(x.z); a[q4 * 8 + 5] = bfhi(x.z); a[q4 * 8 + 6] = bflo(x.w); a[q4 * 8 + 7] = bfhi(x.w); }
    float bf[3][2], bb[3][2];
#pragma unroll
    for (int e = 0; e < 3; ++e)
#pragma unroll
        for (int wh = 0; wh < 2; ++wh) { const int p = 3 * w + e, d = (p / 12) * 24 + p % 12 + 12 * wh;
            float zf = ba[d], zb = ba[48 + d];
#pragma unroll
            for (int r = 0; r < 16; ++r) { zf += a[r] * wa[r * 48 + d]; zb += a[16 + r] * wa[(16 + r) * 48 + d]; }
            const float xf = (fminf(zf, 0.f) - __logf(1.f + __expf(-fabsf(zf)))) * (1.f / 16.f), xb = (fminf(zb, 0.f) - __logf(1.f + __expf(-fabsf(zb)))) * (1.f / 16.f);
            bf[e][wh] = wave_scan_incl(xf);
            const float ab = wave_scan_incl(xb);
            bb[e][wh] = __int_as_float(__builtin_amdgcn_readlane(__float_as_int(ab), 63)) - ab + xb; }
#pragma unroll
    for (int e = 0; e < 3; ++e) { const int p = 3 * w + e, d1 = (p / 12) * 24 + p % 12, d2 = d1 + 12;
        const float qa = q1[e] * cs[e] - q2[e] * sn[e], qb = q1[e] * sn[e] + q2[e] * cs[e], ka = k1[e] * cs[e] - k2[e] * sn[e], kb = k1[e] * sn[e] + k2[e] * cs[e];
        const float f1 = bf[e][0], f2 = bf[e][1], b1 = bb[e][0], b2 = bb[e][1];
        const float fe1 = __builtin_bit_cast(float, __builtin_amdgcn_readlane(__builtin_bit_cast(int, f1), 63)), fe2 = __builtin_bit_cast(float, __builtin_amdgcn_readlane(__builtin_bit_cast(int, f2), 63));
        const float be1 = __builtin_bit_cast(float, __builtin_amdgcn_readlane(__builtin_bit_cast(int, b1), 0)), be2 = __builtin_bit_cast(float, __builtin_amdgcn_readlane(__builtin_bit_cast(int, b2), 0));
        const float ef1 = __expf(f1), ef2 = __expf(f2), eb1 = __expf(b1), eb2 = __expf(b2), nf1 = __expf(-f1), nf2 = __expf(-f2), nb1 = __expf(-b1), nb2 = __expf(-b2);
        ops[j * 48 + d1] = (bf16)f2bf(qa * ef1); ops[j * 48 + d2] = (bf16)f2bf(qb * ef2); ops[3072 + j * 48 + d1] = (bf16)f2bf(ka * nf1); ops[3072 + j * 48 + d2] = (bf16)f2bf(kb * nf2);
        ops[6144 + j * 48 + d1] = (bf16)f2bf(qa * eb1); ops[6144 + j * 48 + d2] = (bf16)f2bf(qb * eb2); ops[9216 + j * 48 + d1] = (bf16)f2bf(ka * nb1); ops[9216 + j * 48 + d2] = (bf16)f2bf(kb * nb2);
        const float ge1 = __expf(fe1), ge2 = __expf(fe2), he1 = __expf(be1), he2 = __expf(be2);
        kef[d1 * VT_LD + j] = (bf16)f2bf(ka * nf1 * ge1); kef[d2 * VT_LD + j] = (bf16)f2bf(kb * nf2 * ge2);
        keb[d1 * VT_LD + j] = (bf16)f2bf(ka * nb1 * he1); keb[d2 * VT_LD + j] = (bf16)f2bf(kb * nb2 * he2);
        if (lane == 0) { float* gd = F.GD + (((size_t)(g.b * 4 + g.hh) * 2) * NCH + g.cpos) * 48; gd[d1] = ge1; gd[d2] = ge2; gd[(size_t)NCH * 48 + d1] = he1; gd[(size_t)NCH * 48 + d2] = he2; } }
    __syncthreads();
    { const int q = lane & 15, g4 = lane >> 4;
      for (int ti = F.wave; ti < 36; ti += NWAVES) { const int dir = ti / 18, dt = (ti % 18) / 6, vtile = ti % 6;
          const LAS bf16* ke = dir ? keb : kef;
          f32x4 acc = (f32x4){0.f, 0.f, 0.f, 0.f};
#pragma unroll
          for (int s2 = 0; s2 < 2; ++s2) { const bf16x8 av = *(const LAS bf16x8*)(ke + (16 * dt + q) * VT_LD + 32 * s2 + 8 * g4), bv = *(const bf16x8*)(vtg + (size_t)(16 * vtile + q) * VTS + 32 * s2 + 8 * g4);
              acc = __builtin_amdgcn_mfma_f32_16x16x32_bf16(av, bv, acc, 0, 0, 0); }
          *(f32x4*)(F.DS + ((((size_t)(g.b * 4 + g.hh) * 2 + dir) * NCH + g.cpos) * 96 + 16 * vtile + q) * 48 + 16 * dt + 4 * g4) = acc; } }
    { u32x4* dst = (u32x4*)(F.OPS + (size_t)u * 12288);
      for (int i = tid; i < 1536; i += NTHREADS) dst[i] = *(const LAS u32x4*)(ops + i * 8); }
    __syncthreads();
}
__device__ __forceinline__ void gla_g2_unit(Frame& F, int u) {
    const int chain = u >> 2, qt = u & 3, dir = chain & 1, tid = F.tid;
    const float* ds = F.DS + (size_t)chain * NCH * 4608; const float* gd = F.GD + (size_t)chain * NCH * 48; bf16* stb = F.STB + (size_t)chain * NCH * 4608;
    const int e0 = qt * 1152 + 2 * tid, e1 = qt * 1152 + 1024 + 2 * tid; const bool h1 = tid < 64;
    const int d0 = e0 % 48, d1 = h1 ? e1 % 48 : 0;
    f32x2 S0 = (f32x2){0.f, 0.f}, S1 = (f32x2){0.f, 0.f};
    for (int st0 = 0; st0 < NCH; st0 += 4) {
        f32x2 x0[4], x1[4], g0[4], g1[4]; int cp[4];
#pragma unroll
        for (int k = 0; k < 4; ++k) { const int st = st0 + k; cp[k] = st < 4 ? (dir ? 3 - st : st) : (dir ? 4 + (67 - st) : st);
            const float* p = ds + (size_t)cp[k] * 4608; const float* gp = gd + cp[k] * 48;
            x0[k] = *(const f32x2*)(p + e0); g0[k] = *(const f32x2*)(gp + d0);
            if (h1) { x1[k] = *(const f32x2*)(p + e1); g1[k] = *(const f32x2*)(gp + d1); } else { x1[k] = (f32x2){0.f, 0.f}; g1[k] = x1[k]; } }
#pragma unroll
        for (int k = 0; k < 4; ++k) { bf16* p = stb + (size_t)cp[k] * 4608;
            *(unsigned*)(p + e0) = pk2(S0.x, S0.y); if (h1) *(unsigned*)(p + e1) = pk2(S1.x, S1.y);
            S0 = g0[k] * S0 + x0[k]; S1 = g1[k] * S1 + x1[k]; }
    }
}
__device__ __forceinline__ void gla_g3_wave(Frame& F, int l, int wu) {
    const int u = wu >> 1, it = wu & 1;
    const GlaU g = gla_unit_geom(u);
    const int lane = F.lane, r = lane & 31, h = lane >> 5;
    const bf16* ops = F.OPS + (size_t)u * 12288 + 16 * 0 + 8 * h;
    const bf16* vtg = F.VTA + (size_t)(384 + g.hh * 96) * VTS + g.seqbase + g.t0;
    const bf16* stf = F.STB + ((((size_t)(g.b * 4 + g.hh) * 2 + 0) * NCH + g.cpos) * 4608) + 8 * h; const bf16* stbk = stf + (size_t)NCH * 4608;
    LAS float* O = (LAS float*)(F.lds + F.wave * 16384);
    bf16x8 qf[3], qb[3];
#pragma unroll
    for (int s3 = 0; s3 < 3; ++s3) { qf[s3] = *(const bf16x8*)(ops + (32 * it + r) * 48 + 16 * s3); qb[s3] = *(const bf16x8*)(ops + 6144 + (32 * it + r) * 48 + 16 * s3); }
    f32x16 X[2];
#pragma unroll
    for (int jt = 0; jt < 2; ++jt) {
        f32x16 xf, xb;
#pragma unroll
        for (int e = 0; e < 16; ++e) { xf[e] = 0.f; xb[e] = 0.f; }
        if (jt <= it) {
#pragma unroll
            for (int s3 = 0; s3 < 3; ++s3) xf = __builtin_amdgcn_mfma_f32_32x32x16_bf16(*(const bf16x8*)(ops + 3072 + (32 * jt + r) * 48 + 16 * s3), qf[s3], xf, 0, 0, 0); }
        if (jt >= it) {
#pragma unroll
            for (int s3 = 0; s3 < 3; ++s3) xb = __builtin_amdgcn_mfma_f32_32x32x16_bf16(*(const bf16x8*)(ops + 9216 + (32 * jt + r) * 48 + 16 * s3), qb[s3], xb, 0, 0, 0); }
        if (jt == it) {
#pragma unroll
            for (int e = 0; e < 16; ++e) { const int jl = (e & 3) + 8 * (e >> 2) + 4 * h; X[jt][e] = (jl <= r ? xf[e] : 0.f) + (jl >= r ? xb[e] : 0.f); }
        } else X[jt] = jt < it ? xf : xb;
    }
    f32x16 o[3];
#pragma unroll
    for (int vt = 0; vt < 3; ++vt)
#pragma unroll
        for (int e = 0; e < 16; ++e) o[vt][e] = 0.f;
#pragma unroll
    for (int jt = 0; jt < 2; ++jt)
#pragma unroll
        for (int s2 = 0; s2 < 2; ++s2) {
            u32x4 aw; aw.x = pk2(X[jt][8 * s2 + 0], X[jt][8 * s2 + 1]); aw.y = pk2(X[jt][8 * s2 + 2], X[jt][8 * s2 + 3]); aw.z = pk2(X[jt][8 * s2 + 4], X[jt][8 * s2 + 5]); aw.w = pk2(X[jt][8 * s2 + 6], X[jt][8 * s2 + 7]);
#pragma unroll
            for (int vt = 0; vt < 3; ++vt) {
                const bf16* vr = vtg + (size_t)(32 * vt + r) * VTS + 32 * jt + 16 * s2 + 4 * h;
                const u32x2 lo = *(const u32x2*)vr, hi = *(const u32x2*)(vr + 8);
                const u32x4 bw = (u32x4){lo.x, lo.y, hi.x, hi.y};
                o[vt] = __builtin_amdgcn_mfma_f32_32x32x16_bf16(__builtin_bit_cast(bf16x8, aw), __builtin_bit_cast(bf16x8, bw), o[vt], 0, 0, 0); } }
#pragma unroll
    for (int s3 = 0; s3 < 3; ++s3)
#pragma unroll
        for (int vt = 0; vt < 3; ++vt) {
            o[vt] = __builtin_amdgcn_mfma_f32_32x32x16_bf16(qf[s3], *(const bf16x8*)(stf + (32 * vt + r) * 48 + 16 * s3), o[vt], 0, 0, 0);
            o[vt] = __builtin_amdgcn_mfma_f32_32x32x16_bf16(qb[s3], *(const bf16x8*)(stbk + (32 * vt + r) * 48 + 16 * s3), o[vt], 0, 0, 0); }
#pragma unroll
    for (int vt = 0; vt < 3; ++vt)
#pragma unroll
        for (int e = 0; e < 16; ++e) O[((e & 3) + 8 * (e >> 2) + 4 * h) * O_LD + 32 * vt + r] = o[vt][e];
    LDS_WAIT(); asm volatile("" ::: "memory");
    { const int i = lane >> 1, half = lane & 1; const size_t row = (size_t)(g.seqbase + g.t0 + 32 * it + i);
      f32x4 ov[12]; float ss = 0.f;
#pragma unroll
      for (int e = 0; e < 12; ++e) { ov[e] = *(const LAS f32x4*)(O + i * O_LD + half * 48 + 4 * e); ss += (ov[e].x * ov[e].x + ov[e].y * ov[e].y) + (ov[e].z * ov[e].z + ov[e].w * ov[e].w); }
      ss = dpp_addp<0xB1>(ss);
      const float rinv = 1.f / sqrtf(ss * (1.f / 96.f) + EPS);
      const float* ng = F.gla_norm_g + (size_t)l * 384 + g.hh * 96 + half * 48;
      const u32x4* gp = (const u32x4*)(F.P + row * NP + C_GG + g.hh * 96 + half * 48);
      u32x4* dst = (u32x4*)(F.MIX + row * DM + g.hh * 96 + half * 48);
#if GLA_CHECK
      { float sn = 0.f; const float* pf = F.OF + row * 384 + g.hh * 96 + half * 48; const float* pb = F.OB + row * 384 + g.hh * 96 + half * 48;
#pragma unroll
        for (int e = 0; e < 48; ++e) { const float on = pf[e] + pb[e]; sn += on * on; }
        sn += __shfl_xor(sn, 1);
        const float rms = sqrtf(sn * (1.f / 96.f)) + 1e-6f; int bad = 0;
#pragma unroll
        for (int e = 0; e < 48; ++e) { const float on = pf[e] + pb[e]; if (!(fabsf(ov[e >> 2][e & 3] - on) <= 0.03f * rms + 0.03f * fabsf(on))) ++bad; }
        if (bad) atomicAdd(F.ctl + 64, (unsigned)bad); }
#endif
#pragma unroll
      for (int q6 = 0; q6 < 6; ++q6) { const u32x4 gw = gp[q6]; const f32x4 n0 = *(const f32x4*)(ng + 8 * q6), n1 = *(const f32x4*)(ng + 8 * q6 + 4); const f32x4 a = ov[2 * q6], b = ov[2 * q6 + 1];
          u32x4 w;
          w.x = pk2(a.x * rinv * n0.x * silu_f(bflo(gw.x)), a.y * rinv * n0.y * silu_f(bfhi(gw.x))); w.y = pk2(a.z * rinv * n0.z * silu_f(bflo(gw.y)), a.w * rinv * n0.w * silu_f(bfhi(gw.y)));
          w.z = pk2(b.x * rinv * n1.x * silu_f(bflo(gw.z)), b.y * rinv * n1.y * silu_f(bfhi(gw.z))); w.w = pk2(b.z * rinv * n1.z * silu_f(bflo(gw.w)), b.w * rinv * n1.w * silu_f(bfhi(gw.w)));
          dst[q6] = w; } }
    LDS_WAIT(); asm volatile("" ::: "memory");
}
__device__ __forceinline__ void ph_gla3(Frame& F, int l) {
    const bool need_ctx = l < DEPTH - 1;
    const int gw = F.vcu * NWAVES + F.wave, NGW = F.G * NWAVES;
    for (int wu = gw; wu < NB * GH * NCH * 2; wu += NGW) { if (!need_ctx && ((wu >> 1) % NCH) < 4) continue; gla_g3_wave(F, l, wu); }
}
__device__ __forceinline__ void ph_prep(Frame& F, int l) {
    const bool need_ctx = l < DEPTH - 1;
    const int tid = F.tid;
#if GLA_CHECK
    for (int u = F.vcu; u < NB * GH * 2; u += F.G) gla_chain(F, l, u);
    __syncthreads();
#endif
    { LAS float* wa = (LAS float*)(F.lds + PREP_WA);
      for (int i = tid; i < 4 * 2 * 16 * 48; i += NTHREADS) { const int hh = i / 1536, dir = (i / 768) & 1, r = (i / 48) % 16, d = i % 48; wa[i] = F.gla_wa2[(((size_t)l * 2 + dir) * 16 + r) * 192 + hh * 48 + d]; }
      for (int i = tid; i < 4 * 2 * 48; i += NTHREADS) { const int hh = i / 96, dir = (i / 48) & 1, d = i % 48; wa[6144 + i] = F.gla_ba[((size_t)l * 2 + dir) * 192 + hh * 48 + d]; }
      LAS bf16* pw = (LAS bf16*)(F.lds + PREP_PW); LAS float* ps = (LAS float*)(F.lds + PREP_PS);
      for (int i = tid; i < 4 * 64 * 64; i += NTHREADS) { const int g = i >> 12, ii = (i >> 6) & 63, o = i & 63; pw[(g * 64 + o) * PW_LD + ii] = (bf16)f2bf(F.pool_w[(size_t)l * 16384 + i]); }
      if (tid < 256) ps[tid] = F.pool_scale[(size_t)l * 256 + tid]; }
    __syncthreads();
    const int NPOOL = NB * 128 + (need_ctx ? NB * 8 : 0), NG1 = NB * GH * NCH, NMIX = 3 * NPOOL;
    for (int k = F.vcu; k < NG1 + NPOOL; k += F.G) {
        if (k < NMIX) { if (k % 3 == 2) pool_unit(F, l, k / 3); else gla_g1_unit(F, l, (k / 3) * 2 + k % 3); }
        else gla_g1_unit(F, l, 2 * NPOOL + (k - NMIX));
    }
}

#define NA_LOG2E 1.4426950408889634f
__device__ __forceinline__ float na_max4(float x) {
    const auto r = __builtin_amdgcn_permlane16_swap(__float_as_uint(x), __float_as_uint(x), false, false);
    x = fmaxf(__uint_as_float(r[0]), __uint_as_float(r[1]));
    const auto t = __builtin_amdgcn_permlane32_swap(__float_as_uint(x), __float_as_uint(x), false, false);
    return fmaxf(__uint_as_float(t[0]), __uint_as_float(t[1]));
}
__device__ __forceinline__ float na_sum4(float x) {
    const auto r = __builtin_amdgcn_permlane16_swap(__float_as_uint(x), __float_as_uint(x), false, false);
    x = __uint_as_float(r[0]) + __uint_as_float(r[1]);
    const auto t = __builtin_amdgcn_permlane32_swap(__float_as_uint(x), __float_as_uint(x), false, false);
    return __uint_as_float(t[0]) + __uint_as_float(t[1]);
}
struct NaCtx {
    __amdgpu_buffer_rsrc_t rP, rV; unsigned voffK, voffV; int b, cw, r0, krlo, nnb; const LAS float* rpb; unsigned bidx[2][4];
    bf16x8 qa[4][2]; float mrun[4], lsum[4]; f32x4 o[4][4];
};
__device__ __forceinline__ int na_segtok(const NaCtx& C, int sg) { return sg < C.nnb ? C.b * SEQ + (C.krlo + sg) * GRIDW + C.cw : TX + C.b * CTXL + 32 * (sg - C.nnb); }
__device__ __forceinline__ void na_load(const NaCtx& C, int sg, bf16x8 (&kb)[2][2], bf16x8 (&vb)[4]) {
    const int tok = na_segtok(C, sg);
#pragma unroll
    for (int par = 0; par < 2; ++par)
#pragma unroll
        for (int s2 = 0; s2 < 2; ++s2) kb[par][s2] = __builtin_bit_cast(bf16x8, __builtin_amdgcn_raw_buffer_load_b128(C.rP, C.voffK, (unsigned)((tok + 4 * par) * (NP * 2) + 64 * s2), 0));
#pragma unroll
    for (int dt = 0; dt < 4; ++dt) vb[dt] = __builtin_bit_cast(bf16x8, __builtin_amdgcn_raw_buffer_load_b128(C.rV, C.voffV, (unsigned)((16 * dt * VTS + tok) * 2), 0));
}
template <bool LATENT>
__device__ __forceinline__ void na_segment(NaCtx& C, int sg, int lane, const bf16x8 (&kb)[2][2], const bf16x8 (&vb)[4]) {
    const int g = lane >> 4;
    const bool nb = LATENT && sg < C.nnb;
    const int kr = C.krlo + sg;
#pragma unroll
    for (int i = 0; i < 4; ++i) {
        if (nb) { const int ri = C.r0 + i, rsi = ri - 4 < 0 ? 0 : (ri - 4 > 56 ? 56 : ri - 4); if (kr < rsi || kr > rsi + 7) continue; }
        float bv[2][4];
        if (nb) { const unsigned rowoff = (unsigned)((kr - (C.r0 + i) + 7) * 32 * 4);
#pragma unroll
            for (int par = 0; par < 2; ++par)
#pragma unroll
                for (int rg = 0; rg < 4; ++rg) bv[par][rg] = *(const LAS float*)((const LAS char*)C.rpb + rowoff + C.bidx[par][rg]); }
        f32x4 st[2];
#pragma unroll
        for (int par = 0; par < 2; ++par) {
            f32x4 a = nb ? (f32x4){bv[par][0], bv[par][1], bv[par][2], bv[par][3]} : (f32x4){0.f, 0.f, 0.f, 0.f};
#pragma unroll
            for (int s2 = 0; s2 < 2; ++s2) a = __builtin_amdgcn_mfma_f32_16x16x32_bf16(kb[par][s2], C.qa[i][s2], a, 0, 0, 0);
            st[par] = a;
        }
        float mx = fmaxf(fmaxf(fmaxf(st[0][0], st[0][1]), fmaxf(st[0][2], st[0][3])), fmaxf(fmaxf(st[1][0], st[1][1]), fmaxf(st[1][2], st[1][3])));
        mx = na_max4(mx);
        if (__any(mx > C.mrun[i] + 8.f)) {
            const float mnew = fmaxf(C.mrun[i], mx), alpha = __builtin_amdgcn_exp2f(C.mrun[i] - mnew);
            C.lsum[i] *= alpha; C.mrun[i] = mnew;
#pragma unroll
            for (int rg = 0; rg < 4; ++rg) { const float ar = __shfl(alpha, 4 * g + rg);
#pragma unroll
                for (int dt = 0; dt < 4; ++dt) C.o[i][dt][rg] *= ar; }
        }
        float psum = 0.f;
#pragma unroll
        for (int par = 0; par < 2; ++par)
#pragma unroll
            for (int rg = 0; rg < 4; ++rg) { const float p = __builtin_amdgcn_exp2f(st[par][rg] - C.mrun[i]); st[par][rg] = p; psum += p; }
        C.lsum[i] += na_sum4(psum);
        u32x4 pw; pw.x = cvt_pk_bf16(st[0][0], st[0][1]); pw.y = cvt_pk_bf16(st[0][2], st[0][3]); pw.z = cvt_pk_bf16(st[1][0], st[1][1]); pw.w = cvt_pk_bf16(st[1][2], st[1][3]);
        const bf16x8 pa = __builtin_bit_cast(bf16x8, pw);
#pragma unroll
        for (int dt = 0; dt < 4; ++dt) C.o[i][dt] = __builtin_amdgcn_mfma_f32_16x16x32_bf16(pa, vb[dt], C.o[i][dt], 0, 0, 0);
    }
}
#ifndef NA_DRYMODE
#define NA_DRYMODE 0
#endif
template <bool LATENT>
__device__ __forceinline__ void na_unit(Frame& F, int l, int u, const LAS float* rpb_lds, bool dry = false) {
    const int lane = F.lane, q = lane & 15, g = lane >> 4;
    NaCtx C;
    int hh, c0 = 0, qrow0, qstep;
    if (LATENT) { const int cb = u & 3, rg4 = (u >> 2) & 15; hh = (u >> 6) % NH; C.b = u / (64 * NH); c0 = cb * 16; C.r0 = rg4 * 4; qrow0 = C.b * SEQ + C.r0 * GRIDW + c0; qstep = GRIDW;
        const int rs0 = C.r0 - 4 < 0 ? 0 : (C.r0 - 4 > 56 ? 56 : C.r0 - 4), r3 = C.r0 + 3, rs3 = r3 - 4 < 0 ? 0 : (r3 - 4 > 56 ? 56 : r3 - 4);
        C.krlo = rs0; C.nnb = rs3 + 7 - rs0 + 1; }
    else { const int qi = u & 3; hh = (u >> 2) % NH; C.b = u / (4 * NH); qrow0 = TX + C.b * CTXL + qi * 64; qstep = 16; C.r0 = 0; C.krlo = 0; C.nnb = 0; }
    C.cw = c0 == 0 ? 0 : (c0 == 48 ? 32 : c0 - 8);
    const int c = c0 + q; const int start = c - 8 < 0 ? 0 : (c - 8 > 48 ? 48 : c - 8);
    C.rpb = rpb_lds + hh * 15 * 32;
    C.rP = __builtin_amdgcn_make_buffer_rsrc((void*)F.P, 0, (int)((size_t)TT * NP * 2), 0x00020000);
    C.rV = __builtin_amdgcn_make_buffer_rsrc((void*)F.VTA, 0, (int)((size_t)VT_NC * VTS * 2), 0x00020000);
    const int koff = 8 * (q >> 2) + (q & 3);
    C.voffK = (unsigned)((koff * NP + C_NAK + hh * NDH + 8 * g) * 2);
    C.voffV = (unsigned)(((hh * NDH + q) * VTS + 8 * g) * 2);
#pragma unroll
    for (int par = 0; par < 2; ++par)
#pragma unroll
        for (int rg = 0; rg < 4; ++rg) { const int kc = C.cw + 8 * g + rg + 4 * par; const bool valid = (kc >= start) && (kc < start + 16);
            C.bidx[par][rg] = (unsigned)((valid ? kc - c + 15 : 31) * 4); }
#pragma unroll
    for (int i = 0; i < 4; ++i) {
#pragma unroll
        for (int s2 = 0; s2 < 2; ++s2) C.qa[i][s2] = *(const bf16x8*)(F.P + (size_t)(qrow0 + i * qstep + q) * NP + C_NAQ + hh * NDH + 32 * s2 + 8 * g);
        C.mrun[i] = -1e30f; C.lsum[i] = 0.f;
#pragma unroll
        for (int dt = 0; dt < 4; ++dt) C.o[i][dt] = (f32x4){0.f, 0.f, 0.f, 0.f}; }
    const int nseg = C.nnb + 8;
    bf16x8 k0[2][2], v0[4], k1[2][2], v1[4];
    na_load(C, 0, k0, v0);
#pragma unroll 1
    for (int sg = 0; sg < nseg; sg += 2) {
        if (sg + 1 < nseg) na_load(C, sg + 1, k1, v1);
        na_segment<LATENT>(C, sg, lane, k0, v0);
        if (sg + 2 < nseg) na_load(C, sg + 2, k0, v0);
        if (sg + 1 < nseg) na_segment<LATENT>(C, sg + 1, lane, k1, v1);
    }
    bf16* mixb = dry ? (bf16*)F.VTC : F.MIX;
#pragma unroll
    for (int i = 0; i < 4; ++i)
#pragma unroll
        for (int rg = 0; rg < 4; ++rg) { const float li = 1.f / __shfl(C.lsum[i], 4 * g + rg);
            bf16* orow = mixb + (size_t)(dry ? 0 : (qrow0 + i * qstep + 4 * g + rg)) * DM + 384 + hh * NDH + q;
#pragma unroll
            for (int dt = 0; dt < 4; ++dt) orow[16 * dt] = (bf16)f2bf(C.o[i][dt][rg] * li); }
}
__device__ __forceinline__ void ph_attn(Frame& F, int l) {
    const bool need_ctx = l < DEPTH - 1;
    const int gw = F.vcu * NWAVES + F.wave, NGW = F.G * NWAVES;
    LAS float* rpb = (LAS float*)(F.lds + TAB_OFF);
    for (int i = F.tid; i < NH * 15 * 32; i += NTHREADS) { const int col = i & 31, hr = i >> 5; rpb[i] = col < 31 ? F.na_rpb[((size_t)l * NH * 15 + hr) * 31 + col] * NA_LOG2E : -1e30f; }
    __syncthreads();
    for (int rep = 0; rep < REPS(11); ++rep)
    for (int u = F.vcu; u < NB * GH * 2 * 4; u += F.G) gla_g2_unit(F, u);
    const bool bg = !GLA_CHECK;
    if (bg && (F.wave & 1)) convert_items(F, l, 3 * (NE * 16 * 32));
    for (int rep = 0; rep < REPS(12); ++rep) {
    for (int u = gw; u < NB * NH * 16 * 4; u += NGW) na_unit<true>(F, l, u, rpb, rep + 1 < REPS(12));
    if (need_ctx) for (int u = gw; u < NB * NH * 4; u += NGW) na_unit<false>(F, l, u, rpb, rep + 1 < REPS(12)); }
    if (bg && !(F.wave & 1)) convert_items(F, l, 3 * (NE * 16 * 32));
}
constexpr int RW_LD = 1032;
static_assert(2 * NE * RW_LD * 2 <= STAGE_BYTES, "router LDS");
__device__ __forceinline__ unsigned f2key(float f, int e) { unsigned u = __builtin_bit_cast(unsigned, f); u = (u & 0x80000000u) ? ~u : (u | 0x80000000u); return (u & ~31u) | (unsigned)(31 - e); }
__device__ __forceinline__ float key2f(unsigned k) { unsigned u = k & ~31u; u = (u & 0x80000000u) ? (u & 0x7fffffffu) : ~u; return __builtin_bit_cast(float, u); }
__device__ __forceinline__ void ph_router(Frame& F, int l, bool dry = false) {
    const int tid = F.tid, lane = F.lane, q = lane & 15, g = lane >> 4;
    LAS bf16* WH = (LAS bf16*)F.lds; LAS bf16* WL = WH + NE * RW_LD;
    LAS int* lcount = (LAS int*)(F.lds + MISC_OFF + 64 * 4);
    volatile LAS int* lbase = (volatile LAS int*)(F.MISC + 96);
    LAS int* apos = (LAS int*)(F.lds + TAB_OFF);
    const float* rw = F.router_w + (size_t)l * DM * NE;
    for (int i = tid; i < DM * NE; i += NTHREADS) { const int c = i >> 5, e = i & 31; const float w = rw[i]; const unsigned hi = f2bf(w); const unsigned lo = f2bf(w - bf2f(hi));
        WH[e * RW_LD + c] = (bf16)hi; WL[e * RW_LD + c] = (bf16)lo; }
    if (tid < NE) lcount[tid] = 0;
    __syncthreads();
    const int M = (l == DEPTH - 1) ? TX : TT;
    const int per = (M + F.G - 1) / F.G, tok0 = F.vcu * per, tok1 = (tok0 + per < M) ? tok0 + per : M;
    const int ntile = tok1 > tok0 ? (tok1 - tok0 + 15) >> 4 : 0;
    const float* g2w = F.norm2_g + (size_t)l * DM + 8 * g;
    const float rb0 = F.router_b[(size_t)l * NE + q], rb1 = F.router_b[(size_t)l * NE + 16 + q];
    for (int tile = F.wave; tile < ntile; tile += NWAVES) {
        const int tbase = tok0 + 16 * tile, t = tbase + q, tq = t < tok1 ? t : tok1 - 1; const bool valid = t < tok1;
        const bf16* xr = F.X + (size_t)tq * DM + 8 * g;
        float ss = 0.f;
#pragma unroll 8
        for (int s = 0; s < 32; ++s) { const u32x4 xw = *(const u32x4*)(xr + 32 * s); const f32x4 a = (f32x4){bflo(xw.x), bfhi(xw.x), bflo(xw.y), bfhi(xw.y)}, b = (f32x4){bflo(xw.z), bfhi(xw.z), bflo(xw.w), bfhi(xw.w)}; ss += (a.x * a.x + a.y * a.y) + (a.z * a.z + a.w * a.w) + (b.x * b.x + b.y * b.y) + (b.z * b.z + b.w * b.w); }
        { const auto r = __builtin_amdgcn_permlane16_swap(__float_as_uint(ss), __float_as_uint(ss), false, false); ss = __uint_as_float(r[0]) + __uint_as_float(r[1]);
          const auto t = __builtin_amdgcn_permlane32_swap(__float_as_uint(ss), __float_as_uint(ss), false, false); ss = __uint_as_float(t[0]) + __uint_as_float(t[1]); }
        const float rinv = 1.f / sqrtf(ss * (1.f / DM) + EPS);
        const int br = tq < TX ? tq / SEQ : NB;
        const float* md = F.mod + ((size_t)l * 9 + br) * 6 * DM + 8 * g;
        unsigned char* hrow = MOE_FP8 ? F.H8 + (size_t)tq * DM + 8 * g : (unsigned char*)(F.H + (size_t)tq * DM + 8 * g);
        f32x4 acc[2]; acc[0] = (f32x4){0.f, 0.f, 0.f, 0.f}; acc[1] = acc[0];
#pragma unroll 2
        for (int s = 0; s < 32; ++s) { const int c = 32 * s;
            const u32x4 xw = *(const u32x4*)(xr + c); const f32x4 xa = (f32x4){bflo(xw.x), bfhi(xw.x), bflo(xw.y), bfhi(xw.y)}, xb = (f32x4){bflo(xw.z), bfhi(xw.z), bflo(xw.w), bfhi(xw.w)}, ga = *(const f32x4*)(g2w + c), gb = *(const f32x4*)(g2w + c + 4);
            const f32x4 ca = *(const f32x4*)(md + 4 * DM + c), cb = *(const f32x4*)(md + 4 * DM + c + 4), sa = *(const f32x4*)(md + 3 * DM + c), sb = *(const f32x4*)(md + 3 * DM + c + 4);
            const f32x4 ha = (xa * rinv * ga) * (ca + 1.f) + sa, hb = (xb * rinv * gb) * (cb + 1.f) + sb;
            u32x4 hw; hw.x = cvt_pk_bf16(ha.x, ha.y); hw.y = cvt_pk_bf16(ha.z, ha.w); hw.z = cvt_pk_bf16(hb.x, hb.y); hw.w = cvt_pk_bf16(hb.z, hb.w);
            u32x4 lw; lw.x = cvt_pk_bf16(ha.x - bflo(hw.x), ha.y - bfhi(hw.x)); lw.y = cvt_pk_bf16(ha.z - bflo(hw.y), ha.w - bfhi(hw.y));
            lw.z = cvt_pk_bf16(hb.x - bflo(hw.z), hb.y - bfhi(hw.z)); lw.w = cvt_pk_bf16(hb.z - bflo(hw.w), hb.w - bfhi(hw.w));
            if (valid) { if (MOE_FP8) { u32x2 h8; h8.x = pk4_fp8(ha.x, ha.y, ha.z, ha.w); h8.y = pk4_fp8(hb.x, hb.y, hb.z, hb.w); *(u32x2*)(hrow + c) = h8; } else *(u32x4*)(hrow + 2 * c) = hw; }
            const bf16x8 ah = __builtin_bit_cast(bf16x8, hw), al = __builtin_bit_cast(bf16x8, lw);
#pragma unroll
            for (int tt = 0; tt < 2; ++tt) { const bf16x8 bh = *(const LAS bf16x8*)(WH + (16 * tt + q) * RW_LD + c + 8 * g), bl = *(const LAS bf16x8*)(WL + (16 * tt + q) * RW_LD + c + 8 * g);
                acc[tt] = __builtin_amdgcn_mfma_f32_16x16x32_bf16(ah, bh, acc[tt], 0, 0, 0);
                acc[tt] = __builtin_amdgcn_mfma_f32_16x16x32_bf16(ah, bl, acc[tt], 0, 0, 0);
                acc[tt] = __builtin_amdgcn_mfma_f32_16x16x32_bf16(al, bh, acc[tt], 0, 0, 0); } }
        unsigned k0[4], k1[4], win[4][4];
#pragma unroll
        for (int rg = 0; rg < 4; ++rg) { k0[rg] = f2key(acc[0][rg] + rb0, q); k1[rg] = f2key(acc[1][rg] + rb1, 16 + q); }
#pragma unroll
        for (int k = 0; k < 4; ++k)
#pragma unroll
            for (int rg = 0; rg < 4; ++rg) { const unsigned m = row16_umax(k0[rg] > k1[rg] ? k0[rg] : k1[rg]);
                win[rg][k] = m; if (k0[rg] == m) k0[rg] = 0u; if (k1[rg] == m) k1[rg] = 0u; }
        { const int rsel = q >> 2, ksel = q & 3;
          unsigned w4[4];
#pragma unroll
          for (int k = 0; k < 4; ++k) w4[k] = rsel == 0 ? win[0][k] : rsel == 1 ? win[1][k] : rsel == 2 ? win[2][k] : win[3][k];
          const float v0 = key2f(w4[0]), e1 = __expf(key2f(w4[1]) - v0), e2 = __expf(key2f(w4[2]) - v0), e3 = __expf(key2f(w4[3]) - v0);
          const float inv = 1.f / (1.f + e1 + e2 + e3);
          const float gt = (ksel == 0 ? 1.f : ksel == 1 ? e1 : ksel == 2 ? e2 : e3) * inv;
          const unsigned wk = ksel == 0 ? w4[0] : ksel == 1 ? w4[1] : ksel == 2 ? w4[2] : w4[3];
          const int e = 31 - (int)(wk & 31u), tt2 = tbase + 4 * g + rsel;
          if (tt2 < tok1 && !dry) { F.GATE[(size_t)tt2 * 4 + ksel] = gt;
              const int pos = __hip_atomic_fetch_add(lcount + e, 1, __ATOMIC_RELAXED, __HIP_MEMORY_SCOPE_WORKGROUP);
              apos[(tt2 - tok0) * 4 + ksel] = (e << 16) | pos; } }
    }
    __syncthreads();
    if (dry) return;
    if (tid < NE) lbase[tid] = (int)__hip_atomic_fetch_add(F.ctl + CW_CNT + (l * NE + tid) * 64, (unsigned)__hip_atomic_load(lcount + tid, __ATOMIC_RELAXED, __HIP_MEMORY_SCOPE_WORKGROUP), __ATOMIC_RELAXED, __HIP_MEMORY_SCOPE_AGENT);
    __syncthreads();
    const int nas = (tok1 > tok0 ? (tok1 - tok0) : 0) * 4;
    for (int i = tid; i < nas; i += NTHREADS) { const int w = apos[i], e = w >> 16, pos = w & 0xffff; F.LIST[(size_t)e * TT + lbase[e] + pos] = tok0 * 4 + i; }
    __syncthreads();
}
__device__ __forceinline__ void moe_tables(Frame& F, int l, int npn) {
    volatile LAS int* tp = (volatile LAS int*)(F.MISC + 16);
    LAS int* tab = (LAS int*)(F.lds + TAB_OFF);
    const int tid = F.tid;
    volatile LAS int* eb = (volatile LAS int*)(F.MISC + 128);
    volatile LAS int* cntl = (volatile LAS int*)(F.MISC + 168);
    if (tid == 0) { int acc = 0, sb = 0;
        for (int e = 0; e < NE; ++e) { tp[e] = acc; eb[e] = sb; const int cnt = (int)__hip_atomic_load(F.ctl + CW_CNT + (l * NE + e) * 64, __ATOMIC_RELAXED, __HIP_MEMORY_SCOPE_AGENT); cntl[e] = cnt; acc += (cnt + 255) >> 8; sb += cnt; }
        tp[NE] = acc; }
    __syncthreads();
    if (npn != 8) return;
#pragma unroll 1
    for (int i2 = 0; i2 < MAXU; i2 += 2) {
        const int i = i2 + (tid >> 8), rr = tid & 255;
        g8::Unit u;
        if (i < MAXU && g8::moe_unit((long)i * F.G + F.vcu, npn, tp, u)) {
            const int cnt = (int)__hip_atomic_load(F.ctl + CW_CNT + (l * NE + u.e) * 64, __ATOMIC_RELAXED, __HIP_MEMORY_SCOPE_AGENT);
            const int idx = u.pm * 256 + rr;
            const int a = idx < cnt ? F.LIST[(size_t)u.e * TT + idx] : -1;
            tab[i * 256 + rr] = a;
            if (u.pn == 0 && a >= 0) { F.INV[a] = eb[u.e] + idx; F.GATES[eb[u.e] + idx] = F.GATE[a]; }
        }
    }
    __syncthreads();
}

__global__ void __launch_bounds__(NTHREADS, 2) mk_fwd(Args args) {
    extern __shared__ __attribute__((aligned(16))) unsigned char lds_raw[];
    Frame F;
    F.lds = (LAS unsigned char*)lds_raw;
    F.MISC = (volatile LAS unsigned*)(F.lds + MISC_OFF);
    F.tid = threadIdx.x; F.lane = F.tid & 63; F.wave = __builtin_amdgcn_readfirstlane(F.tid >> 6);
    F.G = gridDim.x; { const int bx = blockIdx.x; F.vcu = (F.G % 8 == 0) ? (bx % 8) * (F.G / 8) + bx / 8 : bx; }
    frame_ptrs(F);
    for (int u = F.tid; u < 256; u += NTHREADS) F.MISC[u] = 0u;
    __syncthreads();
    const int lo = args.ph_lo, hi = args.ph_hi;
    const bool one_launch = (hi - lo) > 1;
    XcdBarrier bar; bar.bar = F.ctl + CW_BAR; bar.x = 0; bar.st = nullptr;
    if (one_launch) bar = xcd_barrier_post(F.ctl + CW_BAR, F.MISC);
#ifndef PHMASK
#define PHMASK 0xFFFFFFFF
#endif
#define IN(k) (lo <= (k) && (k) < hi)
#define PHON(b) ((PHMASK >> (b)) & 1)
#define STAGGER() do { if (STAG_TICKS > 0 && (blockIdx.x & 8)) { const unsigned long long t0_ = __builtin_amdgcn_s_memrealtime(); while (__builtin_amdgcn_s_memrealtime() - t0_ < (unsigned long long)STAG_TICKS) __builtin_amdgcn_s_sleep(8); } } while (0)
#define REFRESH() do { int tz_ = threadIdx.x; asm volatile("" : "+v"(tz_)); F.tid = tz_; F.lane = tz_ & 63; frame_ptrs(F); } while (0)
#define SEAM(k) do { if (IN(k) && IN((k) + 1)) xcd_barrier(bar); } while (0)

    if (PHON(0) && IN(0)) { for (int rep = 0; rep < REPS(0); ++rep) { REFRESH(); ph_prologue(F); } } SEAM(0);
    if (PHON(1) && IN(1)) { REFRESH(); ph_first_norm(F); } SEAM(1);
    for (int l = 0; l < DEPTH; ++l) {
        const int pb = 2 + PPL * l;
        const bool lastl = (l == DEPTH - 1);
        if (PHON(2) && IN(pb + 0)) for (int rep = 0; rep < REPS(2); ++rep) {
            REFRESH(); STAGGER();
            g8::ProbIn Pb{(const char*)F.H, (const char*)(F.Bin + (size_t)l * NP * DM), F.P, F.VTA, F.G, (int)blockIdx.x, (rep + 1 < REPS(2)) ? 1 : 0};
            g8::gemm_phase(F.lds, Pb);
        }
        SEAM(pb + 0);
        if (PHON(3) && IN(pb + 1)) { for (int rep = 0; rep < REPS(3); ++rep) { REFRESH(); ph_prep(F, l); } } SEAM(pb + 1);
        if (PHON(4) && IN(pb + 2)) { for (int rep = 0; rep < REPS(4); ++rep) { REFRESH(); ph_attn(F, l); } } SEAM(pb + 2);
        if (PHON(10) && IN(pb + 3)) { for (int rep = 0; rep < REPS(10); ++rep) { REFRESH(); ph_gla3(F, l); } } SEAM(pb + 3);
        if (PHON(5) && IN(pb + 4)) for (int rep = 0; rep < REPS(5); ++rep) {
            REFRESH(); STAGGER();
            g8::ProbOut Pb{(const char*)F.MIX, (const char*)(F.Bout + (size_t)l * DM * DM), (rep + 1 < REPS(5)) ? (bf16*)F.ACT : F.X, F.mod + (size_t)l * 9 * 6 * DM, F.G, (int)blockIdx.x, (lastl ? TX : TT) / 256};
            g8::gemm_phase(F.lds, Pb);
        }
        SEAM(pb + 4);
        if (PHON(6) && IN(pb + 5)) { for (int rep = 0; rep < REPS(6); ++rep) { REFRESH(); ph_router(F, l, rep + 1 < REPS(6)); __syncthreads(); } } SEAM(pb + 5);
        if (PHON(7) && IN(pb + 6)) for (int rep = 0; rep < REPS(7); ++rep) {
            REFRESH(); moe_tables(F, l, 8); STAGGER();
            g8::ProbGU Pb{MOE_FP8 ? (const char*)F.H8 : (const char*)F.H, (const char*)F.Bgu + (size_t)l * NE * 2 * DM * DM * (MOE_FP8 ? 1 : 2), (unsigned char*)F.ACT, F.b_gu + (size_t)l * NE * 2 * DM, (volatile LAS int*)(F.MISC + 16), (const LAS int*)(F.lds + TAB_OFF), F.G, F.vcu, (rep + 1 < REPS(7)) ? 1 : 0, (volatile LAS int*)(F.MISC + 128)};
            g8::gemm_phase(F.lds, Pb);
        }
        SEAM(pb + 6);
        if (PHON(8) && IN(pb + 7)) for (int rep = 0; rep < REPS(8); ++rep) {
            REFRESH(); moe_tables(F, l, 4); STAGGER();
            g8::ProbDN Pb{(const char*)F.ACT, (const char*)F.Bdn + (size_t)l * NE * DM * DM * (MOE_FP8 ? 1 : 2), F.YB, F.b_down + (size_t)l * NE * DM, F.GATES, (volatile LAS int*)(F.MISC + 16), F.G, F.vcu, (rep + 1 < REPS(8)) ? 1 : 0, (volatile LAS int*)(F.MISC + 128), (volatile LAS int*)(F.MISC + 168)};
            g8::gemm_phase(F.lds, Pb);
        }
        SEAM(pb + 7);
        if (PHON(9) && IN(pb + 8)) { for (int rep = 0; rep < REPS(9); ++rep) { REFRESH(); ph_combine(F, l, rep + 1 < REPS(9)); } }
        if (!lastl) SEAM(pb + 8);
    }
#undef IN
#undef SEAM
}

extern "C" void kernel_launch(void* const* d_in, const int* in_sizes, int n_in, void* d_out, int out_size, void* d_ws, size_t ws_size, hipStream_t stream) {
    static int grid = 0;
    if (grid == 0) {
        if (n_in != 23 || in_sizes[0] != TX * DM || out_size != TX * DM || ws_size < WS_END) {
            fprintf(stderr, "kernel_launch: unexpected problem (n_in %d, in0 %d, out %d, ws %zu; need ws >= %zu); nothing launched\n", n_in, n_in > 0 ? in_sizes[0] : -1, out_size, ws_size, (size_t)WS_END); grid = -1; return; }
        int dev = 0, cus = 0, per_cu = 0;
        if (hipGetDevice(&dev) != hipSuccess || hipDeviceGetAttribute(&cus, hipDeviceAttributeMultiprocessorCount, dev) != hipSuccess) { fprintf(stderr, "kernel_launch: device query failed\n"); grid = -1; return; }
        if (hipFuncSetAttribute((const void*)mk_fwd, hipFuncAttributeMaxDynamicSharedMemorySize, LDS_BYTES) != hipSuccess) { fprintf(stderr, "kernel_launch: hipFuncSetAttribute failed\n"); grid = -1; return; }
        if (hipOccupancyMaxActiveBlocksPerMultiprocessor(&per_cu, (const void*)mk_fwd, NTHREADS, LDS_BYTES) != hipSuccess || per_cu < 1)
            fprintf(stderr, "kernel_launch: note: occupancy query reports %d workgroups per CU\n", per_cu);
        (void)hipGetLastError();
        grid = cus;
        if ((long)grid * MAXU < (long)(NASG / 256 + NE) * 8) { fprintf(stderr, "kernel_launch: grid %d too small for the MoE unit tables\n", grid); grid = -1; return; }
    }
    if (grid < 0) return;
    if (hipMemsetAsync((char*)d_ws + WS_CTL, 0, CTL_ZERO_BYTES, stream) != hipSuccess) { fprintf(stderr, "kernel_launch: memset failed\n"); return; }
    Args a{};
    for (int i = 0; i < 23; ++i) a.in[i] = (const float*)d_in[i];
    a.out = (float*)d_out; a.ws = (unsigned char*)d_ws;
#if MK_N_LAUNCHES == 1
    a.ph_lo = 0; a.ph_hi = NPHASES;
    hipLaunchKernelGGL(mk_fwd, dim3(grid), dim3(NTHREADS), LDS_BYTES, stream, a);
#else
    for (int p = 0; p < NPHASES; ++p) { a.ph_lo = p; a.ph_hi = p + 1; hipLaunchKernelGGL(mk_fwd, dim3(grid), dim3(NTHREADS), LDS_BYTES, stream, a); }
#endif
    const hipError_t le = hipPeekAtLastError();
    if (le != hipSuccess) fprintf(stderr, "kernel_launch: launch failed: %s\n", hipGetErrorName(le));
}
```

```cpp
#include <hip/hip_runtime.h>
#include <cstdio>
#include <cstdint>
#include <cstddef>

#ifndef MK_N_LAUNCHES
#define MK_N_LAUNCHES 1
#endif

#define GAS __attribute__((address_space(1)))
#define LAS __attribute__((address_space(3)))
typedef unsigned short bf16;
typedef short bf16x8 __attribute__((ext_vector_type(8)));
typedef short bf16x4 __attribute__((ext_vector_type(4)));
typedef float f32x4 __attribute__((ext_vector_type(4)));
typedef float f32x2 __attribute__((ext_vector_type(2)));
typedef unsigned u32x4 __attribute__((ext_vector_type(4)));
typedef unsigned u32x2 __attribute__((ext_vector_type(2)));

constexpr int NB = 8, SEQ = 4096, DM = 1024, CTXL = 256, DEPTH = 4, GRIDW = 64;
constexpr int TX = NB * SEQ, TC = NB * CTXL, TT = TX + TC;
constexpr int NP = 2816;
constexpr int C_NAQ = 0, C_NAK = 384, C_NAV = 768, C_GV = 1152, C_GQ = 1536, C_GK = 1728, C_GG = 1920, C_POOL = 2304, C_AF = 2560, C_AB = 2576;
constexpr int VT_C0 = 768, VT_NC = 768, VTS = TT + 128;
constexpr int NE = 32, TOPK = 4, NASG = TT * TOPK;
constexpr int SLOT_DUMMY = NASG + 256;
constexpr int GH = 4, GDK = 48, GDV = 96, NH = 6, NDH = 64;
constexpr float EPS = 1e-6f;
constexpr int NWAVES = 8, NTHREADS = 512;
constexpr int PPL = 9;
constexpr int NPHASES = 2 + PPL * DEPTH;
#ifndef MOE_FP8
#define MOE_FP8 1
#endif
#ifndef REPMASK
#define REPMASK 0
#endif
#define REPS(b) (1 + ((REPMASK >> (b)) & 1))
#ifndef GLA_CHECK
#define GLA_CHECK 0
#endif

constexpr size_t MiB = 1u << 20;
constexpr size_t WS_CTL = 0, CTL_ZERO_BYTES = 128 * 1024;
constexpr size_t WS_MOD = 2 * MiB;
constexpr size_t WS_BIN = 4 * MiB;
constexpr size_t WS_BOUT = 26 * MiB;
constexpr size_t WS_BGU = 34 * MiB;
constexpr size_t WS_BDN = 546 * MiB;
constexpr size_t WS_X = 802 * MiB;
constexpr size_t WS_H = 938 * MiB;
constexpr size_t WS_P = 1008 * MiB;
constexpr size_t WS_VTX = 1196 * MiB;
constexpr size_t WS_VTC = 1220 * MiB;
constexpr size_t WS_MIX = 1222 * MiB;
constexpr size_t WS_OF = 1290 * MiB;
constexpr size_t WS_OB = 1341 * MiB;
constexpr size_t WS_ACT = 1392 * MiB;
constexpr size_t WS_YB = 1665 * MiB;
constexpr size_t WS_LIST = 1938 * MiB;
constexpr size_t WS_GATE = 1943 * MiB;
constexpr size_t WS_DS = 1944 * MiB;
constexpr size_t WS_GD = 2025 * MiB;
constexpr size_t WS_ROPE = 2026 * MiB;
constexpr size_t WS_VTA = 2027 * MiB;
constexpr size_t WS_OPS = 2080 * MiB;
constexpr size_t WS_STB = 2132 * MiB;
constexpr size_t WS_H8 = 2172 * MiB;
constexpr size_t WS_INV = 2208 * MiB;
constexpr size_t WS_GATES = 2209 * MiB;
constexpr size_t WS_END = 2210 * MiB;
constexpr int CW_BAR = 4096;
constexpr int CW_CNT = 16384;

constexpr int STAGE_BYTES = 132096;
constexpr int MISC_OFF = STAGE_BYTES;
constexpr int TAB_OFF = MISC_OFF + 1024;
constexpr int MAXU = 28;
constexpr int LDS_BYTES = TAB_OFF + MAXU * 1024;
static_assert(LDS_BYTES <= 163840, "LDS");

#define LDS_WAIT() asm volatile("s_waitcnt lgkmcnt(0)" ::: "memory")
#define VM_WAIT() asm volatile("s_waitcnt vmcnt(0)" ::: "memory")
__device__ __forceinline__ unsigned f2bf(float f) { unsigned u = __builtin_bit_cast(unsigned, f); return (u + 0x7fffu + ((u >> 16) & 1u)) >> 16; }
__device__ __forceinline__ unsigned pk2(float lo, float hi) { return f2bf(lo) | (f2bf(hi) << 16); }
__device__ __forceinline__ float bf2f(unsigned b) { return __builtin_bit_cast(float, (b & 0xffffu) << 16); }
__device__ __forceinline__ float bflo(unsigned w) { return __builtin_bit_cast(float, w << 16); }
__device__ __forceinline__ float bfhi(unsigned w) { return __builtin_bit_cast(float, w & 0xffff0000u); }
__device__ __forceinline__ unsigned cvt_pk_bf16(float lo, float hi) { unsigned r; asm volatile("v_cvt_pk_bf16_f32 %0, %1, %2" : "=v"(r) : "v"(lo), "v"(hi)); return r; }
__device__ __forceinline__ unsigned pk4_fp8(float a, float b, float c, float d) { int p = __builtin_amdgcn_cvt_pk_fp8_f32(a, b, 0, false); p = __builtin_amdgcn_cvt_pk_fp8_f32(c, d, p, true); return (unsigned)p; }
constexpr float Y8_SCALE = 16.f, Y8_INV = 1.f / 16.f;
constexpr float W8_SCALE = 64.f, W8_INV = 1.f / 64.f;
template <int CTRL, int RM> __device__ __forceinline__ float dpp_add(float v) { const int t = __builtin_amdgcn_update_dpp(0, __float_as_int(v), CTRL, RM, 0xf, true); return v + __int_as_float(t); }
__device__ __forceinline__ float wave_scan_incl(float x) {
    x = dpp_add<0x111, 0xf>(x); x = dpp_add<0x112, 0xf>(x); x = dpp_add<0x114, 0xf>(x); x = dpp_add<0x118, 0xf>(x);
    x = dpp_add<0x142, 0xa>(x); x = dpp_add<0x143, 0xc>(x); return x;
}
template <int CTRL> __device__ __forceinline__ unsigned dpp_umax(unsigned v) { const unsigned t = (unsigned)__builtin_amdgcn_update_dpp(0, (int)v, CTRL, 0xf, 0xf, true); return t > v ? t : v; }
__device__ __forceinline__ unsigned row16_umax(unsigned v) {
    v = dpp_umax<0xB1>(v); v = dpp_umax<0x4E>(v); v = dpp_umax<0x141>(v); v = dpp_umax<0x140>(v); return v;
}
template <int CTRL> __device__ __forceinline__ float dpp_addp(float v) { const int t = __builtin_amdgcn_update_dpp(0, __float_as_int(v), CTRL, 0xf, 0xf, true); return v + __int_as_float(t); }
__device__ __forceinline__ float wave_sum(float v) {
    v = dpp_addp<0xB1>(v); v = dpp_addp<0x4E>(v); v = dpp_addp<0x141>(v); v = dpp_addp<0x140>(v);
    const auto r = __builtin_amdgcn_permlane16_swap(__float_as_uint(v), __float_as_uint(v), false, false);
    v = __uint_as_float(r[0]) + __uint_as_float(r[1]);
    const auto t = __builtin_amdgcn_permlane32_swap(__float_as_uint(v), __float_as_uint(v), false, false);
    return __uint_as_float(t[0]) + __uint_as_float(t[1]);
}
__device__ __forceinline__ float silu_f(float x) { return x / (1.f + __expf(-x)); }

#define XB_TMO      128
#define XB_XCNT(j)  (256  + 64 * (j))
#define XB_XSUB(j)  (1280 + 64 * (j))
#define XB_XGEN(j)  (2304 + 64 * (j))
#define XB_TOP      3328
#define XB_TOPGEN   3392
#define XCD_BAR_WORDS 3456
#define XB_SPIN_CAP (1u << 18)
__device__ __forceinline__ unsigned xb_ld(unsigned* p)              { return __hip_atomic_load(p, __ATOMIC_RELAXED, __HIP_MEMORY_SCOPE_AGENT); }
__device__ __forceinline__ unsigned xb_add(unsigned* p, unsigned v) { return __hip_atomic_fetch_add(p, v, __ATOMIC_RELAXED, __HIP_MEMORY_SCOPE_AGENT); }
__device__ __forceinline__ unsigned xb_xcc_id() { return (unsigned)__builtin_amdgcn_s_getreg((3 << 11) | 20) & 0xFu; }
#define XB_SPIN(cond, bar) do { unsigned _sp = 0; while (cond) { __builtin_amdgcn_s_sleep(1); \
    if ((++_sp & 255u) == 0u) { if (xb_ld(&(bar)[XB_TMO])) break; if (_sp > XB_SPIN_CAP) { atomicAdd(&(bar)[XB_TMO], 1u); break; } } } } while (0)
struct XcdBarrier { unsigned* bar; unsigned x; volatile LAS unsigned* st; };
__device__ __forceinline__ XcdBarrier xcd_barrier_post(unsigned* bar, volatile LAS unsigned* st) {
    XcdBarrier b; b.bar = bar; b.x = xb_xcc_id(); b.st = st;
    if (threadIdx.x == 0) (void)xb_add(&bar[XB_XCNT(b.x)], 1u);
    return b;
}
__device__ __forceinline__ void xcd_barrier_complete(unsigned* bar, unsigned x, unsigned& nloc, unsigned& nx) {
    const unsigned G = gridDim.x * gridDim.y * gridDim.z;
    unsigned sum, cnt, mine, sp = 0u;
    for (;;) {
        sum = 0u; cnt = 0u; mine = 0u;
#pragma unroll
        for (unsigned j = 0; j < 16; ++j) { const unsigned c = xb_ld(&bar[XB_XCNT(j)]); sum += c; cnt += (c > 0u) ? 1u : 0u; mine = (j == x) ? c : mine; }
        if (sum == G) break;
        __builtin_amdgcn_s_sleep(1);
        if ((++sp & 255u) == 0u) { if (xb_ld(&bar[XB_TMO])) break; if (sp > XB_SPIN_CAP) { atomicAdd(&bar[XB_TMO], 1u); break; } }
    }
    nloc = mine > 0u ? mine : 1u; nx = cnt > 0u ? cnt : 1u;
}
__device__ __forceinline__ void xcd_barrier(const XcdBarrier& b) {
    asm volatile("s_waitcnt vmcnt(0)" ::: "memory");
    __syncthreads();
    if (threadIdx.x == 0) {
        unsigned* bar = b.bar;
        __builtin_amdgcn_s_waitcnt(0);
        unsigned nloc = b.st[0], nx = b.st[1];
        if (nloc == 0u) { xcd_barrier_complete(bar, b.x, nloc, nx); b.st[0] = nloc; b.st[1] = nx; }
        const unsigned old = xb_add(&bar[XB_XSUB(b.x)], 1u);
        const unsigned gen = old / nloc;
        if (old + 1u == (gen + 1u) * nloc) {
            __builtin_amdgcn_fence(__ATOMIC_RELEASE, "agent");
            asm volatile("s_waitcnt vmcnt(0)" ::: "memory");
            const unsigned og = xb_add(&bar[XB_TOP], 1u);
            const unsigned tg = og / nx;
            if (og + 1u == (tg + 1u) * nx) xb_add(&bar[XB_TOPGEN], 1u);
            else XB_SPIN(xb_ld(&bar[XB_TOPGEN]) == tg, bar);
            __builtin_amdgcn_fence(__ATOMIC_ACQUIRE, "agent");
            xb_add(&bar[XB_XGEN(b.x)], 1u);
            asm volatile("s_waitcnt vmcnt(0)" ::: "memory");
        } else {
            XB_SPIN(xb_ld(&bar[XB_XGEN(b.x)]) == gen, bar);
            __builtin_amdgcn_fence(__ATOMIC_ACQUIRE, "agent");
            asm volatile("s_waitcnt vmcnt(0)" ::: "memory");
        }
    }
    __syncthreads();
}

namespace g8 {
constexpr int BM = 256, BK = 64, HALF = 128, HTB = HALF * BK * 2, NXCD = 8, WGM = 8, KD = 1024;
__device__ __forceinline__ int lds_byte(int r, int c) { const int st = (r >> 4) * 2 + (c >> 5), rr = r & 15, cc = c & 31, ob = rr * 64 + cc * 2; return st * 1024 + (ob ^ (((ob >> 9) & 1) << 5)); }
__device__ __forceinline__ void stage_rc(int b, int& R, int& C) { const int st = b / 1024, sb = b % 1024, swz = sb ^ (((sb >> 9) & 1) << 5); R = (st >> 1) * 16 + swz / 64; C = (st & 1) * 32 + (swz % 64) / 2; }
__device__ __forceinline__ int perm32(int rho) { const int n = rho >> 4, i = rho & 15; return 8 * (i >> 2) + 4 * n + (i & 3); }
struct Unit { int pm, pn, e; };
typedef int i32x8 __attribute__((ext_vector_type(8)));
typedef int i32x4 __attribute__((ext_vector_type(4)));
__device__ __forceinline__ i32x8 cat8(bf16x8 a, bf16x8 b) { const i32x4 x = __builtin_bit_cast(i32x4, a), y = __builtin_bit_cast(i32x4, b); return (i32x8){x.x, x.y, x.z, x.w, y.x, y.y, y.z, y.w}; }
__device__ __forceinline__ bool static_unit(long L, int nM, int nN, Unit& u) {
    const int nwg = nM * nN; if (L >= nwg) return false;
    int wgid = (int)L; { const int q = nwg / NXCD, r = nwg % NXCD, xcd = wgid % NXCD, off = wgid / NXCD; wgid = (xcd < r ? xcd * (q + 1) : r * (q + 1) + (xcd - r) * q) + off; }
    const int nig = WGM * nN, gid = wgid / nig, fm = gid * WGM, gsz = (nM - fm) < WGM ? (nM - fm) : WGM;
    u.pm = fm + ((wgid % nig) % gsz); u.pn = (wgid % nig) / gsz; u.e = 0; return true;
}

#ifndef PROBE_DRY
#define PROBE_DRY 0
#endif
#ifndef STAG_TICKS
#define STAG_TICKS 0
#endif
template <class Prob>
__device__ __forceinline__ void gemm_phase(LAS unsigned char* lds, const Prob& P) {

    int tid_ = threadIdx.x; asm volatile("" : "+v"(tid_));
    const int tid = tid_, wid = __builtin_amdgcn_readfirstlane(tid >> 6), lane = tid & 63, wr = wid >> 2, wc = wid & 3, fr = lane & 15, fq = lane >> 4;
    constexpr int RPB = Prob::FP8 ? KD : KD * 2, nt = RPB / (BK * 2);
    unsigned voffB[2];
    { int R0, C0, R1, C1; stage_rc(tid * 16, R0, C0); stage_rc(tid * 16 + 8192, R1, C1); const int Rb0 = Prob::PERM ? ((R0 & ~31) + perm32(R0 & 31)) : R0, Rb1 = Prob::PERM ? ((R1 & ~31) + perm32(R1 & 31)) : R1;
      voffB[0] = (unsigned)(Rb0 * RPB + C0 * 2); voffB[1] = (unsigned)(Rb1 * RPB + C1 * 2); }
    const size_t kstep = (size_t)(BK * 2), hstepB = (size_t)HALF * RPB;
    const unsigned ldsw = (unsigned)wid * 1024u;
    const int aoff = lds_byte(wr * 64 + fr, fq * 8), boff = lds_byte(wc * 32 + fr, fq * 8);
#define G8_SA(b, h) (((b) * 2 + (h)) * HTB)
#define G8_SB(b, h) ((4 + (b) * 2 + (h)) * HTB)
#define G8_STAGE(bufoff, gbase, voff) do { _Pragma("unroll") for (int _i = 0; _i < 2; ++_i) \
        __builtin_amdgcn_global_load_lds((const unsigned*)((const char*)(gbase) + (voff)[_i]), (LAS unsigned*)(lds + (bufoff) + ldsw + _i * 8192), 16, 0, 0); } while (0)
#define G8_LDA(dst, b, h) do { _Pragma("unroll") for (int m = 0; m < 4; ++m) _Pragma("unroll") for (int k = 0; k < 2; ++k) dst[m][k] = *(const LAS bf16x8*)(lds + G8_SA(b, h) + aoff + m * 2048 + k * 1024); } while (0)
#define G8_LDB(dst, b, h) do { _Pragma("unroll") for (int n = 0; n < 2; ++n) _Pragma("unroll") for (int k = 0; k < 2; ++k) dst[n][k] = *(const LAS bf16x8*)(lds + G8_SB(b, h) + boff + n * 2048 + k * 1024); } while (0)
#define G8_MMA(ai, bj, At, Bt) do { __builtin_amdgcn_s_setprio(1); if constexpr (Prob::FP8) { \
        _Pragma("unroll") for (int m = 0; m < 4; ++m) _Pragma("unroll") for (int n = 0; n < 2; ++n) \
        acc[ai][bj][m][n] = __builtin_amdgcn_mfma_scale_f32_16x16x128_f8f6f4(cat8(Bt[n][0], Bt[n][1]), cat8(At[m][0], At[m][1]), acc[ai][bj][m][n], 0, 0, 0, 0x7f7f7f7f, 0, 0x7f7f7f7f); } else { \
        _Pragma("unroll") for (int m = 0; m < 4; ++m) _Pragma("unroll") for (int n = 0; n < 2; ++n) _Pragma("unroll") for (int k = 0; k < 2; ++k) \
        acc[ai][bj][m][n] = __builtin_amdgcn_mfma_f32_16x16x32_bf16(Bt[n][k], At[m][k], acc[ai][bj][m][n], 0, 0, 0); } __builtin_amdgcn_s_setprio(0); } while (0)
#define G8_WAIT_V(n) asm volatile("s_waitcnt vmcnt(" #n ")" ::: "memory")
#define G8_WAIT_L(n) asm volatile("s_waitcnt lgkmcnt(" #n ")" ::: "memory")
#define G8_BAR __builtin_amdgcn_s_barrier()
#define G8_SCHED __builtin_amdgcn_sched_barrier(0)
    Unit cur, nxt; int ui = 0;
    if (!P.next(0, cur)) return;
    f32x4 acc[2][2][4][2];
#pragma unroll
    for (int a = 0; a < 2; ++a)
#pragma unroll
        for (int b = 0; b < 2; ++b)
#pragma unroll
            for (int m = 0; m < 4; ++m)
#pragma unroll
                for (int n = 0; n < 2; ++n) acc[a][b][m][n] = (f32x4){0.f, 0.f, 0.f, 0.f};
    bf16x8 At[4][2], B0[2][2], B1[2][2];
    unsigned cvA[2][2];
    P.a_off(cur, 0, tid, cvA);
    const char* cA = P.a_base(cur);
    const char* cB = P.b_ptr(cur);
    G8_STAGE(G8_SB(0, 0), cB, voffB); G8_STAGE(G8_SB(0, 1), cB + hstepB, voffB); G8_STAGE(G8_SA(0, 0), cA, cvA[0]); G8_STAGE(G8_SA(0, 1), cA, cvA[1]);
    if (wr == 1) G8_BAR;
    G8_WAIT_V(2); G8_BAR;
    G8_STAGE(G8_SB(1, 0), cB + kstep, voffB); G8_STAGE(G8_SA(1, 0), cA + kstep, cvA[0]); G8_STAGE(G8_SB(1, 1), cB + hstepB + kstep, voffB);
    G8_WAIT_V(6); G8_BAR;
    for (;;) {
        const bool has_next = P.next(ui + 1, nxt);
        const char* nB = has_next ? P.b_ptr(nxt) : cB;
        const char* nA = has_next ? P.a_base(nxt) : cA;
        for (int t = 0; t < nt; t += 2) {
            const bool last = (t == nt - 2);
            const char* a1 = cA + (size_t)(t + 1) * kstep;
            const char* a2 = last ? nA : cA + (size_t)(t + 2) * kstep; const char* b2 = last ? nB : cB + (size_t)(t + 2) * kstep;
            const char* a3 = a2 + kstep; const char* b3 = b2 + kstep;
            G8_LDB(B0, 0, 0); G8_LDB(B1, 0, 1); G8_SCHED; G8_LDA(At, 0, 0); G8_STAGE(G8_SA(1, 1), a1, cvA[1]);
            G8_WAIT_V(8); G8_WAIT_L(0); G8_BAR; G8_MMA(0, 0, At, B0); G8_MMA(0, 1, At, B1); G8_BAR; G8_SCHED;
            if (last && has_next) { int tz = threadIdx.x; asm volatile("" : "+v"(tz)); P.a_off(nxt, ui + 1, tz, cvA); }
            G8_LDA(At, 0, 1); G8_STAGE(G8_SB(0, 0), b2, voffB); G8_STAGE(G8_SB(0, 1), b2 + hstepB, voffB); G8_STAGE(G8_SA(0, 0), a2, cvA[0]);
            G8_WAIT_V(8); G8_WAIT_L(0); G8_BAR; G8_MMA(1, 0, At, B0); G8_MMA(1, 1, At, B1); G8_BAR; G8_SCHED;
            G8_LDB(B0, 1, 0); G8_LDB(B1, 1, 1); G8_SCHED; G8_LDA(At, 1, 0); G8_STAGE(G8_SA(0, 1), a2, cvA[1]);
            G8_WAIT_V(8); G8_WAIT_L(0); G8_BAR; G8_MMA(0, 0, At, B0); G8_MMA(0, 1, At, B1); G8_BAR; G8_SCHED;
            G8_LDA(At, 1, 1); G8_STAGE(G8_SB(1, 0), b3, voffB); G8_STAGE(G8_SB(1, 1), b3 + hstepB, voffB); G8_STAGE(G8_SA(1, 0), a3, cvA[0]);
            G8_WAIT_V(8); G8_WAIT_L(0); G8_BAR; G8_MMA(1, 0, At, B0); G8_MMA(1, 1, At, B1); G8_BAR; G8_SCHED;
        }
        if (wr == 0) G8_BAR;
        P.epi(acc, cur, ui, wr, wc, fr, fq);
        if (!has_next) break;
#pragma unroll
        for (int a = 0; a < 2; ++a)
#pragma unroll
            for (int b = 0; b < 2; ++b)
#pragma unroll
                for (int m = 0; m < 4; ++m)
#pragma unroll
                    for (int n = 0; n < 2; ++n) acc[a][b][m][n] = (f32x4){0.f, 0.f, 0.f, 0.f};
        cur = nxt; cB = nB; cA = nA; ++ui;
        if (wr == 1) G8_BAR;
    }
    G8_WAIT_V(0);
    G8_BAR;
#undef G8_SA
#undef G8_SB
#undef G8_STAGE
#undef G8_LDA
#undef G8_LDB
#undef G8_MMA
#undef G8_WAIT_V
#undef G8_WAIT_L
#undef G8_BAR
#undef G8_SCHED
}


struct ProbIn {
    static constexpr bool PERM = true, FP8 = false;
    const char* A; const char* Bt; bf16* O; bf16* VT; int G, c; int dry;
    __device__ __forceinline__ static bool swapped(const Unit& u) { return u.pn >= 3 && u.pn <= 5; }
    __device__ __forceinline__ bool next(int i, Unit& u) const { return static_unit((long)i * G + c, TT / 256, NP / 256, u); }
    __device__ __forceinline__ void a_off(const Unit& u, int, int tid, unsigned (&v)[2][2]) const {
        int R0, C0, R1, C1; stage_rc(tid * 16, R0, C0); stage_rc(tid * 16 + 8192, R1, C1);
        const int rt = swapped(u) ? u.pn : u.pm;
#pragma unroll
        for (int h = 0; h < 2; ++h) { v[h][0] = (unsigned)((rt * 256 + h * 128 + R0) * KD + C0) * 2u; v[h][1] = (unsigned)((rt * 256 + h * 128 + R1) * KD + C1) * 2u; }
    }
    __device__ __forceinline__ const char* a_base(const Unit& u) const { return swapped(u) ? Bt : A; }
    __device__ __forceinline__ const char* b_ptr(const Unit& u) const { return swapped(u) ? A + (size_t)u.pm * 256 * KD * 2 : Bt + (size_t)u.pn * 256 * KD * 2; }
    __device__ __forceinline__ void epi(const f32x4 (&acc)[2][2][4][2], const Unit& u, int, int wr, int wc, int fr, int fq) const {
        if (PROBE_DRY && dry) { asm volatile("" :: "v"(acc[0][0][0][0][0]), "v"(acc[1][1][3][1][3]), "v"(acc[0][1][2][0][1]), "v"(acc[1][0][1][1][2])); return; }
        const bool sw = swapped(u);
        bf16* base = sw ? VT + (size_t)(u.pn * 256 - VT_C0 + wr * 64 + fr) * VTS + u.pm * 256 + wc * 32 + 8 * fq
                        : O + (size_t)(u.pm * 256 + wr * 64 + fr) * NP + u.pn * 256 + wc * 32 + 8 * fq;
        const size_t ld = sw ? (size_t)VTS : (size_t)NP;
#pragma unroll
        for (int ai = 0; ai < 2; ++ai)
#pragma unroll
            for (int m = 0; m < 4; ++m) { bf16* rowp = base + (size_t)(ai * 128 + m * 16) * ld;
#pragma unroll
                for (int bj = 0; bj < 2; ++bj) { const f32x4 v0 = acc[ai][bj][m][0], v1 = acc[ai][bj][m][1];
                    u32x4 w; w.x = cvt_pk_bf16(v0[0], v0[1]); w.y = cvt_pk_bf16(v0[2], v0[3]); w.z = cvt_pk_bf16(v1[0], v1[1]); w.w = cvt_pk_bf16(v1[2], v1[3]);
                    *(u32x4*)(rowp + bj * 128) = w; } }
    }
};
struct ProbOut {
    static constexpr bool PERM = false, FP8 = false;
    const char* A; const char* Bt; bf16* X; const float* modl  ; int G, c, nM;
    __device__ __forceinline__ bool next(int i, Unit& u) const { return static_unit((long)i * G + c, nM, DM / 256, u); }
    __device__ __forceinline__ void a_off(const Unit& u, int, int tid, unsigned (&v)[2][2]) const {
        int R0, C0, R1, C1; stage_rc(tid * 16, R0, C0); stage_rc(tid * 16 + 8192, R1, C1);
#pragma unroll
        for (int h = 0; h < 2; ++h) { v[h][0] = (unsigned)((u.pm * 256 + h * 128 + R0) * KD + C0) * 2u; v[h][1] = (unsigned)((u.pm * 256 + h * 128 + R1) * KD + C1) * 2u; }
    }
    __device__ __forceinline__ const char* a_base(const Unit&) const { return A; }
    __device__ __forceinline__ const char* b_ptr(const Unit& u) const { return Bt + (size_t)u.pn * 256 * KD * 2; }
    __device__ __forceinline__ void epi(const f32x4 (&acc)[2][2][4][2], const Unit& u, int, int wr, int wc, int fr, int fq) const {
        const int r0 = u.pm * 256, br = r0 < TX ? (r0 / SEQ) : NB;
        const float* g1 = modl + (size_t)br * 6 * DM + 2 * DM;
        const int row0 = r0 + wr * 64 + fr, col0 = u.pn * 256 + wc * 32 + 4 * fq;
        f32x4 gv[2][2];
#pragma unroll
        for (int bj = 0; bj < 2; ++bj)
#pragma unroll
            for (int n = 0; n < 2; ++n) gv[bj][n] = *(const f32x4*)(g1 + col0 + bj * 128 + n * 16);
#pragma unroll
        for (int ai = 0; ai < 2; ++ai) {
            u32x2 xv[4][2][2];
#pragma unroll
            for (int m = 0; m < 4; ++m)
#pragma unroll
                for (int bj = 0; bj < 2; ++bj)
#pragma unroll
                    for (int n = 0; n < 2; ++n) xv[m][bj][n] = *(const u32x2*)(X + (size_t)(row0 + ai * 128 + m * 16) * DM + col0 + bj * 128 + n * 16);
#pragma unroll
            for (int m = 0; m < 4; ++m)
#pragma unroll
                for (int bj = 0; bj < 2; ++bj)
#pragma unroll
                    for (int n = 0; n < 2; ++n) { const u32x2 xw = xv[m][bj][n]; const f32x4 y = (f32x4){bflo(xw.x), bfhi(xw.x), bflo(xw.y), bfhi(xw.y)} + gv[bj][n] * acc[ai][bj][m][n];
                        u32x2 w; w.x = cvt_pk_bf16(y[0], y[1]); w.y = cvt_pk_bf16(y[2], y[3]);
                        *(u32x2*)(X + (size_t)(row0 + ai * 128 + m * 16) * DM + col0 + bj * 128 + n * 16) = w; }
        }
    }
};
__device__ __forceinline__ bool moe_unit(long L, int npn, const volatile LAS int* tp, Unit& u) {
    const int q = (int)(L / npn); if (q >= tp[NE]) return false;
    int e = 0;
#pragma unroll 1
    while (tp[e + 1] <= q) ++e;
    u.e = e; u.pm = q - tp[e]; u.pn = (int)(L % npn); return true;
}
struct ProbGU {
    static constexpr bool PERM = true, FP8 = (MOE_FP8 != 0); static constexpr unsigned EB = FP8 ? 1u : 2u;
    const char* A; const char* Bt  ; unsigned char* ACT; const float* bgu  ; const volatile LAS int* tp; const LAS int* tab; int G, c; int dry; const volatile LAS int* eb;
    __device__ __forceinline__ bool next(int i, Unit& u) const { return i < MAXU && moe_unit((long)i * G + c, 8, tp, u); }
    __device__ __forceinline__ void a_off(const Unit&, int ui, int tid, unsigned (&v)[2][2]) const {
        int R0, C0, R1, C1; stage_rc(tid * 16, R0, C0); stage_rc(tid * 16 + 8192, R1, C1);
#pragma unroll
        for (int h = 0; h < 2; ++h) { const int a0 = tab[ui * 256 + h * 128 + R0], a1 = tab[ui * 256 + h * 128 + R1];
            v[h][0] = (unsigned)(a0 < 0 ? TT : (a0 >> 2)) * (unsigned)KD * EB + (unsigned)C0 * 2u; v[h][1] = (unsigned)(a1 < 0 ? TT : (a1 >> 2)) * (unsigned)KD * EB + (unsigned)C1 * 2u; }
    }
    __device__ __forceinline__ const char* a_base(const Unit&) const { return A; }
    __device__ __forceinline__ const char* b_ptr(const Unit& u) const { return Bt + ((size_t)u.e * 2 * DM + (size_t)u.pn * 256) * KD * EB; }
    __device__ __forceinline__ void epi(const f32x4 (&acc)[2][2][4][2], const Unit& u, int ui, int wr, int wc, int fr, int fq) const {
        if (PROBE_DRY && dry) { asm volatile("" :: "v"(acc[0][0][0][0][0]), "v"(acc[1][1][3][1][3]), "v"(acc[0][1][2][0][1]), "v"(acc[1][0][1][1][2])); return; }
        const int cb = u.pn * 128 + wc * 32 + 8 * fq;
        const float* bg = bgu + (size_t)u.e * 2 * DM + cb; const float* bu = bg + DM;
        const f32x4 bg0 = *(const f32x4*)bg, bg1 = *(const f32x4*)(bg + 4), bu0 = *(const f32x4*)bu, bu1 = *(const f32x4*)(bu + 4);
        const int ebu = eb[u.e] + u.pm * 256;
#pragma unroll
        for (int ai = 0; ai < 2; ++ai)
#pragma unroll
            for (int m = 0; m < 4; ++m) {
                const int a = tab[ui * 256 + ai * 128 + wr * 64 + m * 16 + fr];
                unsigned char* rowp = ACT + ((size_t)(a < 0 ? SLOT_DUMMY : ebu + ai * 128 + wr * 64 + m * 16 + fr) * DM + cb) * EB;
                float o[8];
#pragma unroll
                for (int n = 0; n < 2; ++n) { const f32x4 gb = n ? bg1 : bg0, ub = n ? bu1 : bu0;
#pragma unroll
                    for (int j = 0; j < 4; ++j) { float g = acc[ai][0][m][n][j] * (FP8 ? W8_INV : 1.f) + gb[j], uu = acc[ai][1][m][n][j] * (FP8 ? W8_INV : 1.f) + ub[j];
                        g = fminf(g, 7.f); uu = fminf(fmaxf(uu, -7.f), 7.f);
                        o[n * 4 + j] = g * __builtin_amdgcn_rcpf(1.f + __expf(-1.702f * g)) * (uu + 1.f); } }
                if constexpr (FP8) { u32x2 w; w.x = pk4_fp8(o[0], o[1], o[2], o[3]); w.y = pk4_fp8(o[4], o[5], o[6], o[7]); *(u32x2*)rowp = w; }
                else { u32x4 w; w.x = cvt_pk_bf16(o[0], o[1]); w.y = cvt_pk_bf16(o[2], o[3]); w.z = cvt_pk_bf16(o[4], o[5]); w.w = cvt_pk_bf16(o[6], o[7]); *(u32x4*)rowp = w; } }
    }
};
struct ProbDN {
    static constexpr bool PERM = true, FP8 = (MOE_FP8 != 0); static constexpr unsigned EB = FP8 ? 1u : 2u;
    const char* A; const char* Bt  ; bf16* YB; const float* bdn  ; const float* gates  ; const volatile LAS int* tp; int G, c; int dry; const volatile LAS int* eb; const volatile LAS int* cntl;
    __device__ __forceinline__ bool next(int i, Unit& u) const { return i < MAXU && moe_unit((long)i * G + c, 4, tp, u); }
    __device__ __forceinline__ void a_off(const Unit& u, int, int tid, unsigned (&v)[2][2]) const {
        int R0, C0, R1, C1; stage_rc(tid * 16, R0, C0); stage_rc(tid * 16 + 8192, R1, C1);
        const int r0 = eb[u.e] + u.pm * 256;
#pragma unroll
        for (int h = 0; h < 2; ++h) { v[h][0] = (unsigned)(r0 + h * 128 + R0) * (unsigned)KD * EB + (unsigned)C0 * 2u; v[h][1] = (unsigned)(r0 + h * 128 + R1) * (unsigned)KD * EB + (unsigned)C1 * 2u; }
    }
    __device__ __forceinline__ const char* a_base(const Unit&) const { return A; }
    __device__ __forceinline__ const char* b_ptr(const Unit& u) const { return Bt + ((size_t)u.e * DM + (size_t)u.pn * 256) * KD * EB; }
    __device__ __forceinline__ void epi(const f32x4 (&acc)[2][2][4][2], const Unit& u, int ui, int wr, int wc, int fr, int fq) const {
        if (PROBE_DRY && dry) { asm volatile("" :: "v"(acc[0][0][0][0][0]), "v"(acc[1][1][3][1][3]), "v"(acc[0][1][2][0][1]), "v"(acc[1][0][1][1][2])); return; }
        const int col0 = u.pn * 256 + wc * 32 + 8 * fq;
        const float* bd = bdn + (size_t)u.e * DM + col0;
        f32x4 bv[2][2];
#pragma unroll
        for (int bj = 0; bj < 2; ++bj)
#pragma unroll
            for (int n = 0; n < 2; ++n) bv[bj][n] = *(const f32x4*)(bd + bj * 128 + 4 * n);
        int sl[2][4]; float gt[2][4]; const int ebu = eb[u.e] + u.pm * 256, nval = cntl[u.e] - u.pm * 256;
#pragma unroll
        for (int ai = 0; ai < 2; ++ai)
#pragma unroll
            for (int m = 0; m < 4; ++m) { const int rl = ai * 128 + wr * 64 + m * 16 + fr; sl[ai][m] = rl < nval ? ebu + rl : SLOT_DUMMY; gt[ai][m] = gates[sl[ai][m]]; }
#pragma unroll
        for (int ai = 0; ai < 2; ++ai)
#pragma unroll
            for (int m = 0; m < 4; ++m) {
                if constexpr (FP8) {
                    unsigned char* rowp = (unsigned char*)YB + (size_t)sl[ai][m] * DM + col0;
#pragma unroll
                    for (int bj = 0; bj < 2; ++bj) { const f32x4 v0 = (acc[ai][bj][m][0] * W8_INV + bv[bj][0]) * (gt[ai][m] * Y8_SCALE), v1 = (acc[ai][bj][m][1] * W8_INV + bv[bj][1]) * (gt[ai][m] * Y8_SCALE);
                        u32x2 w; w.x = pk4_fp8(v0[0], v0[1], v0[2], v0[3]); w.y = pk4_fp8(v1[0], v1[1], v1[2], v1[3]); *(u32x2*)(rowp + bj * 128) = w; }
                } else {
                    bf16* rowp = YB + (size_t)sl[ai][m] * DM + col0;
#pragma unroll
                    for (int bj = 0; bj < 2; ++bj) { const f32x4 v0 = (acc[ai][bj][m][0] + bv[bj][0]) * gt[ai][m], v1 = (acc[ai][bj][m][1] + bv[bj][1]) * gt[ai][m];
                        u32x4 w; w.x = cvt_pk_bf16(v0[0], v0[1]); w.y = cvt_pk_bf16(v0[2], v0[3]); w.z = cvt_pk_bf16(v1[0], v1[1]); w.w = cvt_pk_bf16(v1[2], v1[3]);
                        *(u32x4*)(rowp + bj * 128) = w; }
                } }
    }
};
}

struct Args { const float* in[23]; float* out; unsigned char* ws; int ph_lo, ph_hi; };
struct Frame {
    LAS unsigned char* lds; volatile LAS unsigned* MISC;
    int tid, lane, wave, G, vcu;
    const float *x, *c, *ctx, *c_ctx, *norm1_g, *norm2_g, *w_ada, *b_ada, *w_in, *gla_wa2, *gla_ba, *gla_norm_g, *na_rpb, *pool_w, *pool_scale, *w_out, *router_w, *router_b, *w_gu, *b_gu, *w_down, *b_down, *final_g;
    float* out; unsigned char* ws; unsigned* ctl;
    float* mod; bf16 *Bin, *Bout, *Bgu, *Bdn; bf16* X; bf16 *H, *P, *VTX, *VTC, *MIX; float *OF, *OB; bf16 *ACT, *YB; int* LIST; float* GATE; float *DS, *GD, *ROPE; bf16 *VTA, *OPS, *STB; unsigned char* H8; int* INV; float* GATES;
};


#define CAS __attribute__((address_space(4)))
__device__ __forceinline__ void frame_ptrs(Frame& F) {
    const CAS unsigned char* ka = (const CAS unsigned char*)__builtin_amdgcn_kernarg_segment_ptr();
    asm volatile("" : "+s"(ka));
    typedef const GAS float* gfp;
    const CAS gfp* in = (const CAS gfp*)ka;
    F.x = (const float*)in[0]; F.c = (const float*)in[1]; F.ctx = (const float*)in[2]; F.c_ctx = (const float*)in[3]; F.norm1_g = (const float*)in[4]; F.norm2_g = (const float*)in[5];
    F.w_ada = (const float*)in[6]; F.b_ada = (const float*)in[7]; F.w_in = (const float*)in[8]; F.gla_wa2 = (const float*)in[9]; F.gla_ba = (const float*)in[10]; F.gla_norm_g = (const float*)in[11];
    F.na_rpb = (const float*)in[12]; F.pool_w = (const float*)in[13]; F.pool_scale = (const float*)in[14]; F.w_out = (const float*)in[15]; F.router_w = (const float*)in[16]; F.router_b = (const float*)in[17];
    F.w_gu = (const float*)in[18]; F.b_gu = (const float*)in[19]; F.w_down = (const float*)in[20]; F.b_down = (const float*)in[21]; F.final_g = (const float*)in[22];
    F.out = (float*)*(GAS float* const CAS*)(ka + 184);
    GAS unsigned char* ws = *(GAS unsigned char* const CAS*)(ka + 192);
    F.ws = (unsigned char*)ws; F.ctl = (unsigned*)(ws + WS_CTL);
    F.mod = (float*)(ws + WS_MOD); F.Bin = (bf16*)(ws + WS_BIN); F.Bout = (bf16*)(ws + WS_BOUT); F.Bgu = (bf16*)(ws + WS_BGU); F.Bdn = (bf16*)(ws + WS_BDN);
    F.X = (bf16*)(ws + WS_X); F.H = (bf16*)(ws + WS_H); F.P = (bf16*)(ws + WS_P); F.VTX = (bf16*)(ws + WS_VTX); F.VTC = (bf16*)(ws + WS_VTC); F.MIX = (bf16*)(ws + WS_MIX);
    F.OF = (float*)(ws + WS_OF); F.OB = (float*)(ws + WS_OB); F.ACT = (bf16*)(ws + WS_ACT); F.YB = (bf16*)(ws + WS_YB); F.LIST = (int*)(ws + WS_LIST); F.GATE = (float*)(ws + WS_GATE);
    F.DS = (float*)(ws + WS_DS); F.GD = (float*)(ws + WS_GD); F.ROPE = (float*)(ws + WS_ROPE); F.VTA = (bf16*)(ws + WS_VTA); F.OPS = (bf16*)(ws + WS_OPS); F.STB = (bf16*)(ws + WS_STB); F.H8 = (unsigned char*)(ws + WS_H8); F.INV = (int*)(ws + WS_INV); F.GATES = (float*)(ws + WS_GATES);
}
static_assert(offsetof(Args, out) == 184 && offsetof(Args, ws) == 192, "Args layout");

__device__ __forceinline__ void in_col_map(int n0, int& dst, float& scale) {
    scale = 1.f;
    if (n0 < 192) { dst = C_GQ + n0; scale = 0.14433756729740643f; }
    else if (n0 < 384) dst = C_GK + (n0 - 192);
    else if (n0 < 768) dst = C_GV + (n0 - 384);
    else if (n0 < 800) dst = C_AF + (n0 - 768);
    else if (n0 < 1184) dst = C_GG + (n0 - 800);
    else if (n0 < 1568) { dst = C_NAQ + (n0 - 1184); scale = 0.125f * 1.4426950408889634f; }
    else if (n0 < 1952) dst = C_NAK + (n0 - 1568);
    else if (n0 < 2336) dst = C_NAV + (n0 - 1952);
    else dst = C_POOL + (n0 - 2336);
}
struct TItem { const float* src; int N; unsigned char* dst; int fp8; float scale; };
__device__ __forceinline__ TItem titem_decode(const Frame& F, int r) {
    constexpr int I_IN = DEPTH * 16 * 81, I_OUT = DEPTH * 16 * 32, I_GU = DEPTH * NE * 16 * 64;
    TItem t; t.fp8 = 0; t.scale = 1.f;
    if (r < I_IN) { const int l = r / (16 * 81), rr = r % (16 * 81), kb = rr / 81, nb = rr % 81; int dst; in_col_map(nb * 32, dst, t.scale);
        t.N = 2592; t.src = F.w_in + (size_t)l * DM * 2592 + (size_t)(kb * 64) * 2592 + nb * 32; t.dst = (unsigned char*)(F.Bin + ((size_t)l * NP + dst) * DM + kb * 64); return t; }
    r -= I_IN;
    if (r < I_OUT) { const int l = r / (16 * 32), rr = r % (16 * 32), kb = rr / 32, nb = rr % 32;
        t.N = DM; t.src = F.w_out + (size_t)l * DM * DM + (size_t)(kb * 64) * DM + nb * 32; t.dst = (unsigned char*)(F.Bout + ((size_t)l * DM + nb * 32) * DM + kb * 64); return t; }
    r -= I_OUT; t.fp8 = MOE_FP8; constexpr size_t EB = MOE_FP8 ? 1 : 2;
    if (r < I_GU) { const int le = r / (16 * 64), rr = r % (16 * 64), kb = rr / 64, nb = rr % 64; const int j0 = nb * 32;
        const int dst = j0 < DM ? (j0 / 128) * 256 + (j0 % 128) : ((j0 - DM) / 128) * 256 + 128 + ((j0 - DM) % 128);
        t.N = 2 * DM; t.src = F.w_gu + (size_t)le * DM * 2 * DM + (size_t)(kb * 64) * 2 * DM + j0; t.dst = (unsigned char*)F.Bgu + (((size_t)le * 2 * DM + dst) * DM + kb * 64) * EB; return t; }
    r -= I_GU;
    { const int le = r / (16 * 32), rr = r % (16 * 32), kb = rr / 32, nb = rr % 32;
        t.N = DM; t.src = F.w_down + (size_t)le * DM * DM + (size_t)(kb * 64) * DM + nb * 32; t.dst = (unsigned char*)F.Bdn + (((size_t)le * DM + nb * 32) * DM + kb * 64) * EB; return t; }
}
__device__ __forceinline__ void titem_load(const TItem& t, int lane, f32x4 (&r)[8]) {
#pragma unroll
    for (int i = 0; i < 8; ++i) r[i] = *(const f32x4*)(t.src + (size_t)((lane >> 3) + 8 * i) * t.N + 4 * (lane & 7));
}
__device__ __forceinline__ void titem_store(const TItem& t, const f32x4 (&r)[8], LAS float* scr, int lane) {
#pragma unroll
    for (int i = 0; i < 8; ++i) { LAS float* p = scr + ((lane >> 3) + 8 * i) * 33 + 4 * (lane & 7); p[0] = r[i].x; p[1] = r[i].y; p[2] = r[i].z; p[3] = r[i].w; }
    LDS_WAIT(); asm volatile("" ::: "memory");
    if (t.fp8) { const int c = lane & 3; const float sc = W8_SCALE;
#pragma unroll
        for (int j = 0; j < 2; ++j) { const int n = (lane >> 2) + 16 * j; const LAS float* s = scr + (16 * c) * 33 + n;
            u32x4 o;
            o.x = pk4_fp8(s[0 * 33] * sc, s[1 * 33] * sc, s[2 * 33] * sc, s[3 * 33] * sc); o.y = pk4_fp8(s[4 * 33] * sc, s[5 * 33] * sc, s[6 * 33] * sc, s[7 * 33] * sc);
            o.z = pk4_fp8(s[8 * 33] * sc, s[9 * 33] * sc, s[10 * 33] * sc, s[11 * 33] * sc); o.w = pk4_fp8(s[12 * 33] * sc, s[13 * 33] * sc, s[14 * 33] * sc, s[15 * 33] * sc);
            *(u32x4*)(t.dst + (size_t)n * DM + 16 * c) = o; }
    } else { const int c = lane & 7; const float sc = t.scale;
#pragma unroll
        for (int j = 0; j < 4; ++j) { const int n = (lane >> 3) + 8 * j; const LAS float* s = scr + (8 * c) * 33 + n;
            u32x4 o; o.x = pk2(s[0 * 33] * sc, s[1 * 33] * sc); o.y = pk2(s[2 * 33] * sc, s[3 * 33] * sc); o.z = pk2(s[4 * 33] * sc, s[5 * 33] * sc); o.w = pk2(s[6 * 33] * sc, s[7 * 33] * sc);
            *(u32x4*)(t.dst + ((size_t)n * DM + 8 * c) * 2) = o; }
    }
    LDS_WAIT(); asm volatile("" ::: "memory");
}
__device__ __forceinline__ int conv_item_id(int t, int lay, int nfix) {
    constexpr int I_IN = DEPTH * 16 * 81, I_OUT = DEPTH * 16 * 32, I_GU = DEPTH * NE * 16 * 64;
    if (t < nfix) return t;
    t -= nfix;
    return t < NE * 16 * 64 ? I_IN + I_OUT + lay * (NE * 16 * 64) + t : I_IN + I_OUT + I_GU + lay * (NE * 16 * 32) + (t - NE * 16 * 64);
}
__device__ __forceinline__ void convert_items(Frame& F, int lay, int ntot, int t0 = 0, int t1 = -1) {
    LAS float* scr = (LAS float*)(F.lds + F.wave * 16384);
    const int gw = F.vcu * NWAVES + F.wave, NGW = F.G * NWAVES, lane = F.lane;
    const int nfix = ntot - 3 * (NE * 16 * 32);
    if (t1 >= 0) ntot = t1;
    int it = t0 + gw; TItem cur = titem_decode(F, conv_item_id(it < ntot ? it : 0, lay, nfix)); f32x4 ra[8];
    if (it < ntot) titem_load(cur, lane, ra);
    while (it < ntot) {
        const int itn = it + NGW; const bool hn = itn < ntot;
        TItem nxt = titem_decode(F, conv_item_id(hn ? itn : 0, lay, nfix)); f32x4 rb[8];
        if (hn) titem_load(nxt, lane, rb);
        titem_store(cur, ra, scr, lane);
        it = itn; cur = nxt;
#pragma unroll
        for (int i = 0; i < 8; ++i) ra[i] = rb[i];
    }
}
#ifndef CONV_QN
#define CONV_QN 2
#endif
#ifndef CONV_QD
#define CONV_QD 3
#endif
__device__ __forceinline__ int lds_grab(LAS int* c, int lane) {
    int j = 0;
    if (lane == 0) j = __hip_atomic_fetch_add(c, 1, __ATOMIC_RELAXED, __HIP_MEMORY_SCOPE_WORKGROUP);
    return __builtin_amdgcn_readfirstlane(j);
}
__device__ __forceinline__ void convert_dyn(Frame& F, int lay, LAS int* cnt, int nper, int quota) {
    LAS float* scr = (LAS float*)(F.lds + F.wave * 16384);
    const int lane = F.lane;
    int ja = lds_grab(cnt, lane); bool more = ja < quota;
    int jb = more ? lds_grab(cnt, lane) : nper; more = more && jb < quota;
    TItem ta = titem_decode(F, conv_item_id(F.vcu + F.G * (ja < nper ? ja : 0), lay, 0)), tb = titem_decode(F, conv_item_id(F.vcu + F.G * (jb < nper ? jb : 0), lay, 0));
    f32x4 ra[8], rb[8];
    if (ja < nper) titem_load(ta, lane, ra);
    if (jb < nper) titem_load(tb, lane, rb);
    while (ja < nper) {
        const int jc = more ? lds_grab(cnt, lane) : nper; more = more && jc < quota;
        TItem tc = titem_decode(F, conv_item_id(F.vcu + F.G * (jc < nper ? jc : 0), lay, 0)); f32x4 rc[8];
        if (jc < nper) titem_load(tc, lane, rc);
        titem_store(ta, ra, scr, lane);
        ja = jb; jb = jc; ta = tb; tb = tc;
#pragma unroll
        for (int i = 0; i < 8; ++i) { ra[i] = rb[i]; rb[i] = rc[i]; }
    }
}
__device__ __forceinline__ void ph_prologue(Frame& F) {
    const int gw = F.vcu * NWAVES + F.wave, NGW = F.G * NWAVES, lane = F.lane;
    constexpr int I_IN = DEPTH * 16 * 81, I_OUT = DEPTH * 16 * 32;
    for (int r = F.vcu; r < DEPTH * 24; r += F.G) {
        const int l = r / 24, j4 = (r % 24) * 256 + 4 * lane, k0 = F.wave * 128;
        const float* W = F.w_ada + (size_t)l * DM * 6 * DM + (size_t)k0 * 6 * DM + j4;
        f32x4 acc[9];
#pragma unroll
        for (int q = 0; q < 9; ++q) acc[q] = (f32x4){0.f, 0.f, 0.f, 0.f};
#pragma unroll 1
        for (int kh = 0; kh < 2; ++kh) {
            float cv[9];
#pragma unroll
            for (int q = 0; q < 8; ++q) cv[q] = silu_f(F.c[q * DM + k0 + 64 * kh + lane]);
            cv[8] = silu_f(F.c_ctx[k0 + 64 * kh + lane]);
#pragma unroll 8
            for (int kk = 0; kk < 64; ++kk) { const f32x4 w = *(const f32x4*)(W + (size_t)(64 * kh + kk) * 6 * DM);
#pragma unroll
                for (int q = 0; q < 9; ++q) acc[q] += __builtin_bit_cast(float, __builtin_amdgcn_readlane(__builtin_bit_cast(int, cv[q]), kk)) * w; }
        }
        LAS float* part = (LAS float*)F.lds;
#pragma unroll
        for (int q = 0; q < 9; ++q) *(LAS f32x4*)(part + (F.wave * 9 + q) * 256 + 4 * lane) = acc[q];
        __syncthreads();
        for (int o = F.tid; o < 9 * 256; o += NTHREADS) { const int q = o >> 8, cc = o & 255; float sum = F.b_ada[(size_t)l * 6 * DM + (r % 24) * 256 + cc];
#pragma unroll
            for (int w = 0; w < NWAVES; ++w) sum += part[(w * 9 + q) * 256 + cc];
            F.mod[((size_t)l * 9 + q) * 6 * DM + (r % 24) * 256 + cc] = sum; }
        __syncthreads();
    }
    convert_items(F, 0, I_IN + I_OUT + 3 * (NE * 16 * 32), 0, I_IN + I_OUT);
#if GLA_CHECK
    for (int lay = 0; lay < DEPTH; ++lay) convert_items(F, lay, 3 * (NE * 16 * 32));
#endif
    if (F.vcu == 0) for (int i = F.tid; i < 64 * 12; i += NTHREADS) { const int pos = i / 12, fi = i % 12;
        const float invf = expf(-((float)(2 * fi) / 24.f) * 9.210340371976184f); const float ang = (float)pos * invf; F.ROPE[i] = cosf(ang); F.ROPE[768 + i] = sinf(ang); }
    const size_t gt = (size_t)F.vcu * NTHREADS + F.tid, NGT = (size_t)F.G * NTHREADS;
    for (size_t i = gt; i < (size_t)DEPTH * 224 * DM / 8; i += NGT) { const size_t l = i / (224 * DM / 8), rr = i % (224 * DM / 8);
        *(u32x4*)(F.Bin + (l * NP + 2592) * DM + rr * 8) = (u32x4){0u, 0u, 0u, 0u}; }
    for (size_t i = gt; i < (size_t)256 * DM / 8; i += NGT) *(u32x4*)(F.H + (size_t)TT * DM + i * 8) = (u32x4){0u, 0u, 0u, 0u};
    for (size_t i = gt; i < (size_t)256 * DM / 16; i += NGT) *(u32x4*)(F.H8 + (size_t)TT * DM + i * 16) = (u32x4){0u, 0u, 0u, 0u};
}

__device__ __forceinline__ void norm_mod_store(const f32x4 (&v)[4], const float* gw, const float* sc, const float* sh, bf16* orow, int lane) {
    float s = 0.f;
#pragma unroll
    for (int j = 0; j < 4; ++j) s += (v[j].x * v[j].x + v[j].y * v[j].y) + (v[j].z * v[j].z + v[j].w * v[j].w);
    const float rinv = 1.f / sqrtf(wave_sum(s) * (1.f / DM) + EPS);
#pragma unroll
    for (int j = 0; j < 4; ++j) { const int c = 4 * lane + 256 * j;
        const f32x4 g = *(const f32x4*)(gw + c), a = *(const f32x4*)(sc + c), b = *(const f32x4*)(sh + c);
        const f32x4 y = (v[j] * rinv * g) * (a + 1.f) + b;
        u32x2 w; w.x = pk2(y.x, y.y); w.y = pk2(y.z, y.w);
        *(u32x2*)(orow + c) = w; }
}
__device__ __forceinline__ void ph_first_norm(Frame& F) {
    const int gw = F.vcu * NWAVES + F.wave, NGW = F.G * NWAVES, lane = F.lane;
    for (int m = gw; m < TT; m += NGW) {
        const float* src = m < TX ? F.x + (size_t)m * DM : F.ctx + (size_t)(m - TX) * DM;
        const int br = m < TX ? m / SEQ : NB;
        f32x4 v[4];
#pragma unroll
        for (int j = 0; j < 4; ++j) { v[j] = *(const f32x4*)(src + 4 * lane + 256 * j); u32x2 w; w.x = pk2(v[j].x, v[j].y); w.y = pk2(v[j].z, v[j].w); *(u32x2*)(F.X + (size_t)m * DM + 4 * lane + 256 * j) = w; }
        const float* md = F.mod + (size_t)br * 6 * DM;
        norm_mod_store(v, F.norm1_g, md + DM, md, F.H + (size_t)m * DM, lane);
    }
}
__device__ __forceinline__ void ph_combine(Frame& F, int l, bool dry = false) {
    const int gw = F.vcu * NWAVES + F.wave, NGW = F.G * NWAVES, lane = F.lane;
    bf16* Xo = dry ? (bf16*)F.ACT : F.X; bf16* Ho = dry ? (bf16*)F.P : F.H; float* Oo = dry ? (float*)F.ACT : F.out;
    const int M = (l == DEPTH - 1) ? TX : TT;
    const int cA = 8 * lane, cB = 512 + 8 * lane;
    for (int m0 = gw; m0 < M; m0 += 2 * NGW) {
        u32x4 yw[2][4][2]; u32x4 xw[2][2]; bool have[2]; int br[2];
#pragma unroll
        for (int rr = 0; rr < 2; ++rr) { const int m = m0 + rr * NGW; have[rr] = m < M; const int mm = have[rr] ? m : m0; br[rr] = mm < TX ? mm / SEQ : NB;
            const u32x4 sl4 = *(const u32x4*)(F.INV + (size_t)mm * 4); const unsigned slk[4] = {sl4.x, sl4.y, sl4.z, sl4.w};
#pragma unroll
            for (int k = 0; k < 4; ++k) {
                if (MOE_FP8) { const unsigned char* yr = (const unsigned char*)F.YB + (size_t)slk[k] * DM; const u32x2 a = *(const u32x2*)(yr + cA), b = *(const u32x2*)(yr + cB);
                    yw[rr][k][0] = (u32x4){a.x, a.y, 0u, 0u}; yw[rr][k][1] = (u32x4){b.x, b.y, 0u, 0u}; }
                else { yw[rr][k][0] = *(const u32x4*)(F.YB + (size_t)slk[k] * DM + cA); yw[rr][k][1] = *(const u32x4*)(F.YB + (size_t)slk[k] * DM + cB); } }
            const bf16* xr = F.X + (size_t)mm * DM;
            xw[rr][0] = *(const u32x4*)(xr + cA); xw[rr][1] = *(const u32x4*)(xr + cB); }
#pragma unroll
        for (int rr = 0; rr < 2; ++rr) { if (!have[rr]) continue;
            const int m = m0 + rr * NGW;
            const float* md = F.mod + ((size_t)l * 9 + br[rr]) * 6 * DM;
            f32x4 y[4];
#pragma unroll
            for (int j = 0; j < 4; ++j) y[j] = (f32x4){0.f, 0.f, 0.f, 0.f};
#pragma unroll
            for (int k = 0; k < 4; ++k) { const u32x4 a = yw[rr][k][0], b = yw[rr][k][1];
                if (MOE_FP8) { const f32x2 a0 = __builtin_amdgcn_cvt_pk_f32_fp8((int)a.x, false), a1 = __builtin_amdgcn_cvt_pk_f32_fp8((int)a.x, true), a2 = __builtin_amdgcn_cvt_pk_f32_fp8((int)a.y, false), a3 = __builtin_amdgcn_cvt_pk_f32_fp8((int)a.y, true);
                    const f32x2 b0 = __builtin_amdgcn_cvt_pk_f32_fp8((int)b.x, false), b1 = __builtin_amdgcn_cvt_pk_f32_fp8((int)b.x, true), b2 = __builtin_amdgcn_cvt_pk_f32_fp8((int)b.y, false), b3 = __builtin_amdgcn_cvt_pk_f32_fp8((int)b.y, true);
                    y[0] += (f32x4){a0.x, a0.y, a1.x, a1.y}; y[1] += (f32x4){a2.x, a2.y, a3.x, a3.y}; y[2] += (f32x4){b0.x, b0.y, b1.x, b1.y}; y[3] += (f32x4){b2.x, b2.y, b3.x, b3.y}; }
                else { y[0] += (f32x4){bflo(a.x), bfhi(a.x), bflo(a.y), bfhi(a.y)}; y[1] += (f32x4){bflo(a.z), bfhi(a.z), bflo(a.w), bfhi(a.w)};
                    y[2] += (f32x4){bflo(b.x), bfhi(b.x), bflo(b.y), bfhi(b.y)}; y[3] += (f32x4){bflo(b.z), bfhi(b.z), bflo(b.w), bfhi(b.w)}; } }
            if (MOE_FP8) {
#pragma unroll
                for (int j = 0; j < 4; ++j) y[j] *= Y8_INV; }
            const int cc[4] = {cA, cA + 4, cB, cB + 4};
            f32x4 v[4]; float ss = 0.f;
            const f32x4 xv4[4] = {(f32x4){bflo(xw[rr][0].x), bfhi(xw[rr][0].x), bflo(xw[rr][0].y), bfhi(xw[rr][0].y)}, (f32x4){bflo(xw[rr][0].z), bfhi(xw[rr][0].z), bflo(xw[rr][0].w), bfhi(xw[rr][0].w)},
                                  (f32x4){bflo(xw[rr][1].x), bfhi(xw[rr][1].x), bflo(xw[rr][1].y), bfhi(xw[rr][1].y)}, (f32x4){bflo(xw[rr][1].z), bfhi(xw[rr][1].z), bflo(xw[rr][1].w), bfhi(xw[rr][1].w)}};
#pragma unroll
            for (int j = 0; j < 4; ++j) { v[j] = xv4[j] + *(const f32x4*)(md + 5 * DM + cc[j]) * y[j]; ss += (v[j].x * v[j].x + v[j].y * v[j].y) + (v[j].z * v[j].z + v[j].w * v[j].w); }
            const float rinv = 1.f / sqrtf(wave_sum(ss) * (1.f / DM) + EPS);
            if (l < DEPTH - 1) {
                { u32x4 x0, x1; x0.x = pk2(v[0].x, v[0].y); x0.y = pk2(v[0].z, v[0].w); x0.z = pk2(v[1].x, v[1].y); x0.w = pk2(v[1].z, v[1].w);
                  x1.x = pk2(v[2].x, v[2].y); x1.y = pk2(v[2].z, v[2].w); x1.z = pk2(v[3].x, v[3].y); x1.w = pk2(v[3].z, v[3].w);
                  *(u32x4*)(Xo + (size_t)m * DM + cA) = x0; *(u32x4*)(Xo + (size_t)m * DM + cB) = x1; }
                const float* mn = F.mod + ((size_t)(l + 1) * 9 + br[rr]) * 6 * DM; const float* gw1 = F.norm1_g + (size_t)(l + 1) * DM;
                f32x4 h[4];
#pragma unroll
                for (int j = 0; j < 4; ++j) h[j] = (v[j] * rinv * *(const f32x4*)(gw1 + cc[j])) * (*(const f32x4*)(mn + DM + cc[j]) + 1.f) + *(const f32x4*)(mn + cc[j]);
                u32x4 w0, w1; w0.x = pk2(h[0].x, h[0].y); w0.y = pk2(h[0].z, h[0].w); w0.z = pk2(h[1].x, h[1].y); w0.w = pk2(h[1].z, h[1].w);
                w1.x = pk2(h[2].x, h[2].y); w1.y = pk2(h[2].z, h[2].w); w1.z = pk2(h[3].x, h[3].y); w1.w = pk2(h[3].z, h[3].w);
                *(u32x4*)(Ho + (size_t)m * DM + cA) = w0; *(u32x4*)(Ho + (size_t)m * DM + cB) = w1;
            } else {
#pragma unroll
                for (int j = 0; j < 4; ++j) { f32x4 o = v[j] * rinv * *(const f32x4*)(F.final_g + cc[j]);
#if GLA_CHECK
                    if (__hip_atomic_load(F.ctl + 64, __ATOMIC_RELAXED, __HIP_MEMORY_SCOPE_AGENT) != 0u) { const float q = __builtin_nanf(""); o = (f32x4){q, q, q, q}; }
#endif
                    *(f32x4*)(Oo + (size_t)m * DM + cc[j]) = o; }
            }
        }
    }
}

constexpr int PL_U = 0, PL_P = 49152, PL_LD = 264, PREP_PW = 81920, PW_LD = 72, PREP_PS = PREP_PW + 4 * 64 * PW_LD * 2;
static_assert(PREP_PS + 1024 <= STAGE_BYTES && PL_P + 32 * PL_LD * 2 <= PREP_PW, "pool LDS map");
__device__ __forceinline__ void pool_unit(Frame& F, int l, int u) {
    LAS float* U = (LAS float*)(F.lds + PL_U);
    LAS bf16* PL = (LAS bf16*)(F.lds + PL_P);
    const LAS bf16* PW = (const LAS bf16*)(F.lds + PREP_PW); const LAS float* PS = (const LAS float*)(F.lds + PREP_PS);
    const int tid = F.tid;
    int s, tb, seqbase, tlen;
    if (u < NB * 128) { s = u / 128; tb = u % 128; seqbase = s * SEQ; tlen = SEQ; } else { const int v = u - NB * 128; s = v / 8; tb = v % 8; seqbase = TX + s * CTXL; tlen = CTXL; }
    const int t0 = tb * 32;
    for (int i = tid; i < 48 * 32; i += NTHREADS) { const int rr = i / 32, ch = i % 32, t = t0 - 8 + rr;
        f32x4 a = (f32x4){0.f, 0.f, 0.f, 0.f}, b = a;
        if (t >= 0 && t < tlen) { const u32x4 w = *(const u32x4*)(F.P + (size_t)(seqbase + t) * NP + C_POOL + ch * 8);
            a = (f32x4){bflo(w.x), bfhi(w.x), bflo(w.y), bfhi(w.y)}; b = (f32x4){bflo(w.z), bfhi(w.z), bflo(w.w), bfhi(w.w)}; }
        *(LAS f32x4*)(U + rr * 256 + ch * 8) = a; *(LAS f32x4*)(U + rr * 256 + ch * 8 + 4) = b; }
    __syncthreads();
    { const int tt = tid >> 4, cg = tid & 15, g = cg >> 2, w = 2 << g, t = t0 + tt;
      int lo = t - w / 2; if (lo < 0) lo = 0; int hi = t + w - w / 2; if (hi > tlen) hi = tlen;
      const float inv = 1.f / (float)(hi - lo);
      f32x4 sum[4];
#pragma unroll
      for (int q4 = 0; q4 < 4; ++q4) sum[q4] = (f32x4){0.f, 0.f, 0.f, 0.f};
      for (int jj = lo; jj < hi; ++jj) {
#pragma unroll
          for (int q4 = 0; q4 < 4; ++q4) sum[q4] += *(const LAS f32x4*)(U + (jj - t0 + 8) * 256 + cg * 16 + 4 * q4); }
      u32x4 w0, w1;
      { const f32x4 y0 = sum[0] * inv - *(const LAS f32x4*)(U + (tt + 8) * 256 + cg * 16), y1 = sum[1] * inv - *(const LAS f32x4*)(U + (tt + 8) * 256 + cg * 16 + 4);
        const f32x4 y2 = sum[2] * inv - *(const LAS f32x4*)(U + (tt + 8) * 256 + cg * 16 + 8), y3 = sum[3] * inv - *(const LAS f32x4*)(U + (tt + 8) * 256 + cg * 16 + 12);
        w0.x = pk2(y0.x, y0.y); w0.y = pk2(y0.z, y0.w); w0.z = pk2(y1.x, y1.y); w0.w = pk2(y1.z, y1.w);
        w1.x = pk2(y2.x, y2.y); w1.y = pk2(y2.z, y2.w); w1.z = pk2(y3.x, y3.y); w1.w = pk2(y3.z, y3.w); }
      *(LAS u32x4*)(PL + tt * PL_LD + cg * 16) = w0; *(LAS u32x4*)(PL + tt * PL_LD + cg * 16 + 8) = w1; }
    __syncthreads();
    { const int lane = F.lane, q = lane & 15, g4 = lane >> 4;
#pragma unroll
      for (int k = 0; k < 4; ++k) { const int ti = F.wave * 4 + k, mt = ti & 1, ct = ti >> 1, g = ct >> 2, ot = ct & 3;
          f32x4 acc = (f32x4){0.f, 0.f, 0.f, 0.f};
#pragma unroll
          for (int s2 = 0; s2 < 2; ++s2) { const bf16x8 a = *(const LAS bf16x8*)(PW + (g * 64 + 16 * ot + q) * PW_LD + 32 * s2 + 8 * g4), b = *(const LAS bf16x8*)(PL + (16 * mt + q) * PL_LD + g * 64 + 32 * s2 + 8 * g4);
              acc = __builtin_amdgcn_mfma_f32_16x16x32_bf16(a, b, acc, 0, 0, 0); }
          const f32x4 y = acc * *(const LAS f32x4*)(PS + g * 64 + 16 * ot + 4 * g4);
          u32x2 w; w.x = pk2(y.x, y.y); w.y = pk2(y.z, y.w);
          *(u32x2*)(F.MIX + (size_t)(seqbase + t0 + 16 * mt + q) * DM + 768 + g * 64 + 16 * ot + 4 * g4) = w; } }
    __syncthreads();
}
#if GLA_CHECK
__device__ __forceinline__ void gla_chain(Frame& F, int l, int u) {
    const int tid = F.tid;
    const int dir = u & 1, hh = (u >> 1) & 3, b = u >> 3;
    LAS float* qs = (LAS float*)F.lds;
    LAS float* ks = qs + 64 * 48;
    LAS float* as = ks + 64 * 48;
    LAS float* vs = as + 64 * 48;
    LAS float* os = vs + 64 * 96;
    LAS float* rc = os + 64 * 96;
    LAS float* rs = rc + 64 * 12;
    LAS float* wa = rs + 64 * 12;
    LAS float* ba = wa + 16 * 48;
    for (int i = tid; i < 64 * 12; i += NTHREADS) { const int pos = i / 12, fi = i % 12;
        const float invf = expf(-((float)(2 * fi) / 24.f) * 9.210340371976184f);
        const float ang = (float)pos * invf; rc[i] = cosf(ang); rs[i] = sinf(ang); }
    for (int i = tid; i < 16 * 48; i += NTHREADS) { const int r = i / 48, d = i % 48; wa[i] = F.gla_wa2[(((size_t)l * 2 + dir) * 16 + r) * 192 + hh * 48 + d]; }
    if (tid < 48) ba[tid] = F.gla_ba[((size_t)l * 2 + dir) * 192 + hh * 48 + tid];
    __syncthreads();
    float S[12];
#pragma unroll
    for (int i = 0; i < 12; ++i) S[i] = 0.f;
    const int vv = tid >> 2, dg = tid & 3;
    float* Odir = dir ? F.OB : F.OF;
    const bool need_ctx = l < DEPTH - 1;
    for (int cidx = 0; cidx < 4 + 64; ++cidx) {
        const bool isctx = cidx < 4;
        const int nch = isctx ? 4 : 64, ci0 = isctx ? cidx : cidx - 4, ci = dir ? (nch - 1 - ci0) : ci0;
        const int seqbase = isctx ? TX + b * CTXL : b * SEQ, t0 = ci * 64;
        for (int i = tid; i < 64 * 2 * 2 * 12; i += NTHREADS) {
            const int fi = i % 12, hf = (i / 12) & 1, isk = (i / 24) & 1, j = i / 48;
            const bf16* row = F.P + (size_t)(seqbase + t0 + j) * NP + (isk ? C_GK : C_GQ) + hh * 48 + hf * 24;
            const float x1 = bf2f(row[fi]), x2 = bf2f(row[12 + fi]);
            float o1 = x1, o2 = x2;
            if (!isctx) { const int t = t0 + j, pos = hf ? (t % GRIDW) : (t / GRIDW); const float cs = rc[pos * 12 + fi], sn = rs[pos * 12 + fi]; o1 = x1 * cs - x2 * sn; o2 = x1 * sn + x2 * cs; }
            LAS float* dst = (isk ? ks : qs) + j * 48 + hf * 24;
            dst[fi] = o1; dst[12 + fi] = o2; }
        for (int i = tid; i < 64 * 48; i += NTHREADS) { const int j = i / 48, d = i % 48;
            const bf16* row = F.P + (size_t)(seqbase + t0 + j) * NP + (dir ? C_AB : C_AF);
            float z = ba[d];
#pragma unroll
            for (int r = 0; r < 16; ++r) z += bf2f(row[r]) * wa[r * 48 + d];
            const float ls = fminf(z, 0.f) - log1pf(expf(-fabsf(z)));
            as[i] = expf(ls * (1.f / 16.f)); }
        for (int i = tid; i < 64 * 96; i += NTHREADS) { const int j = i / 96, d = i % 96; vs[i] = bf2f(F.VTA[(size_t)(384 + hh * 96 + d) * VTS + seqbase + t0 + j]); }
        __syncthreads();
        if (tid < 384) {
            for (int st = 0; st < 64; ++st) {
                const int j = dir ? 63 - st : st;
                const float vj = vs[j * 96 + vv];
                float part = 0.f;
#pragma unroll
                for (int q4 = 0; q4 < 3; ++q4) {
                    const f32x4 a4 = *(const LAS f32x4*)(as + j * 48 + dg * 12 + q4 * 4), k4 = *(const LAS f32x4*)(ks + j * 48 + dg * 12 + q4 * 4), qq = *(const LAS f32x4*)(qs + j * 48 + dg * 12 + q4 * 4);
#pragma unroll
                    for (int e = 0; e < 4; ++e) { const float sn = a4[e] * S[q4 * 4 + e] + k4[e] * vj; S[q4 * 4 + e] = sn; part += qq[e] * sn; } }
                part += __shfl_xor(part, 1); part += __shfl_xor(part, 2);
                if (dg == 0) os[j * 96 + vv] = part;
            }
        }
        __syncthreads();
        if (!isctx || need_ctx)
            for (int i = tid; i < 64 * 96; i += NTHREADS) { const int j = i / 96, d = i % 96; Odir[(size_t)(seqbase + t0 + j) * 384 + hh * 96 + d] = os[i]; }
        __syncthreads();
    }
}

#endif
typedef float f32x16 __attribute__((ext_vector_type(16)));
constexpr int GL_BF = 0, GL_BB = 12288, GL_WA = 24576, GL_VT = 31232, GL_KEF = 45056, GL_KEB = 51968;
constexpr int GL_QF = 45056, GL_KF = 52224, GL_QB = 59392, GL_KB = 66560, GL_STF = 73728, GL_STB = 84480, GL_O = 95232;
constexpr int VT_LD = 72, QK_LD = 56, ST_LD = 56, O_LD = 100, NCH = 68;
struct GlaU { int b, hh, cpos, seqbase, t0, isctx; };
__device__ __forceinline__ GlaU gla_unit_geom(int u) { GlaU g; g.cpos = u % NCH; g.hh = (u / NCH) & 3; g.b = u / (NCH * 4); g.isctx = g.cpos < 4;
    const int ci = g.isctx ? g.cpos : g.cpos - 4; g.seqbase = g.isctx ? TX + g.b * CTXL : g.b * SEQ; g.t0 = ci * 64; return g; }
__device__ __forceinline__ void gla_rope_pair(const Frame& F, const GlaU& g, const bf16* row, int j, int hf, int fi, float& o1, float& o2) {
    const float x1 = bf2f(row[fi]), x2 = bf2f(row[12 + fi]); o1 = x1; o2 = x2;
    if (!g.isctx) { const int t = g.t0 + j, pos = hf ? (t % GRIDW) : (t / GRIDW); const float cs = F.ROPE[pos * 12 + fi], sn = F.ROPE[768 + pos * 12 + fi]; o1 = x1 * cs - x2 * sn; o2 = x1 * sn + x2 * cs; }
}
constexpr int G1_BF = 0, G1_BB = 12288, G1_KEF = 24576, G1_KEB = 31488, G1_OPS = 38400;
constexpr int PREP_WA = TAB_OFF;
__device__ __forceinline__ void gla_g1_unit(Frame& F, int l, int u) {
    const GlaU g = gla_unit_geom(u);
    LAS bf16* kef = (LAS bf16*)(F.lds + G1_KEF); LAS bf16* keb = (LAS bf16*)(F.lds + G1_KEB); LAS bf16* ops = (LAS bf16*)(F.lds + G1_OPS);
    const LAS float* wa = (const LAS float*)(F.lds + PREP_WA) + g.hh * 1536; const LAS float* ba = (const LAS float*)(F.lds + PREP_WA) + 6144 + g.hh * 96;
    const bf16* vtg = F.VTA + (size_t)(384 + g.hh * 96) * VTS + g.seqbase + g.t0;
    const int tid = F.tid, lane = F.lane, j = lane, w = F.wave;
    const bf16* prow = F.P + (size_t)(g.seqbase + g.t0 + j) * NP;
    u32x4 araw[4];
#pragma unroll
    for (int q4 = 0; q4 < 4; ++q4) araw[q4] = *(const u32x4*)(prow + C_AF + 8 * q4);
    float q1[3], q2[3], k1[3], k2[3], cs[3], sn[3];
#pragma unroll
    for (int e = 0; e < 3; ++e) { const int p = 3 * w + e, hf = p / 12, fi = p % 12, cb = g.hh * 48 + hf * 24 + fi;
        q1[e] = bf2f(prow[C_GQ + cb]); q2[e] = bf2f(prow[C_GQ + cb + 12]); k1[e] = bf2f(prow[C_GK + cb]); k2[e] = bf2f(prow[C_GK + cb + 12]);
        const int t = g.t0 + j, pos = hf ? (t % GRIDW) : (t / GRIDW);
        cs[e] = g.isctx ? 1.f : F.ROPE[pos * 12 + fi]; sn[e] = g.isctx ? 0.f : F.ROPE[768 + pos * 12 + fi]; }
    float a[32];
#pragma unroll
    for (int q4 = 0; q4 < 4; ++q4) { const u32x4 x = araw[q4]; a[q4 * 8 + 0] = bflo(x.x); a[q4 * 8 + 1] = bfhi(x.x); a[q4 * 8 + 2] = bflo(x.y); a[q4 * 8 + 3] = bfhi(x.y);
        a[q4 * 8 + 4] = bflo(x.z); a[q4 * 8 + 5] = bfhi(x.z); a[q4 * 8 + 6] = bflo(x.w); a[q4 * 8 + 7] = bfhi(x.w); }
    float bf[3][2], bb[3][2];
#pragma unroll
    for (int e = 0; e < 3; ++e)
#pragma unroll
        for (int wh = 0; wh < 2; ++wh) { const int p = 3 * w + e, d = (p / 12) * 24 + p % 12 + 12 * wh;
            float zf = ba[d], zb = ba[48 + d];
#pragma unroll
            for (int r = 0; r < 16; ++r) { zf += a[r] * wa[r * 48 + d]; zb += a[16 + r] * wa[(16 + r) * 48 + d]; }
            const float xf = (fminf(zf, 0.f) - __logf(1.f + __expf(-fabsf(zf)))) * (1.f / 16.f), xb = (fminf(zb, 0.f) - __logf(1.f + __expf(-fabsf(zb)))) * (1.f / 16.f);
            bf[e][wh] = wave_scan_incl(xf);
            const float ab = wave_scan_incl(xb);
            bb[e][wh] = __int_as_float(__builtin_amdgcn_readlane(__float_as_int(ab), 63)) - ab + xb; }
#pragma unroll
    for (int e = 0; e < 3; ++e) { const int p = 3 * w + e, d1 = (p / 12) * 24 + p % 12, d2 = d1 + 12;
        const float qa = q1[e] * cs[e] - q2[e] * sn[e], qb = q1[e] * sn[e] + q2[e] * cs[e], ka = k1[e] * cs[e] - k2[e] * sn[e], kb = k1[e] * sn[e] + k2[e] * cs[e];
        const float f1 = bf[e][0], f2 = bf[e][1], b1 = bb[e][0], b2 = bb[e][1];
        const float fe1 = __builtin_bit_cast(float, __builtin_amdgcn_readlane(__builtin_bit_cast(int, f1), 63)), fe2 = __builtin_bit_cast(float, __builtin_amdgcn_readlane(__builtin_bit_cast(int, f2), 63));
        const float be1 = __builtin_bit_cast(float, __builtin_amdgcn_readlane(__builtin_bit_cast(int, b1), 0)), be2 = __builtin_bit_cast(float, __builtin_amdgcn_readlane(__builtin_bit_cast(int, b2), 0));
        const float ef1 = __expf(f1), ef2 = __expf(f2), eb1 = __expf(b1), eb2 = __expf(b2), nf1 = __expf(-f1), nf2 = __expf(-f2), nb1 = __expf(-b1), nb2 = __expf(-b2);
        ops[j * 48 + d1] = (bf16)f2bf(qa * ef1); ops[j * 48 + d2] = (bf16)f2bf(qb * ef2); ops[3072 + j * 48 + d1] = (bf16)f2bf(ka * nf1); ops[3072 + j * 48 + d2] = (bf16)f2bf(kb * nf2);
        ops[6144 + j * 48 + d1] = (bf16)f2bf(qa * eb1); ops[6144 + j * 48 + d2] = (bf16)f2bf(qb * eb2); ops[9216 + j * 48 + d1] = (bf16)f2bf(ka * nb1); ops[9216 + j * 48 + d2] = (bf16)f2bf(kb * nb2);
        const float ge1 = __expf(fe1), ge2 = __expf(fe2), he1 = __expf(be1), he2 = __expf(be2);
        kef[d1 * VT_LD + j] = (bf16)f2bf(ka * nf1 * ge1); kef[d2 * VT_LD + j] = (bf16)f2bf(kb * nf2 * ge2);
        keb[d1 * VT_LD + j] = (bf16)f2bf(ka * nb1 * he1); keb[d2 * VT_LD + j] = (bf16)f2bf(kb * nb2 * he2);
        if (lane == 0) { float* gd = F.GD + (((size_t)(g.b * 4 + g.hh) * 2) * NCH + g.cpos) * 48; gd[d1] = ge1; gd[d2] = ge2; gd[(size_t)NCH * 48 + d1] = he1; gd[(size_t)NCH * 48 + d2] = he2; } }
    __syncthreads();
    { const int q = lane & 15, g4 = lane >> 4;
      for (int ti = F.wave; ti < 36; ti += NWAVES) { const int dir = ti / 18, dt = (ti % 18) / 6, vtile = ti % 6;
          const LAS bf16* ke = dir ? keb : kef;
          f32x4 acc = (f32x4){0.f, 0.f, 0.f, 0.f};
#pragma unroll
          for (int s2 = 0; s2 < 2; ++s2) { const bf16x8 av = *(const LAS bf16x8*)(ke + (16 * dt + q) * VT_LD + 32 * s2 + 8 * g4), bv = *(const bf16x8*)(vtg + (size_t)(16 * vtile + q) * VTS + 32 * s2 + 8 * g4);
              acc = __builtin_amdgcn_mfma_f32_16x16x32_bf16(av, bv, acc, 0, 0, 0); }
          *(f32x4*)(F.DS + ((((size_t)(g.b * 4 + g.hh) * 2 + dir) * NCH + g.cpos) * 96 + 16 * vtile + q) * 48 + 16 * dt + 4 * g4) = acc; } }
    { u32x4* dst = (u32x4*)(F.OPS + (size_t)u * 12288);
      for (int i = tid; i < 1536; i += NTHREADS) dst[i] = *(const LAS u32x4*)(ops + i * 8); }
    __syncthreads();
}
__device__ __forceinline__ void gla_g2_unit(Frame& F, int u) {
    const int chain = u >> 2, qt = u & 3, dir = chain & 1, tid = F.tid;
    const float* ds = F.DS + (size_t)chain * NCH * 4608; const float* gd = F.GD + (size_t)chain * NCH * 48; bf16* stb = F.STB + (size_t)chain * NCH * 4608;
    const int e0 = qt * 1152 + 2 * tid, e1 = qt * 1152 + 1024 + 2 * tid; const bool h1 = tid < 64;
    const int d0 = e0 % 48, d1 = h1 ? e1 % 48 : 0;
    f32x2 S0 = (f32x2){0.f, 0.f}, S1 = (f32x2){0.f, 0.f};
    for (int st0 = 0; st0 < NCH; st0 += 4) {
        f32x2 x0[4], x1[4], g0[4], g1[4]; int cp[4];
#pragma unroll
        for (int k = 0; k < 4; ++k) { const int st = st0 + k; cp[k] = st < 4 ? (dir ? 3 - st : st) : (dir ? 4 + (67 - st) : st);
            const float* p = ds + (size_t)cp[k] * 4608; const float* gp = gd + cp[k] * 48;
            x0[k] = *(const f32x2*)(p + e0); g0[k] = *(const f32x2*)(gp + d0);
            if (h1) { x1[k] = *(const f32x2*)(p + e1); g1[k] = *(const f32x2*)(gp + d1); } else { x1[k] = (f32x2){0.f, 0.f}; g1[k] = x1[k]; } }
#pragma unroll
        for (int k = 0; k < 4; ++k) { bf16* p = stb + (size_t)cp[k] * 4608;
            *(unsigned*)(p + e0) = pk2(S0.x, S0.y); if (h1) *(unsigned*)(p + e1) = pk2(S1.x, S1.y);
            S0 = g0[k] * S0 + x0[k]; S1 = g1[k] * S1 + x1[k]; }
    }
}
__device__ __forceinline__ void gla_g3_wave(Frame& F, int l, int wu) {
    const int u = wu >> 1, it = wu & 1;
    const GlaU g = gla_unit_geom(u);
    const int lane = F.lane, r = lane & 31, h = lane >> 5;
    const bf16* ops = F.OPS + (size_t)u * 12288 + 16 * 0 + 8 * h;
    const bf16* vtg = F.VTA + (size_t)(384 + g.hh * 96) * VTS + g.seqbase + g.t0;
    const bf16* stf = F.STB + ((((size_t)(g.b * 4 + g.hh) * 2 + 0) * NCH + g.cpos) * 4608) + 8 * h; const bf16* stbk = stf + (size_t)NCH * 4608;
    LAS float* O = (LAS float*)(F.lds + F.wave * 16384);
    bf16x8 qf[3], qb[3];
#pragma unroll
    for (int s3 = 0; s3 < 3; ++s3) { qf[s3] = *(const bf16x8*)(ops + (32 * it + r) * 48 + 16 * s3); qb[s3] = *(const bf16x8*)(ops + 6144 + (32 * it + r) * 48 + 16 * s3); }
    f32x16 X[2];
#pragma unroll
    for (int jt = 0; jt < 2; ++jt) {
        f32x16 xf, xb;
#pragma unroll
        for (int e = 0; e < 16; ++e) { xf[e] = 0.f; xb[e] = 0.f; }
        if (jt <= it) {
#pragma unroll
            for (int s3 = 0; s3 < 3; ++s3) xf = __builtin_amdgcn_mfma_f32_32x32x16_bf16(*(const bf16x8*)(ops + 3072 + (32 * jt + r) * 48 + 16 * s3), qf[s3], xf, 0, 0, 0); }
        if (jt >= it) {
#pragma unroll
            for (int s3 = 0; s3 < 3; ++s3) xb = __builtin_amdgcn_mfma_f32_32x32x16_bf16(*(const bf16x8*)(ops + 9216 + (32 * jt + r) * 48 + 16 * s3), qb[s3], xb, 0, 0, 0); }
        if (jt == it) {
#pragma unroll
            for (int e = 0; e < 16; ++e) { const int jl = (e & 3) + 8 * (e >> 2) + 4 * h; X[jt][e] = (jl <= r ? xf[e] : 0.f) + (jl >= r ? xb[e] : 0.f); }
        } else X[jt] = jt < it ? xf : xb;
    }
    f32x16 o[3];
#pragma unroll
    for (int vt = 0; vt < 3; ++vt)
#pragma unroll
        for (int e = 0; e < 16; ++e) o[vt][e] = 0.f;
#pragma unroll
    for (int jt = 0; jt < 2; ++jt)
#pragma unroll
        for (int s2 = 0; s2 < 2; ++s2) {
            u32x4 aw; aw.x = pk2(X[jt][8 * s2 + 0], X[jt][8 * s2 + 1]); aw.y = pk2(X[jt][8 * s2 + 2], X[jt][8 * s2 + 3]); aw.z = pk2(X[jt][8 * s2 + 4], X[jt][8 * s2 + 5]); aw.w = pk2(X[jt][8 * s2 + 6], X[jt][8 * s2 + 7]);
#pragma unroll
            for (int vt = 0; vt < 3; ++vt) {
                const bf16* vr = vtg + (size_t)(32 * vt + r) * VTS + 32 * jt + 16 * s2 + 4 * h;
                const u32x2 lo = *(const u32x2*)vr, hi = *(const u32x2*)(vr + 8);
                const u32x4 bw = (u32x4){lo.x, lo.y, hi.x, hi.y};
                o[vt] = __builtin_amdgcn_mfma_f32_32x32x16_bf16(__builtin_bit_cast(bf16x8, aw), __builtin_bit_cast(bf16x8, bw), o[vt], 0, 0, 0); } }
#pragma unroll
    for (int s3 = 0; s3 < 3; ++s3)
#pragma unroll
        for (int vt = 0; vt < 3; ++vt) {
            o[vt] = __builtin_amdgcn_mfma_f32_32x32x16_bf16(qf[s3], *(const bf16x8*)(stf + (32 * vt + r) * 48 + 16 * s3), o[vt], 0, 0, 0);
            o[vt] = __builtin_amdgcn_mfma_f32_32x32x16_bf16(qb[s3], *(const bf16x8*)(stbk + (32 * vt + r) * 48 + 16 * s3), o[vt], 0, 0, 0); }
#pragma unroll
    for (int vt = 0; vt < 3; ++vt)
#pragma unroll
        for (int e = 0; e < 16; ++e) O[((e & 3) + 8 * (e >> 2) + 4 * h) * O_LD + 32 * vt + r] = o[vt][e];
    LDS_WAIT(); asm volatile("" ::: "memory");
    { const int i = lane >> 1, half = lane & 1; const size_t row = (size_t)(g.seqbase + g.t0 + 32 * it + i);
      f32x4 ov[12]; float ss = 0.f;
#pragma unroll
      for (int e = 0; e < 12; ++e) { ov[e] = *(const LAS f32x4*)(O + i * O_LD + half * 48 + 4 * e); ss += (ov[e].x * ov[e].x + ov[e].y * ov[e].y) + (ov[e].z * ov[e].z + ov[e].w * ov[e].w); }
      ss = dpp_addp<0xB1>(ss);
      const float rinv = 1.f / sqrtf(ss * (1.f / 96.f) + EPS);
      const float* ng = F.gla_norm_g + (size_t)l * 384 + g.hh * 96 + half * 48;
      const u32x4* gp = (const u32x4*)(F.P + row * NP + C_GG + g.hh * 96 + half * 48);
      u32x4* dst = (u32x4*)(F.MIX + row * DM + g.hh * 96 + half * 48);
#if GLA_CHECK
      { float sn = 0.f; const float* pf = F.OF + row * 384 + g.hh * 96 + half * 48; const float* pb = F.OB + row * 384 + g.hh * 96 + half * 48;
#pragma unroll
        for (int e = 0; e < 48; ++e) { const float on = pf[e] + pb[e]; sn += on * on; }
        sn += __shfl_xor(sn, 1);
        const float rms = sqrtf(sn * (1.f / 96.f)) + 1e-6f; int bad = 0;
#pragma unroll
        for (int e = 0; e < 48; ++e) { const float on = pf[e] + pb[e]; if (!(fabsf(ov[e >> 2][e & 3] - on) <= 0.03f * rms + 0.03f * fabsf(on))) ++bad; }
        if (bad) atomicAdd(F.ctl + 64, (unsigned)bad); }
#endif
#pragma unroll
      for (int q6 = 0; q6 < 6; ++q6) { const u32x4 gw = gp[q6]; const f32x4 n0 = *(const f32x4*)(ng + 8 * q6), n1 = *(const f32x4*)(ng + 8 * q6 + 4); const f32x4 a = ov[2 * q6], b = ov[2 * q6 + 1];
          u32x4 w;
          w.x = pk2(a.x * rinv * n0.x * silu_f(bflo(gw.x)), a.y * rinv * n0.y * silu_f(bfhi(gw.x))); w.y = pk2(a.z * rinv * n0.z * silu_f(bflo(gw.y)), a.w * rinv * n0.w * silu_f(bfhi(gw.y)));
          w.z = pk2(b.x * rinv * n1.x * silu_f(bflo(gw.z)), b.y * rinv * n1.y * silu_f(bfhi(gw.z))); w.w = pk2(b.z * rinv * n1.z * silu_f(bflo(gw.w)), b.w * rinv * n1.w * silu_f(bfhi(gw.w)));
          dst[q6] = w; } }
    LDS_WAIT(); asm volatile("" ::: "memory");
}
__device__ __forceinline__ void ph_gla3(Frame& F, int l) {
    const bool need_ctx = l < DEPTH - 1;
    const int gw = F.vcu * NWAVES + F.wave, NGW = F.G * NWAVES;
    for (int wu = gw; wu < NB * GH * NCH * 2; wu += NGW) { if (!need_ctx && ((wu >> 1) % NCH) < 4) continue; gla_g3_wave(F, l, wu); }
}
__device__ __forceinline__ void ph_prep(Frame& F, int l) {
    const bool need_ctx = l < DEPTH - 1;
    const int tid = F.tid;
#if GLA_CHECK
    for (int u = F.vcu; u < NB * GH * 2; u += F.G) gla_chain(F, l, u);
    __syncthreads();
#endif
    { LAS float* wa = (LAS float*)(F.lds + PREP_WA);
      for (int i = tid; i < 4 * 2 * 16 * 48; i += NTHREADS) { const int hh = i / 1536, dir = (i / 768) & 1, r = (i / 48) % 16, d = i % 48; wa[i] = F.gla_wa2[(((size_t)l * 2 + dir) * 16 + r) * 192 + hh * 48 + d]; }
      for (int i = tid; i < 4 * 2 * 48; i += NTHREADS) { const int hh = i / 96, dir = (i / 48) & 1, d = i % 48; wa[6144 + i] = F.gla_ba[((size_t)l * 2 + dir) * 192 + hh * 48 + d]; }
      LAS bf16* pw = (LAS bf16*)(F.lds + PREP_PW); LAS float* ps = (LAS float*)(F.lds + PREP_PS);
      for (int i = tid; i < 4 * 64 * 64; i += NTHREADS) { const int g = i >> 12, ii = (i >> 6) & 63, o = i & 63; pw[(g * 64 + o) * PW_LD + ii] = (bf16)f2bf(F.pool_w[(size_t)l * 16384 + i]); }
      if (tid < 256) ps[tid] = F.pool_scale[(size_t)l * 256 + tid]; }
    __syncthreads();
    const int NPOOL = NB * 128 + (need_ctx ? NB * 8 : 0), NG1 = NB * GH * NCH, NMIX = 3 * NPOOL;
    for (int k = F.vcu; k < NG1 + NPOOL; k += F.G) {
        if (k < NMIX) { if (k % 3 == 2) pool_unit(F, l, k / 3); else gla_g1_unit(F, l, (k / 3) * 2 + k % 3); }
        else gla_g1_unit(F, l, 2 * NPOOL + (k - NMIX));
    }
}

#define NA_LOG2E 1.4426950408889634f
__device__ __forceinline__ float na_max4(float x) {
    const auto r = __builtin_amdgcn_permlane16_swap(__float_as_uint(x), __float_as_uint(x), false, false);
    x = fmaxf(__uint_as_float(r[0]), __uint_as_float(r[1]));
    const auto t = __builtin_amdgcn_permlane32_swap(__float_as_uint(x), __float_as_uint(x), false, false);
    return fmaxf(__uint_as_float(t[0]), __uint_as_float(t[1]));
}
__device__ __forceinline__ float na_sum4(float x) {
    const auto r = __builtin_amdgcn_permlane16_swap(__float_as_uint(x), __float_as_uint(x), false, false);
    x = __uint_as_float(r[0]) + __uint_as_float(r[1]);
    const auto t = __builtin_amdgcn_permlane32_swap(__float_as_uint(x), __float_as_uint(x), false, false);
    return __uint_as_float(t[0]) + __uint_as_float(t[1]);
}
struct NaCtx {
    __amdgpu_buffer_rsrc_t rP, rV; unsigned voffK, voffV; int b, cw, r0, krlo, nnb; const LAS float* rpb; unsigned bidx[2][4];
    bf16x8 qa[4][2]; float mrun[4], lsum[4]; f32x4 o[4][4];
};
__device__ __forceinline__ int na_segtok(const NaCtx& C, int sg) { return sg < C.nnb ? C.b * SEQ + (C.krlo + sg) * GRIDW + C.cw : TX + C.b * CTXL + 32 * (sg - C.nnb); }
__device__ __forceinline__ void na_load(const NaCtx& C, int sg, bf16x8 (&kb)[2][2], bf16x8 (&vb)[4]) {
    const int tok = na_segtok(C, sg);
#pragma unroll
    for (int par = 0; par < 2; ++par)
#pragma unroll
        for (int s2 = 0; s2 < 2; ++s2) kb[par][s2] = __builtin_bit_cast(bf16x8, __builtin_amdgcn_raw_buffer_load_b128(C.rP, C.voffK, (unsigned)((tok + 4 * par) * (NP * 2) + 64 * s2), 0));
#pragma unroll
    for (int dt = 0; dt < 4; ++dt) vb[dt] = __builtin_bit_cast(bf16x8, __builtin_amdgcn_raw_buffer_load_b128(C.rV, C.voffV, (unsigned)((16 * dt * VTS + tok) * 2), 0));
}
template <bool LATENT>
__device__ __forceinline__ void na_segment(NaCtx& C, int sg, int lane, const bf16x8 (&kb)[2][2], const bf16x8 (&vb)[4]) {
    const int g = lane >> 4;
    const bool nb = LATENT && sg < C.nnb;
    const int kr = C.krlo + sg;
#pragma unroll
    for (int i = 0; i < 4; ++i) {
        if (nb) { const int ri = C.r0 + i, rsi = ri - 4 < 0 ? 0 : (ri - 4 > 56 ? 56 : ri - 4); if (kr < rsi || kr > rsi + 7) continue; }
        float bv[2][4];
        if (nb) { const unsigned rowoff = (unsigned)((kr - (C.r0 + i) + 7) * 32 * 4);
#pragma unroll
            for (int par = 0; par < 2; ++par)
#pragma unroll
                for (int rg = 0; rg < 4; ++rg) bv[par][rg] = *(const LAS float*)((const LAS char*)C.rpb + rowoff + C.bidx[par][rg]); }
        f32x4 st[2];
#pragma unroll
        for (int par = 0; par < 2; ++par) {
            f32x4 a = nb ? (f32x4){bv[par][0], bv[par][1], bv[par][2], bv[par][3]} : (f32x4){0.f, 0.f, 0.f, 0.f};
#pragma unroll
            for (int s2 = 0; s2 < 2; ++s2) a = __builtin_amdgcn_mfma_f32_16x16x32_bf16(kb[par][s2], C.qa[i][s2], a, 0, 0, 0);
            st[par] = a;
        }
        float mx = fmaxf(fmaxf(fmaxf(st[0][0], st[0][1]), fmaxf(st[0][2], st[0][3])), fmaxf(fmaxf(st[1][0], st[1][1]), fmaxf(st[1][2], st[1][3])));
        mx = na_max4(mx);
        if (__any(mx > C.mrun[i] + 8.f)) {
            const float mnew = fmaxf(C.mrun[i], mx), alpha = __builtin_amdgcn_exp2f(C.mrun[i] - mnew);
            C.lsum[i] *= alpha; C.mrun[i] = mnew;
#pragma unroll
            for (int rg = 0; rg < 4; ++rg) { const float ar = __shfl(alpha, 4 * g + rg);
#pragma unroll
                for (int dt = 0; dt < 4; ++dt) C.o[i][dt][rg] *= ar; }
        }
        float psum = 0.f;
#pragma unroll
        for (int par = 0; par < 2; ++par)
#pragma unroll
            for (int rg = 0; rg < 4; ++rg) { const float p = __builtin_amdgcn_exp2f(st[par][rg] - C.mrun[i]); st[par][rg] = p; psum += p; }
        C.lsum[i] += na_sum4(psum);
        u32x4 pw; pw.x = cvt_pk_bf16(st[0][0], st[0][1]); pw.y = cvt_pk_bf16(st[0][2], st[0][3]); pw.z = cvt_pk_bf16(st[1][0], st[1][1]); pw.w = cvt_pk_bf16(st[1][2], st[1][3]);
        const bf16x8 pa = __builtin_bit_cast(bf16x8, pw);
#pragma unroll
        for (int dt = 0; dt < 4; ++dt) C.o[i][dt] = __builtin_amdgcn_mfma_f32_16x16x32_bf16(pa, vb[dt], C.o[i][dt], 0, 0, 0);
    }
}
#ifndef NA_DRYMODE
#define NA_DRYMODE 0
#endif
template <bool LATENT>
__device__ __forceinline__ void na_unit(Frame& F, int l, int u, const LAS float* rpb_lds, bool dry = false) {
    const int lane = F.lane, q = lane & 15, g = lane >> 4;
    NaCtx C;
    int hh, c0 = 0, qrow0, qstep;
    if (LATENT) { const int cb = u & 3, rg4 = (u >> 2) & 15; hh = (u >> 6) % NH; C.b = u / (64 * NH); c0 = cb * 16; C.r0 = rg4 * 4; qrow0 = C.b * SEQ + C.r0 * GRIDW + c0; qstep = GRIDW;
        const int rs0 = C.r0 - 4 < 0 ? 0 : (C.r0 - 4 > 56 ? 56 : C.r0 - 4), r3 = C.r0 + 3, rs3 = r3 - 4 < 0 ? 0 : (r3 - 4 > 56 ? 56 : r3 - 4);
        C.krlo = rs0; C.nnb = rs3 + 7 - rs0 + 1; }
    else { const int qi = u & 3; hh = (u >> 2) % NH; C.b = u / (4 * NH); qrow0 = TX + C.b * CTXL + qi * 64; qstep = 16; C.r0 = 0; C.krlo = 0; C.nnb = 0; }
    C.cw = c0 == 0 ? 0 : (c0 == 48 ? 32 : c0 - 8);
    const int c = c0 + q; const int start = c - 8 < 0 ? 0 : (c - 8 > 48 ? 48 : c - 8);
    C.rpb = rpb_lds + hh * 15 * 32;
    C.rP = __builtin_amdgcn_make_buffer_rsrc((void*)F.P, 0, (int)((size_t)TT * NP * 2), 0x00020000);
    C.rV = __builtin_amdgcn_make_buffer_rsrc((void*)F.VTA, 0, (int)((size_t)VT_NC * VTS * 2), 0x00020000);
    const int koff = 8 * (q >> 2) + (q & 3);
    C.voffK = (unsigned)((koff * NP + C_NAK + hh * NDH + 8 * g) * 2);
    C.voffV = (unsigned)(((hh * NDH + q) * VTS + 8 * g) * 2);
#pragma unroll
    for (int par = 0; par < 2; ++par)
#pragma unroll
        for (int rg = 0; rg < 4; ++rg) { const int kc = C.cw + 8 * g + rg + 4 * par; const bool valid = (kc >= start) && (kc < start + 16);
            C.bidx[par][rg] = (unsigned)((valid ? kc - c + 15 : 31) * 4); }
#pragma unroll
    for (int i = 0; i < 4; ++i) {
#pragma unroll
        for (int s2 = 0; s2 < 2; ++s2) C.qa[i][s2] = *(const bf16x8*)(F.P + (size_t)(qrow0 + i * qstep + q) * NP + C_NAQ + hh * NDH + 32 * s2 + 8 * g);
        C.mrun[i] = -1e30f; C.lsum[i] = 0.f;
#pragma unroll
        for (int dt = 0; dt < 4; ++dt) C.o[i][dt] = (f32x4){0.f, 0.f, 0.f, 0.f}; }
    const int nseg = C.nnb + 8;
    bf16x8 k0[2][2], v0[4], k1[2][2], v1[4];
    na_load(C, 0, k0, v0);
#pragma unroll 1
    for (int sg = 0; sg < nseg; sg += 2) {
        if (sg + 1 < nseg) na_load(C, sg + 1, k1, v1);
        na_segment<LATENT>(C, sg, lane, k0, v0);
        if (sg + 2 < nseg) na_load(C, sg + 2, k0, v0);
        if (sg + 1 < nseg) na_segment<LATENT>(C, sg + 1, lane, k1, v1);
    }
    bf16* mixb = dry ? (bf16*)F.VTC : F.MIX;
#pragma unroll
    for (int i = 0; i < 4; ++i)
#pragma unroll
        for (int rg = 0; rg < 4; ++rg) { const float li = 1.f / __shfl(C.lsum[i], 4 * g + rg);
            bf16* orow = mixb + (size_t)(dry ? 0 : (qrow0 + i * qstep + 4 * g + rg)) * DM + 384 + hh * NDH + q;
#pragma unroll
            for (int dt = 0; dt < 4; ++dt) orow[16 * dt] = (bf16)f2bf(C.o[i][dt][rg] * li); }
}
__device__ __forceinline__ void ph_attn(Frame& F, int l) {
    const bool need_ctx = l < DEPTH - 1;
    const int gw = F.vcu * NWAVES + F.wave, NGW = F.G * NWAVES;
    LAS float* rpb = (LAS float*)(F.lds + TAB_OFF);
    for (int i = F.tid; i < NH * 15 * 32; i += NTHREADS) { const int col = i & 31, hr = i >> 5; rpb[i] = col < 31 ? F.na_rpb[((size_t)l * NH * 15 + hr) * 31 + col] * NA_LOG2E : -1e30f; }
    LAS int* ccnt = (LAS int*)(F.lds + MISC_OFF + 240 * 4);
    if (F.tid == 0) *ccnt = 0;
    __syncthreads();
    for (int rep = 0; rep < REPS(11); ++rep)
    for (int u = F.vcu; u < NB * GH * 2 * 4; u += F.G) gla_g2_unit(F, u);
    const bool bg = !GLA_CHECK;
    constexpr int NCONV = 3 * (NE * 16 * 32), NLAT = NB * NH * 16 * 4, NCTXU = NB * NH * 4;
    const int nper = (NCONV - F.vcu + F.G - 1) / F.G;
    if (bg && (F.wave & 1)) convert_dyn(F, l, ccnt, nper, nper * CONV_QN / CONV_QD);
    for (int rep = 0; rep < REPS(12); ++rep) {
    { const int nfull = NLAT / NGW, per = (NLAT - nfull * NGW + F.G - 1) / F.G, slot = (F.wave & 1) ? 4 + (F.wave >> 1) : (F.wave >> 1);
      for (int k = 0; k <= nfull; ++k) { const int u = k < nfull ? gw + k * NGW : (slot < per ? nfull * NGW + F.vcu * per + slot : NLAT);
          if (u < NLAT) na_unit<true>(F, l, u, rpb, rep + 1 < REPS(12)); } }
    if (need_ctx) { const int nfull = NCTXU / NGW, per = (NCTXU - nfull * NGW + F.G - 1) / F.G, slot = (F.wave & 1) ? (F.wave >> 1) : 4 + (F.wave >> 1);
      for (int k = 0; k <= nfull; ++k) { const int u = k < nfull ? gw + k * NGW : (slot < per ? nfull * NGW + F.vcu * per + slot : NCTXU);
          if (u < NCTXU) na_unit<false>(F, l, u, rpb, rep + 1 < REPS(12)); } } }
    if (bg) convert_dyn(F, l, ccnt, nper, nper);
}
constexpr int RW_LD = 1032;
static_assert(2 * NE * RW_LD * 2 <= STAGE_BYTES, "router LDS");
__device__ __forceinline__ unsigned f2key(float f, int e) { unsigned u = __builtin_bit_cast(unsigned, f); u = (u & 0x80000000u) ? ~u : (u | 0x80000000u); return (u & ~31u) | (unsigned)(31 - e); }
__device__ __forceinline__ float key2f(unsigned k) { unsigned u = k & ~31u; u = (u & 0x80000000u) ? (u & 0x7fffffffu) : ~u; return __builtin_bit_cast(float, u); }
__device__ __forceinline__ void ph_router(Frame& F, int l, bool dry = false) {
    const int tid = F.tid, lane = F.lane, q = lane & 15, g = lane >> 4;
    LAS bf16* WH = (LAS bf16*)F.lds; LAS bf16* WL = WH + NE * RW_LD;
    LAS int* lcount = (LAS int*)(F.lds + MISC_OFF + 64 * 4);
    volatile LAS int* lbase = (volatile LAS int*)(F.MISC + 96);
    LAS int* apos = (LAS int*)(F.lds + TAB_OFF);
    const float* rw = F.router_w + (size_t)l * DM * NE;
    for (int i = tid; i < DM * NE; i += NTHREADS) { const int c = i >> 5, e = i & 31; const float w = rw[i]; const unsigned hi = f2bf(w); const unsigned lo = f2bf(w - bf2f(hi));
        WH[e * RW_LD + c] = (bf16)hi; WL[e * RW_LD + c] = (bf16)lo; }
    if (tid < NE) lcount[tid] = 0;
    __syncthreads();
    const int M = (l == DEPTH - 1) ? TX : TT;
    const int per = (M + F.G - 1) / F.G, tok0 = F.vcu * per, tok1 = (tok0 + per < M) ? tok0 + per : M;
    const int ntile = tok1 > tok0 ? (tok1 - tok0 + 15) >> 4 : 0;
    const float* g2w = F.norm2_g + (size_t)l * DM + 8 * g;
    const float rb0 = F.router_b[(size_t)l * NE + q], rb1 = F.router_b[(size_t)l * NE + 16 + q];
    for (int tile = F.wave; tile < ntile; tile += NWAVES) {
        const int tbase = tok0 + 16 * tile, t = tbase + q, tq = t < tok1 ? t : tok1 - 1; const bool valid = t < tok1;
        const bf16* xr = F.X + (size_t)tq * DM + 8 * g;
        float ss = 0.f;
#pragma unroll 8
        for (int s = 0; s < 32; ++s) { const u32x4 xw = *(const u32x4*)(xr + 32 * s); const f32x4 a = (f32x4){bflo(xw.x), bfhi(xw.x), bflo(xw.y), bfhi(xw.y)}, b = (f32x4){bflo(xw.z), bfhi(xw.z), bflo(xw.w), bfhi(xw.w)}; ss += (a.x * a.x + a.y * a.y) + (a.z * a.z + a.w * a.w) + (b.x * b.x + b.y * b.y) + (b.z * b.z + b.w * b.w); }
        { const auto r = __builtin_amdgcn_permlane16_swap(__float_as_uint(ss), __float_as_uint(ss), false, false); ss = __uint_as_float(r[0]) + __uint_as_float(r[1]);
          const auto t = __builtin_amdgcn_permlane32_swap(__float_as_uint(ss), __float_as_uint(ss), false, false); ss = __uint_as_float(t[0]) + __uint_as_float(t[1]); }
        const float rinv = 1.f / sqrtf(ss * (1.f / DM) + EPS);
        const int br = tq < TX ? tq / SEQ : NB;
        const float* md = F.mod + ((size_t)l * 9 + br) * 6 * DM + 8 * g;
        unsigned char* hrow = MOE_FP8 ? F.H8 + (size_t)tq * DM + 8 * g : (unsigned char*)(F.H + (size_t)tq * DM + 8 * g);
        f32x4 acc[2]; acc[0] = (f32x4){0.f, 0.f, 0.f, 0.f}; acc[1] = acc[0];
#pragma unroll 2
        for (int s = 0; s < 32; ++s) { const int c = 32 * s;
            const u32x4 xw = *(const u32x4*)(xr + c); const f32x4 xa = (f32x4){bflo(xw.x), bfhi(xw.x), bflo(xw.y), bfhi(xw.y)}, xb = (f32x4){bflo(xw.z), bfhi(xw.z), bflo(xw.w), bfhi(xw.w)}, ga = *(const f32x4*)(g2w + c), gb = *(const f32x4*)(g2w + c + 4);
            const f32x4 ca = *(const f32x4*)(md + 4 * DM + c), cb = *(const f32x4*)(md + 4 * DM + c + 4), sa = *(const f32x4*)(md + 3 * DM + c), sb = *(const f32x4*)(md + 3 * DM + c + 4);
            const f32x4 ha = (xa * rinv * ga) * (ca + 1.f) + sa, hb = (xb * rinv * gb) * (cb + 1.f) + sb;
            u32x4 hw; hw.x = cvt_pk_bf16(ha.x, ha.y); hw.y = cvt_pk_bf16(ha.z, ha.w); hw.z = cvt_pk_bf16(hb.x, hb.y); hw.w = cvt_pk_bf16(hb.z, hb.w);
            u32x4 lw; lw.x = cvt_pk_bf16(ha.x - bflo(hw.x), ha.y - bfhi(hw.x)); lw.y = cvt_pk_bf16(ha.z - bflo(hw.y), ha.w - bfhi(hw.y));
            lw.z = cvt_pk_bf16(hb.x - bflo(hw.z), hb.y - bfhi(hw.z)); lw.w = cvt_pk_bf16(hb.z - bflo(hw.w), hb.w - bfhi(hw.w));
            if (valid) { if (MOE_FP8) { u32x2 h8; h8.x = pk4_fp8(ha.x, ha.y, ha.z, ha.w); h8.y = pk4_fp8(hb.x, hb.y, hb.z, hb.w); *(u32x2*)(hrow + c) = h8; } else *(u32x4*)(hrow + 2 * c) = hw; }
            const bf16x8 ah = __builtin_bit_cast(bf16x8, hw), al = __builtin_bit_cast(bf16x8, lw);
#pragma unroll
            for (int tt = 0; tt < 2; ++tt) { const bf16x8 bh = *(const LAS bf16x8*)(WH + (16 * tt + q) * RW_LD + c + 8 * g), bl = *(const LAS bf16x8*)(WL + (16 * tt + q) * RW_LD + c + 8 * g);
                acc[tt] = __builtin_amdgcn_mfma_f32_16x16x32_bf16(ah, bh, acc[tt], 0, 0, 0);
                acc[tt] = __builtin_amdgcn_mfma_f32_16x16x32_bf16(ah, bl, acc[tt], 0, 0, 0);
                acc[tt] = __builtin_amdgcn_mfma_f32_16x16x32_bf16(al, bh, acc[tt], 0, 0, 0); } }
        unsigned k0[4], k1[4], win[4][4];
#pragma unroll
        for (int rg = 0; rg < 4; ++rg) { k0[rg] = f2key(acc[0][rg] + rb0, q); k1[rg] = f2key(acc[1][rg] + rb1, 16 + q); }
#pragma unroll
        for (int k = 0; k < 4; ++k)
#pragma unroll
            for (int rg = 0; rg < 4; ++rg) { const unsigned m = row16_umax(k0[rg] > k1[rg] ? k0[rg] : k1[rg]);
                win[rg][k] = m; if (k0[rg] == m) k0[rg] = 0u; if (k1[rg] == m) k1[rg] = 0u; }
        { const int rsel = q >> 2, ksel = q & 3;
          unsigned w4[4];
#pragma unroll
          for (int k = 0; k < 4; ++k) w4[k] = rsel == 0 ? win[0][k] : rsel == 1 ? win[1][k] : rsel == 2 ? win[2][k] : win[3][k];
          const float v0 = key2f(w4[0]), e1 = __expf(key2f(w4[1]) - v0), e2 = __expf(key2f(w4[2]) - v0), e3 = __expf(key2f(w4[3]) - v0);
          const float inv = 1.f / (1.f + e1 + e2 + e3);
          const float gt = (ksel == 0 ? 1.f : ksel == 1 ? e1 : ksel == 2 ? e2 : e3) * inv;
          const unsigned wk = ksel == 0 ? w4[0] : ksel == 1 ? w4[1] : ksel == 2 ? w4[2] : w4[3];
          const int e = 31 - (int)(wk & 31u), tt2 = tbase + 4 * g + rsel;
          if (tt2 < tok1 && !dry) { F.GATE[(size_t)tt2 * 4 + ksel] = gt;
              const int pos = __hip_atomic_fetch_add(lcount + e, 1, __ATOMIC_RELAXED, __HIP_MEMORY_SCOPE_WORKGROUP);
              apos[(tt2 - tok0) * 4 + ksel] = (e << 16) | pos; } }
    }
    __syncthreads();
    if (dry) return;
    if (tid < NE) lbase[tid] = (int)__hip_atomic_fetch_add(F.ctl + CW_CNT + (l * NE + tid) * 64, (unsigned)__hip_atomic_load(lcount + tid, __ATOMIC_RELAXED, __HIP_MEMORY_SCOPE_WORKGROUP), __ATOMIC_RELAXED, __HIP_MEMORY_SCOPE_AGENT);
    __syncthreads();
    const int nas = (tok1 > tok0 ? (tok1 - tok0) : 0) * 4;
    for (int i = tid; i < nas; i += NTHREADS) { const int w = apos[i], e = w >> 16, pos = w & 0xffff; F.LIST[(size_t)e * TT + lbase[e] + pos] = tok0 * 4 + i; }
    __syncthreads();
}
__device__ __forceinline__ void moe_tables(Frame& F, int l, int npn) {
    volatile LAS int* tp = (volatile LAS int*)(F.MISC + 16);
    LAS int* tab = (LAS int*)(F.lds + TAB_OFF);
    const int tid = F.tid;
    volatile LAS int* eb = (volatile LAS int*)(F.MISC + 128);
    volatile LAS int* cntl = (volatile LAS int*)(F.MISC + 168);
    if (tid == 0) { int acc = 0, sb = 0;
        for (int e = 0; e < NE; ++e) { tp[e] = acc; eb[e] = sb; const int cnt = (int)__hip_atomic_load(F.ctl + CW_CNT + (l * NE + e) * 64, __ATOMIC_RELAXED, __HIP_MEMORY_SCOPE_AGENT); cntl[e] = cnt; acc += (cnt + 255) >> 8; sb += cnt; }
        tp[NE] = acc; }
    __syncthreads();
    if (npn != 8) return;
#pragma unroll 1
    for (int i2 = 0; i2 < MAXU; i2 += 2) {
        const int i = i2 + (tid >> 8), rr = tid & 255;
        g8::Unit u;
        if (i < MAXU && g8::moe_unit((long)i * F.G + F.vcu, npn, tp, u)) {
            const int cnt = (int)__hip_atomic_load(F.ctl + CW_CNT + (l * NE + u.e) * 64, __ATOMIC_RELAXED, __HIP_MEMORY_SCOPE_AGENT);
            const int idx = u.pm * 256 + rr;
            const int a = idx < cnt ? F.LIST[(size_t)u.e * TT + idx] : -1;
            tab[i * 256 + rr] = a;
            if (u.pn == 0 && a >= 0) { F.INV[a] = eb[u.e] + idx; F.GATES[eb[u.e] + idx] = F.GATE[a]; }
        }
    }
    __syncthreads();
}

__global__ void __launch_bounds__(NTHREADS, 2) mk_fwd(Args args) {
    extern __shared__ __attribute__((aligned(16))) unsigned char lds_raw[];
    Frame F;
    F.lds = (LAS unsigned char*)lds_raw;
    F.MISC = (volatile LAS unsigned*)(F.lds + MISC_OFF);
    F.tid = threadIdx.x; F.lane = F.tid & 63; F.wave = __builtin_amdgcn_readfirstlane(F.tid >> 6);
    F.G = gridDim.x; { const int bx = blockIdx.x; F.vcu = (F.G % 8 == 0) ? (bx % 8) * (F.G / 8) + bx / 8 : bx; }
    frame_ptrs(F);
    for (int u = F.tid; u < 256; u += NTHREADS) F.MISC[u] = 0u;
    __syncthreads();
    const int lo = args.ph_lo, hi = args.ph_hi;
    const bool one_launch = (hi - lo) > 1;
    XcdBarrier bar; bar.bar = F.ctl + CW_BAR; bar.x = 0; bar.st = nullptr;
    if (one_launch) bar = xcd_barrier_post(F.ctl + CW_BAR, F.MISC);
#ifndef PHMASK
#define PHMASK 0xFFFFFFFF
#endif
#define IN(k) (lo <= (k) && (k) < hi)
#define PHON(b) ((PHMASK >> (b)) & 1)
#define STAGGER() do { if (STAG_TICKS > 0 && (blockIdx.x & 8)) { const unsigned long long t0_ = __builtin_amdgcn_s_memrealtime(); while (__builtin_amdgcn_s_memrealtime() - t0_ < (unsigned long long)STAG_TICKS) __builtin_amdgcn_s_sleep(8); } } while (0)
#define REFRESH() do { int tz_ = threadIdx.x; asm volatile("" : "+v"(tz_)); F.tid = tz_; F.lane = tz_ & 63; frame_ptrs(F); } while (0)
#define SEAM(k) do { if (IN(k) && IN((k) + 1)) xcd_barrier(bar); } while (0)

    if (PHON(0) && IN(0)) { for (int rep = 0; rep < REPS(0); ++rep) { REFRESH(); ph_prologue(F); } } SEAM(0);
    if (PHON(1) && IN(1)) { REFRESH(); ph_first_norm(F); } SEAM(1);
    for (int l = 0; l < DEPTH; ++l) {
        const int pb = 2 + PPL * l;
        const bool lastl = (l == DEPTH - 1);
        if (PHON(2) && IN(pb + 0)) for (int rep = 0; rep < REPS(2); ++rep) {
            REFRESH(); STAGGER();
            g8::ProbIn Pb{(const char*)F.H, (const char*)(F.Bin + (size_t)l * NP * DM), F.P, F.VTA, F.G, (int)blockIdx.x, (rep + 1 < REPS(2)) ? 1 : 0};
            g8::gemm_phase(F.lds, Pb);
        }
        SEAM(pb + 0);
        if (PHON(3) && IN(pb + 1)) { for (int rep = 0; rep < REPS(3); ++rep) { REFRESH(); ph_prep(F, l); } } SEAM(pb + 1);
        if (PHON(4) && IN(pb + 2)) { for (int rep = 0; rep < REPS(4); ++rep) { REFRESH(); ph_attn(F, l); } } SEAM(pb + 2);
        if (PHON(10) && IN(pb + 3)) { for (int rep = 0; rep < REPS(10); ++rep) { REFRESH(); ph_gla3(F, l); } } SEAM(pb + 3);
        if (PHON(5) && IN(pb + 4)) for (int rep = 0; rep < REPS(5); ++rep) {
            REFRESH(); STAGGER();
            g8::ProbOut Pb{(const char*)F.MIX, (const char*)(F.Bout + (size_t)l * DM * DM), (rep + 1 < REPS(5)) ? (bf16*)F.ACT : F.X, F.mod + (size_t)l * 9 * 6 * DM, F.G, (int)blockIdx.x, (lastl ? TX : TT) / 256};
            g8::gemm_phase(F.lds, Pb);
        }
        SEAM(pb + 4);
        if (PHON(6) && IN(pb + 5)) { for (int rep = 0; rep < REPS(6); ++rep) { REFRESH(); ph_router(F, l, rep + 1 < REPS(6)); __syncthreads(); } } SEAM(pb + 5);
        if (PHON(7) && IN(pb + 6)) for (int rep = 0; rep < REPS(7); ++rep) {
            REFRESH(); moe_tables(F, l, 8); STAGGER();
            g8::ProbGU Pb{MOE_FP8 ? (const char*)F.H8 : (const char*)F.H, (const char*)F.Bgu + (size_t)l * NE * 2 * DM * DM * (MOE_FP8 ? 1 : 2), (unsigned char*)F.ACT, F.b_gu + (size_t)l * NE * 2 * DM, (volatile LAS int*)(F.MISC + 16), (const LAS int*)(F.lds + TAB_OFF), F.G, F.vcu, (rep + 1 < REPS(7)) ? 1 : 0, (volatile LAS int*)(F.MISC + 128)};
            g8::gemm_phase(F.lds, Pb);
        }
        SEAM(pb + 6);
        if (PHON(8) && IN(pb + 7)) for (int rep = 0; rep < REPS(8); ++rep) {
            REFRESH(); moe_tables(F, l, 4); STAGGER();
            g8::ProbDN Pb{(const char*)F.ACT, (const char*)F.Bdn + (size_t)l * NE * DM * DM * (MOE_FP8 ? 1 : 2), F.YB, F.b_down + (size_t)l * NE * DM, F.GATES, (volatile LAS int*)(F.MISC + 16), F.G, F.vcu, (rep + 1 < REPS(8)) ? 1 : 0, (volatile LAS int*)(F.MISC + 128), (volatile LAS int*)(F.MISC + 168)};
            g8::gemm_phase(F.lds, Pb);
        }
        SEAM(pb + 7);
        if (PHON(9) && IN(pb + 8)) { for (int rep = 0; rep < REPS(9); ++rep) { REFRESH(); ph_combine(F, l, rep + 1 < REPS(9)); } }
        if (!lastl) SEAM(pb + 8);
    }
#undef IN
#undef SEAM
}

extern "C" void kernel_launch(void* const* d_in, const int* in_sizes, int n_in, void* d_out, int out_size, void* d_ws, size_t ws_size, hipStream_t stream) {
    static int grid = 0;
    if (grid == 0) {
        if (n_in != 23 || in_sizes[0] != TX * DM || out_size != TX * DM || ws_size < WS_END) {
            fprintf(stderr, "kernel_launch: unexpected problem (n_in %d, in0 %d, out %d, ws %zu; need ws >= %zu); nothing launched\n", n_in, n_in > 0 ? in_sizes[0] : -1, out_size, ws_size, (size_t)WS_END); grid = -1; return; }
        int dev = 0, cus = 0, per_cu = 0;
        if (hipGetDevice(&dev) != hipSuccess || hipDeviceGetAttribute(&cus, hipDeviceAttributeMultiprocessorCount, dev) != hipSuccess) { fprintf(stderr, "kernel_launch: device query failed\n"); grid = -1; return; }
        if (hipFuncSetAttribute((const void*)mk_fwd, hipFuncAttributeMaxDynamicSharedMemorySize, LDS_BYTES) != hipSuccess) { fprintf(stderr, "kernel_launch: hipFuncSetAttribute failed\n"); grid = -1; return; }
        if (hipOccupancyMaxActiveBlocksPerMultiprocessor(&per_cu, (const void*)mk_fwd, NTHREADS, LDS_BYTES) != hipSuccess || per_cu < 1)
            fprintf(stderr, "kernel_launch: note: occupancy query reports %d workgroups per CU\n", per_cu);
        (void)hipGetLastError();
        grid = cus;
        if ((long)grid * MAXU < (long)(NASG / 256 + NE) * 8) { fprintf(stderr, "kernel_launch: grid %d too small for the MoE unit tables\n", grid); grid = -1; return; }
    }
    if (grid < 0) return;
    if (hipMemsetAsync((char*)d_ws + WS_CTL, 0, CTL_ZERO_BYTES, stream) != hipSuccess) { fprintf(stderr, "kernel_launch: memset failed\n"); return; }
    Args a{};
    for (int i = 0; i < 23; ++i) a.in[i] = (const float*)d_in[i];
    a.out = (float*)d_out; a.ws = (unsigned char*)d_ws;
#if MK_N_LAUNCHES == 1
    a.ph_lo = 0; a.ph_hi = NPHASES;
    hipLaunchKernelGGL(mk_fwd, dim3(grid), dim3(NTHREADS), LDS_BYTES, stream, a);
#else
    for (int p = 0; p < NPHASES; ++p) { a.ph_lo = p; a.ph_hi = p + 1; hipLaunchKernelGGL(mk_fwd, dim3(grid), dim3(NTHREADS), LDS_BYTES, stream, a); }
#endif
    const hipError_t le = hipPeekAtLastError();
    if (le != hipSuccess) fprintf(stderr, "kernel_launch: launch failed: %s\n", hipGetErrorName(le));
}
```

```cpp
#include <hip/hip_runtime.h>
#include <cstdio>
#include <cstdint>
#include <cstddef>

#ifndef MK_N_LAUNCHES
#define MK_N_LAUNCHES 1
#endif

#define GAS __attribute__((address_space(1)))
#define LAS __attribute__((address_space(3)))
typedef unsigned short bf16;
typedef short bf16x8 __attribute__((ext_vector_type(8)));
typedef short bf16x4 __attribute__((ext_vector_type(4)));
typedef float f32x4 __attribute__((ext_vector_type(4)));
typedef float f32x2 __attribute__((ext_vector_type(2)));
typedef unsigned u32x4 __attribute__((ext_vector_type(4)));
typedef unsigned u32x2 __attribute__((ext_vector_type(2)));

constexpr int NB = 8, SEQ = 4096, DM = 1024, CTXL = 256, DEPTH = 4, GRIDW = 64;
constexpr int TX = NB * SEQ, TC = NB * CTXL, TT = TX + TC;
constexpr int NP = 2816;
constexpr int C_NAQ = 0, C_NAK = 384, C_NAV = 768, C_GV = 1152, C_GQ = 1536, C_GK = 1728, C_GG = 1920, C_POOL = 2304, C_AF = 2560, C_AB = 2576;
constexpr int VT_C0 = 768, VT_NC = 768, VTS = TT + 128;
constexpr int NE = 32, TOPK = 4, NASG = TT * TOPK;
constexpr int SLOT_DUMMY = NASG + 256;
constexpr int GH = 4, GDK = 48, GDV = 96, NH = 6, NDH = 64;
constexpr float EPS = 1e-6f;
constexpr int NWAVES = 8, NTHREADS = 512;
constexpr int PPL = 9;
constexpr int NPHASES = 2 + PPL * DEPTH;
#ifndef MOE_FP8
#define MOE_FP8 1
#endif
#ifndef REPMASK
#define REPMASK 0
#endif
#define REPS(b) (1 + ((REPMASK >> (b)) & 1))
#ifndef GLA_CHECK
#define GLA_CHECK 0
#endif

constexpr size_t MiB = 1u << 20;
constexpr size_t WS_CTL = 0, CTL_ZERO_BYTES = 128 * 1024;
constexpr size_t WS_MOD = 2 * MiB;
constexpr size_t WS_BIN = 4 * MiB;
constexpr size_t WS_BOUT = 26 * MiB;
constexpr size_t WS_BGU = 34 * MiB;
constexpr size_t WS_BDN = 546 * MiB;
constexpr size_t WS_X = 802 * MiB;
constexpr size_t WS_H = 938 * MiB;
constexpr size_t WS_P = 1008 * MiB;
constexpr size_t WS_VTX = 1196 * MiB;
constexpr size_t WS_VTC = 1220 * MiB;
constexpr size_t WS_MIX = 1222 * MiB;
constexpr size_t WS_OF = 1290 * MiB;
constexpr size_t WS_OB = 1341 * MiB;
constexpr size_t WS_ACT = 1392 * MiB;
constexpr size_t WS_YB = 1665 * MiB;
constexpr size_t WS_LIST = 1938 * MiB;
constexpr size_t WS_GATE = 1943 * MiB;
constexpr size_t WS_DS = 1944 * MiB;
constexpr size_t WS_GD = 2025 * MiB;
constexpr size_t WS_ROPE = 2026 * MiB;
constexpr size_t WS_VTA = 2027 * MiB;
constexpr size_t WS_OPS = 2080 * MiB;
constexpr size_t WS_STB = 2132 * MiB;
constexpr size_t WS_H8 = 2172 * MiB;
constexpr size_t WS_INV = 2208 * MiB;
constexpr size_t WS_GATES = 2209 * MiB;
constexpr size_t WS_END = 2210 * MiB;
constexpr int CW_BAR = 4096;
constexpr int CW_CTXF = 25600;
constexpr int CW_CNT = 16384;

constexpr int STAGE_BYTES = 132096;
constexpr int MISC_OFF = STAGE_BYTES;
constexpr int TAB_OFF = MISC_OFF + 1024;
constexpr int MAXU = 28;
constexpr int LDS_BYTES = TAB_OFF + MAXU * 1024;
static_assert(LDS_BYTES <= 163840, "LDS");

#define LDS_WAIT() asm volatile("s_waitcnt lgkmcnt(0)" ::: "memory")
#define VM_WAIT() asm volatile("s_waitcnt vmcnt(0)" ::: "memory")
__device__ __forceinline__ unsigned f2bf(float f) { unsigned u = __builtin_bit_cast(unsigned, f); return (u + 0x7fffu + ((u >> 16) & 1u)) >> 16; }
__device__ __forceinline__ unsigned pk2(float lo, float hi) { return f2bf(lo) | (f2bf(hi) << 16); }
__device__ __forceinline__ float bf2f(unsigned b) { return __builtin_bit_cast(float, (b & 0xffffu) << 16); }
__device__ __forceinline__ float bflo(unsigned w) { return __builtin_bit_cast(float, w << 16); }
__device__ __forceinline__ float bfhi(unsigned w) { return __builtin_bit_cast(float, w & 0xffff0000u); }
__device__ __forceinline__ unsigned cvt_pk_bf16(float lo, float hi) { unsigned r; asm volatile("v_cvt_pk_bf16_f32 %0, %1, %2" : "=v"(r) : "v"(lo), "v"(hi)); return r; }
__device__ __forceinline__ unsigned pk4_fp8(float a, float b, float c, float d) { int p = __builtin_amdgcn_cvt_pk_fp8_f32(a, b, 0, false); p = __builtin_amdgcn_cvt_pk_fp8_f32(c, d, p, true); return (unsigned)p; }
constexpr float Y8_SCALE = 16.f, Y8_INV = 1.f / 16.f;
constexpr float W8_SCALE = 64.f, W8_INV = 1.f / 64.f;
template <int CTRL, int RM> __device__ __forceinline__ float dpp_add(float v) { const int t = __builtin_amdgcn_update_dpp(0, __float_as_int(v), CTRL, RM, 0xf, true); return v + __int_as_float(t); }
__device__ __forceinline__ float wave_scan_incl(float x) {
    x = dpp_add<0x111, 0xf>(x); x = dpp_add<0x112, 0xf>(x); x = dpp_add<0x114, 0xf>(x); x = dpp_add<0x118, 0xf>(x);
    x = dpp_add<0x142, 0xa>(x); x = dpp_add<0x143, 0xc>(x); return x;
}
template <int CTRL> __device__ __forceinline__ unsigned dpp_umax(unsigned v) { const unsigned t = (unsigned)__builtin_amdgcn_update_dpp(0, (int)v, CTRL, 0xf, 0xf, true); return t > v ? t : v; }
__device__ __forceinline__ unsigned row16_umax(unsigned v) {
    v = dpp_umax<0xB1>(v); v = dpp_umax<0x4E>(v); v = dpp_umax<0x141>(v); v = dpp_umax<0x140>(v); return v;
}
template <int CTRL> __device__ __forceinline__ float dpp_addp(float v) { const int t = __builtin_amdgcn_update_dpp(0, __float_as_int(v), CTRL, 0xf, 0xf, true); return v + __int_as_float(t); }
__device__ __forceinline__ float wave_sum(float v) {
    v = dpp_addp<0xB1>(v); v = dpp_addp<0x4E>(v); v = dpp_addp<0x141>(v); v = dpp_addp<0x140>(v);
    const auto r = __builtin_amdgcn_permlane16_swap(__float_as_uint(v), __float_as_uint(v), false, false);
    v = __uint_as_float(r[0]) + __uint_as_float(r[1]);
    const auto t = __builtin_amdgcn_permlane32_swap(__float_as_uint(v), __float_as_uint(v), false, false);
    return __uint_as_float(t[0]) + __uint_as_float(t[1]);
}
__device__ __forceinline__ float silu_f(float x) { return x / (1.f + __expf(-x)); }

#define XB_TMO      128
#define XB_XCNT(j)  (256  + 64 * (j))
#define XB_XSUB(j)  (1280 + 64 * (j))
#define XB_XGEN(j)  (2304 + 64 * (j))
#define XB_TOP      3328
#define XB_TOPGEN   3392
#define XCD_BAR_WORDS 3456
#define XB_SPIN_CAP (1u << 18)
__device__ __forceinline__ unsigned xb_ld(unsigned* p)              { return __hip_atomic_load(p, __ATOMIC_RELAXED, __HIP_MEMORY_SCOPE_AGENT); }
__device__ __forceinline__ unsigned xb_add(unsigned* p, unsigned v) { return __hip_atomic_fetch_add(p, v, __ATOMIC_RELAXED, __HIP_MEMORY_SCOPE_AGENT); }
__device__ __forceinline__ unsigned xb_xcc_id() { return (unsigned)__builtin_amdgcn_s_getreg((3 << 11) | 20) & 0xFu; }
#define XB_SPIN(cond, bar) do { unsigned _sp = 0; while (cond) { __builtin_amdgcn_s_sleep(1); \
    if ((++_sp & 255u) == 0u) { if (xb_ld(&(bar)[XB_TMO])) break; if (_sp > XB_SPIN_CAP) { atomicAdd(&(bar)[XB_TMO], 1u); break; } } } } while (0)
struct XcdBarrier { unsigned* bar; unsigned x; volatile LAS unsigned* st; };
__device__ __forceinline__ XcdBarrier xcd_barrier_post(unsigned* bar, volatile LAS unsigned* st) {
    XcdBarrier b; b.bar = bar; b.x = xb_xcc_id(); b.st = st;
    if (threadIdx.x == 0) (void)xb_add(&bar[XB_XCNT(b.x)], 1u);
    return b;
}
__device__ __forceinline__ void xcd_barrier_complete(unsigned* bar, unsigned x, unsigned& nloc, unsigned& nx) {
    const unsigned G = gridDim.x * gridDim.y * gridDim.z;
    unsigned sum, cnt, mine, sp = 0u;
    for (;;) {
        sum = 0u; cnt = 0u; mine = 0u;
#pragma unroll
        for (unsigned j = 0; j < 16; ++j) { const unsigned c = xb_ld(&bar[XB_XCNT(j)]); sum += c; cnt += (c > 0u) ? 1u : 0u; mine = (j == x) ? c : mine; }
        if (sum == G) break;
        __builtin_amdgcn_s_sleep(1);
        if ((++sp & 255u) == 0u) { if (xb_ld(&bar[XB_TMO])) break; if (sp > XB_SPIN_CAP) { atomicAdd(&bar[XB_TMO], 1u); break; } }
    }
    nloc = mine > 0u ? mine : 1u; nx = cnt > 0u ? cnt : 1u;
}
__device__ __forceinline__ void xcd_barrier(const XcdBarrier& b) {
    asm volatile("s_waitcnt vmcnt(0)" ::: "memory");
    __syncthreads();
    if (threadIdx.x == 0) {
        unsigned* bar = b.bar;
        __builtin_amdgcn_s_waitcnt(0);
        unsigned nloc = b.st[0], nx = b.st[1];
        if (nloc == 0u) { xcd_barrier_complete(bar, b.x, nloc, nx); b.st[0] = nloc; b.st[1] = nx; }
        const unsigned old = xb_add(&bar[XB_XSUB(b.x)], 1u);
        const unsigned gen = old / nloc;
        if (old + 1u == (gen + 1u) * nloc) {
            __builtin_amdgcn_fence(__ATOMIC_RELEASE, "agent");
            asm volatile("s_waitcnt vmcnt(0)" ::: "memory");
            const unsigned og = xb_add(&bar[XB_TOP], 1u);
            const unsigned tg = og / nx;
            if (og + 1u == (tg + 1u) * nx) xb_add(&bar[XB_TOPGEN], 1u);
            else XB_SPIN(xb_ld(&bar[XB_TOPGEN]) == tg, bar);
            __builtin_amdgcn_fence(__ATOMIC_ACQUIRE, "agent");
            xb_add(&bar[XB_XGEN(b.x)], 1u);
            asm volatile("s_waitcnt vmcnt(0)" ::: "memory");
        } else {
            XB_SPIN(xb_ld(&bar[XB_XGEN(b.x)]) == gen, bar);
            __builtin_amdgcn_fence(__ATOMIC_ACQUIRE, "agent");
            asm volatile("s_waitcnt vmcnt(0)" ::: "memory");
        }
    }
    __syncthreads();
}

namespace g8 {
constexpr int BM = 256, BK = 64, HALF = 128, HTB = HALF * BK * 2, NXCD = 8, WGM = 8, KD = 1024;
__device__ __forceinline__ int lds_byte(int r, int c) { const int st = (r >> 4) * 2 + (c >> 5), rr = r & 15, cc = c & 31, ob = rr * 64 + cc * 2; return st * 1024 + (ob ^ (((ob >> 9) & 1) << 5)); }
__device__ __forceinline__ void stage_rc(int b, int& R, int& C) { const int st = b / 1024, sb = b % 1024, swz = sb ^ (((sb >> 9) & 1) << 5); R = (st >> 1) * 16 + swz / 64; C = (st & 1) * 32 + (swz % 64) / 2; }
__device__ __forceinline__ int perm32(int rho) { const int n = rho >> 4, i = rho & 15; return 8 * (i >> 2) + 4 * n + (i & 3); }
struct Unit { int pm, pn, e; };
typedef int i32x8 __attribute__((ext_vector_type(8)));
typedef int i32x4 __attribute__((ext_vector_type(4)));
__device__ __forceinline__ i32x8 cat8(bf16x8 a, bf16x8 b) { const i32x4 x = __builtin_bit_cast(i32x4, a), y = __builtin_bit_cast(i32x4, b); return (i32x8){x.x, x.y, x.z, x.w, y.x, y.y, y.z, y.w}; }
__device__ __forceinline__ bool static_unit(long L, int nM, int nN, Unit& u) {
    const int nwg = nM * nN; if (L >= nwg) return false;
    int wgid = (int)L; { const int q = nwg / NXCD, r = nwg % NXCD, xcd = wgid % NXCD, off = wgid / NXCD; wgid = (xcd < r ? xcd * (q + 1) : r * (q + 1) + (xcd - r) * q) + off; }
    const int nig = WGM * nN, gid = wgid / nig, fm = gid * WGM, gsz = (nM - fm) < WGM ? (nM - fm) : WGM;
    u.pm = fm + ((wgid % nig) % gsz); u.pn = (wgid % nig) / gsz; u.e = 0; return true;
}

#ifndef PROBE_DRY
#define PROBE_DRY 0
#endif
#ifndef STAG_TICKS
#define STAG_TICKS 0
#endif
template <class Prob>
__device__ __forceinline__ void gemm_phase(LAS unsigned char* lds, const Prob& P) {

    int tid_ = threadIdx.x; asm volatile("" : "+v"(tid_));
    const int tid = tid_, wid = __builtin_amdgcn_readfirstlane(tid >> 6), lane = tid & 63, wr = wid >> 2, wc = wid & 3, fr = lane & 15, fq = lane >> 4;
    constexpr int RPB = Prob::FP8 ? KD : KD * 2, nt = RPB / (BK * 2);
    unsigned voffB[2];
    { int R0, C0, R1, C1; stage_rc(tid * 16, R0, C0); stage_rc(tid * 16 + 8192, R1, C1); const int Rb0 = Prob::PERM ? ((R0 & ~31) + perm32(R0 & 31)) : R0, Rb1 = Prob::PERM ? ((R1 & ~31) + perm32(R1 & 31)) : R1;
      voffB[0] = (unsigned)(Rb0 * RPB + C0 * 2); voffB[1] = (unsigned)(Rb1 * RPB + C1 * 2); }
    const size_t kstep = (size_t)(BK * 2), hstepB = (size_t)HALF * RPB;
    const unsigned ldsw = (unsigned)wid * 1024u;
    const int aoff = lds_byte(wr * 64 + fr, fq * 8), boff = lds_byte(wc * 32 + fr, fq * 8);
#define G8_SA(b, h) (((b) * 2 + (h)) * HTB)
#define G8_SB(b, h) ((4 + (b) * 2 + (h)) * HTB)
#define G8_STAGE(bufoff, gbase, voff) do { _Pragma("unroll") for (int _i = 0; _i < 2; ++_i) \
        __builtin_amdgcn_global_load_lds((const unsigned*)((const char*)(gbase) + (voff)[_i]), (LAS unsigned*)(lds + (bufoff) + ldsw + _i * 8192), 16, 0, 0); } while (0)
#define G8_LDA(dst, b, h) do { _Pragma("unroll") for (int m = 0; m < 4; ++m) _Pragma("unroll") for (int k = 0; k < 2; ++k) dst[m][k] = *(const LAS bf16x8*)(lds + G8_SA(b, h) + aoff + m * 2048 + k * 1024); } while (0)
#define G8_LDB(dst, b, h) do { _Pragma("unroll") for (int n = 0; n < 2; ++n) _Pragma("unroll") for (int k = 0; k < 2; ++k) dst[n][k] = *(const LAS bf16x8*)(lds + G8_SB(b, h) + boff + n * 2048 + k * 1024); } while (0)
#define G8_MMA(ai, bj, At, Bt) do { __builtin_amdgcn_s_setprio(1); if constexpr (Prob::FP8) { \
        _Pragma("unroll") for (int m = 0; m < 4; ++m) _Pragma("unroll") for (int n = 0; n < 2; ++n) \
        acc[ai][bj][m][n] = __builtin_amdgcn_mfma_scale_f32_16x16x128_f8f6f4(cat8(Bt[n][0], Bt[n][1]), cat8(At[m][0], At[m][1]), acc[ai][bj][m][n], 0, 0, 0, 0x7f7f7f7f, 0, 0x7f7f7f7f); } else { \
        _Pragma("unroll") for (int m = 0; m < 4; ++m) _Pragma("unroll") for (int n = 0; n < 2; ++n) _Pragma("unroll") for (int k = 0; k < 2; ++k) \
        acc[ai][bj][m][n] = __builtin_amdgcn_mfma_f32_16x16x32_bf16(Bt[n][k], At[m][k], acc[ai][bj][m][n], 0, 0, 0); } __builtin_amdgcn_s_setprio(0); } while (0)
#define G8_WAIT_V(n) asm volatile("s_waitcnt vmcnt(" #n ")" ::: "memory")
#define G8_WAIT_L(n) asm volatile("s_waitcnt lgkmcnt(" #n ")" ::: "memory")
#define G8_BAR __builtin_amdgcn_s_barrier()
#define G8_SCHED __builtin_amdgcn_sched_barrier(0)
    Unit cur, nxt; int ui = 0;
    if (!P.next(0, cur)) return;
    f32x4 acc[2][2][4][2];
#pragma unroll
    for (int a = 0; a < 2; ++a)
#pragma unroll
        for (int b = 0; b < 2; ++b)
#pragma unroll
            for (int m = 0; m < 4; ++m)
#pragma unroll
                for (int n = 0; n < 2; ++n) acc[a][b][m][n] = (f32x4){0.f, 0.f, 0.f, 0.f};
    bf16x8 At[4][2], B0[2][2], B1[2][2];
    unsigned cvA[2][2];
    P.a_off(cur, 0, tid, cvA);
    const char* cA = P.a_base(cur);
    const char* cB = P.b_ptr(cur);
    G8_STAGE(G8_SB(0, 0), cB, voffB); G8_STAGE(G8_SB(0, 1), cB + hstepB, voffB); G8_STAGE(G8_SA(0, 0), cA, cvA[0]); G8_STAGE(G8_SA(0, 1), cA, cvA[1]);
    if (wr == 1) G8_BAR;
    G8_WAIT_V(2); G8_BAR;
    G8_STAGE(G8_SB(1, 0), cB + kstep, voffB); G8_STAGE(G8_SA(1, 0), cA + kstep, cvA[0]); G8_STAGE(G8_SB(1, 1), cB + hstepB + kstep, voffB);
    G8_WAIT_V(6); G8_BAR;
    for (;;) {
        const bool has_next = P.next(ui + 1, nxt);
        const char* nB = has_next ? P.b_ptr(nxt) : cB;
        const char* nA = has_next ? P.a_base(nxt) : cA;
        for (int t = 0; t < nt; t += 2) {
            const bool last = (t == nt - 2);
            const char* a1 = cA + (size_t)(t + 1) * kstep;
            const char* a2 = last ? nA : cA + (size_t)(t + 2) * kstep; const char* b2 = last ? nB : cB + (size_t)(t + 2) * kstep;
            const char* a3 = a2 + kstep; const char* b3 = b2 + kstep;
            G8_LDB(B0, 0, 0); G8_LDB(B1, 0, 1); G8_SCHED; G8_LDA(At, 0, 0); G8_STAGE(G8_SA(1, 1), a1, cvA[1]);
            G8_WAIT_V(8); G8_WAIT_L(0); G8_BAR; G8_MMA(0, 0, At, B0); G8_MMA(0, 1, At, B1); G8_BAR; G8_SCHED;
            if (last && has_next) { int tz = threadIdx.x; asm volatile("" : "+v"(tz)); P.a_off(nxt, ui + 1, tz, cvA); }
            G8_LDA(At, 0, 1); G8_STAGE(G8_SB(0, 0), b2, voffB); G8_STAGE(G8_SB(0, 1), b2 + hstepB, voffB); G8_STAGE(G8_SA(0, 0), a2, cvA[0]);
            G8_WAIT_V(8); G8_WAIT_L(0); G8_BAR; G8_MMA(1, 0, At, B0); G8_MMA(1, 1, At, B1); G8_BAR; G8_SCHED;
            G8_LDB(B0, 1, 0); G8_LDB(B1, 1, 1); G8_SCHED; G8_LDA(At, 1, 0); G8_STAGE(G8_SA(0, 1), a2, cvA[1]);
            G8_WAIT_V(8); G8_WAIT_L(0); G8_BAR; G8_MMA(0, 0, At, B0); G8_MMA(0, 1, At, B1); G8_BAR; G8_SCHED;
            G8_LDA(At, 1, 1); G8_STAGE(G8_SB(1, 0), b3, voffB); G8_STAGE(G8_SB(1, 1), b3 + hstepB, voffB); G8_STAGE(G8_SA(1, 0), a3, cvA[0]);
            G8_WAIT_V(8); G8_WAIT_L(0); G8_BAR; G8_MMA(1, 0, At, B0); G8_MMA(1, 1, At, B1); G8_BAR; G8_SCHED;
        }
        if (wr == 0) G8_BAR;
        P.epi(acc, cur, ui, wr, wc, fr, fq);
        if (!has_next) break;
#pragma unroll
        for (int a = 0; a < 2; ++a)
#pragma unroll
            for (int b = 0; b < 2; ++b)
#pragma unroll
                for (int m = 0; m < 4; ++m)
#pragma unroll
                    for (int n = 0; n < 2; ++n) acc[a][b][m][n] = (f32x4){0.f, 0.f, 0.f, 0.f};
        cur = nxt; cB = nB; cA = nA; ++ui;
        if (wr == 1) G8_BAR;
    }
    G8_WAIT_V(0);
    G8_BAR;
#undef G8_SA
#undef G8_SB
#undef G8_STAGE
#undef G8_LDA
#undef G8_LDB
#undef G8_MMA
#undef G8_WAIT_V
#undef G8_WAIT_L
#undef G8_BAR
#undef G8_SCHED
}


struct ProbIn {
    static constexpr bool PERM = true, FP8 = false;
    const char* A; const char* Bt; bf16* O; bf16* VT; int G, c; int dry;
    __device__ __forceinline__ static bool swapped(const Unit& u) { return u.pn >= 3 && u.pn <= 5; }
    __device__ __forceinline__ bool next(int i, Unit& u) const { return static_unit((long)i * G + c, TT / 256, NP / 256, u); }
    __device__ __forceinline__ void a_off(const Unit& u, int, int tid, unsigned (&v)[2][2]) const {
        int R0, C0, R1, C1; stage_rc(tid * 16, R0, C0); stage_rc(tid * 16 + 8192, R1, C1);
        const int rt = swapped(u) ? u.pn : u.pm;
#pragma unroll
        for (int h = 0; h < 2; ++h) { v[h][0] = (unsigned)((rt * 256 + h * 128 + R0) * KD + C0) * 2u; v[h][1] = (unsigned)((rt * 256 + h * 128 + R1) * KD + C1) * 2u; }
    }
    __device__ __forceinline__ const char* a_base(const Unit& u) const { return swapped(u) ? Bt : A; }
    __device__ __forceinline__ const char* b_ptr(const Unit& u) const { return swapped(u) ? A + (size_t)u.pm * 256 * KD * 2 : Bt + (size_t)u.pn * 256 * KD * 2; }
    __device__ __forceinline__ void epi(const f32x4 (&acc)[2][2][4][2], const Unit& u, int, int wr, int wc, int fr, int fq) const {
        if (PROBE_DRY && dry) { asm volatile("" :: "v"(acc[0][0][0][0][0]), "v"(acc[1][1][3][1][3]), "v"(acc[0][1][2][0][1]), "v"(acc[1][0][1][1][2])); return; }
        const bool sw = swapped(u);
        bf16* base = sw ? VT + (size_t)(u.pn * 256 - VT_C0 + wr * 64 + fr) * VTS + u.pm * 256 + wc * 32 + 8 * fq
                        : O + (size_t)(u.pm * 256 + wr * 64 + fr) * NP + u.pn * 256 + wc * 32 + 8 * fq;
        const size_t ld = sw ? (size_t)VTS : (size_t)NP;
#pragma unroll
        for (int ai = 0; ai < 2; ++ai)
#pragma unroll
            for (int m = 0; m < 4; ++m) { bf16* rowp = base + (size_t)(ai * 128 + m * 16) * ld;
#pragma unroll
                for (int bj = 0; bj < 2; ++bj) { const f32x4 v0 = acc[ai][bj][m][0], v1 = acc[ai][bj][m][1];
                    u32x4 w; w.x = cvt_pk_bf16(v0[0], v0[1]); w.y = cvt_pk_bf16(v0[2], v0[3]); w.z = cvt_pk_bf16(v1[0], v1[1]); w.w = cvt_pk_bf16(v1[2], v1[3]);
                    *(u32x4*)(rowp + bj * 128) = w; } }
    }
};
struct ProbOut {
    static constexpr bool PERM = false, FP8 = false;
    const char* A; const char* Bt; bf16* X; const float* modl  ; int G, c, nM, fpm, fpn;
    __device__ __forceinline__ bool next(int i, Unit& u) const { if (fpm >= 0) { u.pm = fpm; u.pn = fpn; u.e = 0; return i == 0; } return static_unit((long)i * G + c, nM, DM / 256, u); }
    __device__ __forceinline__ void a_off(const Unit& u, int, int tid, unsigned (&v)[2][2]) const {
        int R0, C0, R1, C1; stage_rc(tid * 16, R0, C0); stage_rc(tid * 16 + 8192, R1, C1);
#pragma unroll
        for (int h = 0; h < 2; ++h) { v[h][0] = (unsigned)((u.pm * 256 + h * 128 + R0) * KD + C0) * 2u; v[h][1] = (unsigned)((u.pm * 256 + h * 128 + R1) * KD + C1) * 2u; }
    }
    __device__ __forceinline__ const char* a_base(const Unit&) const { return A; }
    __device__ __forceinline__ const char* b_ptr(const Unit& u) const { return Bt + (size_t)u.pn * 256 * KD * 2; }
    __device__ __forceinline__ void epi(const f32x4 (&acc)[2][2][4][2], const Unit& u, int, int wr, int wc, int fr, int fq) const {
        const int r0 = u.pm * 256, br = r0 < TX ? (r0 / SEQ) : NB;
        const float* g1 = modl + (size_t)br * 6 * DM + 2 * DM;
        const int row0 = r0 + wr * 64 + fr, col0 = u.pn * 256 + wc * 32 + 4 * fq;
        f32x4 gv[2][2];
#pragma unroll
        for (int bj = 0; bj < 2; ++bj)
#pragma unroll
            for (int n = 0; n < 2; ++n) gv[bj][n] = *(const f32x4*)(g1 + col0 + bj * 128 + n * 16);
#pragma unroll
        for (int ai = 0; ai < 2; ++ai) {
            u32x2 xv[4][2][2];
#pragma unroll
            for (int m = 0; m < 4; ++m)
#pragma unroll
                for (int bj = 0; bj < 2; ++bj)
#pragma unroll
                    for (int n = 0; n < 2; ++n) xv[m][bj][n] = *(const u32x2*)(X + (size_t)(row0 + ai * 128 + m * 16) * DM + col0 + bj * 128 + n * 16);
#pragma unroll
            for (int m = 0; m < 4; ++m)
#pragma unroll
                for (int bj = 0; bj < 2; ++bj)
#pragma unroll
                    for (int n = 0; n < 2; ++n) { const u32x2 xw = xv[m][bj][n]; const f32x4 y = (f32x4){bflo(xw.x), bfhi(xw.x), bflo(xw.y), bfhi(xw.y)} + gv[bj][n] * acc[ai][bj][m][n];
                        u32x2 w; w.x = cvt_pk_bf16(y[0], y[1]); w.y = cvt_pk_bf16(y[2], y[3]);
                        *(u32x2*)(X + (size_t)(row0 + ai * 128 + m * 16) * DM + col0 + bj * 128 + n * 16) = w; }
        }
    }
};
__device__ __forceinline__ bool moe_unit(long L, int npn, const volatile LAS int* tp, Unit& u) {
    const int q = (int)(L / npn); if (q >= tp[NE]) return false;
    int e = 0;
#pragma unroll 1
    while (tp[e + 1] <= q) ++e;
    u.e = e; u.pm = q - tp[e]; u.pn = (int)(L % npn); return true;
}
struct ProbGU {
    static constexpr bool PERM = true, FP8 = (MOE_FP8 != 0); static constexpr unsigned EB = FP8 ? 1u : 2u;
    const char* A; const char* Bt  ; unsigned char* ACT; const float* bgu  ; const volatile LAS int* tp; const LAS int* tab; int G, c; int dry; const volatile LAS int* eb;
    __device__ __forceinline__ bool next(int i, Unit& u) const { return i < MAXU && moe_unit((long)i * G + c, 8, tp, u); }
    __device__ __forceinline__ void a_off(const Unit&, int ui, int tid, unsigned (&v)[2][2]) const {
        int R0, C0, R1, C1; stage_rc(tid * 16, R0, C0); stage_rc(tid * 16 + 8192, R1, C1);
#pragma unroll
        for (int h = 0; h < 2; ++h) { const int a0 = tab[ui * 256 + h * 128 + R0], a1 = tab[ui * 256 + h * 128 + R1];
            v[h][0] = (unsigned)(a0 < 0 ? TT : (a0 >> 2)) * (unsigned)KD * EB + (unsigned)C0 * 2u; v[h][1] = (unsigned)(a1 < 0 ? TT : (a1 >> 2)) * (unsigned)KD * EB + (unsigned)C1 * 2u; }
    }
    __device__ __forceinline__ const char* a_base(const Unit&) const { return A; }
    __device__ __forceinline__ const char* b_ptr(const Unit& u) const { return Bt + ((size_t)u.e * 2 * DM + (size_t)u.pn * 256) * KD * EB; }
    __device__ __forceinline__ void epi(const f32x4 (&acc)[2][2][4][2], const Unit& u, int ui, int wr, int wc, int fr, int fq) const {
        if (PROBE_DRY && dry) { asm volatile("" :: "v"(acc[0][0][0][0][0]), "v"(acc[1][1][3][1][3]), "v"(acc[0][1][2][0][1]), "v"(acc[1][0][1][1][2])); return; }
        const int cb = u.pn * 128 + wc * 32 + 8 * fq;
        const float* bg = bgu + (size_t)u.e * 2 * DM + cb; const float* bu = bg + DM;
        const f32x4 bg0 = *(const f32x4*)bg, bg1 = *(const f32x4*)(bg + 4), bu0 = *(const f32x4*)bu, bu1 = *(const f32x4*)(bu + 4);
        const int ebu = eb[u.e] + u.pm * 256;
#pragma unroll
        for (int ai = 0; ai < 2; ++ai)
#pragma unroll
            for (int m = 0; m < 4; ++m) {
                const int a = tab[ui * 256 + ai * 128 + wr * 64 + m * 16 + fr];
                unsigned char* rowp = ACT + ((size_t)(a < 0 ? SLOT_DUMMY : ebu + ai * 128 + wr * 64 + m * 16 + fr) * DM + cb) * EB;
                float o[8];
#pragma unroll
                for (int n = 0; n < 2; ++n) { const f32x4 gb = n ? bg1 : bg0, ub = n ? bu1 : bu0;
#pragma unroll
                    for (int j = 0; j < 4; ++j) { float g = acc[ai][0][m][n][j] * (FP8 ? W8_INV : 1.f) + gb[j], uu = acc[ai][1][m][n][j] * (FP8 ? W8_INV : 1.f) + ub[j];
                        g = fminf(g, 7.f); uu = fminf(fmaxf(uu, -7.f), 7.f);
                        o[n * 4 + j] = g * __builtin_amdgcn_rcpf(1.f + __expf(-1.702f * g)) * (uu + 1.f); } }
                if constexpr (FP8) { u32x2 w; w.x = pk4_fp8(o[0], o[1], o[2], o[3]); w.y = pk4_fp8(o[4], o[5], o[6], o[7]); *(u32x2*)rowp = w; }
                else { u32x4 w; w.x = cvt_pk_bf16(o[0], o[1]); w.y = cvt_pk_bf16(o[2], o[3]); w.z = cvt_pk_bf16(o[4], o[5]); w.w = cvt_pk_bf16(o[6], o[7]); *(u32x4*)rowp = w; } }
    }
};
struct ProbDN {
    static constexpr bool PERM = true, FP8 = (MOE_FP8 != 0); static constexpr unsigned EB = FP8 ? 1u : 2u;
    const char* A; const char* Bt  ; bf16* YB; const float* bdn  ; const float* gates  ; const volatile LAS int* tp; int G, c; int dry; const volatile LAS int* eb; const volatile LAS int* cntl;
    __device__ __forceinline__ bool next(int i, Unit& u) const { return i < MAXU && moe_unit((long)i * G + c, 4, tp, u); }
    __device__ __forceinline__ void a_off(const Unit& u, int, int tid, unsigned (&v)[2][2]) const {
        int R0, C0, R1, C1; stage_rc(tid * 16, R0, C0); stage_rc(tid * 16 + 8192, R1, C1);
        const int r0 = eb[u.e] + u.pm * 256;
#pragma unroll
        for (int h = 0; h < 2; ++h) { v[h][0] = (unsigned)(r0 + h * 128 + R0) * (unsigned)KD * EB + (unsigned)C0 * 2u; v[h][1] = (unsigned)(r0 + h * 128 + R1) * (unsigned)KD * EB + (unsigned)C1 * 2u; }
    }
    __device__ __forceinline__ const char* a_base(const Unit&) const { return A; }
    __device__ __forceinline__ const char* b_ptr(const Unit& u) const { return Bt + ((size_t)u.e * DM + (size_t)u.pn * 256) * KD * EB; }
    __device__ __forceinline__ void epi(const f32x4 (&acc)[2][2][4][2], const Unit& u, int ui, int wr, int wc, int fr, int fq) const {
        if (PROBE_DRY && dry) { asm volatile("" :: "v"(acc[0][0][0][0][0]), "v"(acc[1][1][3][1][3]), "v"(acc[0][1][2][0][1]), "v"(acc[1][0][1][1][2])); return; }
        const int col0 = u.pn * 256 + wc * 32 + 8 * fq;
        const float* bd = bdn + (size_t)u.e * DM + col0;
        f32x4 bv[2][2];
#pragma unroll
        for (int bj = 0; bj < 2; ++bj)
#pragma unroll
            for (int n = 0; n < 2; ++n) bv[bj][n] = *(const f32x4*)(bd + bj * 128 + 4 * n);
        int sl[2][4]; float gt[2][4]; const int ebu = eb[u.e] + u.pm * 256, nval = cntl[u.e] - u.pm * 256;
#pragma unroll
        for (int ai = 0; ai < 2; ++ai)
#pragma unroll
            for (int m = 0; m < 4; ++m) { const int rl = ai * 128 + wr * 64 + m * 16 + fr; sl[ai][m] = rl < nval ? ebu + rl : SLOT_DUMMY; gt[ai][m] = gates[sl[ai][m]]; }
#pragma unroll
        for (int ai = 0; ai < 2; ++ai)
#pragma unroll
            for (int m = 0; m < 4; ++m) {
                if constexpr (FP8) {
                    unsigned char* rowp = (unsigned char*)YB + (size_t)sl[ai][m] * DM + col0;
#pragma unroll
                    for (int bj = 0; bj < 2; ++bj) { const f32x4 v0 = (acc[ai][bj][m][0] * W8_INV + bv[bj][0]) * (gt[ai][m] * Y8_SCALE), v1 = (acc[ai][bj][m][1] * W8_INV + bv[bj][1]) * (gt[ai][m] * Y8_SCALE);
                        u32x2 w; w.x = pk4_fp8(v0[0], v0[1], v0[2], v0[3]); w.y = pk4_fp8(v1[0], v1[1], v1[2], v1[3]); *(u32x2*)(rowp + bj * 128) = w; }
                } else {
                    bf16* rowp = YB + (size_t)sl[ai][m] * DM + col0;
#pragma unroll
                    for (int bj = 0; bj < 2; ++bj) { const f32x4 v0 = (acc[ai][bj][m][0] + bv[bj][0]) * gt[ai][m], v1 = (acc[ai][bj][m][1] + bv[bj][1]) * gt[ai][m];
                        u32x4 w; w.x = cvt_pk_bf16(v0[0], v0[1]); w.y = cvt_pk_bf16(v0[2], v0[3]); w.z = cvt_pk_bf16(v1[0], v1[1]); w.w = cvt_pk_bf16(v1[2], v1[3]);
                        *(u32x4*)(rowp + bj * 128) = w; }
                } }
    }
};
}

struct Args { const float* in[23]; float* out; unsigned char* ws; int ph_lo, ph_hi; };
struct Frame {
    LAS unsigned char* lds; volatile LAS unsigned* MISC;
    int tid, lane, wave, G, vcu;
    const float *x, *c, *ctx, *c_ctx, *norm1_g, *norm2_g, *w_ada, *b_ada, *w_in, *gla_wa2, *gla_ba, *gla_norm_g, *na_rpb, *pool_w, *pool_scale, *w_out, *router_w, *router_b, *w_gu, *b_gu, *w_down, *b_down, *final_g;
    float* out; unsigned char* ws; unsigned* ctl;
    float* mod; bf16 *Bin, *Bout, *Bgu, *Bdn; bf16* X; bf16 *H, *P, *VTX, *VTC, *MIX; float *OF, *OB; bf16 *ACT, *YB; int* LIST; float* GATE; float *DS, *GD, *ROPE; bf16 *VTA, *OPS, *STB; unsigned char* H8; int* INV; float* GATES;
};


#define CAS __attribute__((address_space(4)))
__device__ __forceinline__ void frame_ptrs(Frame& F) {
    const CAS unsigned char* ka = (const CAS unsigned char*)__builtin_amdgcn_kernarg_segment_ptr();
    asm volatile("" : "+s"(ka));
    typedef const GAS float* gfp;
    const CAS gfp* in = (const CAS gfp*)ka;
    F.x = (const float*)in[0]; F.c = (const float*)in[1]; F.ctx = (const float*)in[2]; F.c_ctx = (const float*)in[3]; F.norm1_g = (const float*)in[4]; F.norm2_g = (const float*)in[5];
    F.w_ada = (const float*)in[6]; F.b_ada = (const float*)in[7]; F.w_in = (const float*)in[8]; F.gla_wa2 = (const float*)in[9]; F.gla_ba = (const float*)in[10]; F.gla_norm_g = (const float*)in[11];
    F.na_rpb = (const float*)in[12]; F.pool_w = (const float*)in[13]; F.pool_scale = (const float*)in[14]; F.w_out = (const float*)in[15]; F.router_w = (const float*)in[16]; F.router_b = (const float*)in[17];
    F.w_gu = (const float*)in[18]; F.b_gu = (const float*)in[19]; F.w_down = (const float*)in[20]; F.b_down = (const float*)in[21]; F.final_g = (const float*)in[22];
    F.out = (float*)*(GAS float* const CAS*)(ka + 184);
    GAS unsigned char* ws = *(GAS unsigned char* const CAS*)(ka + 192);
    F.ws = (unsigned char*)ws; F.ctl = (unsigned*)(ws + WS_CTL);
    F.mod = (float*)(ws + WS_MOD); F.Bin = (bf16*)(ws + WS_BIN); F.Bout = (bf16*)(ws + WS_BOUT); F.Bgu = (bf16*)(ws + WS_BGU); F.Bdn = (bf16*)(ws + WS_BDN);
    F.X = (bf16*)(ws + WS_X); F.H = (bf16*)(ws + WS_H); F.P = (bf16*)(ws + WS_P); F.VTX = (bf16*)(ws + WS_VTX); F.VTC = (bf16*)(ws + WS_VTC); F.MIX = (bf16*)(ws + WS_MIX);
    F.OF = (float*)(ws + WS_OF); F.OB = (float*)(ws + WS_OB); F.ACT = (bf16*)(ws + WS_ACT); F.YB = (bf16*)(ws + WS_YB); F.LIST = (int*)(ws + WS_LIST); F.GATE = (float*)(ws + WS_GATE);
    F.DS = (float*)(ws + WS_DS); F.GD = (float*)(ws + WS_GD); F.ROPE = (float*)(ws + WS_ROPE); F.VTA = (bf16*)(ws + WS_VTA); F.OPS = (bf16*)(ws + WS_OPS); F.STB = (bf16*)(ws + WS_STB); F.H8 = (unsigned char*)(ws + WS_H8); F.INV = (int*)(ws + WS_INV); F.GATES = (float*)(ws + WS_GATES);
}
static_assert(offsetof(Args, out) == 184 && offsetof(Args, ws) == 192, "Args layout");

__device__ __forceinline__ void in_col_map(int n0, int& dst, float& scale) {
    scale = 1.f;
    if (n0 < 192) { dst = C_GQ + n0; scale = 0.14433756729740643f; }
    else if (n0 < 384) dst = C_GK + (n0 - 192);
    else if (n0 < 768) dst = C_GV + (n0 - 384);
    else if (n0 < 800) dst = C_AF + (n0 - 768);
    else if (n0 < 1184) dst = C_GG + (n0 - 800);
    else if (n0 < 1568) { dst = C_NAQ + (n0 - 1184); scale = 0.125f * 1.4426950408889634f; }
    else if (n0 < 1952) dst = C_NAK + (n0 - 1568);
    else if (n0 < 2336) dst = C_NAV + (n0 - 1952);
    else dst = C_POOL + (n0 - 2336);
}
struct TItem { const float* src; int N; unsigned char* dst; int fp8; float scale; };
__device__ __forceinline__ TItem titem_decode(const Frame& F, int r) {
    constexpr int I_IN = DEPTH * 16 * 81, I_OUT = DEPTH * 16 * 32, I_GU = DEPTH * NE * 16 * 64;
    TItem t; t.fp8 = 0; t.scale = 1.f;
    if (r < I_IN) { const int l = r / (16 * 81), rr = r % (16 * 81), kb = rr / 81, nb = rr % 81; int dst; in_col_map(nb * 32, dst, t.scale);
        t.N = 2592; t.src = F.w_in + (size_t)l * DM * 2592 + (size_t)(kb * 64) * 2592 + nb * 32; t.dst = (unsigned char*)(F.Bin + ((size_t)l * NP + dst) * DM + kb * 64); return t; }
    r -= I_IN;
    if (r < I_OUT) { const int l = r / (16 * 32), rr = r % (16 * 32), kb = rr / 32, nb = rr % 32;
        t.N = DM; t.src = F.w_out + (size_t)l * DM * DM + (size_t)(kb * 64) * DM + nb * 32; t.dst = (unsigned char*)(F.Bout + ((size_t)l * DM + nb * 32) * DM + kb * 64); return t; }
    r -= I_OUT; t.fp8 = MOE_FP8; constexpr size_t EB = MOE_FP8 ? 1 : 2;
    if (r < I_GU) { const int le = r / (16 * 64), rr = r % (16 * 64), kb = rr / 64, nb = rr % 64; const int j0 = nb * 32;
        const int dst = j0 < DM ? (j0 / 128) * 256 + (j0 % 128) : ((j0 - DM) / 128) * 256 + 128 + ((j0 - DM) % 128);
        t.N = 2 * DM; t.src = F.w_gu + (size_t)le * DM * 2 * DM + (size_t)(kb * 64) * 2 * DM + j0; t.dst = (unsigned char*)F.Bgu + (((size_t)le * 2 * DM + dst) * DM + kb * 64) * EB; return t; }
    r -= I_GU;
    { const int le = r / (16 * 32), rr = r % (16 * 32), kb = rr / 32, nb = rr % 32;
        t.N = DM; t.src = F.w_down + (size_t)le * DM * DM + (size_t)(kb * 64) * DM + nb * 32; t.dst = (unsigned char*)F.Bdn + (((size_t)le * DM + nb * 32) * DM + kb * 64) * EB; return t; }
}
__device__ __forceinline__ void titem_load(const TItem& t, int lane, f32x4 (&r)[8]) {
#pragma unroll
    for (int i = 0; i < 8; ++i) r[i] = __builtin_nontemporal_load((const f32x4*)(t.src + (size_t)((lane >> 3) + 8 * i) * t.N + 4 * (lane & 7)));
}
__device__ __forceinline__ void titem_store(const TItem& t, const f32x4 (&r)[8], LAS float* scr, int lane) {
#pragma unroll
    for (int i = 0; i < 8; ++i) { LAS float* p = scr + ((lane >> 3) + 8 * i) * 33 + 4 * (lane & 7); p[0] = r[i].x; p[1] = r[i].y; p[2] = r[i].z; p[3] = r[i].w; }
    LDS_WAIT(); asm volatile("" ::: "memory");
    if (t.fp8) { const int c = lane & 3; const float sc = W8_SCALE;
#pragma unroll
        for (int j = 0; j < 2; ++j) { const int n = (lane >> 2) + 16 * j; const LAS float* s = scr + (16 * c) * 33 + n;
            u32x4 o;
            o.x = pk4_fp8(s[0 * 33] * sc, s[1 * 33] * sc, s[2 * 33] * sc, s[3 * 33] * sc); o.y = pk4_fp8(s[4 * 33] * sc, s[5 * 33] * sc, s[6 * 33] * sc, s[7 * 33] * sc);
            o.z = pk4_fp8(s[8 * 33] * sc, s[9 * 33] * sc, s[10 * 33] * sc, s[11 * 33] * sc); o.w = pk4_fp8(s[12 * 33] * sc, s[13 * 33] * sc, s[14 * 33] * sc, s[15 * 33] * sc);
            *(u32x4*)(t.dst + (size_t)n * DM + 16 * c) = o; }
    } else { const int c = lane & 7; const float sc = t.scale;
#pragma unroll
        for (int j = 0; j < 4; ++j) { const int n = (lane >> 3) + 8 * j; const LAS float* s = scr + (8 * c) * 33 + n;
            u32x4 o; o.x = pk2(s[0 * 33] * sc, s[1 * 33] * sc); o.y = pk2(s[2 * 33] * sc, s[3 * 33] * sc); o.z = pk2(s[4 * 33] * sc, s[5 * 33] * sc); o.w = pk2(s[6 * 33] * sc, s[7 * 33] * sc);
            *(u32x4*)(t.dst + ((size_t)n * DM + 8 * c) * 2) = o; }
    }
    LDS_WAIT(); asm volatile("" ::: "memory");
}
__device__ __forceinline__ int conv_item_id(int t, int lay, int nfix) {
    constexpr int I_IN = DEPTH * 16 * 81, I_OUT = DEPTH * 16 * 32, I_GU = DEPTH * NE * 16 * 64;
    if (t < nfix) return t;
    t -= nfix;
    return t < NE * 16 * 64 ? I_IN + I_OUT + lay * (NE * 16 * 64) + t : I_IN + I_OUT + I_GU + lay * (NE * 16 * 32) + (t - NE * 16 * 64);
}
__device__ __forceinline__ void convert_items(Frame& F, int lay, int ntot, int t0 = 0, int t1 = -1) {
    LAS float* scr = (LAS float*)(F.lds + F.wave * 16384);
    const int gw = F.vcu * NWAVES + F.wave, NGW = F.G * NWAVES, lane = F.lane;
    const int nfix = ntot - 3 * (NE * 16 * 32);
    if (t1 >= 0) ntot = t1;
    int it = t0 + gw; TItem cur = titem_decode(F, conv_item_id(it < ntot ? it : 0, lay, nfix)); f32x4 ra[8];
    if (it < ntot) titem_load(cur, lane, ra);
    while (it < ntot) {
        const int itn = it + NGW; const bool hn = itn < ntot;
        TItem nxt = titem_decode(F, conv_item_id(hn ? itn : 0, lay, nfix)); f32x4 rb[8];
        if (hn) titem_load(nxt, lane, rb);
        titem_store(cur, ra, scr, lane);
        it = itn; cur = nxt;
#pragma unroll
        for (int i = 0; i < 8; ++i) ra[i] = rb[i];
    }
}
#ifndef CONV_QN
#define CONV_QN 2
#endif
#ifndef CONV_QD
#define CONV_QD 3
#endif
__device__ __forceinline__ int lds_grab(LAS int* c, int lane) {
    int j = 0;
    if (lane == 0) j = __hip_atomic_fetch_add(c, 1, __ATOMIC_RELAXED, __HIP_MEMORY_SCOPE_WORKGROUP);
    return __builtin_amdgcn_readfirstlane(j);
}
__device__ __forceinline__ void convert_dyn(Frame& F, int lay, LAS int* cnt, int nper, int quota) {
    LAS float* scr = (LAS float*)(F.lds + F.wave * 16384);
    const int lane = F.lane;
    int ja = lds_grab(cnt, lane); bool more = ja < quota;
    int jb = more ? lds_grab(cnt, lane) : nper; more = more && jb < quota;
    TItem ta = titem_decode(F, conv_item_id(F.vcu + F.G * (ja < nper ? ja : 0), lay, 0)), tb = titem_decode(F, conv_item_id(F.vcu + F.G * (jb < nper ? jb : 0), lay, 0));
    f32x4 ra[8], rb[8];
    if (ja < nper) titem_load(ta, lane, ra);
    if (jb < nper) titem_load(tb, lane, rb);
    while (ja < nper) {
        const int jc = more ? lds_grab(cnt, lane) : nper; more = more && jc < quota;
        TItem tc = titem_decode(F, conv_item_id(F.vcu + F.G * (jc < nper ? jc : 0), lay, 0)); f32x4 rc[8];
        if (jc < nper) titem_load(tc, lane, rc);
        titem_store(ta, ra, scr, lane);
        ja = jb; jb = jc; ta = tb; tb = tc;
#pragma unroll
        for (int i = 0; i < 8; ++i) { ra[i] = rb[i]; rb[i] = rc[i]; }
    }
}
__device__ __forceinline__ void ph_prologue(Frame& F) {
    const int gw = F.vcu * NWAVES + F.wave, NGW = F.G * NWAVES, lane = F.lane;
    constexpr int I_IN = DEPTH * 16 * 81, I_OUT = DEPTH * 16 * 32;
    for (int r = F.vcu; r < DEPTH * 24; r += F.G) {
        const int l = r / 24, j4 = (r % 24) * 256 + 4 * lane, k0 = F.wave * 128;
        const float* W = F.w_ada + (size_t)l * DM * 6 * DM + (size_t)k0 * 6 * DM + j4;
        f32x4 acc[9];
#pragma unroll
        for (int q = 0; q < 9; ++q) acc[q] = (f32x4){0.f, 0.f, 0.f, 0.f};
#pragma unroll 1
        for (int kh = 0; kh < 2; ++kh) {
            float cv[9];
#pragma unroll
            for (int q = 0; q < 8; ++q) cv[q] = silu_f(F.c[q * DM + k0 + 64 * kh + lane]);
            cv[8] = silu_f(F.c_ctx[k0 + 64 * kh + lane]);
#pragma unroll 8
            for (int kk = 0; kk < 64; ++kk) { const f32x4 w = *(const f32x4*)(W + (size_t)(64 * kh + kk) * 6 * DM);
#pragma unroll
                for (int q = 0; q < 9; ++q) acc[q] += __builtin_bit_cast(float, __builtin_amdgcn_readlane(__builtin_bit_cast(int, cv[q]), kk)) * w; }
        }
        LAS float* part = (LAS float*)F.lds;
#pragma unroll
        for (int q = 0; q < 9; ++q) *(LAS f32x4*)(part + (F.wave * 9 + q) * 256 + 4 * lane) = acc[q];
        __syncthreads();
        for (int o = F.tid; o < 9 * 256; o += NTHREADS) { const int q = o >> 8, cc = o & 255; float sum = F.b_ada[(size_t)l * 6 * DM + (r % 24) * 256 + cc];
#pragma unroll
            for (int w = 0; w < NWAVES; ++w) sum += part[(w * 9 + q) * 256 + cc];
            F.mod[((size_t)l * 9 + q) * 6 * DM + (r % 24) * 256 + cc] = sum; }
        __syncthreads();
    }
    convert_items(F, 0, I_IN + I_OUT + 3 * (NE * 16 * 32), 0, I_IN + I_OUT);
#if GLA_CHECK
    for (int lay = 0; lay < DEPTH; ++lay) convert_items(F, lay, 3 * (NE * 16 * 32));
#endif
    if (F.vcu == 0) for (int i = F.tid; i < 64 * 12; i += NTHREADS) { const int pos = i / 12, fi = i % 12;
        const float invf = expf(-((float)(2 * fi) / 24.f) * 9.210340371976184f); const float ang = (float)pos * invf; F.ROPE[i] = cosf(ang); F.ROPE[768 + i] = sinf(ang); }
    const size_t gt = (size_t)F.vcu * NTHREADS + F.tid, NGT = (size_t)F.G * NTHREADS;
    for (size_t i = gt; i < (size_t)DEPTH * 224 * DM / 8; i += NGT) { const size_t l = i / (224 * DM / 8), rr = i % (224 * DM / 8);
        *(u32x4*)(F.Bin + (l * NP + 2592) * DM + rr * 8) = (u32x4){0u, 0u, 0u, 0u}; }
    for (size_t i = gt; i < (size_t)256 * DM / 8; i += NGT) *(u32x4*)(F.H + (size_t)TT * DM + i * 8) = (u32x4){0u, 0u, 0u, 0u};
    for (size_t i = gt; i < (size_t)256 * DM / 16; i += NGT) *(u32x4*)(F.H8 + (size_t)TT * DM + i * 16) = (u32x4){0u, 0u, 0u, 0u};
}

__device__ __forceinline__ void norm_mod_store(const f32x4 (&v)[4], const float* gw, const float* sc, const float* sh, bf16* orow, int lane) {
    float s = 0.f;
#pragma unroll
    for (int j = 0; j < 4; ++j) s += (v[j].x * v[j].x + v[j].y * v[j].y) + (v[j].z * v[j].z + v[j].w * v[j].w);
    const float rinv = 1.f / sqrtf(wave_sum(s) * (1.f / DM) + EPS);
#pragma unroll
    for (int j = 0; j < 4; ++j) { const int c = 4 * lane + 256 * j;
        const f32x4 g = *(const f32x4*)(gw + c), a = *(const f32x4*)(sc + c), b = *(const f32x4*)(sh + c);
        const f32x4 y = (v[j] * rinv * g) * (a + 1.f) + b;
        u32x2 w; w.x = pk2(y.x, y.y); w.y = pk2(y.z, y.w);
        *(u32x2*)(orow + c) = w; }
}
__device__ __forceinline__ void ph_first_norm(Frame& F) {
    const int gw = F.vcu * NWAVES + F.wave, NGW = F.G * NWAVES, lane = F.lane;
    for (int m = gw; m < TT; m += NGW) {
        const float* src = m < TX ? F.x + (size_t)m * DM : F.ctx + (size_t)(m - TX) * DM;
        const int br = m < TX ? m / SEQ : NB;
        f32x4 v[4];
#pragma unroll
        for (int j = 0; j < 4; ++j) { v[j] = *(const f32x4*)(src + 4 * lane + 256 * j); u32x2 w; w.x = pk2(v[j].x, v[j].y); w.y = pk2(v[j].z, v[j].w); *(u32x2*)(F.X + (size_t)m * DM + 4 * lane + 256 * j) = w; }
        const float* md = F.mod + (size_t)br * 6 * DM;
        norm_mod_store(v, F.norm1_g, md + DM, md, F.H + (size_t)m * DM, lane);
    }
}
__device__ __forceinline__ void ph_combine(Frame& F, int l, bool dry = false) {
    const int gw = F.vcu * NWAVES + F.wave, NGW = F.G * NWAVES, lane = F.lane;
    bf16* Xo = dry ? (bf16*)F.ACT : F.X; bf16* Ho = dry ? (bf16*)F.P : F.H; float* Oo = dry ? (float*)F.ACT : F.out;
    const int M = (l == DEPTH - 1) ? TX : TT;
    const int cA = 8 * lane, cB = 512 + 8 * lane;
    for (int m0 = gw; m0 < M; m0 += 2 * NGW) {
        u32x4 yw[2][4][2]; u32x4 xw[2][2]; bool have[2]; int br[2];
#pragma unroll
        for (int rr = 0; rr < 2; ++rr) { const int m = m0 + rr * NGW; have[rr] = m < M; const int mm = have[rr] ? m : m0; br[rr] = mm < TX ? mm / SEQ : NB;
            const u32x4 sl4 = *(const u32x4*)(F.INV + (size_t)mm * 4); const unsigned slk[4] = {sl4.x, sl4.y, sl4.z, sl4.w};
#pragma unroll
            for (int k = 0; k < 4; ++k) {
                if (MOE_FP8) { const unsigned char* yr = (const unsigned char*)F.YB + (size_t)slk[k] * DM; const u32x2 a = *(const u32x2*)(yr + cA), b = *(const u32x2*)(yr + cB);
                    yw[rr][k][0] = (u32x4){a.x, a.y, 0u, 0u}; yw[rr][k][1] = (u32x4){b.x, b.y, 0u, 0u}; }
                else { yw[rr][k][0] = *(const u32x4*)(F.YB + (size_t)slk[k] * DM + cA); yw[rr][k][1] = *(const u32x4*)(F.YB + (size_t)slk[k] * DM + cB); } }
            const bf16* xr = F.X + (size_t)mm * DM;
            xw[rr][0] = *(const u32x4*)(xr + cA); xw[rr][1] = *(const u32x4*)(xr + cB); }
#pragma unroll
        for (int rr = 0; rr < 2; ++rr) { if (!have[rr]) continue;
            const int m = m0 + rr * NGW;
            const float* md = F.mod + ((size_t)l * 9 + br[rr]) * 6 * DM;
            f32x4 y[4];
#pragma unroll
            for (int j = 0; j < 4; ++j) y[j] = (f32x4){0.f, 0.f, 0.f, 0.f};
#pragma unroll
            for (int k = 0; k < 4; ++k) { const u32x4 a = yw[rr][k][0], b = yw[rr][k][1];
                if (MOE_FP8) { const f32x2 a0 = __builtin_amdgcn_cvt_pk_f32_fp8((int)a.x, false), a1 = __builtin_amdgcn_cvt_pk_f32_fp8((int)a.x, true), a2 = __builtin_amdgcn_cvt_pk_f32_fp8((int)a.y, false), a3 = __builtin_amdgcn_cvt_pk_f32_fp8((int)a.y, true);
                    const f32x2 b0 = __builtin_amdgcn_cvt_pk_f32_fp8((int)b.x, false), b1 = __builtin_amdgcn_cvt_pk_f32_fp8((int)b.x, true), b2 = __builtin_amdgcn_cvt_pk_f32_fp8((int)b.y, false), b3 = __builtin_amdgcn_cvt_pk_f32_fp8((int)b.y, true);
                    y[0] += (f32x4){a0.x, a0.y, a1.x, a1.y}; y[1] += (f32x4){a2.x, a2.y, a3.x, a3.y}; y[2] += (f32x4){b0.x, b0.y, b1.x, b1.y}; y[3] += (f32x4){b2.x, b2.y, b3.x, b3.y}; }
                else { y[0] += (f32x4){bflo(a.x), bfhi(a.x), bflo(a.y), bfhi(a.y)}; y[1] += (f32x4){bflo(a.z), bfhi(a.z), bflo(a.w), bfhi(a.w)};
                    y[2] += (f32x4){bflo(b.x), bfhi(b.x), bflo(b.y), bfhi(b.y)}; y[3] += (f32x4){bflo(b.z), bfhi(b.z), bflo(b.w), bfhi(b.w)}; } }
            if (MOE_FP8) {
#pragma unroll
                for (int j = 0; j < 4; ++j) y[j] *= Y8_INV; }
            const int cc[4] = {cA, cA + 4, cB, cB + 4};
            f32x4 v[4]; float ss = 0.f;
            const f32x4 xv4[4] = {(f32x4){bflo(xw[rr][0].x), bfhi(xw[rr][0].x), bflo(xw[rr][0].y), bfhi(xw[rr][0].y)}, (f32x4){bflo(xw[rr][0].z), bfhi(xw[rr][0].z), bflo(xw[rr][0].w), bfhi(xw[rr][0].w)},
                                  (f32x4){bflo(xw[rr][1].x), bfhi(xw[rr][1].x), bflo(xw[rr][1].y), bfhi(xw[rr][1].y)}, (f32x4){bflo(xw[rr][1].z), bfhi(xw[rr][1].z), bflo(xw[rr][1].w), bfhi(xw[rr][1].w)}};
#pragma unroll
            for (int j = 0; j < 4; ++j) { v[j] = xv4[j] + *(const f32x4*)(md + 5 * DM + cc[j]) * y[j]; ss += (v[j].x * v[j].x + v[j].y * v[j].y) + (v[j].z * v[j].z + v[j].w * v[j].w); }
            const float rinv = 1.f / sqrtf(wave_sum(ss) * (1.f / DM) + EPS);
            if (l < DEPTH - 1) {
                { u32x4 x0, x1; x0.x = pk2(v[0].x, v[0].y); x0.y = pk2(v[0].z, v[0].w); x0.z = pk2(v[1].x, v[1].y); x0.w = pk2(v[1].z, v[1].w);
                  x1.x = pk2(v[2].x, v[2].y); x1.y = pk2(v[2].z, v[2].w); x1.z = pk2(v[3].x, v[3].y); x1.w = pk2(v[3].z, v[3].w);
                  *(u32x4*)(Xo + (size_t)m * DM + cA) = x0; *(u32x4*)(Xo + (size_t)m * DM + cB) = x1; }
                const float* mn = F.mod + ((size_t)(l + 1) * 9 + br[rr]) * 6 * DM; const float* gw1 = F.norm1_g + (size_t)(l + 1) * DM;
                f32x4 h[4];
#pragma unroll
                for (int j = 0; j < 4; ++j) h[j] = (v[j] * rinv * *(const f32x4*)(gw1 + cc[j])) * (*(const f32x4*)(mn + DM + cc[j]) + 1.f) + *(const f32x4*)(mn + cc[j]);
                u32x4 w0, w1; w0.x = pk2(h[0].x, h[0].y); w0.y = pk2(h[0].z, h[0].w); w0.z = pk2(h[1].x, h[1].y); w0.w = pk2(h[1].z, h[1].w);
                w1.x = pk2(h[2].x, h[2].y); w1.y = pk2(h[2].z, h[2].w); w1.z = pk2(h[3].x, h[3].y); w1.w = pk2(h[3].z, h[3].w);
                *(u32x4*)(Ho + (size_t)m * DM + cA) = w0; *(u32x4*)(Ho + (size_t)m * DM + cB) = w1;
            } else {
#pragma unroll
                for (int j = 0; j < 4; ++j) { f32x4 o = v[j] * rinv * *(const f32x4*)(F.final_g + cc[j]);
#if GLA_CHECK
                    if (__hip_atomic_load(F.ctl + 64, __ATOMIC_RELAXED, __HIP_MEMORY_SCOPE_AGENT) != 0u) { const float q = __builtin_nanf(""); o = (f32x4){q, q, q, q}; }
#endif
                    *(f32x4*)(Oo + (size_t)m * DM + cc[j]) = o; }
            }
        }
    }
}

constexpr int PL_U = 0, PL_P = 49152, PL_LD = 264, PREP_PW = 81920, PW_LD = 72, PREP_PS = PREP_PW + 4 * 64 * PW_LD * 2;
static_assert(PREP_PS + 1024 <= STAGE_BYTES && PL_P + 32 * PL_LD * 2 <= PREP_PW, "pool LDS map");
__device__ __forceinline__ void pool_unit(Frame& F, int l, int u) {
    LAS float* U = (LAS float*)(F.lds + PL_U);
    LAS bf16* PL = (LAS bf16*)(F.lds + PL_P);
    const LAS bf16* PW = (const LAS bf16*)(F.lds + PREP_PW); const LAS float* PS = (const LAS float*)(F.lds + PREP_PS);
    const int tid = F.tid;
    int s, tb, seqbase, tlen;
    if (u < NB * 128) { s = u / 128; tb = u % 128; seqbase = s * SEQ; tlen = SEQ; } else { const int v = u - NB * 128; s = v / 8; tb = v % 8; seqbase = TX + s * CTXL; tlen = CTXL; }
    const int t0 = tb * 32;
    for (int i = tid; i < 48 * 32; i += NTHREADS) { const int rr = i / 32, ch = i % 32, t = t0 - 8 + rr;
        f32x4 a = (f32x4){0.f, 0.f, 0.f, 0.f}, b = a;
        if (t >= 0 && t < tlen) { const u32x4 w = *(const u32x4*)(F.P + (size_t)(seqbase + t) * NP + C_POOL + ch * 8);
            a = (f32x4){bflo(w.x), bfhi(w.x), bflo(w.y), bfhi(w.y)}; b = (f32x4){bflo(w.z), bfhi(w.z), bflo(w.w), bfhi(w.w)}; }
        *(LAS f32x4*)(U + rr * 256 + ch * 8) = a; *(LAS f32x4*)(U + rr * 256 + ch * 8 + 4) = b; }
    __syncthreads();
    { const int tt = tid >> 4, cg = tid & 15, g = cg >> 2, w = 2 << g, t = t0 + tt;
      int lo = t - w / 2; if (lo < 0) lo = 0; int hi = t + w - w / 2; if (hi > tlen) hi = tlen;
      const float inv = 1.f / (float)(hi - lo);
      f32x4 sum[4];
#pragma unroll
      for (int q4 = 0; q4 < 4; ++q4) sum[q4] = (f32x4){0.f, 0.f, 0.f, 0.f};
      for (int jj = lo; jj < hi; ++jj) {
#pragma unroll
          for (int q4 = 0; q4 < 4; ++q4) sum[q4] += *(const LAS f32x4*)(U + (jj - t0 + 8) * 256 + cg * 16 + 4 * q4); }
      u32x4 w0, w1;
      { const f32x4 y0 = sum[0] * inv - *(const LAS f32x4*)(U + (tt + 8) * 256 + cg * 16), y1 = sum[1] * inv - *(const LAS f32x4*)(U + (tt + 8) * 256 + cg * 16 + 4);
        const f32x4 y2 = sum[2] * inv - *(const LAS f32x4*)(U + (tt + 8) * 256 + cg * 16 + 8), y3 = sum[3] * inv - *(const LAS f32x4*)(U + (tt + 8) * 256 + cg * 16 + 12);
        w0.x = pk2(y0.x, y0.y); w0.y = pk2(y0.z, y0.w); w0.z = pk2(y1.x, y1.y); w0.w = pk2(y1.z, y1.w);
        w1.x = pk2(y2.x, y2.y); w1.y = pk2(y2.z, y2.w); w1.z = pk2(y3.x, y3.y); w1.w = pk2(y3.z, y3.w); }
      *(LAS u32x4*)(PL + tt * PL_LD + cg * 16) = w0; *(LAS u32x4*)(PL + tt * PL_LD + cg * 16 + 8) = w1; }
    __syncthreads();
    { const int lane = F.lane, q = lane & 15, g4 = lane >> 4;
#pragma unroll
      for (int k = 0; k < 4; ++k) { const int ti = F.wave * 4 + k, mt = ti & 1, ct = ti >> 1, g = ct >> 2, ot = ct & 3;
          f32x4 acc = (f32x4){0.f, 0.f, 0.f, 0.f};
#pragma unroll
          for (int s2 = 0; s2 < 2; ++s2) { const bf16x8 a = *(const LAS bf16x8*)(PW + (g * 64 + 16 * ot + q) * PW_LD + 32 * s2 + 8 * g4), b = *(const LAS bf16x8*)(PL + (16 * mt + q) * PL_LD + g * 64 + 32 * s2 + 8 * g4);
              acc = __builtin_amdgcn_mfma_f32_16x16x32_bf16(a, b, acc, 0, 0, 0); }
          const f32x4 y = acc * *(const LAS f32x4*)(PS + g * 64 + 16 * ot + 4 * g4);
          u32x2 w; w.x = pk2(y.x, y.y); w.y = pk2(y.z, y.w);
          *(u32x2*)(F.MIX + (size_t)(seqbase + t0 + 16 * mt + q) * DM + 768 + g * 64 + 16 * ot + 4 * g4) = w; } }
    __syncthreads();
}
#if GLA_CHECK
__device__ __forceinline__ void gla_chain(Frame& F, int l, int u) {
    const int tid = F.tid;
    const int dir = u & 1, hh = (u >> 1) & 3, b = u >> 3;
    LAS float* qs = (LAS float*)F.lds;
    LAS float* ks = qs + 64 * 48;
    LAS float* as = ks + 64 * 48;
    LAS float* vs = as + 64 * 48;
    LAS float* os = vs + 64 * 96;
    LAS float* rc = os + 64 * 96;
    LAS float* rs = rc + 64 * 12;
    LAS float* wa = rs + 64 * 12;
    LAS float* ba = wa + 16 * 48;
    for (int i = tid; i < 64 * 12; i += NTHREADS) { const int pos = i / 12, fi = i % 12;
        const float invf = expf(-((float)(2 * fi) / 24.f) * 9.210340371976184f);
        const float ang = (float)pos * invf; rc[i] = cosf(ang); rs[i] = sinf(ang); }
    for (int i = tid; i < 16 * 48; i += NTHREADS) { const int r = i / 48, d = i % 48; wa[i] = F.gla_wa2[(((size_t)l * 2 + dir) * 16 + r) * 192 + hh * 48 + d]; }
    if (tid < 48) ba[tid] = F.gla_ba[((size_t)l * 2 + dir) * 192 + hh * 48 + tid];
    __syncthreads();
    float S[12];
#pragma unroll
    for (int i = 0; i < 12; ++i) S[i] = 0.f;
    const int vv = tid >> 2, dg = tid & 3;
    float* Odir = dir ? F.OB : F.OF;
    const bool need_ctx = l < DEPTH - 1;
    for (int cidx = 0; cidx < 4 + 64; ++cidx) {
        const bool isctx = cidx < 4;
        const int nch = isctx ? 4 : 64, ci0 = isctx ? cidx : cidx - 4, ci = dir ? (nch - 1 - ci0) : ci0;
        const int seqbase = isctx ? TX + b * CTXL : b * SEQ, t0 = ci * 64;
        for (int i = tid; i < 64 * 2 * 2 * 12; i += NTHREADS) {
            const int fi = i % 12, hf = (i / 12) & 1, isk = (i / 24) & 1, j = i / 48;
            const bf16* row = F.P + (size_t)(seqbase + t0 + j) * NP + (isk ? C_GK : C_GQ) + hh * 48 + hf * 24;
            const float x1 = bf2f(row[fi]), x2 = bf2f(row[12 + fi]);
            float o1 = x1, o2 = x2;
            if (!isctx) { const int t = t0 + j, pos = hf ? (t % GRIDW) : (t / GRIDW); const float cs = rc[pos * 12 + fi], sn = rs[pos * 12 + fi]; o1 = x1 * cs - x2 * sn; o2 = x1 * sn + x2 * cs; }
            LAS float* dst = (isk ? ks : qs) + j * 48 + hf * 24;
            dst[fi] = o1; dst[12 + fi] = o2; }
        for (int i = tid; i < 64 * 48; i += NTHREADS) { const int j = i / 48, d = i % 48;
            const bf16* row = F.P + (size_t)(seqbase + t0 + j) * NP + (dir ? C_AB : C_AF);
            float z = ba[d];
#pragma unroll
            for (int r = 0; r < 16; ++r) z += bf2f(row[r]) * wa[r * 48 + d];
            const float ls = fminf(z, 0.f) - log1pf(expf(-fabsf(z)));
            as[i] = expf(ls * (1.f / 16.f)); }
        for (int i = tid; i < 64 * 96; i += NTHREADS) { const int j = i / 96, d = i % 96; vs[i] = bf2f(F.VTA[(size_t)(384 + hh * 96 + d) * VTS + seqbase + t0 + j]); }
        __syncthreads();
        if (tid < 384) {
            for (int st = 0; st < 64; ++st) {
                const int j = dir ? 63 - st : st;
                const float vj = vs[j * 96 + vv];
                float part = 0.f;
#pragma unroll
                for (int q4 = 0; q4 < 3; ++q4) {
                    const f32x4 a4 = *(const LAS f32x4*)(as + j * 48 + dg * 12 + q4 * 4), k4 = *(const LAS f32x4*)(ks + j * 48 + dg * 12 + q4 * 4), qq = *(const LAS f32x4*)(qs + j * 48 + dg * 12 + q4 * 4);
#pragma unroll
                    for (int e = 0; e < 4; ++e) { const float sn = a4[e] * S[q4 * 4 + e] + k4[e] * vj; S[q4 * 4 + e] = sn; part += qq[e] * sn; } }
                part += __shfl_xor(part, 1); part += __shfl_xor(part, 2);
                if (dg == 0) os[j * 96 + vv] = part;
            }
        }
        __syncthreads();
        if (!isctx || need_ctx)
            for (int i = tid; i < 64 * 96; i += NTHREADS) { const int j = i / 96, d = i % 96; Odir[(size_t)(seqbase + t0 + j) * 384 + hh * 96 + d] = os[i]; }
        __syncthreads();
    }
}

#endif
typedef float f32x16 __attribute__((ext_vector_type(16)));
constexpr int GL_BF = 0, GL_BB = 12288, GL_WA = 24576, GL_VT = 31232, GL_KEF = 45056, GL_KEB = 51968;
constexpr int GL_QF = 45056, GL_KF = 52224, GL_QB = 59392, GL_KB = 66560, GL_STF = 73728, GL_STB = 84480, GL_O = 95232;
constexpr int VT_LD = 72, QK_LD = 56, ST_LD = 56, O_LD = 100, NCH = 68;
struct GlaU { int b, hh, cpos, seqbase, t0, isctx; };
__device__ __forceinline__ GlaU gla_unit_geom(int u) { GlaU g; g.cpos = u % NCH; g.hh = (u / NCH) & 3; g.b = u / (NCH * 4); g.isctx = g.cpos < 4;
    const int ci = g.isctx ? g.cpos : g.cpos - 4; g.seqbase = g.isctx ? TX + g.b * CTXL : g.b * SEQ; g.t0 = ci * 64; return g; }
__device__ __forceinline__ void gla_rope_pair(const Frame& F, const GlaU& g, const bf16* row, int j, int hf, int fi, float& o1, float& o2) {
    const float x1 = bf2f(row[fi]), x2 = bf2f(row[12 + fi]); o1 = x1; o2 = x2;
    if (!g.isctx) { const int t = g.t0 + j, pos = hf ? (t % GRIDW) : (t / GRIDW); const float cs = F.ROPE[pos * 12 + fi], sn = F.ROPE[768 + pos * 12 + fi]; o1 = x1 * cs - x2 * sn; o2 = x1 * sn + x2 * cs; }
}
constexpr int G1_BF = 0, G1_BB = 12288, G1_KEF = 24576, G1_KEB = 31488, G1_OPS = 38400;
constexpr int PREP_WA = TAB_OFF;
__device__ __forceinline__ void gla_g1_unit(Frame& F, int l, int u) {
    const GlaU g = gla_unit_geom(u);
    LAS bf16* kef = (LAS bf16*)(F.lds + G1_KEF); LAS bf16* keb = (LAS bf16*)(F.lds + G1_KEB); LAS bf16* ops = (LAS bf16*)(F.lds + G1_OPS);
    const LAS float* wa = (const LAS float*)(F.lds + PREP_WA) + g.hh * 1536; const LAS float* ba = (const LAS float*)(F.lds + PREP_WA) + 6144 + g.hh * 96;
    const bf16* vtg = F.VTA + (size_t)(384 + g.hh * 96) * VTS + g.seqbase + g.t0;
    const int tid = F.tid, lane = F.lane, j = lane, w = F.wave;
    const bf16* prow = F.P + (size_t)(g.seqbase + g.t0 + j) * NP;
    u32x4 araw[4];
#pragma unroll
    for (int q4 = 0; q4 < 4; ++q4) araw[q4] = *(const u32x4*)(prow + C_AF + 8 * q4);
    float q1[3], q2[3], k1[3], k2[3], cs[3], sn[3];
#pragma unroll
    for (int e = 0; e < 3; ++e) { const int p = 3 * w + e, hf = p / 12, fi = p % 12, cb = g.hh * 48 + hf * 24 + fi;
        q1[e] = bf2f(prow[C_GQ + cb]); q2[e] = bf2f(prow[C_GQ + cb + 12]); k1[e] = bf2f(prow[C_GK + cb]); k2[e] = bf2f(prow[C_GK + cb + 12]);
        const int t = g.t0 + j, pos = hf ? (t % GRIDW) : (t / GRIDW);
        cs[e] = g.isctx ? 1.f : F.ROPE[pos * 12 + fi]; sn[e] = g.isctx ? 0.f : F.ROPE[768 + pos * 12 + fi]; }
    float a[32];
#pragma unroll
    for (int q4 = 0; q4 < 4; ++q4) { const u32x4 x = araw[q4]; a[q4 * 8 + 0] = bflo(x.x); a[q4 * 8 + 1] = bfhi(x.x); a[q4 * 8 + 2] = bflo(x.y); a[q4 * 8 + 3] = bfhi(x.y);
        a[q4 * 8 + 4] = bflo(x.z); a[q4 * 8 + 5] = bfhi(x.z); a[q4 * 8 + 6] = bflo(x.w); a[q4 * 8 + 7] = bfhi(x.w); }
    float bf[3][2], bb[3][2];
#pragma unroll
    for (int e = 0; e < 3; ++e)
#pragma unroll
        for (int wh = 0; wh < 2; ++wh) { const int p = 3 * w + e, d = (p / 12) * 24 + p % 12 + 12 * wh;
            float zf = ba[d], zb = ba[48 + d];
#pragma unroll
            for (int r = 0; r < 16; ++r) { zf += a[r] * wa[r * 48 + d]; zb += a[16 + r] * wa[(16 + r) * 48 + d]; }
            const float xf = (fminf(zf, 0.f) - __logf(1.f + __expf(-fabsf(zf)))) * (1.f / 16.f), xb = (fminf(zb, 0.f) - __logf(1.f + __expf(-fabsf(zb)))) * (1.f / 16.f);
            bf[e][wh] = wave_scan_incl(xf);
            const float ab = wave_scan_incl(xb);
            bb[e][wh] = __int_as_float(__builtin_amdgcn_readlane(__float_as_int(ab), 63)) - ab + xb; }
#pragma unroll
    for (int e = 0; e < 3; ++e) { const int p = 3 * w + e, d1 = (p / 12) * 24 + p % 12, d2 = d1 + 12;
        const float qa = q1[e] * cs[e] - q2[e] * sn[e], qb = q1[e] * sn[e] + q2[e] * cs[e], ka = k1[e] * cs[e] - k2[e] * sn[e], kb = k1[e] * sn[e] + k2[e] * cs[e];
        const float f1 = bf[e][0], f2 = bf[e][1], b1 = bb[e][0], b2 = bb[e][1];
        const float fe1 = __builtin_bit_cast(float, __builtin_amdgcn_readlane(__builtin_bit_cast(int, f1), 63)), fe2 = __builtin_bit_cast(float, __builtin_amdgcn_readlane(__builtin_bit_cast(int, f2), 63));
        const float be1 = __builtin_bit_cast(float, __builtin_amdgcn_readlane(__builtin_bit_cast(int, b1), 0)), be2 = __builtin_bit_cast(float, __builtin_amdgcn_readlane(__builtin_bit_cast(int, b2), 0));
        const float ef1 = __expf(f1), ef2 = __expf(f2), eb1 = __expf(b1), eb2 = __expf(b2), nf1 = __expf(-f1), nf2 = __expf(-f2), nb1 = __expf(-b1), nb2 = __expf(-b2);
        ops[j * 48 + d1] = (bf16)f2bf(qa * ef1); ops[j * 48 + d2] = (bf16)f2bf(qb * ef2); ops[3072 + j * 48 + d1] = (bf16)f2bf(ka * nf1); ops[3072 + j * 48 + d2] = (bf16)f2bf(kb * nf2);
        ops[6144 + j * 48 + d1] = (bf16)f2bf(qa * eb1); ops[6144 + j * 48 + d2] = (bf16)f2bf(qb * eb2); ops[9216 + j * 48 + d1] = (bf16)f2bf(ka * nb1); ops[9216 + j * 48 + d2] = (bf16)f2bf(kb * nb2);
        const float ge1 = __expf(fe1), ge2 = __expf(fe2), he1 = __expf(be1), he2 = __expf(be2);
        kef[d1 * VT_LD + j] = (bf16)f2bf(ka * nf1 * ge1); kef[d2 * VT_LD + j] = (bf16)f2bf(kb * nf2 * ge2);
        keb[d1 * VT_LD + j] = (bf16)f2bf(ka * nb1 * he1); keb[d2 * VT_LD + j] = (bf16)f2bf(kb * nb2 * he2);
        if (lane == 0) { float* gd = F.GD + (((size_t)(g.b * 4 + g.hh) * 2) * NCH + g.cpos) * 48; gd[d1] = ge1; gd[d2] = ge2; gd[(size_t)NCH * 48 + d1] = he1; gd[(size_t)NCH * 48 + d2] = he2; } }
    __syncthreads();
    { const int q = lane & 15, g4 = lane >> 4;
      for (int ti = F.wave; ti < 36; ti += NWAVES) { const int dir = ti / 18, dt = (ti % 18) / 6, vtile = ti % 6;
          const LAS bf16* ke = dir ? keb : kef;
          f32x4 acc = (f32x4){0.f, 0.f, 0.f, 0.f};
#pragma unroll
          for (int s2 = 0; s2 < 2; ++s2) { const bf16x8 av = *(const LAS bf16x8*)(ke + (16 * dt + q) * VT_LD + 32 * s2 + 8 * g4), bv = *(const bf16x8*)(vtg + (size_t)(16 * vtile + q) * VTS + 32 * s2 + 8 * g4);
              acc = __builtin_amdgcn_mfma_f32_16x16x32_bf16(av, bv, acc, 0, 0, 0); }
          *(f32x4*)(F.DS + ((((size_t)(g.b * 4 + g.hh) * 2 + dir) * NCH + g.cpos) * 96 + 16 * vtile + q) * 48 + 16 * dt + 4 * g4) = acc; } }
    { u32x4* dst = (u32x4*)(F.OPS + (size_t)u * 12288);
      for (int i = tid; i < 1536; i += NTHREADS) dst[i] = *(const LAS u32x4*)(ops + i * 8); }
    __syncthreads();
}
__device__ __forceinline__ void gla_g2_unit(Frame& F, int u) {
    const int chain = u >> 2, qt = u & 3, dir = chain & 1, tid = F.tid;
    const float* ds = F.DS + (size_t)chain * NCH * 4608; const float* gd = F.GD + (size_t)chain * NCH * 48; bf16* stb = F.STB + (size_t)chain * NCH * 4608;
    const int e0 = qt * 1152 + 2 * tid, e1 = qt * 1152 + 1024 + 2 * tid; const bool h1 = tid < 64;
    const int d0 = e0 % 48, d1 = h1 ? e1 % 48 : 0;
    f32x2 S0 = (f32x2){0.f, 0.f}, S1 = (f32x2){0.f, 0.f};
    for (int st0 = 0; st0 < NCH; st0 += 4) {
        f32x2 x0[4], x1[4], g0[4], g1[4]; int cp[4];
#pragma unroll
        for (int k = 0; k < 4; ++k) { const int st = st0 + k; cp[k] = st < 4 ? (dir ? 3 - st : st) : (dir ? 4 + (67 - st) : st);
            const float* p = ds + (size_t)cp[k] * 4608; const float* gp = gd + cp[k] * 48;
            x0[k] = *(const f32x2*)(p + e0); g0[k] = *(const f32x2*)(gp + d0);
            if (h1) { x1[k] = *(const f32x2*)(p + e1); g1[k] = *(const f32x2*)(gp + d1); } else { x1[k] = (f32x2){0.f, 0.f}; g1[k] = x1[k]; } }
#pragma unroll
        for (int k = 0; k < 4; ++k) { bf16* p = stb + (size_t)cp[k] * 4608;
            *(unsigned*)(p + e0) = pk2(S0.x, S0.y); if (h1) *(unsigned*)(p + e1) = pk2(S1.x, S1.y);
            S0 = g0[k] * S0 + x0[k]; S1 = g1[k] * S1 + x1[k]; }
    }
}
__device__ __forceinline__ void gla_g3_wave(Frame& F, int l, int wu) {
    const int u = wu >> 1, it = wu & 1;
    const GlaU g = gla_unit_geom(u);
    const int lane = F.lane, r = lane & 31, h = lane >> 5;
    const bf16* ops = F.OPS + (size_t)u * 12288 + 16 * 0 + 8 * h;
    const bf16* vtg = F.VTA + (size_t)(384 + g.hh * 96) * VTS + g.seqbase + g.t0;
    const bf16* stf = F.STB + ((((size_t)(g.b * 4 + g.hh) * 2 + 0) * NCH + g.cpos) * 4608) + 8 * h; const bf16* stbk = stf + (size_t)NCH * 4608;
    LAS float* O = (LAS float*)(F.lds + F.wave * 16384);
    bf16x8 qf[3], qb[3];
#pragma unroll
    for (int s3 = 0; s3 < 3; ++s3) { qf[s3] = *(const bf16x8*)(ops + (32 * it + r) * 48 + 16 * s3); qb[s3] = *(const bf16x8*)(ops + 6144 + (32 * it + r) * 48 + 16 * s3); }
    f32x16 X[2];
#pragma unroll
    for (int jt = 0; jt < 2; ++jt) {
        f32x16 xf, xb;
#pragma unroll
        for (int e = 0; e < 16; ++e) { xf[e] = 0.f; xb[e] = 0.f; }
        if (jt <= it) {
#pragma unroll
            for (int s3 = 0; s3 < 3; ++s3) xf = __builtin_amdgcn_mfma_f32_32x32x16_bf16(*(const bf16x8*)(ops + 3072 + (32 * jt + r) * 48 + 16 * s3), qf[s3], xf, 0, 0, 0); }
        if (jt >= it) {
#pragma unroll
            for (int s3 = 0; s3 < 3; ++s3) xb = __builtin_amdgcn_mfma_f32_32x32x16_bf16(*(const bf16x8*)(ops + 9216 + (32 * jt + r) * 48 + 16 * s3), qb[s3], xb, 0, 0, 0); }
        if (jt == it) {
#pragma unroll
            for (int e = 0; e < 16; ++e) { const int jl = (e & 3) + 8 * (e >> 2) + 4 * h; X[jt][e] = (jl <= r ? xf[e] : 0.f) + (jl >= r ? xb[e] : 0.f); }
        } else X[jt] = jt < it ? xf : xb;
    }
    f32x16 o[3];
#pragma unroll
    for (int vt = 0; vt < 3; ++vt)
#pragma unroll
        for (int e = 0; e < 16; ++e) o[vt][e] = 0.f;
#pragma unroll
    for (int jt = 0; jt < 2; ++jt)
#pragma unroll
        for (int s2 = 0; s2 < 2; ++s2) {
            u32x4 aw; aw.x = pk2(X[jt][8 * s2 + 0], X[jt][8 * s2 + 1]); aw.y = pk2(X[jt][8 * s2 + 2], X[jt][8 * s2 + 3]); aw.z = pk2(X[jt][8 * s2 + 4], X[jt][8 * s2 + 5]); aw.w = pk2(X[jt][8 * s2 + 6], X[jt][8 * s2 + 7]);
#pragma unroll
            for (int vt = 0; vt < 3; ++vt) {
                const bf16* vr = vtg + (size_t)(32 * vt + r) * VTS + 32 * jt + 16 * s2 + 4 * h;
                const u32x2 lo = *(const u32x2*)vr, hi = *(const u32x2*)(vr + 8);
                const u32x4 bw = (u32x4){lo.x, lo.y, hi.x, hi.y};
                o[vt] = __builtin_amdgcn_mfma_f32_32x32x16_bf16(__builtin_bit_cast(bf16x8, aw), __builtin_bit_cast(bf16x8, bw), o[vt], 0, 0, 0); } }
#pragma unroll
    for (int s3 = 0; s3 < 3; ++s3)
#pragma unroll
        for (int vt = 0; vt < 3; ++vt) {
            o[vt] = __builtin_amdgcn_mfma_f32_32x32x16_bf16(qf[s3], *(const bf16x8*)(stf + (32 * vt + r) * 48 + 16 * s3), o[vt], 0, 0, 0);
            o[vt] = __builtin_amdgcn_mfma_f32_32x32x16_bf16(qb[s3], *(const bf16x8*)(stbk + (32 * vt + r) * 48 + 16 * s3), o[vt], 0, 0, 0); }
#pragma unroll
    for (int vt = 0; vt < 3; ++vt)
#pragma unroll
        for (int e = 0; e < 16; ++e) O[((e & 3) + 8 * (e >> 2) + 4 * h) * O_LD + 32 * vt + r] = o[vt][e];
    LDS_WAIT(); asm volatile("" ::: "memory");
    { const int i = lane >> 1, half = lane & 1; const size_t row = (size_t)(g.seqbase + g.t0 + 32 * it + i);
      f32x4 ov[12]; float ss = 0.f;
#pragma unroll
      for (int e = 0; e < 12; ++e) { ov[e] = *(const LAS f32x4*)(O + i * O_LD + half * 48 + 4 * e); ss += (ov[e].x * ov[e].x + ov[e].y * ov[e].y) + (ov[e].z * ov[e].z + ov[e].w * ov[e].w); }
      ss = dpp_addp<0xB1>(ss);
      const float rinv = 1.f / sqrtf(ss * (1.f / 96.f) + EPS);
      const float* ng = F.gla_norm_g + (size_t)l * 384 + g.hh * 96 + half * 48;
      const u32x4* gp = (const u32x4*)(F.P + row * NP + C_GG + g.hh * 96 + half * 48);
      u32x4* dst = (u32x4*)(F.MIX + row * DM + g.hh * 96 + half * 48);
#if GLA_CHECK
      { float sn = 0.f; const float* pf = F.OF + row * 384 + g.hh * 96 + half * 48; const float* pb = F.OB + row * 384 + g.hh * 96 + half * 48;
#pragma unroll
        for (int e = 0; e < 48; ++e) { const float on = pf[e] + pb[e]; sn += on * on; }
        sn += __shfl_xor(sn, 1);
        const float rms = sqrtf(sn * (1.f / 96.f)) + 1e-6f; int bad = 0;
#pragma unroll
        for (int e = 0; e < 48; ++e) { const float on = pf[e] + pb[e]; if (!(fabsf(ov[e >> 2][e & 3] - on) <= 0.03f * rms + 0.03f * fabsf(on))) ++bad; }
        if (bad) atomicAdd(F.ctl + 64, (unsigned)bad); }
#endif
#pragma unroll
      for (int q6 = 0; q6 < 6; ++q6) { const u32x4 gw = gp[q6]; const f32x4 n0 = *(const f32x4*)(ng + 8 * q6), n1 = *(const f32x4*)(ng + 8 * q6 + 4); const f32x4 a = ov[2 * q6], b = ov[2 * q6 + 1];
          u32x4 w;
          w.x = pk2(a.x * rinv * n0.x * silu_f(bflo(gw.x)), a.y * rinv * n0.y * silu_f(bfhi(gw.x))); w.y = pk2(a.z * rinv * n0.z * silu_f(bflo(gw.y)), a.w * rinv * n0.w * silu_f(bfhi(gw.y)));
          w.z = pk2(b.x * rinv * n1.x * silu_f(bflo(gw.z)), b.y * rinv * n1.y * silu_f(bfhi(gw.z))); w.w = pk2(b.z * rinv * n1.z * silu_f(bflo(gw.w)), b.w * rinv * n1.w * silu_f(bfhi(gw.w)));
          dst[q6] = w; } }
    LDS_WAIT(); asm volatile("" ::: "memory");
}
__device__ __forceinline__ void ph_gla3(Frame& F, int l) {
    const bool need_ctx = l < DEPTH - 1;
    const int gw = F.vcu * NWAVES + F.wave, NGW = F.G * NWAVES;
    for (int wu = gw; wu < NB * GH * NCH * 2; wu += NGW) { if (!need_ctx && ((wu >> 1) % NCH) < 4) continue; gla_g3_wave(F, l, wu); }
}
__device__ __forceinline__ void ph_prep(Frame& F, int l) {
    const bool need_ctx = l < DEPTH - 1;
    const int tid = F.tid;
#if GLA_CHECK
    for (int u = F.vcu; u < NB * GH * 2; u += F.G) gla_chain(F, l, u);
    __syncthreads();
#endif
    { LAS float* wa = (LAS float*)(F.lds + PREP_WA);
      for (int i = tid; i < 4 * 2 * 16 * 48; i += NTHREADS) { const int hh = i / 1536, dir = (i / 768) & 1, r = (i / 48) % 16, d = i % 48; wa[i] = F.gla_wa2[(((size_t)l * 2 + dir) * 16 + r) * 192 + hh * 48 + d]; }
      for (int i = tid; i < 4 * 2 * 48; i += NTHREADS) { const int hh = i / 96, dir = (i / 48) & 1, d = i % 48; wa[6144 + i] = F.gla_ba[((size_t)l * 2 + dir) * 192 + hh * 48 + d]; }
      LAS bf16* pw = (LAS bf16*)(F.lds + PREP_PW); LAS float* ps = (LAS float*)(F.lds + PREP_PS);
      for (int i = tid; i < 4 * 64 * 64; i += NTHREADS) { const int g = i >> 12, ii = (i >> 6) & 63, o = i & 63; pw[(g * 64 + o) * PW_LD + ii] = (bf16)f2bf(F.pool_w[(size_t)l * 16384 + i]); }
      if (tid < 256) ps[tid] = F.pool_scale[(size_t)l * 256 + tid]; }
    __syncthreads();
    const int NPOOL = NB * 128 + (need_ctx ? NB * 8 : 0), NG1 = NB * GH * NCH, NMIX = 3 * NPOOL;
    for (int k = F.vcu; k < NG1 + NPOOL; k += F.G) {
        if (k < NMIX) { if (k % 3 == 2) pool_unit(F, l, k / 3); else gla_g1_unit(F, l, (k / 3) * 2 + k % 3); }
        else gla_g1_unit(F, l, 2 * NPOOL + (k - NMIX));
    }
}

#define NA_LOG2E 1.4426950408889634f
__device__ __forceinline__ float na_max4(float x) {
    const auto r = __builtin_amdgcn_permlane16_swap(__float_as_uint(x), __float_as_uint(x), false, false);
    x = fmaxf(__uint_as_float(r[0]), __uint_as_float(r[1]));
    const auto t = __builtin_amdgcn_permlane32_swap(__float_as_uint(x), __float_as_uint(x), false, false);
    return fmaxf(__uint_as_float(t[0]), __uint_as_float(t[1]));
}
__device__ __forceinline__ float na_sum4(float x) {
    const auto r = __builtin_amdgcn_permlane16_swap(__float_as_uint(x), __float_as_uint(x), false, false);
    x = __uint_as_float(r[0]) + __uint_as_float(r[1]);
    const auto t = __builtin_amdgcn_permlane32_swap(__float_as_uint(x), __float_as_uint(x), false, false);
    return __uint_as_float(t[0]) + __uint_as_float(t[1]);
}
struct NaCtx {
    __amdgpu_buffer_rsrc_t rP, rV; unsigned voffK, voffV; int b, cw, r0, krlo, nnb; const LAS float* rpb; unsigned bidx[2][4];
    bf16x8 qa[4][2]; float mrun[4], lsum[4]; f32x4 o[4][4];
};
__device__ __forceinline__ int na_segtok(const NaCtx& C, int sg) { return sg < C.nnb ? C.b * SEQ + (C.krlo + sg) * GRIDW + C.cw : TX + C.b * CTXL + 32 * (sg - C.nnb); }
__device__ __forceinline__ void na_load(const NaCtx& C, int sg, bf16x8 (&kb)[2][2], bf16x8 (&vb)[4]) {
    const int tok = na_segtok(C, sg);
#pragma unroll
    for (int par = 0; par < 2; ++par)
#pragma unroll
        for (int s2 = 0; s2 < 2; ++s2) kb[par][s2] = __builtin_bit_cast(bf16x8, __builtin_amdgcn_raw_buffer_load_b128(C.rP, C.voffK, (unsigned)((tok + 4 * par) * (NP * 2) + 64 * s2), 0));
#pragma unroll
    for (int dt = 0; dt < 4; ++dt) vb[dt] = __builtin_bit_cast(bf16x8, __builtin_amdgcn_raw_buffer_load_b128(C.rV, C.voffV, (unsigned)((16 * dt * VTS + tok) * 2), 0));
}
template <bool LATENT>
__device__ __forceinline__ void na_segment(NaCtx& C, int sg, int lane, const bf16x8 (&kb)[2][2], const bf16x8 (&vb)[4]) {
    const int g = lane >> 4;
    const bool nb = LATENT && sg < C.nnb;
    const int kr = C.krlo + sg;
#pragma unroll
    for (int i = 0; i < 4; ++i) {
        if (nb) { const int ri = C.r0 + i, rsi = ri - 4 < 0 ? 0 : (ri - 4 > 56 ? 56 : ri - 4); if (kr < rsi || kr > rsi + 7) continue; }
        float bv[2][4];
        if (nb) { const unsigned rowoff = (unsigned)((kr - (C.r0 + i) + 7) * 32 * 4);
#pragma unroll
            for (int par = 0; par < 2; ++par)
#pragma unroll
                for (int rg = 0; rg < 4; ++rg) bv[par][rg] = *(const LAS float*)((const LAS char*)C.rpb + rowoff + C.bidx[par][rg]); }
        f32x4 st[2];
#pragma unroll
        for (int par = 0; par < 2; ++par) {
            f32x4 a = nb ? (f32x4){bv[par][0], bv[par][1], bv[par][2], bv[par][3]} : (f32x4){0.f, 0.f, 0.f, 0.f};
#pragma unroll
            for (int s2 = 0; s2 < 2; ++s2) a = __builtin_amdgcn_mfma_f32_16x16x32_bf16(kb[par][s2], C.qa[i][s2], a, 0, 0, 0);
            st[par] = a;
        }
        float mx = fmaxf(fmaxf(fmaxf(st[0][0], st[0][1]), fmaxf(st[0][2], st[0][3])), fmaxf(fmaxf(st[1][0], st[1][1]), fmaxf(st[1][2], st[1][3])));
        mx = na_max4(mx);
        if (__any(mx > C.mrun[i] + 8.f)) {
            const float mnew = fmaxf(C.mrun[i], mx), alpha = __builtin_amdgcn_exp2f(C.mrun[i] - mnew);
            C.lsum[i] *= alpha; C.mrun[i] = mnew;
#pragma unroll
            for (int rg = 0; rg < 4; ++rg) { const float ar = __shfl(alpha, 4 * g + rg);
#pragma unroll
                for (int dt = 0; dt < 4; ++dt) C.o[i][dt][rg] *= ar; }
        }
        float psum = 0.f;
#pragma unroll
        for (int par = 0; par < 2; ++par)
#pragma unroll
            for (int rg = 0; rg < 4; ++rg) { const float p = __builtin_amdgcn_exp2f(st[par][rg] - C.mrun[i]); st[par][rg] = p; psum += p; }
        C.lsum[i] += na_sum4(psum);
        u32x4 pw; pw.x = cvt_pk_bf16(st[0][0], st[0][1]); pw.y = cvt_pk_bf16(st[0][2], st[0][3]); pw.z = cvt_pk_bf16(st[1][0], st[1][1]); pw.w = cvt_pk_bf16(st[1][2], st[1][3]);
        const bf16x8 pa = __builtin_bit_cast(bf16x8, pw);
#pragma unroll
        for (int dt = 0; dt < 4; ++dt) C.o[i][dt] = __builtin_amdgcn_mfma_f32_16x16x32_bf16(pa, vb[dt], C.o[i][dt], 0, 0, 0);
    }
}
#ifndef NA_DRYMODE
#define NA_DRYMODE 0
#endif
template <bool LATENT>
__device__ __forceinline__ void na_unit(Frame& F, int l, int u, const LAS float* rpb_lds, bool dry = false) {
    const int lane = F.lane, q = lane & 15, g = lane >> 4;
    NaCtx C;
    int hh, c0 = 0, qrow0, qstep;
    if (LATENT) { const int cb = u & 3, rg4 = (u >> 2) & 15; hh = (u >> 6) % NH; C.b = u / (64 * NH); c0 = cb * 16; C.r0 = rg4 * 4; qrow0 = C.b * SEQ + C.r0 * GRIDW + c0; qstep = GRIDW;
        const int rs0 = C.r0 - 4 < 0 ? 0 : (C.r0 - 4 > 56 ? 56 : C.r0 - 4), r3 = C.r0 + 3, rs3 = r3 - 4 < 0 ? 0 : (r3 - 4 > 56 ? 56 : r3 - 4);
        C.krlo = rs0; C.nnb = rs3 + 7 - rs0 + 1; }
    else { const int qi = u & 3; hh = (u >> 2) % NH; C.b = u / (4 * NH); qrow0 = TX + C.b * CTXL + qi * 64; qstep = 16; C.r0 = 0; C.krlo = 0; C.nnb = 0; }
    C.cw = c0 == 0 ? 0 : (c0 == 48 ? 32 : c0 - 8);
    const int c = c0 + q; const int start = c - 8 < 0 ? 0 : (c - 8 > 48 ? 48 : c - 8);
    C.rpb = rpb_lds + hh * 15 * 32;
    C.rP = __builtin_amdgcn_make_buffer_rsrc((void*)F.P, 0, (int)((size_t)TT * NP * 2), 0x00020000);
    C.rV = __builtin_amdgcn_make_buffer_rsrc((void*)F.VTA, 0, (int)((size_t)VT_NC * VTS * 2), 0x00020000);
    const int koff = 8 * (q >> 2) + (q & 3);
    C.voffK = (unsigned)((koff * NP + C_NAK + hh * NDH + 8 * g) * 2);
    C.voffV = (unsigned)(((hh * NDH + q) * VTS + 8 * g) * 2);
#pragma unroll
    for (int par = 0; par < 2; ++par)
#pragma unroll
        for (int rg = 0; rg < 4; ++rg) { const int kc = C.cw + 8 * g + rg + 4 * par; const bool valid = (kc >= start) && (kc < start + 16);
            C.bidx[par][rg] = (unsigned)((valid ? kc - c + 15 : 31) * 4); }
#pragma unroll
    for (int i = 0; i < 4; ++i) {
#pragma unroll
        for (int s2 = 0; s2 < 2; ++s2) C.qa[i][s2] = *(const bf16x8*)(F.P + (size_t)(qrow0 + i * qstep + q) * NP + C_NAQ + hh * NDH + 32 * s2 + 8 * g);
        C.mrun[i] = -1e30f; C.lsum[i] = 0.f;
#pragma unroll
        for (int dt = 0; dt < 4; ++dt) C.o[i][dt] = (f32x4){0.f, 0.f, 0.f, 0.f}; }
    const int nseg = C.nnb + 8;
    bf16x8 k0[2][2], v0[4], k1[2][2], v1[4];
    na_load(C, 0, k0, v0);
#pragma unroll 1
    for (int sg = 0; sg < nseg; sg += 2) {
        if (sg + 1 < nseg) na_load(C, sg + 1, k1, v1);
        na_segment<LATENT>(C, sg, lane, k0, v0);
        if (sg + 2 < nseg) na_load(C, sg + 2, k0, v0);
        if (sg + 1 < nseg) na_segment<LATENT>(C, sg + 1, lane, k1, v1);
    }
    bf16* mixb = dry ? (bf16*)F.VTC : F.MIX;
#pragma unroll
    for (int i = 0; i < 4; ++i)
#pragma unroll
        for (int rg = 0; rg < 4; ++rg) { const float li = 1.f / __shfl(C.lsum[i], 4 * g + rg);
            bf16* orow = mixb + (size_t)(dry ? 0 : (qrow0 + i * qstep + 4 * g + rg)) * DM + 384 + hh * NDH + q;
#pragma unroll
            for (int dt = 0; dt < 4; ++dt) orow[16 * dt] = (bf16)f2bf(C.o[i][dt][rg] * li); }
}
__device__ __forceinline__ void ph_attn(Frame& F, int l) {
    const bool need_ctx = l < DEPTH - 1;
    const int gw = F.vcu * NWAVES + F.wave, NGW = F.G * NWAVES;
    LAS float* rpb = (LAS float*)(F.lds + TAB_OFF);
    for (int i = F.tid; i < NH * 15 * 32; i += NTHREADS) { const int col = i & 31, hr = i >> 5; rpb[i] = col < 31 ? F.na_rpb[((size_t)l * NH * 15 + hr) * 31 + col] * NA_LOG2E : -1e30f; }
    LAS int* ccnt = (LAS int*)(F.lds + MISC_OFF + 240 * 4);
    if (F.tid == 0) *ccnt = 0;
    __syncthreads();
    for (int rep = 0; rep < REPS(11); ++rep)
    for (int u = F.vcu; u < NB * GH * 2 * 4; u += F.G) gla_g2_unit(F, u);
    const bool bg = !GLA_CHECK;
    constexpr int NCONV = 3 * (NE * 16 * 32), NLAT = NB * NH * 16 * 4, NCTXU = NB * NH * 4;
    const int nper = (NCONV - F.vcu + F.G - 1) / F.G;
    if (bg && (F.wave & 1)) convert_dyn(F, l, ccnt, nper, nper * CONV_QN / CONV_QD);
    for (int rep = 0; rep < REPS(12); ++rep) {
    { const int nfull = NLAT / NGW, per = (NLAT - nfull * NGW + F.G - 1) / F.G, slot = (F.wave & 1) ? 4 + (F.wave >> 1) : (F.wave >> 1);
      for (int k = 0; k <= nfull; ++k) { const int u = k < nfull ? gw + k * NGW : (slot < per ? nfull * NGW + F.vcu * per + slot : NLAT);
          if (u < NLAT) na_unit<true>(F, l, u, rpb, rep + 1 < REPS(12)); } }
    if (need_ctx) { const int nfull = NCTXU / NGW, per = (NCTXU - nfull * NGW + F.G - 1) / F.G, slot = (F.wave & 1) ? (F.wave >> 1) : 4 + (F.wave >> 1);
      for (int k = 0; k <= nfull; ++k) { const int u = k < nfull ? gw + k * NGW : (slot < per ? nfull * NGW + F.vcu * per + slot : NCTXU);
          if (u < NCTXU) na_unit<false>(F, l, u, rpb, rep + 1 < REPS(12)); } } }
    if (bg) convert_dyn(F, l, ccnt, nper, nper);
}
constexpr int RW_LD = 1032;
static_assert(2 * NE * RW_LD * 2 <= STAGE_BYTES, "router LDS");
__device__ __forceinline__ unsigned f2key(float f, int e) { unsigned u = __builtin_bit_cast(unsigned, f); u = (u & 0x80000000u) ? ~u : (u | 0x80000000u); return (u & ~31u) | (unsigned)(31 - e); }
__device__ __forceinline__ float key2f(unsigned k) { unsigned u = k & ~31u; u = (u & 0x80000000u) ? (u & 0x7fffffffu) : ~u; return __builtin_bit_cast(float, u); }
__device__ __forceinline__ void ph_router(Frame& F, int l, int tok0, int tok1, bool dry = false) {
    const int tid = F.tid, lane = F.lane, q = lane & 15, g = lane >> 4;
    LAS bf16* WH = (LAS bf16*)F.lds; LAS bf16* WL = WH + NE * RW_LD;
    LAS int* lcount = (LAS int*)(F.lds + MISC_OFF + 64 * 4);
    volatile LAS int* lbase = (volatile LAS int*)(F.MISC + 96);
    LAS int* apos = (LAS int*)(F.lds + TAB_OFF);
    const float* rw = F.router_w + (size_t)l * DM * NE;
    for (int i = tid; i < DM * NE; i += NTHREADS) { const int c = i >> 5, e = i & 31; const float w = rw[i]; const unsigned hi = f2bf(w); const unsigned lo = f2bf(w - bf2f(hi));
        WH[e * RW_LD + c] = (bf16)hi; WL[e * RW_LD + c] = (bf16)lo; }
    if (tid < NE) lcount[tid] = 0;
    LAS float* nt = (LAS float*)(F.lds + TAB_OFF + 4096);
    const int br0 = tok0 < TX ? tok0 / SEQ : NB, br1 = tok1 > tok0 ? (tok1 - 1 < TX ? (tok1 - 1) / SEQ : NB) : br0;
    for (int i = tid; i < 2 * DM; i += NTHREADS) { const int t = i >> 10, c = i & (DM - 1); const float* md = F.mod + ((size_t)l * 9 + (t ? br1 : br0)) * 6 * DM;
        nt[t * 2 * DM + c] = F.norm2_g[(size_t)l * DM + c] * (md[4 * DM + c] + 1.f); nt[t * 2 * DM + DM + c] = md[3 * DM + c]; }
    __syncthreads();
    const int ntile = tok1 > tok0 ? (tok1 - tok0 + 15) >> 4 : 0;
    const float rb0 = F.router_b[(size_t)l * NE + q], rb1 = F.router_b[(size_t)l * NE + 16 + q];
    for (int tile = F.wave; tile < ntile; tile += NWAVES) {
        const int tbase = tok0 + 16 * tile, t = tbase + q, tq = t < tok1 ? t : tok1 - 1; const bool valid = t < tok1;
        const bf16* xr = F.X + (size_t)tq * DM + 8 * g;
        float ss = 0.f;
#pragma unroll 8
        for (int s = 0; s < 32; ++s) { const u32x4 xw = *(const u32x4*)(xr + 32 * s); const f32x4 a = (f32x4){bflo(xw.x), bfhi(xw.x), bflo(xw.y), bfhi(xw.y)}, b = (f32x4){bflo(xw.z), bfhi(xw.z), bflo(xw.w), bfhi(xw.w)}; ss += (a.x * a.x + a.y * a.y) + (a.z * a.z + a.w * a.w) + (b.x * b.x + b.y * b.y) + (b.z * b.z + b.w * b.w); }
        { const auto r = __builtin_amdgcn_permlane16_swap(__float_as_uint(ss), __float_as_uint(ss), false, false); ss = __uint_as_float(r[0]) + __uint_as_float(r[1]);
          const auto t = __builtin_amdgcn_permlane32_swap(__float_as_uint(ss), __float_as_uint(ss), false, false); ss = __uint_as_float(t[0]) + __uint_as_float(t[1]); }
        const float rinv = 1.f / sqrtf(ss * (1.f / DM) + EPS);
        const int br = tq < TX ? tq / SEQ : NB;
        const LAS float* ntl = nt + (br == br0 ? 0 : 2 * DM) + 8 * g;
        unsigned char* hrow = MOE_FP8 ? F.H8 + (size_t)tq * DM + 8 * g : (unsigned char*)(F.H + (size_t)tq * DM + 8 * g);
        f32x4 acc[2]; acc[0] = (f32x4){0.f, 0.f, 0.f, 0.f}; acc[1] = acc[0];
#pragma unroll 8
        for (int s = 0; s < 32; ++s) { const int c = 32 * s;
            const u32x4 xw = *(const u32x4*)(xr + c); const f32x4 xa = (f32x4){bflo(xw.x), bfhi(xw.x), bflo(xw.y), bfhi(xw.y)}, xb = (f32x4){bflo(xw.z), bfhi(xw.z), bflo(xw.w), bfhi(xw.w)};
            const f32x4 ga = *(const LAS f32x4*)(ntl + c), gb = *(const LAS f32x4*)(ntl + c + 4), sa = *(const LAS f32x4*)(ntl + DM + c), sb = *(const LAS f32x4*)(ntl + DM + c + 4);
            const f32x4 ha = (xa * rinv) * ga + sa, hb = (xb * rinv) * gb + sb;
            u32x4 hw; hw.x = cvt_pk_bf16(ha.x, ha.y); hw.y = cvt_pk_bf16(ha.z, ha.w); hw.z = cvt_pk_bf16(hb.x, hb.y); hw.w = cvt_pk_bf16(hb.z, hb.w);
            u32x4 lw; lw.x = cvt_pk_bf16(ha.x - bflo(hw.x), ha.y - bfhi(hw.x)); lw.y = cvt_pk_bf16(ha.z - bflo(hw.y), ha.w - bfhi(hw.y));
            lw.z = cvt_pk_bf16(hb.x - bflo(hw.z), hb.y - bfhi(hw.z)); lw.w = cvt_pk_bf16(hb.z - bflo(hw.w), hb.w - bfhi(hw.w));
            if (valid) { if (MOE_FP8) { u32x2 h8; h8.x = pk4_fp8(ha.x, ha.y, ha.z, ha.w); h8.y = pk4_fp8(hb.x, hb.y, hb.z, hb.w); *(u32x2*)(hrow + c) = h8; } else *(u32x4*)(hrow + 2 * c) = hw; }
            const bf16x8 ah = __builtin_bit_cast(bf16x8, hw), al = __builtin_bit_cast(bf16x8, lw);
#pragma unroll
            for (int tt = 0; tt < 2; ++tt) { const bf16x8 bh = *(const LAS bf16x8*)(WH + (16 * tt + q) * RW_LD + c + 8 * g), bl = *(const LAS bf16x8*)(WL + (16 * tt + q) * RW_LD + c + 8 * g);
                acc[tt] = __builtin_amdgcn_mfma_f32_16x16x32_bf16(ah, bh, acc[tt], 0, 0, 0);
                acc[tt] = __builtin_amdgcn_mfma_f32_16x16x32_bf16(ah, bl, acc[tt], 0, 0, 0);
                acc[tt] = __builtin_amdgcn_mfma_f32_16x16x32_bf16(al, bh, acc[tt], 0, 0, 0); } }
        unsigned k0[4], k1[4], win[4][4];
#pragma unroll
        for (int rg = 0; rg < 4; ++rg) { k0[rg] = f2key(acc[0][rg] + rb0, q); k1[rg] = f2key(acc[1][rg] + rb1, 16 + q); }
#pragma unroll
        for (int k = 0; k < 4; ++k)
#pragma unroll
            for (int rg = 0; rg < 4; ++rg) { const unsigned m = row16_umax(k0[rg] > k1[rg] ? k0[rg] : k1[rg]);
                win[rg][k] = m; if (k0[rg] == m) k0[rg] = 0u; if (k1[rg] == m) k1[rg] = 0u; }
        { const int rsel = q >> 2, ksel = q & 3;
          unsigned w4[4];
#pragma unroll
          for (int k = 0; k < 4; ++k) w4[k] = rsel == 0 ? win[0][k] : rsel == 1 ? win[1][k] : rsel == 2 ? win[2][k] : win[3][k];
          const float v0 = key2f(w4[0]), e1 = __expf(key2f(w4[1]) - v0), e2 = __expf(key2f(w4[2]) - v0), e3 = __expf(key2f(w4[3]) - v0);
          const float inv = 1.f / (1.f + e1 + e2 + e3);
          const float gt = (ksel == 0 ? 1.f : ksel == 1 ? e1 : ksel == 2 ? e2 : e3) * inv;
          const unsigned wk = ksel == 0 ? w4[0] : ksel == 1 ? w4[1] : ksel == 2 ? w4[2] : w4[3];
          const int e = 31 - (int)(wk & 31u), tt2 = tbase + 4 * g + rsel;
          if (tt2 < tok1 && !dry) { F.GATE[(size_t)tt2 * 4 + ksel] = gt;
              const int pos = __hip_atomic_fetch_add(lcount + e, 1, __ATOMIC_RELAXED, __HIP_MEMORY_SCOPE_WORKGROUP);
              apos[(tt2 - tok0) * 4 + ksel] = (e << 16) | pos; } }
    }
    __syncthreads();
    if (dry) return;
    if (tid < NE) lbase[tid] = (int)__hip_atomic_fetch_add(F.ctl + CW_CNT + (l * NE + tid) * 64, (unsigned)__hip_atomic_load(lcount + tid, __ATOMIC_RELAXED, __HIP_MEMORY_SCOPE_WORKGROUP), __ATOMIC_RELAXED, __HIP_MEMORY_SCOPE_AGENT);
    __syncthreads();
    const int nas = (tok1 > tok0 ? (tok1 - tok0) : 0) * 4;
    for (int i = tid; i < nas; i += NTHREADS) { const int w = apos[i], e = w >> 16, pos = w & 0xffff; F.LIST[(size_t)e * TT + lbase[e] + pos] = tok0 * 4 + i; }
    __syncthreads();
}
__device__ __forceinline__ void moe_tables(Frame& F, int l, int npn) {
    volatile LAS int* tp = (volatile LAS int*)(F.MISC + 16);
    LAS int* tab = (LAS int*)(F.lds + TAB_OFF);
    const int tid = F.tid;
    volatile LAS int* eb = (volatile LAS int*)(F.MISC + 128);
    volatile LAS int* cntl = (volatile LAS int*)(F.MISC + 168);
    if (tid == 0) { int acc = 0, sb = 0;
        for (int e = 0; e < NE; ++e) { tp[e] = acc; eb[e] = sb; const int cnt = (int)__hip_atomic_load(F.ctl + CW_CNT + (l * NE + e) * 64, __ATOMIC_RELAXED, __HIP_MEMORY_SCOPE_AGENT); cntl[e] = cnt; acc += (cnt + 255) >> 8; sb += cnt; }
        tp[NE] = acc; }
    __syncthreads();
    if (npn != 8) return;
#pragma unroll 1
    for (int i2 = 0; i2 < MAXU; i2 += 2) {
        const int i = i2 + (tid >> 8), rr = tid & 255;
        g8::Unit u;
        if (i < MAXU && g8::moe_unit((long)i * F.G + F.vcu, npn, tp, u)) {
            const int cnt = (int)__hip_atomic_load(F.ctl + CW_CNT + (l * NE + u.e) * 64, __ATOMIC_RELAXED, __HIP_MEMORY_SCOPE_AGENT);
            const int idx = u.pm * 256 + rr;
            const int a = idx < cnt ? F.LIST[(size_t)u.e * TT + idx] : -1;
            tab[i * 256 + rr] = a;
            if (u.pn == 0 && a >= 0) { F.INV[a] = eb[u.e] + idx; F.GATES[eb[u.e] + idx] = F.GATE[a]; }
        }
    }
    __syncthreads();
}

__global__ void __launch_bounds__(NTHREADS, 2) mk_fwd(Args args) {
    extern __shared__ __attribute__((aligned(16))) unsigned char lds_raw[];
    Frame F;
    F.lds = (LAS unsigned char*)lds_raw;
    F.MISC = (volatile LAS unsigned*)(F.lds + MISC_OFF);
    F.tid = threadIdx.x; F.lane = F.tid & 63; F.wave = __builtin_amdgcn_readfirstlane(F.tid >> 6);
    F.G = gridDim.x; { const int bx = blockIdx.x; F.vcu = (F.G % 8 == 0) ? (bx % 8) * (F.G / 8) + bx / 8 : bx; }
    frame_ptrs(F);
    for (int u = F.tid; u < 256; u += NTHREADS) F.MISC[u] = 0u;
    __syncthreads();
    const int lo = args.ph_lo, hi = args.ph_hi;
    const bool one_launch = (hi - lo) > 1;
    XcdBarrier bar; bar.bar = F.ctl + CW_BAR; bar.x = 0; bar.st = nullptr;
    if (one_launch) bar = xcd_barrier_post(F.ctl + CW_BAR, F.MISC);
#ifndef PHMASK
#define PHMASK 0xFFFFFFFF
#endif
#define IN(k) (lo <= (k) && (k) < hi)
#define PHON(b) ((PHMASK >> (b)) & 1)
#define STAGGER() do { if (STAG_TICKS > 0 && (blockIdx.x & 8)) { const unsigned long long t0_ = __builtin_amdgcn_s_memrealtime(); while (__builtin_amdgcn_s_memrealtime() - t0_ < (unsigned long long)STAG_TICKS) __builtin_amdgcn_s_sleep(8); } } while (0)
#define REFRESH() do { int tz_ = threadIdx.x; asm volatile("" : "+v"(tz_)); F.tid = tz_; F.lane = tz_ & 63; frame_ptrs(F); } while (0)
#define SEAM(k) do { if (IN(k) && IN((k) + 1)) xcd_barrier(bar); } while (0)

    if (PHON(0) && IN(0)) { for (int rep = 0; rep < REPS(0); ++rep) { REFRESH(); ph_prologue(F); } } SEAM(0);
    if (PHON(1) && IN(1)) { REFRESH(); ph_first_norm(F); } SEAM(1);
    for (int l = 0; l < DEPTH; ++l) {
        const int pb = 2 + PPL * l;
        const bool lastl = (l == DEPTH - 1);
        if (PHON(2) && IN(pb + 0)) for (int rep = 0; rep < REPS(2); ++rep) {
            REFRESH(); STAGGER();
            g8::ProbIn Pb{(const char*)F.H, (const char*)(F.Bin + (size_t)l * NP * DM), F.P, F.VTA, F.G, (int)blockIdx.x, (rep + 1 < REPS(2)) ? 1 : 0};
            g8::gemm_phase(F.lds, Pb);
        }
        SEAM(pb + 0);
        if (PHON(3) && IN(pb + 1)) { for (int rep = 0; rep < REPS(3); ++rep) { REFRESH(); ph_prep(F, l); } } SEAM(pb + 1);
        if (PHON(4) && IN(pb + 2)) { for (int rep = 0; rep < REPS(4); ++rep) { REFRESH(); ph_attn(F, l); } } SEAM(pb + 2);
        if (PHON(10) && IN(pb + 3)) { for (int rep = 0; rep < REPS(10); ++rep) { REFRESH(); ph_gla3(F, l); } } SEAM(pb + 3);
        const bool split = !lastl && F.G == 256;
        const int cidx = (split && (F.vcu & 7) == 0) ? (F.vcu >> 3) : -1;
#pragma unroll 1
        for (int k = 4; k <= 5; ++k) {
            if (PHON(5) && IN(pb + k) && (k == 4 || cidx >= 0)) for (int rep = 0; rep < (k == 4 ? REPS(5) : 1); ++rep) {
                REFRESH(); STAGGER();
                g8::ProbOut Pb{(const char*)F.MIX, (const char*)(F.Bout + (size_t)l * DM * DM), (rep + 1 < REPS(5) && k == 4) ? (bf16*)F.ACT : F.X, F.mod + (size_t)l * 9 * 6 * DM, F.G, (int)blockIdx.x,
                               ((lastl || split) ? TX : TT) / 256, k == 5 ? TX / 256 + (cidx >> 2) : -1, cidx & 3};
                g8::gemm_phase(F.lds, Pb);
            }
            if (k == 4) SEAM(pb + 4);
        }
        if (PHON(6) && IN(pb + 5)) {
            int tok0, tok1;
            if (split) {
                if (cidx >= 0) { tok0 = TX + 256 * (cidx >> 2) + 64 * (cidx & 3); tok1 = tok0 + 64;
                    asm volatile("s_waitcnt vmcnt(0)" ::: "memory");
                    __syncthreads();
                    if (threadIdx.x == 0) { unsigned* fl = F.ctl + CW_CTXF + (l * 8 + (cidx >> 2)) * 64;
                        __builtin_amdgcn_fence(__ATOMIC_RELEASE, "agent");
                        (void)xb_add(fl, 1u);
                        XB_SPIN(xb_ld(fl) < 4u, F.ctl + CW_BAR);
                        __builtin_amdgcn_fence(__ATOMIC_ACQUIRE, "agent"); }
                    __syncthreads(); }
                else { const int r = F.vcu - (F.vcu >> 3) - 1, per = (TX + 223) / 224; tok0 = r * per; tok1 = tok0 + per < TX ? tok0 + per : TX; if (tok0 > TX) tok0 = TX; }
            } else { const int M = lastl ? TX : TT, per = (M + F.G - 1) / F.G; tok0 = F.vcu * per; tok1 = tok0 + per < M ? tok0 + per : M; if (tok0 > M) tok0 = M; }
            for (int rep = 0; rep < REPS(6); ++rep) { REFRESH(); ph_router(F, l, tok0, tok1, rep + 1 < REPS(6)); __syncthreads(); } }
        SEAM(pb + 5);
        if (PHON(7) && IN(pb + 6)) for (int rep = 0; rep < REPS(7); ++rep) {
            REFRESH(); moe_tables(F, l, 8); STAGGER();
            g8::ProbGU Pb{MOE_FP8 ? (const char*)F.H8 : (const char*)F.H, (const char*)F.Bgu + (size_t)l * NE * 2 * DM * DM * (MOE_FP8 ? 1 : 2), (unsigned char*)F.ACT, F.b_gu + (size_t)l * NE * 2 * DM, (volatile LAS int*)(F.MISC + 16), (const LAS int*)(F.lds + TAB_OFF), F.G, F.vcu, (rep + 1 < REPS(7)) ? 1 : 0, (volatile LAS int*)(F.MISC + 128)};
            g8::gemm_phase(F.lds, Pb);
        }
        SEAM(pb + 6);
        if (PHON(8) && IN(pb + 7)) for (int rep = 0; rep < REPS(8); ++rep) {
            REFRESH(); moe_tables(F, l, 4); STAGGER();
            g8::ProbDN Pb{(const char*)F.ACT, (const char*)F.Bdn + (size_t)l * NE * DM * DM * (MOE_FP8 ? 1 : 2), F.YB, F.b_down + (size_t)l * NE * DM, F.GATES, (volatile LAS int*)(F.MISC + 16), F.G, F.vcu, (rep + 1 < REPS(8)) ? 1 : 0, (volatile LAS int*)(F.MISC + 128), (volatile LAS int*)(F.MISC + 168)};
            g8::gemm_phase(F.lds, Pb);
        }
        SEAM(pb + 7);
        if (PHON(9) && IN(pb + 8)) { for (int rep = 0; rep < REPS(9); ++rep) { REFRESH(); ph_combine(F, l, rep + 1 < REPS(9)); } }
        if (!lastl) SEAM(pb + 8);
    }
#undef IN
#undef SEAM
}

extern "C" void kernel_launch(void* const* d_in, const int* in_sizes, int n_in, void* d_out, int out_size, void* d_ws, size_t ws_size, hipStream_t stream) {
    static int grid = 0;
    if (grid == 0) {
        if (n_in != 23 || in_sizes[0] != TX * DM || out_size != TX * DM || ws_size < WS_END) {
            fprintf(stderr, "kernel_launch: unexpected problem (n_in %d, in0 %d, out %d, ws %zu; need ws >= %zu); nothing launched\n", n_in, n_in > 0 ? in_sizes[0] : -1, out_size, ws_size, (size_t)WS_END); grid = -1; return; }
        int dev = 0, cus = 0, per_cu = 0;
        if (hipGetDevice(&dev) != hipSuccess || hipDeviceGetAttribute(&cus, hipDeviceAttributeMultiprocessorCount, dev) != hipSuccess) { fprintf(stderr, "kernel_launch: device query failed\n"); grid = -1; return; }
        if (hipFuncSetAttribute((const void*)mk_fwd, hipFuncAttributeMaxDynamicSharedMemorySize, LDS_BYTES) != hipSuccess) { fprintf(stderr, "kernel_launch: hipFuncSetAttribute failed\n"); grid = -1; return; }
        if (hipOccupancyMaxActiveBlocksPerMultiprocessor(&per_cu, (const void*)mk_fwd, NTHREADS, LDS_BYTES) != hipSuccess || per_cu < 1)
            fprintf(stderr, "kernel_launch: note: occupancy query reports %d workgroups per CU\n", per_cu);
        (void)hipGetLastError();
        grid = cus;
        if ((long)grid * MAXU < (long)(NASG / 256 + NE) * 8) { fprintf(stderr, "kernel_launch: grid %d too small for the MoE unit tables\n", grid); grid = -1; return; }
    }
    if (grid < 0) return;
    if (hipMemsetAsync((char*)d_ws + WS_CTL, 0, CTL_ZERO_BYTES, stream) != hipSuccess) { fprintf(stderr, "kernel_launch: memset failed\n"); return; }
    Args a{};
    for (int i = 0; i < 23; ++i) a.in[i] = (const float*)d_in[i];
    a.out = (float*)d_out; a.ws = (unsigned char*)d_ws;
#if MK_N_LAUNCHES == 1
    a.ph_lo = 0; a.ph_hi = NPHASES;
    hipLaunchKernelGGL(mk_fwd, dim3(grid), dim3(NTHREADS), LDS_BYTES, stream, a);
#else
    for (int p = 0; p < NPHASES; ++p) { a.ph_lo = p; a.ph_hi = p + 1; hipLaunchKernelGGL(mk_fwd, dim3(grid), dim3(NTHREADS), LDS_BYTES, stream, a); }
#endif
    const hipError_t le = hipPeekAtLastError();
    if (le != hipSuccess) fprintf(stderr, "kernel_launch: launch failed: %s\n", hipGetErrorName(le));
}
```
